# Optimizing an MI355X kernel written in HIP

```python
import math
import jax
import jax.numpy as jnp
from jax import lax
import numpy as np

D_MODEL = 1024
BATCH = 2
SEQ = 8192
DEPTH = 4

MIX_W = 256
N_BRANCH = 4
GM_CHUNK = 128
GM_GROUPS = 4
GM_GD = MIX_W // GM_GROUPS
ATT_HEADS = 4
ATT_HD = MIX_W // ATT_HEADS
DIL_PATTERNS = ((128, 1), (512, 4), (2048, 16))
ATT_BLOCK = 64
REL_BUCKETS = 32
REL_MAX_DIST = 1024
ML_HEADS = 4
ML_HD = MIX_W // ML_HEADS
ML_CHUNK = 64
ML_CONV = 3
POOL_WINDOWS = (2, 4, 8, 16)
POOL_GD = MIX_W // len(POOL_WINDOWS)
N_EXPERTS = 16
EXPERT_FF = 1024
EC_FACTOR = 2
DEEPNORM_ALPHA = (2 * DEPTH) ** 0.25
DEEPNORM_BETA = (8 * DEPTH) ** -0.25
LN_EPS = 1e-5
IN_SIZES = (MIX_W, MIX_W,
            3 * MIX_W,
            4 * MIX_W,
            2 * ML_HEADS, 2 * ML_HEADS,
            MIX_W,
            N_BRANCH * D_MODEL)
N_IN = 10 * MIX_W + 4 * ML_HEADS + N_BRANCH * D_MODEL

kernel_name = 'hybrid_gated_mixers_ec_moe_encoder'


def _standardize(x):
    xf = x.astype(jnp.float32)
    mu = jnp.mean(xf, axis=-1, keepdims=True)
    var = jnp.mean(jnp.square(xf - mu), axis=-1, keepdims=True)
    return (xf - mu) * lax.rsqrt(var + LN_EPS)


def layer_norm(x, g, b):
    return (_standardize(x) * g + b).astype(x.dtype)


def gmlp_spatial_gate(u, v, ln_g, ws, bs):
    B, S, _ = u.shape
    vn = (_standardize(v) * ln_g).astype(v.dtype)
    vc = vn.reshape(B, S // GM_CHUNK, GM_CHUNK, GM_GROUPS, GM_GD)
    mixed = jnp.einsum('gpq,bcqgd->bcpgd', ws, vc) + jnp.transpose(bs)[None, None, :, :, None]
    return u * mixed.reshape(B, S, MIX_W)


def t5_bucket(rel):
    half = REL_BUCKETS // 2
    max_exact = half // 2
    ret = jnp.where(rel > 0, half, 0)
    n = jnp.abs(rel)
    nf = jnp.maximum(n, 1).astype(jnp.float32)
    large = max_exact + (jnp.log(nf / max_exact) / math.log(REL_MAX_DIST / max_exact)
                         * (half - max_exact)).astype(jnp.int32)
    large = jnp.minimum(large, half - 1)
    return ret + jnp.where(n < max_exact, n, large)


def dilated_window_attention(q, k, v, rel_bias, window, dil):
    B, S, H, Dh = q.shape
    side = (window // 2) // dil
    L = S // dil
    nb = -(-L // ATT_BLOCK)
    Lp = nb * ATT_BLOCK

    def to_blocks(t):
        t = t.reshape(B, L, dil, H, Dh).transpose(0, 2, 3, 1, 4)
        t = jnp.pad(t, ((0, 0), (0, 0), (0, 0), (0, Lp - L), (0, 0)))
        return t.reshape(B, dil, H, nb, ATT_BLOCK, Dh)

    def band(t):
        tp = jnp.pad(t, ((0, 0), (0, 0), (0, 0), (1, 1), (0, 0), (0, 0)))
        return jnp.concatenate([tp[:, :, :, :-2], tp[:, :, :, 1:-1], tp[:, :, :, 2:]], axis=4)

    qb = to_blocks(q)
    kw = band(to_blocks(k))
    vw = band(to_blocks(v))
    rel_local = jnp.arange(3 * ATT_BLOCK)[None, :] - ATT_BLOCK - jnp.arange(ATT_BLOCK)[:, None]
    bias = jnp.transpose(rel_bias[t5_bucket(dil * rel_local)], (2, 0, 1))
    kpos = (jnp.arange(nb)[:, None] - 1) * ATT_BLOCK + jnp.arange(3 * ATT_BLOCK)[None, :]
    valid = (jnp.abs(rel_local) <= side)[None] & ((kpos >= 0) & (kpos < L))[:, None, :]
    logits = (jnp.einsum('brhnqd,brhnkd->brhnqk', qb, kw).astype(jnp.float32) * ATT_HD ** -0.5
              + bias[:, None].astype(jnp.float32))
    logits = jnp.where(valid, logits, -1e30)
    lse = jax.nn.logsumexp(logits, axis=-1)
    p = jnp.exp(logits - lse[..., None])
    o = jnp.einsum('brhnqk,brhnkd->brhnqd', p.astype(v.dtype), vw)
    o = o.reshape(B, dil, H, Lp, Dh)[:, :, :, :L].transpose(0, 3, 1, 2, 4).reshape(B, S, H, Dh)
    lse = lse.reshape(B, dil, H, Lp)[..., :L].transpose(0, 3, 1, 2).reshape(B, S, H)
    return o, lse


def dilated_mixture_attention(q, k, v, rel_bias):
    outs, lses = [], []
    for window, dil in DIL_PATTERNS:
        o, l = dilated_window_attention(q, k, v, rel_bias, window, dil)
        outs.append(o)
        lses.append(l)
    wts = jax.nn.softmax(jnp.stack(lses, axis=0), axis=0)
    return jnp.einsum('pbsh,pbshd->bshd', wts.astype(q.dtype), jnp.stack(outs, axis=0))


def depthwise_conv(x, w):
    K, C = w.shape
    pad = K // 2
    return lax.conv_general_dilated(x, w[:, None, :], window_strides=(1,),
                                    padding=[(pad, K - 1 - pad)],
                                    dimension_numbers=('NWC', 'WIO', 'NWC'),
                                    feature_group_count=C)


def mlstm_scan(q, k, v, li, lf):
    B, H, S, Dh = q.shape
    nc = S // ML_CHUNK

    def chunks(t):
        return jnp.moveaxis(t.reshape(B, H, nc, ML_CHUNK, *t.shape[3:]), 2, 0)

    tri = jnp.tril(jnp.ones((ML_CHUNK, ML_CHUNK), dtype=bool))

    def step(carry, inp):
        C, n, m = carry
        qc, kc, vc, lic, lfc = inp
        b = jnp.cumsum(lfc, axis=-1)
        D = jnp.where(tri, b[..., :, None] - b[..., None, :] + lic[..., None, :], -jnp.inf)
        m_inter = b + m[..., None]
        m_t = jnp.maximum(jnp.max(D, axis=-1), m_inter)
        inter_w = jnp.exp(m_inter - m_t)
        s = jnp.einsum('bhtd,bhsd->bhts', qc, kc) * jnp.exp(D - m_t[..., None])
        num = (jnp.einsum('bhts,bhsd->bhtd', s, vc)
               + inter_w[..., None] * jnp.einsum('bhvk,bhtk->bhtv', C, qc))
        den = jnp.sum(s, axis=-1) + inter_w * jnp.einsum('bhk,bhtk->bht', n, qc)
        h = num / jnp.maximum(jnp.abs(den), jnp.exp(-m_t))[..., None]
        g = b[..., -1]
        w_s = g[..., None] - b + lic
        m_new = jnp.maximum(g + m, jnp.max(w_s, axis=-1))
        decay = jnp.exp(g + m - m_new)
        ws = jnp.exp(w_s - m_new[..., None])
        C = decay[..., None, None] * C + jnp.einsum('bhs,bhsv,bhsk->bhvk', ws, vc, kc)
        n = decay[..., None] * n + jnp.einsum('bhs,bhsk->bhk', ws, kc)
        return (C, n, m_new), h

    init = (jnp.zeros((B, H, Dh, Dh), jnp.float32), jnp.zeros((B, H, Dh), jnp.float32),
            jnp.zeros((B, H), jnp.float32))
    _, hs = lax.scan(step, init, (chunks(q), chunks(k), chunks(v), chunks(li), chunks(lf)))
    return jnp.moveaxis(hs, 0, 2).reshape(B, H, S, Dh)


def bidirectional_mlstm(q, k, v, li, lf):
    flip = lambda t: jnp.flip(t, axis=2)
    fwd = mlstm_scan(q, k, v, li[0], lf[0])
    bwd = flip(mlstm_scan(flip(q), flip(k), flip(v), flip(li[1]), flip(lf[1])))
    return fwd + bwd


def head_norm(h, g):
    B, H, S, Dh = h.shape
    mu = jnp.mean(h, axis=-1, keepdims=True)
    var = jnp.mean(jnp.square(h - mu), axis=-1, keepdims=True)
    hn = (h - mu) * lax.rsqrt(var + LN_EPS)
    return hn.transpose(0, 2, 1, 3).reshape(B, S, H * Dh) * g


def pool_mixer(xd, pool_w, pool_scale):
    B, S, _ = xd.shape
    xg = xd.reshape(B, S, len(POOL_WINDOWS), POOL_GD).astype(jnp.float32)
    cs = jnp.pad(jnp.cumsum(xg, axis=1), ((0, 0), (1, 0), (0, 0), (0, 0)))
    pos = jnp.arange(S)
    outs = []
    for gi, win in enumerate(POOL_WINDOWS):
        lo = jnp.clip(pos - win // 2, 0, S)
        hi = jnp.clip(pos + win // 2, 0, S)
        cg = cs[:, :, gi]
        mean = (cg[:, hi] - cg[:, lo]) / (hi - lo).astype(jnp.float32)[None, :, None]
        outs.append(mean - xg[:, :, gi])
    pooled = jnp.stack(outs, axis=2).astype(xd.dtype)
    mixed = jnp.einsum('bsgi,gio->bsgo', pooled, pool_w)
    return mixed.reshape(B, S, MIX_W) * pool_scale


def mixer_sublayer(x, w_in, b_in, gm_ln_g, gm_ws, gm_bs, rel_bias, ml_conv, ml_fbias,
                   ml_norm_g, pool_w, pool_scale, w_branch, w_out):
    B, S, _ = x.shape
    h = jnp.einsum('bsd,dn->bsn', x, w_in) + b_in
    split_points = np.cumsum(IN_SIZES)[:-1].tolist()
    a_u, a_v, b_qkv, c_qkvo, c_ig, c_fg, d_x, gate_raw = jnp.split(h, split_points, axis=-1)

    y_a = gmlp_spatial_gate(jax.nn.gelu(a_u), jax.nn.gelu(a_v), gm_ln_g, gm_ws, gm_bs)

    qkv = b_qkv.reshape(B, S, 3, ATT_HEADS, ATT_HD)
    y_b = dilated_mixture_attention(qkv[:, :, 0], qkv[:, :, 1], qkv[:, :, 2], rel_bias)
    y_b = y_b.reshape(B, S, MIX_W)

    c_qk = jax.nn.silu(depthwise_conv(c_qkvo[..., :2 * MIX_W], ml_conv))
    heads = lambda t: t.reshape(B, S, ML_HEADS, ML_HD).transpose(0, 2, 1, 3).astype(jnp.float32)
    c_q = heads(c_qk[..., :MIX_W])
    c_k = heads(c_qk[..., MIX_W:]) * ML_HD ** -0.5
    c_v = heads(c_qkvo[..., 2 * MIX_W:3 * MIX_W])
    c_o = c_qkvo[..., 3 * MIX_W:]
    li = c_ig.reshape(B, S, 2, ML_HEADS).astype(jnp.float32).transpose(2, 0, 3, 1)
    lf = jax.nn.log_sigmoid(c_fg.reshape(B, S, 2, ML_HEADS).astype(jnp.float32)
                            + ml_fbias).transpose(2, 0, 3, 1)
    y_c = head_norm(bidirectional_mlstm(c_q, c_k, c_v, li, lf), ml_norm_g)
    y_c = (jax.nn.sigmoid(c_o.astype(jnp.float32)) * y_c).astype(x.dtype)

    y_d = pool_mixer(d_x, pool_w, pool_scale)

    ys = jnp.stack([y_a, y_b.astype(x.dtype), y_c, y_d.astype(x.dtype)], axis=2)
    proj = jnp.einsum('bsnc,ncd->bsnd', ys, w_branch)
    gates = jax.nn.sigmoid(gate_raw.reshape(B, S, N_BRANCH, D_MODEL))
    merged = jnp.einsum('bsnd,bsnd->bsd', gates, proj)
    return jnp.einsum('bsd,de->bse', merged, w_out)


def expert_choice_ffn(x, w_router, w1, w3, w2):
    B, T, D = x.shape
    cap = EC_FACTOR * T // N_EXPERTS
    aff = jax.nn.softmax(jnp.einsum('btd,de->bte', x, w_router).astype(jnp.float32), axis=-1)
    gate, idx = lax.top_k(jnp.swapaxes(aff, 1, 2), cap)
    xs = jax.vmap(lambda xb, ib: xb[ib])(x, idx)
    hid = jax.nn.silu(jnp.einsum('becd,edf->becf', xs, w1)) * jnp.einsum('becd,edf->becf', xs, w3)
    ye = jnp.einsum('becf,efd->becd', hid, w2) * gate[..., None].astype(x.dtype)
    scatter = lambda yb, ib: jnp.zeros((T, D), yb.dtype).at[ib.reshape(-1)].add(yb.reshape(-1, D))
    return jax.vmap(scatter)(ye, idx)


def setup_inputs(seed: int = 0) -> dict:
    key = jax.random.key(seed)
    ks = jax.random.split(key, 24)
    nrm = lambda k, shape, scale: jax.random.normal(k, shape, jnp.float32) * scale
    L = DEPTH
    return {
        'x': nrm(ks[0], (BATCH, SEQ, D_MODEL), 1.0),
        'w_in': nrm(ks[1], (L, D_MODEL, N_IN), D_MODEL ** -0.5),
        'b_in': nrm(ks[2], (L, N_IN), 0.02),
        'gm_ln_g': 1.0 + nrm(ks[3], (L, MIX_W), 0.02),
        'gm_ws': nrm(ks[4], (L, GM_GROUPS, GM_CHUNK, GM_CHUNK), GM_CHUNK ** -0.5),
        'gm_bs': 1.0 + nrm(ks[5], (L, GM_GROUPS, GM_CHUNK), 0.02),
        'rel_bias': nrm(ks[6], (REL_BUCKETS, ATT_HEADS), 0.3),
        'ml_conv': nrm(ks[7], (L, ML_CONV, 2 * MIX_W), ML_CONV ** -0.5),
        'ml_fbias': jnp.linspace(3.0, 6.0, ML_HEADS, dtype=jnp.float32) + nrm(ks[8], (L, 2, ML_HEADS), 0.1),
        'ml_norm_g': 1.0 + nrm(ks[9], (L, MIX_W), 0.02),
        'pool_w': nrm(ks[10], (L, len(POOL_WINDOWS), POOL_GD, POOL_GD), POOL_GD ** -0.5),
        'pool_scale': 1.0 + nrm(ks[11], (L, MIX_W), 0.02),
        'w_branch': nrm(ks[12], (L, N_BRANCH, MIX_W, D_MODEL), MIX_W ** -0.5),
        'w_out': nrm(ks[13], (L, D_MODEL, D_MODEL), D_MODEL ** -0.5 * DEEPNORM_BETA),
        'ln1_g': 1.0 + nrm(ks[14], (L, D_MODEL), 0.02),
        'ln1_b': nrm(ks[15], (L, D_MODEL), 0.02),
        'w_router': nrm(ks[16], (L, D_MODEL, N_EXPERTS), D_MODEL ** -0.5),
        'w_e1': nrm(ks[17], (L, N_EXPERTS, D_MODEL, EXPERT_FF), D_MODEL ** -0.5),
        'w_e3': nrm(ks[18], (L, N_EXPERTS, D_MODEL, EXPERT_FF), D_MODEL ** -0.5),
        'w_e2': nrm(ks[19], (L, N_EXPERTS, EXPERT_FF, D_MODEL), EXPERT_FF ** -0.5 * DEEPNORM_BETA),
        'ln2_g': 1.0 + nrm(ks[20], (L, D_MODEL), 0.02),
        'ln2_b': nrm(ks[21], (L, D_MODEL), 0.02),
    }


def reference(x, w_in, b_in, gm_ln_g, gm_ws, gm_bs, rel_bias, ml_conv, ml_fbias, ml_norm_g,
              pool_w, pool_scale, w_branch, w_out, ln1_g, ln1_b, w_router, w_e1, w_e3, w_e2,
              ln2_g, ln2_b):
    for l in range(DEPTH):
        mix = mixer_sublayer(x, w_in[l], b_in[l], gm_ln_g[l], gm_ws[l], gm_bs[l], rel_bias,
                             ml_conv[l], ml_fbias[l], ml_norm_g[l], pool_w[l], pool_scale[l],
                             w_branch[l], w_out[l])
        x = layer_norm(DEEPNORM_ALPHA * x + mix, ln1_g[l], ln1_b[l])
        ffn = expert_choice_ffn(x, w_router[l], w_e1[l], w_e3[l], w_e2[l])
        x = layer_norm(DEEPNORM_ALPHA * x + ffn, ln2_g[l], ln2_b[l])
    return x
```

```cpp
#include <hip/hip_runtime.h>
#include <cstdio>
#include <cstdint>

#ifndef PH_MASK
#define PH_MASK 0xFFFF
#endif
#define PHEN(k) ((PH_MASK >> (k)) & 1)
#ifndef MK_PER_PHASE
#define MK_PER_PHASE 1
#endif

#define GAS __attribute__((address_space(1)))
#define LAS __attribute__((address_space(3)))
typedef unsigned short bf16;
typedef short bf16x8 __attribute__((ext_vector_type(8)));
typedef float f32x4 __attribute__((ext_vector_type(4)));
typedef float f32x2 __attribute__((ext_vector_type(2)));
typedef unsigned u32x4 __attribute__((ext_vector_type(4)));
typedef unsigned u32x2 __attribute__((ext_vector_type(2)));
typedef GAS unsigned gu32;
#define RLX_AGENT __ATOMIC_RELAXED, __HIP_MEMORY_SCOPE_AGENT
#define LDS_WAIT() asm volatile("s_waitcnt lgkmcnt(0)" ::: "memory")
#define VM_WAIT() asm volatile("s_waitcnt vmcnt(0)" ::: "memory")

constexpr int BATCH = 2, SEQ = 8192, D = 1024, T = BATCH * SEQ, DEPTH = 4;
constexpr int NIN = 6672;
constexpr int NH = 6656;
constexpr int NINP = 6912;
constexpr int NE = 16, CAP = 1024, FF = 1024, NSLOT = BATCH * NE * CAP;
constexpr float ALPHA = 1.6817928305074292f;
constexpr float LN_EPS = 1e-5f;
constexpr int HU = 0, HV = 256, HAQ = 512, HAK = 768, HAV = 1024, HCQ = 1280, HCK = 1536, HCV = 1792, HCO = 2048, HDX = 2304, HG = 2560;

constexpr size_t MiB = 1u << 20;
constexpr size_t WS_CTL = 0, CTL_ZERO_BYTES = 64 * 1024;
constexpr size_t WS_BIN = 1 * MiB;
constexpr size_t WS_W = 2 * MiB, LW = 114 * MiB;
constexpr size_t OW_IN = 0, OW_B = 14 * MiB, OW_O = 16 * MiB, OW_13 = 18 * MiB, OW_2 = 82 * MiB;
constexpr size_t WS_XF = 458 * MiB;
constexpr size_t WS_XB = 522 * MiB;
constexpr size_t WS_BIG = 554 * MiB;
constexpr size_t WS_XS = WS_BIG, WS_HID = WS_BIG + 64 * MiB, WS_YE = WS_BIG + 128 * MiB;
constexpr size_t WS_GI = 762 * MiB;
constexpr size_t WS_ATTO = 763 * MiB;
constexpr size_t WS_ATTL = 811 * MiB;
constexpr size_t WS_YS = 812 * MiB;
constexpr size_t WS_MGF = 844 * MiB;
constexpr size_t WS_MGB = 908 * MiB;
constexpr size_t WS_QC = 940 * MiB, WS_KC = 956 * MiB;
constexpr size_t WS_DC = 972 * MiB;
constexpr size_t WS_DG = 1005 * MiB;
constexpr size_t WS_AFF = 1006 * MiB;
constexpr size_t WS_IDX = 1007 * MiB;
constexpr size_t WS_GATE = 1007 * MiB + 512 * 1024;
constexpr size_t WS_SLOT = 1008 * MiB;
constexpr size_t WS_END = 1009 * MiB;

constexpr int CW_BAR = 4096;

constexpr int RING_BYTES = 131072;
constexpr int LDSCTL_OFF = RING_BYTES, MISC_OFF = LDSCTL_OFF + 320;
constexpr int LDS_BYTES = 147456;
constexpr int NWAVES = 8, NTHREADS = 512;

__device__ __forceinline__ float bf2f(unsigned v) { return __uint_as_float(v << 16); }
__device__ __forceinline__ unsigned f2bf(float f) { unsigned u = __float_as_uint(f); return (u + 0x7fffu + ((u >> 16) & 1u)) >> 16; }
__device__ __forceinline__ unsigned pk2(float lo, float hi) { return f2bf(lo) | (f2bf(hi) << 16); }
__device__ __forceinline__ void unpack8(const u32x4 w, float (&o)[8]) {
    o[0] = __uint_as_float(w.x << 16); o[1] = __uint_as_float(w.x & 0xffff0000u);
    o[2] = __uint_as_float(w.y << 16); o[3] = __uint_as_float(w.y & 0xffff0000u);
    o[4] = __uint_as_float(w.z << 16); o[5] = __uint_as_float(w.z & 0xffff0000u);
    o[6] = __uint_as_float(w.w << 16); o[7] = __uint_as_float(w.w & 0xffff0000u);
}
__device__ __forceinline__ float sigmoidf_(float x) { return 1.0f / (1.0f + __expf(-x)); }
__device__ __forceinline__ float siluf_(float x) { return x / (1.0f + __expf(-x)); }
__device__ __forceinline__ float gelu_tanh(float x) { const float u = 1.5957691216057308f * (x + 0.044715f * x * x * x); return x / (1.0f + __expf(-u)); }
__device__ __forceinline__ float logsigmoidf_(float z) { return fminf(z, 0.f) - log1pf(__expf(-fabsf(z))); }
__device__ __forceinline__ float shx(float v, int o, int lane) { return __int_as_float(__builtin_amdgcn_ds_bpermute((lane ^ o) << 2, __float_as_int(v))); }
__device__ __forceinline__ float wave_sum(float v, int lane) {
#pragma unroll
    for (int o = 1; o < 64; o <<= 1) v += shx(v, o, lane);
    return v;
}

#define XB_TMO      128
#define XB_XCNT(j)  (256  + 64 * (j))
#define XB_XSUB(j)  (1280 + 64 * (j))
#define XB_XGEN(j)  (2304 + 64 * (j))
#define XB_TOP      3328
#define XB_TOPGEN   3392
#define XCD_BAR_WORDS 3456
#define XB_SPIN_CAP (1u << 18)
__device__ __forceinline__ unsigned xb_ld(unsigned* p)              { return __hip_atomic_load(p, __ATOMIC_RELAXED, __HIP_MEMORY_SCOPE_AGENT); }
__device__ __forceinline__ unsigned xb_add(unsigned* p, unsigned v) { return __hip_atomic_fetch_add(p, v, __ATOMIC_RELAXED, __HIP_MEMORY_SCOPE_AGENT); }
__device__ __forceinline__ unsigned xb_xcc_id() { return (unsigned)__builtin_amdgcn_s_getreg((3 << 11) | 20) & 0xFu; }
#define XB_SPIN(cond, bar) do { unsigned _sp = 0; while (cond) { __builtin_amdgcn_s_sleep(1); \
    if ((++_sp & 255u) == 0u) { if (xb_ld(&(bar)[XB_TMO])) break; if (_sp > XB_SPIN_CAP) { atomicAdd(&(bar)[XB_TMO], 1u); break; } } } } while (0)
struct XcdBarrier { unsigned* bar; unsigned x; volatile LAS unsigned* st; };
__device__ __forceinline__ XcdBarrier xcd_barrier_post(unsigned* bar, volatile LAS unsigned* st) {
    XcdBarrier b; b.bar = bar; b.x = xb_xcc_id(); b.st = st;
    if (threadIdx.x == 0) (void)xb_add(&bar[XB_XCNT(b.x)], 1u);
    return b;
}
__device__ __forceinline__ void xcd_barrier_complete(unsigned* bar, unsigned x, unsigned& nloc, unsigned& nx) {
    const unsigned G = gridDim.x * gridDim.y * gridDim.z;
    unsigned sum, cnt, mine, sp = 0u;
    for (;;) {
        sum = 0u; cnt = 0u; mine = 0u;
#pragma unroll
        for (unsigned j = 0; j < 16; ++j) { const unsigned c = xb_ld(&bar[XB_XCNT(j)]); sum += c; cnt += (c > 0u) ? 1u : 0u; mine = (j == x) ? c : mine; }
        if (sum == G) break;
        __builtin_amdgcn_s_sleep(1);
        if ((++sp & 255u) == 0u) { if (xb_ld(&bar[XB_TMO])) break; if (sp > XB_SPIN_CAP) { atomicAdd(&bar[XB_TMO], 1u); break; } }
    }
    nloc = mine > 0u ? mine : 1u; nx = cnt > 0u ? cnt : 1u;
}
__device__ __forceinline__ void xcd_barrier(const XcdBarrier& b) {
    asm volatile("s_waitcnt vmcnt(0)" ::: "memory");
    __syncthreads();
    if (threadIdx.x == 0) {
        unsigned* bar = b.bar;
        __builtin_amdgcn_s_waitcnt(0);
        unsigned nloc = b.st[0], nx = b.st[1];
        if (nloc == 0u) { xcd_barrier_complete(bar, b.x, nloc, nx); b.st[0] = nloc; b.st[1] = nx; }
        const unsigned old = xb_add(&bar[XB_XSUB(b.x)], 1u);
        const unsigned gen = old / nloc;
        if (old + 1u == (gen + 1u) * nloc) {
            __builtin_amdgcn_fence(__ATOMIC_RELEASE, "agent");
            asm volatile("s_waitcnt vmcnt(0)" ::: "memory");
            const unsigned og = xb_add(&bar[XB_TOP], 1u);
            const unsigned tg = og / nx;
            if (og + 1u == (tg + 1u) * nx) xb_add(&bar[XB_TOPGEN], 1u);
            else XB_SPIN(xb_ld(&bar[XB_TOPGEN]) == tg, bar);
            __builtin_amdgcn_fence(__ATOMIC_ACQUIRE, "agent");
            xb_add(&bar[XB_XGEN(b.x)], 1u);
            asm volatile("s_waitcnt vmcnt(0)" ::: "memory");
        } else {
            XB_SPIN(xb_ld(&bar[XB_XGEN(b.x)]) == gen, bar);
            __builtin_amdgcn_fence(__ATOMIC_ACQUIRE, "agent");
            asm volatile("s_waitcnt vmcnt(0)" ::: "memory");
        }
    }
    __syncthreads();
}

namespace pg8 {
constexpr int BM = 256, BK = 64, HALF = 128, HTB = HALF * BK * 2, STAGE_BYTES = 8 * HTB, NXCD = 8, WGM = 8;
__host__ __device__ __forceinline__ int lds_byte(int r, int c) { const int st = (r >> 4) * 2 + (c >> 5), rr = r & 15, cc = c & 31, ob = rr * 64 + cc * 2; return st * 1024 + (ob ^ (((ob >> 9) & 1) << 5)); }
__host__ __device__ __forceinline__ void stage_rc(int b, int& R, int& C) { const int st = b / 1024, sb = b % 1024, swz = sb ^ (((sb >> 9) & 1) << 5); R = (st >> 1) * 16 + swz / 64; C = (st & 1) * 32 + (swz % 64) / 2; }
__host__ __device__ __forceinline__ int perm32(int rho) { const int n = rho >> 4, i = rho & 15; return 8 * (i >> 2) + 4 * n + (i & 3); }

struct Unit { int pm, pn, aux; const char* A; const char* B; };
struct GemmP { int K, lda, ldb; };

__device__ __forceinline__ bool tile_of(int i, int G, int c, int nM, int nN, int& pm, int& pn) {
    const int nwg = nM * nN; const int L = i * G + c; if (L >= nwg) return false;
    int wgid = L; { const int q = nwg / NXCD, r = nwg % NXCD, xcd = wgid % NXCD, off = wgid / NXCD; wgid = (xcd < r ? xcd * (q + 1) : r * (q + 1) + (xcd - r) * q) + off; }
    const int nig = WGM * nN, gid = wgid / nig, fm = gid * WGM, gsz = (nM - fm) < WGM ? (nM - fm) : WGM;
    pm = fm + ((wgid % nig) % gsz); pn = (wgid % nig) / gsz; return true;
}

__device__ __forceinline__ unsigned cvt_pk_bf16(float lo, float hi) { unsigned r; asm volatile("v_cvt_pk_bf16_f32 %0, %1, %2" : "=v"(r) : "v"(lo), "v"(hi)); return r; }

template <class Epi, class Sched, bool ALIGN_EPI>
__device__ __forceinline__ void gemm_phase(LAS unsigned char* lds, const int tid, const GemmP g, const Sched& S, const Epi& E) {
    const int wid = __builtin_amdgcn_readfirstlane(tid >> 6), lane = tid & 63, wr = wid >> 2, wc = wid & 3, fr = lane & 15, fq = lane >> 4;
    const int K = g.K, nt = K / BK;
    unsigned voffA[2], voffB[2];
#pragma unroll
    for (int i = 0; i < 2; ++i) { int R, C; stage_rc(tid * 16 + i * 8192, R, C); const int Rb = Epi::PERM ? ((R & ~31) + perm32(R & 31)) : R;
        voffA[i] = (unsigned)(R * g.lda + C) * 2u; voffB[i] = (unsigned)(Rb * g.ldb + C) * 2u; }
    const size_t kstep = (size_t)(BK * 2);
    const size_t hstepA = (size_t)HALF * g.lda * 2, hstepB = (size_t)HALF * g.ldb * 2;
    const unsigned ldsw = (unsigned)wid * 1024u;
    const int aoff = lds_byte(wr * 64 + fr, fq * 8), boff = lds_byte(wc * 32 + fr, fq * 8);
#define PG8_SA(b, h) (((b) * 2 + (h)) * HTB)
#define PG8_SB(b, h) ((4 + (b) * 2 + (h)) * HTB)
#define PG8_STAGE(bufoff, gbase, voff) do { _Pragma("unroll") for (int _i = 0; _i < 2; ++_i) \
        __builtin_amdgcn_global_load_lds((const unsigned*)((const char*)(gbase) + (voff)[_i]), (LAS unsigned*)(lds + (bufoff) + ldsw + _i * 8192), 16, 0, 0); } while (0)
#define PG8_LDA(dst, b, h) do { _Pragma("unroll") for (int m = 0; m < 4; ++m) _Pragma("unroll") for (int k = 0; k < 2; ++k) dst[m][k] = *(const LAS bf16x8*)(lds + PG8_SA(b, h) + aoff + m * 2048 + k * 1024); } while (0)
#define PG8_LDB(dst, b, h) do { _Pragma("unroll") for (int n = 0; n < 2; ++n) _Pragma("unroll") for (int k = 0; k < 2; ++k) dst[n][k] = *(const LAS bf16x8*)(lds + PG8_SB(b, h) + boff + n * 2048 + k * 1024); } while (0)
#define PG8_MMA(ai, bj, At, Bt) do { __builtin_amdgcn_s_setprio(1); _Pragma("unroll") for (int m = 0; m < 4; ++m) _Pragma("unroll") for (int n = 0; n < 2; ++n) _Pragma("unroll") for (int k = 0; k < 2; ++k) \
        acc[ai][bj][m][n] = __builtin_amdgcn_mfma_f32_16x16x32_bf16(Bt[n][k], At[m][k], acc[ai][bj][m][n], 0, 0, 0); __builtin_amdgcn_s_setprio(0); } while (0)
#define PG8_WAIT_V(n) asm volatile("s_waitcnt vmcnt(" #n ")" ::: "memory")
#define PG8_WAIT_L(n) asm volatile("s_waitcnt lgkmcnt(" #n ")" ::: "memory")
#define PG8_BAR __builtin_amdgcn_s_barrier()
#define PG8_SCHED __builtin_amdgcn_sched_barrier(0)
    Unit cur, nxt; int ui = 0;
    if (!S.next(0, cur)) return;
    float zf = 0.f; asm volatile("" : "+v"(zf));
    f32x4 acc[2][2][4][2];
#pragma unroll
    for (int a = 0; a < 2; ++a)
#pragma unroll
        for (int b = 0; b < 2; ++b)
#pragma unroll
            for (int m = 0; m < 4; ++m)
#pragma unroll
                for (int n = 0; n < 2; ++n) acc[a][b][m][n] = (f32x4){zf, zf, zf, zf};
    bf16x8 At[4][2], B0[2][2], B1[2][2];
    const char* cA = cur.A; const char* cB = cur.B;
    PG8_STAGE(PG8_SB(0, 0), cB, voffB); PG8_STAGE(PG8_SB(0, 1), cB + hstepB, voffB); PG8_STAGE(PG8_SA(0, 0), cA, voffA); PG8_STAGE(PG8_SA(0, 1), cA + hstepA, voffA);
    if (wr == 1) PG8_BAR;
    PG8_WAIT_V(2); PG8_BAR;
    PG8_STAGE(PG8_SB(1, 0), cB + kstep, voffB); PG8_STAGE(PG8_SA(1, 0), cA + kstep, voffA); PG8_STAGE(PG8_SB(1, 1), cB + hstepB + kstep, voffB);
    PG8_WAIT_V(6); PG8_BAR;
    for (;;) {
        const bool has_next = S.next(ui + 1, nxt);
        const char* nA = has_next ? nxt.A : cA; const char* nB = has_next ? nxt.B : cB;
        for (int t = 0; t < nt; t += 2) {
            const bool last = (t == nt - 2);
            const char* a1 = cA + (size_t)(t + 1) * kstep;
            const char* a2 = last ? nA : cA + (size_t)(t + 2) * kstep; const char* b2 = last ? nB : cB + (size_t)(t + 2) * kstep;
            const char* a3 = a2 + kstep; const char* b3 = b2 + kstep;
            PG8_LDB(B0, 0, 0); PG8_LDB(B1, 0, 1); PG8_SCHED; PG8_LDA(At, 0, 0); PG8_STAGE(PG8_SA(1, 1), a1 + hstepA, voffA);
            PG8_WAIT_V(8); PG8_WAIT_L(0); PG8_BAR; PG8_MMA(0, 0, At, B0); PG8_MMA(0, 1, At, B1); PG8_BAR; PG8_SCHED;
            PG8_LDA(At, 0, 1); PG8_STAGE(PG8_SB(0, 0), b2, voffB); PG8_STAGE(PG8_SB(0, 1), b2 + hstepB, voffB); PG8_STAGE(PG8_SA(0, 0), a2, voffA);
            PG8_WAIT_V(8); PG8_WAIT_L(0); PG8_BAR; PG8_MMA(1, 0, At, B0); PG8_MMA(1, 1, At, B1); PG8_BAR; PG8_SCHED;
            PG8_LDB(B0, 1, 0); PG8_LDB(B1, 1, 1); PG8_SCHED; PG8_LDA(At, 1, 0); PG8_STAGE(PG8_SA(0, 1), a2 + hstepA, voffA);
            PG8_WAIT_V(8); PG8_WAIT_L(0); PG8_BAR; PG8_MMA(0, 0, At, B0); PG8_MMA(0, 1, At, B1); PG8_BAR; PG8_SCHED;
            PG8_LDA(At, 1, 1); PG8_STAGE(PG8_SB(1, 0), b3, voffB); PG8_STAGE(PG8_SB(1, 1), b3 + hstepB, voffB); PG8_STAGE(PG8_SA(1, 0), a3, voffA);
            PG8_WAIT_V(8); PG8_WAIT_L(0); PG8_BAR; PG8_MMA(1, 0, At, B0); PG8_MMA(1, 1, At, B1); PG8_BAR; PG8_SCHED;
        }
        if constexpr (ALIGN_EPI) { if (wr == 0) PG8_BAR; }
        E(acc, cur, wr, wc, fr, fq);
        if (!has_next) break;
#pragma unroll
        for (int a = 0; a < 2; ++a)
#pragma unroll
            for (int b = 0; b < 2; ++b)
#pragma unroll
                for (int m = 0; m < 4; ++m)
#pragma unroll
                    for (int n = 0; n < 2; ++n) acc[a][b][m][n] = (f32x4){zf, zf, zf, zf};
        cur = nxt; cA = nA; cB = nB; ++ui;
        if constexpr (ALIGN_EPI) { if (wr == 1) PG8_BAR; }
    }
    PG8_WAIT_V(0);
    if constexpr (!ALIGN_EPI) { if (wr == 0) PG8_BAR; }
    PG8_BAR;
#undef PG8_SA
#undef PG8_SB
#undef PG8_STAGE
#undef PG8_LDA
#undef PG8_LDB
#undef PG8_MMA
#undef PG8_WAIT_V
#undef PG8_WAIT_L
#undef PG8_BAR
#undef PG8_SCHED
}
}

struct Frame { LAS unsigned char* lds; int tid, lane, wave, G, bid; float zf; unsigned zu; };
#define FRAME_SETUP Frame F; { int t_ = threadIdx.x, b_ = blockIdx.x, g_ = gridDim.x; float z_ = 0.f; unsigned zu_ = 0u; asm volatile("" : "+v"(t_), "+s"(b_), "+s"(g_), "+v"(z_), "+v"(zu_)); \
    F.lds = lds_base(); F.tid = t_; F.lane = t_ & 63; F.wave = __builtin_amdgcn_readfirstlane(t_ >> 6); F.G = g_; F.bid = b_; F.zf = z_; F.zu = zu_; }
extern __shared__ __attribute__((aligned(16))) unsigned char lds_dyn[];
__device__ __forceinline__ LAS unsigned char* lds_base() { return (LAS unsigned char*)lds_dyn; }
typedef const __attribute__((address_space(4))) unsigned long long karg_t;
__device__ __forceinline__ unsigned long long karg(int k) { asm volatile("" : "+s"(k)); return ((karg_t*)__builtin_amdgcn_kernarg_segment_ptr())[k]; }
__device__ __forceinline__ const float* inp(int k) { return (const float*)karg(k); }
__device__ __forceinline__ float* outp() { return (float*)karg(22); }
__device__ __forceinline__ unsigned char* wsp() { return (unsigned char*)karg(23); }
enum { I_X = 0, I_WIN, I_BIN, I_GMLNG, I_GMWS, I_GMBS, I_RELB, I_MLCONV, I_MLFB, I_MLNG, I_POOLW, I_POOLS, I_WBR, I_WOUT, I_LN1G, I_LN1B, I_WR, I_WE1, I_WE3, I_WE2, I_LN2G, I_LN2B };
__device__ __forceinline__ bf16* wl(unsigned char* ws, int l, size_t off) { return (bf16*)(ws + WS_W + (size_t)l * LW + off); }

#define WS_PTRS unsigned char* ws = wsp(); float* BIN = (float*)(ws + WS_BIN); float* XF = (float*)(ws + WS_XF); bf16* XB = (bf16*)(ws + WS_XB); bf16* H = (bf16*)(ws + WS_BIG); bf16* XS = (bf16*)(ws + WS_XS); \
    bf16* HID = (bf16*)(ws + WS_HID); bf16* YE = (bf16*)(ws + WS_YE); float* GI = (float*)(ws + WS_GI); float* ATTO = (float*)(ws + WS_ATTO); float* ATTL = (float*)(ws + WS_ATTL); bf16* YS = (bf16*)(ws + WS_YS); \
    float* MGF = (float*)(ws + WS_MGF); bf16* MGB = (bf16*)(ws + WS_MGB); float* QC = (float*)(ws + WS_QC); float* KC = (float*)(ws + WS_KC); float* DC = (float*)(ws + WS_DC); float* DG = (float*)(ws + WS_DG); \
    float* AFF = (float*)(ws + WS_AFF); float* GATE = (float*)(ws + WS_GATE); int* IDX = (int*)(ws + WS_IDX); int* SLOT = (int*)(ws + WS_SLOT); \
    (void)BIN; (void)XF; (void)XB; (void)H; (void)XS; (void)HID; (void)YE; (void)GI; (void)ATTO; (void)ATTL; (void)YS; (void)MGF; (void)MGB; (void)QC; (void)KC; (void)DC; (void)DG; (void)AFF; (void)GATE; (void)IDX; (void)SLOT
__device__ __forceinline__ void tr_item(const float* W, int ldw, int k0, int n0, int ncols, bf16* WT, int ldt, int trow0, LAS float* scr, int lane) {
    const int c = lane & 31; const bool cv = c < ncols;
#pragma unroll 8
    for (int i = 0; i < 32; ++i) { const int kk = 2 * i + (lane >> 5); scr[kk * 33 + c] = cv ? W[(size_t)(k0 + kk) * ldw + n0 + c] : 0.f; }
    LDS_WAIT(); asm volatile("" ::: "memory");
    const int ch = lane & 7;
#pragma unroll
    for (int j = 0; j < 4; ++j) { const int n = (lane >> 3) + 8 * j; const LAS float* s = scr + (8 * ch) * 33 + n;
        u32x4 o; o.x = pk2(s[0 * 33], s[1 * 33]); o.y = pk2(s[2 * 33], s[3 * 33]); o.z = pk2(s[4 * 33], s[5 * 33]); o.w = pk2(s[6 * 33], s[7 * 33]);
        if (n < ncols) *(GAS u32x4*)(WT + (size_t)(trow0 + n) * ldt + k0 + 8 * ch) = o; }
    LDS_WAIT(); asm volatile("" ::: "memory");
}
constexpr int IT_IN = 16 * 209, IT_B = 512, IT_O = 512, IT_13 = 16384, IT_2 = 8192, IT_LAYER = IT_IN + IT_B + IT_O + IT_13 + IT_2;
__device__ __forceinline__ void p0_prologue() {
    FRAME_SETUP;
    WS_PTRS; const float* x = inp(I_X); const float* w_in = inp(I_WIN); const float* b_in = inp(I_BIN); const float* w_branch = inp(I_WBR); const float* w_out = inp(I_WOUT); const float* w_e1 = inp(I_WE1); const float* w_e3 = inp(I_WE3); const float* w_e2 = inp(I_WE2);
    LAS float* scr = (LAS float*)(F.lds + F.wave * 16384);
    const int gw = F.bid * NWAVES + F.wave, NGW = F.G * NWAVES, lane = F.lane;
    for (int it = gw; it < IT_LAYER * DEPTH; it += NGW) {
        const int l = it / IT_LAYER; int r = it % IT_LAYER;
        if (r < IT_IN) { const int kb = r / 209, cb = r % 209; int n0, trow, nc;
            if (cb < 72) { n0 = 32 * cb; trow = n0; nc = 32; } else if (cb < 208) { n0 = 2320 + 32 * (cb - 72); trow = 2304 + 32 * (cb - 72); nc = 32; } else { n0 = 2304; trow = 6656; nc = 16; }
            tr_item(w_in + (size_t)l * D * NIN, NIN, 64 * kb, n0, nc, wl(ws, l, OW_IN), D, trow, scr, lane); continue; }
        r -= IT_IN;
        if (r < IT_B) { const int n = r / 128, q = r % 128, kb = q / 32, nb = q % 32;
            tr_item(w_branch + ((size_t)(l * 4 + n) * 256) * D, D, 64 * kb, 32 * nb, 32, wl(ws, l, OW_B) + (size_t)n * D * 256, 256, 32 * nb, scr, lane); continue; }
        r -= IT_B;
        if (r < IT_O) { const int kb = r / 32, nb = r % 32;
            tr_item(w_out + (size_t)l * D * D, D, 64 * kb, 32 * nb, 32, wl(ws, l, OW_O), D, 32 * nb, scr, lane); continue; }
        r -= IT_O;
        if (r < IT_13) { const int e = r / 1024, q = r % 1024, which = q / 512, q2 = q % 512, kb = q2 / 32, nb = q2 % 32, f0 = 32 * nb;
            const int trow = (f0 / 128) * 256 + (f0 % 128) + which * 128;
            const float* src = (which ? w_e3 : w_e1) + ((size_t)(l * NE + e) * D) * FF;
            tr_item(src, FF, 64 * kb, f0, 32, wl(ws, l, OW_13) + (size_t)e * 2048 * D, D, trow, scr, lane); continue; }
        r -= IT_13;
        { const int e = r / 512, q = r % 512, kb = q / 32, nb = q % 32;
            tr_item(w_e2 + ((size_t)(l * NE + e) * FF) * D, D, 64 * kb, 32 * nb, 32, wl(ws, l, OW_2) + (size_t)e * D * FF, FF, 32 * nb, scr, lane); }
    }
    const int gt = F.bid * NTHREADS + F.tid, NGT = F.G * NTHREADS;
    for (int i = gt; i < DEPTH * 240 * (D / 8); i += NGT) { const int l = i / (240 * (D / 8)), r = i % (240 * (D / 8));
        *(GAS u32x4*)(wl(ws, l, OW_IN) + (size_t)NIN * D + (size_t)r * 8) = (u32x4){F.zu, F.zu, F.zu, F.zu}; }
    for (int i = gt; i < DEPTH * NINP; i += NGT) { const int l = i / NINP, c = i % NINP;
        float v = 0.f; if (c < 2304) v = b_in[l * NIN + c]; else if (c < NH) v = b_in[l * NIN + c + 16]; else if (c < NH + 16) v = b_in[l * NIN + c - NH + 2304];
        BIN[i] = v; }
    for (int i = gt; i < T * D / 4; i += NGT) { const f32x4 v = ((const GAS f32x4*)x)[i]; ((GAS f32x4*)XF)[i] = v;
        u32x2 w; w.x = pk2(v.x, v.y); w.y = pk2(v.z, v.w); ((GAS u32x2*)XB)[i] = w; }
}

typedef f32x4 Acc[2][2][4][2];
struct SchedG1 { int G, c; const char* A; const char* B;
    __device__ __forceinline__ bool next(int i, pg8::Unit& u) const { int pm, pn; if (!pg8::tile_of(i, G, c, T / 256, NINP / 256, pm, pn)) return false;
        u.pm = pm; u.pn = pn; u.aux = 0; u.A = A + (size_t)pm * 256 * D * 2; u.B = B + (size_t)pn * 256 * D * 2; return true; } };
struct EpiG1 { static constexpr bool PERM = true; bf16* H; float* GI; const float* bias;
    __device__ __forceinline__ void operator()(const Acc& acc, const pg8::Unit& u, int wr, int wc, int fr, int fq) const {
        const int row0 = u.pm * 256 + wr * 64 + fr;
        if (u.pn < 26) {
            const int col0 = u.pn * 256 + wc * 32 + 8 * fq; const bool act = u.pn < 2;
            f32x4 bv[2][2];
#pragma unroll
            for (int bj = 0; bj < 2; ++bj)
#pragma unroll
                for (int n = 0; n < 2; ++n) bv[bj][n] = *(const f32x4*)(bias + col0 + bj * 128 + 4 * n);
#pragma unroll
            for (int ai = 0; ai < 2; ++ai)
#pragma unroll
                for (int m = 0; m < 4; ++m) { bf16* rowp = H + (size_t)(row0 + ai * 128 + m * 16) * NH + col0;
#pragma unroll
                    for (int bj = 0; bj < 2; ++bj) { f32x4 v0 = acc[ai][bj][m][0] + bv[bj][0], v1 = acc[ai][bj][m][1] + bv[bj][1];
                        if (act) { v0 = (f32x4){gelu_tanh(v0[0]), gelu_tanh(v0[1]), gelu_tanh(v0[2]), gelu_tanh(v0[3])}; v1 = (f32x4){gelu_tanh(v1[0]), gelu_tanh(v1[1]), gelu_tanh(v1[2]), gelu_tanh(v1[3])}; }
                        u32x4 w; w.x = pk2(v0[0], v0[1]); w.y = pk2(v0[2], v0[3]); w.z = pk2(v1[0], v1[1]); w.w = pk2(v1[2], v1[3]);
                        *(u32x4*)(rowp + bj * 128) = w; } }
        } else if (wc == 0 && fq < 2) {
#pragma unroll
            for (int ai = 0; ai < 2; ++ai)
#pragma unroll
                for (int m = 0; m < 4; ++m) { float* rowp = GI + (size_t)(row0 + ai * 128 + m * 16) * 16 + 8 * fq;
#pragma unroll
                    for (int n = 0; n < 2; ++n) { const f32x4 b = *(const f32x4*)(bias + NH + 8 * fq + 4 * n); *(f32x4*)(rowp + 4 * n) = acc[ai][0][m][n] + b; } }
        }
    } };
struct SchedG2 { int G, c; const char* A; const char* B;
    __device__ __forceinline__ bool next(int i, pg8::Unit& u) const { int pm, pn; if (!pg8::tile_of(i >> 2, G, c, T / 256, D / 256, pm, pn)) return false; const int n = i & 3;
        u.pm = pm; u.pn = pn; u.aux = n; u.A = A + (size_t)pm * 256 * D * 2 + (size_t)n * 256 * 2; u.B = B + (size_t)n * D * 256 * 2 + (size_t)pn * 256 * 256 * 2; return true; } };
struct EpiG2 { static constexpr bool PERM = true; const bf16* H; float* MGF; bf16* MGB;
    __device__ __forceinline__ void operator()(const Acc& acc, const pg8::Unit& u, int wr, int wc, int fr, int fq) const {
        const int n = u.aux;
        const size_t rowb = (size_t)(u.pm * 256 + wr * 64 + fr); const int col0 = u.pn * 256 + wc * 32 + 8 * fq;
        const bf16* hp = H + rowb * NH + HG + n * D + col0; float* mp0 = MGF + rowb * D + col0; bf16* bp = MGB + rowb * D + col0;
#pragma unroll
        for (int ai = 0; ai < 2; ++ai)
#pragma unroll
            for (int m = 0; m < 4; ++m) {
#pragma unroll
                for (int bj = 0; bj < 2; ++bj) { const int ro = ai * 128 + m * 16;
                    float gv[8]; unpack8(*(const u32x4*)(hp + (size_t)ro * NH + bj * 128), gv);
                    f32x4 v0 = acc[ai][bj][m][0], v1 = acc[ai][bj][m][1];
                    v0 = (f32x4){v0[0] * sigmoidf_(gv[0]), v0[1] * sigmoidf_(gv[1]), v0[2] * sigmoidf_(gv[2]), v0[3] * sigmoidf_(gv[3])};
                    v1 = (f32x4){v1[0] * sigmoidf_(gv[4]), v1[1] * sigmoidf_(gv[5]), v1[2] * sigmoidf_(gv[6]), v1[3] * sigmoidf_(gv[7])};
                    float* mp = mp0 + (size_t)ro * D + bj * 128;
                    { const f32x4 p0 = *(const f32x4*)mp, p1 = *(const f32x4*)(mp + 4); const float ks = n > 0 ? 1.f : 0.f;
                      v0 = (f32x4){n > 0 ? v0[0] + p0[0] : v0[0], n > 0 ? v0[1] + p0[1] : v0[1], n > 0 ? v0[2] + p0[2] : v0[2], n > 0 ? v0[3] + p0[3] : v0[3]};
                      v1 = (f32x4){n > 0 ? v1[0] + p1[0] : v1[0], n > 0 ? v1[1] + p1[1] : v1[1], n > 0 ? v1[2] + p1[2] : v1[2], n > 0 ? v1[3] + p1[3] : v1[3]}; (void)ks; }
                    *(f32x4*)mp = v0; *(f32x4*)(mp + 4) = v1;
                    { u32x4 w; w.x = pk2(v0[0], v0[1]); w.y = pk2(v0[2], v0[3]); w.z = pk2(v1[0], v1[1]); w.w = pk2(v1[2], v1[3]); *(u32x4*)(bp + (size_t)ro * D + bj * 128) = w; }
                    asm volatile("" ::: "memory"); } }
    } };
struct SchedG3 { int G, c; const char* A; const char* B;
    __device__ __forceinline__ bool next(int i, pg8::Unit& u) const { int pm, pn; if (!pg8::tile_of(i, G, c, T / 256, D / 256, pm, pn)) return false;
        u.pm = pm; u.pn = pn; u.aux = 0; u.A = A + (size_t)pm * 256 * D * 2; u.B = B + (size_t)pn * 256 * D * 2; return true; } };
struct EpiG3 { static constexpr bool PERM = true; const float* XF; float* R;
    __device__ __forceinline__ void operator()(const Acc& acc, const pg8::Unit& u, int wr, int wc, int fr, int fq) const {
        const int row0 = u.pm * 256 + wr * 64 + fr, col0 = u.pn * 256 + wc * 32 + 8 * fq;
#pragma unroll
        for (int ai = 0; ai < 2; ++ai)
#pragma unroll
            for (int m = 0; m < 4; ++m) { const size_t row = (size_t)(row0 + ai * 128 + m * 16);
#pragma unroll
                for (int bj = 0; bj < 2; ++bj) { const size_t o = row * D + col0 + bj * 128;
                    const f32x4 x0 = *(const f32x4*)(XF + o), x1 = *(const f32x4*)(XF + o + 4);
                    *(f32x4*)(R + o) = x0 * ALPHA + acc[ai][bj][m][0]; *(f32x4*)(R + o + 4) = x1 * ALPHA + acc[ai][bj][m][1]; } }
    } };
struct SchedG4 { int G, c; const char* A; const char* B;
    __device__ __forceinline__ bool next(int i, pg8::Unit& u) const { int pm, pn; if (!pg8::tile_of(i, G, c, NSLOT / 256, 2048 / 256, pm, pn)) return false; const int e = (pm >> 2) & 15;
        u.pm = pm; u.pn = pn; u.aux = e; u.A = A + (size_t)pm * 256 * D * 2; u.B = B + (size_t)e * 2048 * D * 2 + (size_t)pn * 256 * D * 2; return true; } };
struct EpiG4 { static constexpr bool PERM = true; bf16* HID;
    __device__ __forceinline__ void operator()(const Acc& acc, const pg8::Unit& u, int wr, int wc, int fr, int fq) const {
        const int row0 = u.pm * 256 + wr * 64 + fr, col0 = u.pn * 128 + wc * 32 + 8 * fq;
#pragma unroll
        for (int ai = 0; ai < 2; ++ai)
#pragma unroll
            for (int m = 0; m < 4; ++m) { const size_t row = (size_t)(row0 + ai * 128 + m * 16);
                const f32x4 a0 = acc[ai][0][m][0], a1 = acc[ai][0][m][1], g0 = acc[ai][1][m][0], g1 = acc[ai][1][m][1];
                u32x4 w; w.x = pk2(siluf_(a0[0]) * g0[0], siluf_(a0[1]) * g0[1]); w.y = pk2(siluf_(a0[2]) * g0[2], siluf_(a0[3]) * g0[3]);
                w.z = pk2(siluf_(a1[0]) * g1[0], siluf_(a1[1]) * g1[1]); w.w = pk2(siluf_(a1[2]) * g1[2], siluf_(a1[3]) * g1[3]);
                *(u32x4*)(HID + row * FF + col0) = w; }
    } };
struct SchedG5 { int G, c; const char* A; const char* B;
    __device__ __forceinline__ bool next(int i, pg8::Unit& u) const { int pm, pn; if (!pg8::tile_of(i, G, c, NSLOT / 256, D / 256, pm, pn)) return false; const int e = (pm >> 2) & 15;
        u.pm = pm; u.pn = pn; u.aux = e; u.A = A + (size_t)pm * 256 * FF * 2; u.B = B + (size_t)e * D * FF * 2 + (size_t)pn * 256 * FF * 2; return true; } };
struct EpiG5 { static constexpr bool PERM = true; const float* GATE; bf16* YE;
    __device__ __forceinline__ void operator()(const Acc& acc, const pg8::Unit& u, int wr, int wc, int fr, int fq) const {
        const int row0 = u.pm * 256 + wr * 64 + fr, col0 = u.pn * 256 + wc * 32 + 8 * fq;
#pragma unroll
        for (int ai = 0; ai < 2; ++ai)
#pragma unroll
            for (int m = 0; m < 4; ++m) { const size_t row = (size_t)(row0 + ai * 128 + m * 16); const float gt = GATE[row];
#pragma unroll
                for (int bj = 0; bj < 2; ++bj) { const f32x4 v0 = acc[ai][bj][m][0] * gt, v1 = acc[ai][bj][m][1] * gt;
                    u32x4 w; w.x = pk2(v0[0], v0[1]); w.y = pk2(v0[2], v0[3]); w.z = pk2(v1[0], v1[1]); w.w = pk2(v1[2], v1[3]);
                    *(u32x4*)(YE + row * D + col0 + bj * 128) = w; } }
    } };

__device__ __forceinline__ void mlstm_c1(int l, int item) {
    FRAME_SETUP;
    WS_PTRS; const float* ml_conv = inp(I_MLCONV); const float* ml_fbias = inp(I_MLFB);
    const int tid = F.tid;
    const int c = item & 127, h = (item >> 7) & 3, b = item >> 9;
    const int p0 = b * SEQ + c * 64, hc = h * 64;
    LAS float* qs = (LAS float*)F.lds; LAS float* ks = qs + 64 * 65; LAS float* vs = ks + 64 * 65; LAS float* gt = vs + 64 * 65;
    {
        const int row = tid >> 3, cg = (tid & 7) * 8, s = c * 64 + row;
        const bf16* hr = H + (size_t)(p0 + row) * NH;
        const float* cw = ml_conv + (size_t)l * 3 * 512;
        float qv[8], kv[8];
#pragma unroll
        for (int j = 0; j < 8; ++j) { qv[j] = 0.f; kv[j] = 0.f; }
#pragma unroll
        for (int dr = -1; dr <= 1; ++dr) {
            if (s + dr >= 0 && s + dr < SEQ) {
                const bf16* r2 = hr + (ptrdiff_t)dr * NH;
                float q8[8], k8[8]; unpack8(*(const u32x4*)(r2 + HCQ + hc + cg), q8); unpack8(*(const u32x4*)(r2 + HCK + hc + cg), k8);
#pragma unroll
                for (int j = 0; j < 8; ++j) { qv[j] += cw[(dr + 1) * 512 + hc + cg + j] * q8[j]; kv[j] += cw[(dr + 1) * 512 + 256 + hc + cg + j] * k8[j]; }
            }
        }
        float v8[8]; unpack8(*(const u32x4*)(hr + HCV + hc + cg), v8);
#pragma unroll
        for (int j = 0; j < 8; ++j) { qv[j] = siluf_(qv[j]); kv[j] = siluf_(kv[j]) * 0.125f; qs[row * 65 + cg + j] = qv[j]; ks[row * 65 + cg + j] = kv[j]; vs[row * 65 + cg + j] = v8[j]; }
        float* qo = QC + (size_t)(p0 + row) * 256 + hc + cg; float* ko = KC + (size_t)(p0 + row) * 256 + hc + cg;
        *(f32x4*)qo = (f32x4){qv[0], qv[1], qv[2], qv[3]}; *(f32x4*)(qo + 4) = (f32x4){qv[4], qv[5], qv[6], qv[7]};
        *(f32x4*)ko = (f32x4){kv[0], kv[1], kv[2], kv[3]}; *(f32x4*)(ko + 4) = (f32x4){kv[4], kv[5], kv[6], kv[7]};
    }
    if (tid < 64) { const float* gi = GI + (size_t)(p0 + tid) * 16; const float* fb = ml_fbias + l * 8;
        gt[tid] = gi[h]; gt[64 + tid] = logsigmoidf_(gi[8 + h] + fb[h]); gt[128 + tid] = gi[4 + h]; gt[192 + tid] = logsigmoidf_(gi[12 + h] + fb[4 + h]); }
    __syncthreads();
    if (tid == 0) { float cs = 0.f; for (int s = 0; s < 64; ++s) { cs += gt[64 + s]; gt[256 + s] = cs; } }
    if (tid == 64) { float cs = 0.f; for (int s = 63; s >= 0; --s) { cs += gt[192 + s]; gt[320 + s] = cs; } }
    __syncthreads();
    if (tid < 64) gt[384 + tid] = __expf(gt[256 + 63] - gt[256 + tid] + gt[tid]);
    else if (tid < 128) { const int s = tid - 64; gt[448 + s] = __expf(gt[320] - gt[320 + s] + gt[128 + s]); }
    __syncthreads();
    {
        const int dir = tid >> 8, tp = tid & 255, k = tp & 63, v0 = (tp >> 6) * 16;
        const LAS float* w = gt + 384 + dir * 64;
        float acc[16]; float accn = 0.f;
#pragma unroll
        for (int i = 0; i < 16; ++i) acc[i] = 0.f;
        for (int s = 0; s < 64; ++s) { const float kk = ks[s * 65 + k], wk = w[s] * kk; accn += wk;
#pragma unroll
            for (int i = 0; i < 16; ++i) acc[i] += wk * vs[s * 65 + v0 + i]; }
        const int chain = ((dir * 2 + b) * 4 + h) * 128 + c; float* dc = DC + (size_t)chain * 4160;
#pragma unroll
        for (int i = 0; i < 16; ++i) dc[(v0 + i) * 64 + k] = acc[i];
        if (v0 == 0) dc[4096 + k] = accn;
        if (tp == 0) DG[chain] = dir == 0 ? gt[256 + 63] : gt[320];
    }
    __syncthreads();
}
__device__ __forceinline__ void mlstm_scan(int item) {
    FRAME_SETUP;
    WS_PTRS;
    const int g = item * NTHREADS + F.tid; if (g >= 16 * 4160) return;
    const int chain = g / 4160, e = g % 4160, dir = chain >> 3, base = chain * 128;
    float S = 0.f;
    for (int i0 = 0; i0 < 128; i0 += 8) {
        float tmp[8], dec[8];
#pragma unroll
        for (int j = 0; j < 8; ++j) { const int c = dir ? 127 - (i0 + j) : (i0 + j); tmp[j] = DC[(size_t)(base + c) * 4160 + e]; dec[j] = __expf(DG[base + c]); }
#pragma unroll
        for (int j = 0; j < 8; ++j) { const int c = dir ? 127 - (i0 + j) : (i0 + j); DC[(size_t)(base + c) * 4160 + e] = S; S = dec[j] * S + tmp[j]; }
    }
}
__device__ __forceinline__ void mlstm_c3(int l, int item) {
    FRAME_SETUP;
    WS_PTRS; const float* ml_fbias = inp(I_MLFB); const float* ml_norm_g = inp(I_MLNG);
    const int tid = F.tid;
    const int c = item & 127, h = (item >> 7) & 3, b = item >> 9;
    const int p0 = b * SEQ + c * 64, hc = h * 64;
    LAS float* qs = (LAS float*)F.lds; LAS float* ks = qs + 64 * 65; LAS float* vs = ks + 64 * 65; LAS float* Cs = vs + 64 * 65; LAS float* Ss = Cs + 64 * 65;
    LAS float* gt = Ss + 64 * 65; LAS float* ns = gt + 512;
    {
        const int row = tid >> 3, cg = (tid & 7) * 8;
        const float* qi = QC + (size_t)(p0 + row) * 256 + hc + cg; const float* ki = KC + (size_t)(p0 + row) * 256 + hc + cg;
        const f32x4 q0 = *(const f32x4*)qi, q1 = *(const f32x4*)(qi + 4), k0 = *(const f32x4*)ki, k1 = *(const f32x4*)(ki + 4);
        float v8[8]; unpack8(*(const u32x4*)(H + (size_t)(p0 + row) * NH + HCV + hc + cg), v8);
#pragma unroll
        for (int j = 0; j < 4; ++j) { qs[row * 65 + cg + j] = q0[j]; qs[row * 65 + cg + 4 + j] = q1[j]; ks[row * 65 + cg + j] = k0[j]; ks[row * 65 + cg + 4 + j] = k1[j]; }
#pragma unroll
        for (int j = 0; j < 8; ++j) vs[row * 65 + cg + j] = v8[j];
    }
    if (tid < 64) { const float* gi = GI + (size_t)(p0 + tid) * 16; const float* fb = ml_fbias + l * 8;
        gt[tid] = gi[h]; gt[64 + tid] = logsigmoidf_(gi[8 + h] + fb[h]); gt[128 + tid] = gi[4 + h]; gt[192 + tid] = logsigmoidf_(gi[12 + h] + fb[4 + h]); }
    __syncthreads();
    if (tid == 0) { float cs = 0.f; for (int s = 0; s < 64; ++s) { cs += gt[64 + s]; gt[256 + s] = cs; } }
    if (tid == 64) { float cs = 0.f; for (int s = 63; s >= 0; --s) { cs += gt[192 + s]; gt[320 + s] = cs; } }
    const int t = tid & 63, sg = (tid >> 6) * 8, vg = sg;
    float hacc[8];
#pragma unroll
    for (int i = 0; i < 8; ++i) hacc[i] = 0.f;
    for (int dir = 0; dir < 2; ++dir) {
        const int chain = ((dir * 2 + b) * 4 + h) * 128 + c; const float* dc = DC + (size_t)chain * 4160;
        { const f32x4 c0 = *(const f32x4*)(dc + tid * 8), c1 = *(const f32x4*)(dc + tid * 8 + 4); const int v = tid >> 3, k0 = (tid & 7) * 8;
#pragma unroll
            for (int j = 0; j < 4; ++j) { Cs[v * 65 + k0 + j] = c0[j]; Cs[v * 65 + k0 + 4 + j] = c1[j]; } }
        if (tid < 64) ns[tid] = dc[4096 + tid];
        __syncthreads();
        const LAS float* cum = gt + (dir == 0 ? 256 : 320); const LAS float* li = gt + (dir == 0 ? 0 : 128);
        {
            float sacc[8];
#pragma unroll
            for (int i = 0; i < 8; ++i) sacc[i] = 0.f;
            for (int d = 0; d < 64; ++d) { const float qd = qs[t * 65 + d];
#pragma unroll
                for (int i = 0; i < 8; ++i) sacc[i] += qd * ks[(sg + i) * 65 + d]; }
            const float ct = cum[t];
#pragma unroll
            for (int i = 0; i < 8; ++i) { const int s = sg + i; const bool valid = dir == 0 ? (s <= t) : (s >= t);
                Ss[t * 65 + s] = valid ? sacc[i] * __expf(ct - cum[s] + li[s]) : 0.f; }
        }
        __syncthreads();
        {
            float nacc[8], iacc[8]; float den = 0.f, nq = 0.f;
#pragma unroll
            for (int i = 0; i < 8; ++i) { nacc[i] = 0.f; iacc[i] = 0.f; }
            for (int s = 0; s < 64; ++s) { const float sv = Ss[t * 65 + s]; den += sv;
#pragma unroll
                for (int i = 0; i < 8; ++i) nacc[i] += sv * vs[s * 65 + vg + i]; }
            for (int k = 0; k < 64; ++k) { const float qk = qs[t * 65 + k]; nq += ns[k] * qk;
#pragma unroll
                for (int i = 0; i < 8; ++i) iacc[i] += Cs[(vg + i) * 65 + k] * qk; }
            const float ew = __expf(cum[t]);
            const float dn = den + ew * nq; const float inv = 1.0f / fmaxf(fabsf(dn), 1.0f);
#pragma unroll
            for (int i = 0; i < 8; ++i) hacc[i] += (nacc[i] + ew * iacc[i]) * inv;
        }
        __syncthreads();
    }
#pragma unroll
    for (int i = 0; i < 8; ++i) Ss[t * 65 + vg + i] = hacc[i];
    __syncthreads();
    {
        float s1 = 0.f;
        for (int d = 0; d < 64; ++d) s1 += Ss[t * 65 + d];
        const float mu = s1 * (1.0f / 64.0f); float s2 = 0.f;
        for (int d = 0; d < 64; ++d) { const float dv = Ss[t * 65 + d] - mu; s2 += dv * dv; }
        const float rstd = 1.0f / sqrtf(s2 * (1.0f / 64.0f) + LN_EPS);
        float o8[8]; unpack8(*(const u32x4*)(H + (size_t)(p0 + t) * NH + HCO + hc + vg), o8);
        const float* ng = ml_norm_g + l * 256 + hc + vg;
        float y[8];
#pragma unroll
        for (int i = 0; i < 8; ++i) y[i] = (hacc[i] - mu) * rstd * ng[i] * sigmoidf_(o8[i]);
        u32x4 w; w.x = pk2(y[0], y[1]); w.y = pk2(y[2], y[3]); w.z = pk2(y[4], y[5]); w.w = pk2(y[6], y[7]);
        *(u32x4*)(YS + (size_t)(p0 + t) * D + 512 + hc + vg) = w;
    }
    __syncthreads();
}
__device__ __forceinline__ void gmlp_item(int l, int item) {
    FRAME_SETUP;
    WS_PTRS; const float* gm_ln_g = inp(I_GMLNG); const float* gm_ws = inp(I_GMWS); const float* gm_bs = inp(I_GMBS);
    const int tid = F.tid;
    const int g = item & 3, ch = (item >> 2) & 63, b = item >> 8;
    const int p0 = b * SEQ + ch * 128;
    LAS float* vn = (LAS float*)F.lds; LAS float* wsl = vn + 128 * 64; LAS float* mu = wsl + 128 * 128; LAS float* rs = mu + 128;
    {
        const int row = tid >> 2, part = tid & 3;
        const bf16* vr = H + (size_t)(p0 + row) * NH + HV + part * 64;
        float s = 0.f, s2 = 0.f;
#pragma unroll
        for (int q = 0; q < 8; ++q) { float v8[8]; unpack8(*(const u32x4*)(vr + q * 8), v8);
#pragma unroll
            for (int j = 0; j < 8; ++j) { s += v8[j]; s2 += v8[j] * v8[j]; } }
        s += shx(s, 1, F.lane); s += shx(s, 2, F.lane); s2 += shx(s2, 1, F.lane); s2 += shx(s2, 2, F.lane);
        const float mean = s * (1.0f / 256.0f), var = fmaxf(s2 * (1.0f / 256.0f) - mean * mean, 0.f);
        if (part == 0) { mu[row] = mean; rs[row] = 1.0f / sqrtf(var + LN_EPS); }
    }
    { const f32x4* src = (const f32x4*)(gm_ws + (size_t)(l * 4 + g) * 128 * 128);
        for (int i = tid; i < 128 * 128 / 4; i += NTHREADS) ((LAS f32x4*)wsl)[i] = src[i]; }
    __syncthreads();
    {
        const int row = tid >> 2, d0 = (tid & 3) * 16;
        const bf16* vr = H + (size_t)(p0 + row) * NH + HV + g * 64 + d0; const float* lg = gm_ln_g + l * 256 + g * 64 + d0;
        const float m = mu[row], r = rs[row];
#pragma unroll
        for (int q = 0; q < 2; ++q) { float v8[8]; unpack8(*(const u32x4*)(vr + q * 8), v8);
#pragma unroll
            for (int j = 0; j < 8; ++j) vn[row * 64 + d0 + q * 8 + j] = (v8[j] - m) * r * lg[q * 8 + j]; }
    }
    __syncthreads();
    {
        const int d = tid & 63, pg = (tid >> 6) * 16;
        float acc[16];
#pragma unroll
        for (int i = 0; i < 16; ++i) acc[i] = 0.f;
        for (int q = 0; q < 128; ++q) { const float xv = vn[q * 64 + d];
#pragma unroll
            for (int i = 0; i < 16; ++i) acc[i] += wsl[(pg + i) * 128 + q] * xv; }
        const float* bs = gm_bs + (size_t)(l * 4 + g) * 128;
#pragma unroll
        for (int i = 0; i < 16; ++i) { const int p = pg + i; const float mixed = acc[i] + bs[p];
            const float u = bf2f(H[(size_t)(p0 + p) * NH + HU + g * 64 + d]);
            YS[(size_t)(p0 + p) * D + g * 64 + d] = (bf16)f2bf(u * mixed); }
    }
    __syncthreads();
}
__device__ __forceinline__ void pool_item(int l, int item) {
    FRAME_SETUP;
    WS_PTRS; const float* pool_w = inp(I_POOLW); const float* pool_scale = inp(I_POOLS);
    const int tid = F.tid;
    const int g = item & 3, tb = item >> 2, b = tb >> 7, s0 = (tb & 127) * 64, p0 = b * SEQ + s0, half = 1 << g;
    LAS float* xr = (LAS float*)F.lds; LAS float* pl = xr + 80 * 64;
    for (int i = tid; i < 80 * 8; i += NTHREADS) { const int rr = i >> 3, cg = (i & 7) * 8, s = s0 - 8 + rr;
        float v8[8];
        if (s >= 0 && s < SEQ) unpack8(*(const u32x4*)(H + (size_t)(b * SEQ + s) * NH + HDX + g * 64 + cg), v8);
        else {
#pragma unroll
            for (int j = 0; j < 8; ++j) v8[j] = 0.f; }
#pragma unroll
        for (int j = 0; j < 8; ++j) xr[rr * 64 + cg + j] = v8[j]; }
    __syncthreads();
    {
        const int t = tid >> 3, cg = (tid & 7) * 8, s = s0 + t;
        const int lo = max(s - half, 0), hi = min(s + half, SEQ); const float inv = 1.0f / (float)(hi - lo);
#pragma unroll
        for (int j = 0; j < 8; ++j) { float sum = 0.f;
            for (int sp = lo; sp < hi; ++sp) sum += xr[(sp - s0 + 8) * 64 + cg + j];
            pl[t * 65 + cg + j] = sum * inv - xr[(t + 8) * 64 + cg + j]; }
    }
    __syncthreads();
    {
        const int o = tid & 63, tg = (tid >> 6) * 8;
        const float* pw = pool_w + (size_t)(l * 4 + g) * 64 * 64;
        float acc[8];
#pragma unroll
        for (int j = 0; j < 8; ++j) acc[j] = 0.f;
        for (int i = 0; i < 64; ++i) { const float w = pw[i * 64 + o];
#pragma unroll
            for (int j = 0; j < 8; ++j) acc[j] += pl[(tg + j) * 65 + i] * w; }
        const float sc = pool_scale[l * 256 + g * 64 + o];
#pragma unroll
        for (int j = 0; j < 8; ++j) YS[(size_t)(p0 + tg + j) * D + 768 + g * 64 + o] = (bf16)f2bf(acc[j] * sc);
    }
    __syncthreads();
}
__device__ __forceinline__ void att_item(int item) {
    FRAME_SETUP;
    WS_PTRS; const float* rel_bias = inp(I_RELB);
    const int tid = F.tid;
    const int pat = item >> 10, idx = item & 1023, dil = 1 << (2 * pat), L = SEQ / dil, nb = L >> 6;
    const int n = idx % nb, r = (idx / nb) % dil, h = (idx >> 7) & 3, b = idx >> 9;
    LAS float* Kl = (LAS float*)F.lds; LAS bf16* Vl = (LAS bf16*)(Kl + 192 * 64); LAS float* P = (LAS float*)(Vl + 192 * 64); LAS float* bt = P + 64 * 193;
    for (int i = tid; i < 192 * 8; i += NTHREADS) { const int kk = i >> 3, cg = (i & 7) * 8, kidx = 64 * (n - 1) + kk;
        u32x4 k8 = (u32x4){0u, 0u, 0u, 0u}, v8 = (u32x4){F.zu, F.zu, F.zu, F.zu};
        if (kidx >= 0 && kidx < L) { const bf16* row = H + (size_t)(b * SEQ + r + dil * kidx) * NH; k8 = *(const u32x4*)(row + HAK + h * 64 + cg); v8 = *(const u32x4*)(row + HAV + h * 64 + cg); }
        float kf[8]; unpack8(k8, kf);
#pragma unroll
        for (int j = 0; j < 8; ++j) Kl[kk * 64 + cg + j] = kf[j];
        *(LAS u32x4*)(Vl + kk * 64 + cg) = v8; }
    if (tid < 129) { const int j = tid - 64, rel = dil * j, na = rel < 0 ? -rel : rel;
        int bucket = na < 8 ? na : 8 + (na >= 15) + (na >= 27) + (na >= 50) + (na >= 91) + (na >= 166) + (na >= 305) + (na >= 559);
        if (rel > 0) bucket += 16;
        bt[tid] = rel_bias[bucket * 4 + h]; }
    const int q = tid & 63, part = tid >> 6;
    const int qpos = r + dil * (64 * n + q);
    float qreg[64];
    { const bf16* qrow = H + (size_t)(b * SEQ + qpos) * NH + HAQ + h * 64;
#pragma unroll
        for (int c8 = 0; c8 < 8; ++c8) { float t8[8]; unpack8(*(const u32x4*)(qrow + c8 * 8), t8);
#pragma unroll
            for (int j = 0; j < 8; ++j) qreg[c8 * 8 + j] = t8[j]; } }
    __syncthreads();
    for (int jj = 0; jj < 24; ++jj) { const int kk = part * 24 + jj;
        float dot = 0.f;
#pragma unroll
        for (int d4 = 0; d4 < 16; ++d4) { const f32x4 kv = *(const LAS f32x4*)(Kl + kk * 64 + d4 * 4);
            dot += qreg[d4 * 4] * kv[0] + qreg[d4 * 4 + 1] * kv[1] + qreg[d4 * 4 + 2] * kv[2] + qreg[d4 * 4 + 3] * kv[3]; }
        const int relj = kk - 64 - q, kidx = 64 * (n - 1) + kk;
        const bool valid = relj >= -64 && relj <= 64 && kidx >= 0 && kidx < L;
        const int bi = min(max(relj + 64, 0), 128);
        P[q * 193 + kk] = valid ? dot * 0.125f + bt[bi] : -1e30f; }
    __syncthreads();
    float mx = -3.0e38f;
    for (int kk = 0; kk < 192; ++kk) mx = fmaxf(mx, P[q * 193 + kk]);
    float lsum = 0.f;
    for (int kk = 0; kk < 192; ++kk) lsum += __expf(P[q * 193 + kk] - mx);
    __syncthreads();
    for (int jj = 0; jj < 24; ++jj) { const int kk = part * 24 + jj; P[q * 193 + kk] = __expf(P[q * 193 + kk] - mx); }
    __syncthreads();
    {
        const int d0 = part * 8;
        float o[8];
#pragma unroll
        for (int i = 0; i < 8; ++i) o[i] = 0.f;
        for (int kk = 0; kk < 192; ++kk) { const float p = P[q * 193 + kk]; float v8[8]; unpack8(*(const LAS u32x4*)(Vl + kk * 64 + d0), v8);
#pragma unroll
            for (int i = 0; i < 8; ++i) o[i] += p * v8[i]; }
        const float inv = 1.0f / lsum; const size_t tok = (size_t)b * SEQ + qpos;
        float* op = ATTO + ((size_t)pat * T + tok) * 256 + h * 64 + d0;
        *(f32x4*)op = (f32x4){o[0] * inv, o[1] * inv, o[2] * inv, o[3] * inv}; *(f32x4*)(op + 4) = (f32x4){o[4] * inv, o[5] * inv, o[6] * inv, o[7] * inv};
        if (part == 0) ATTL[((size_t)pat * T + tok) * 4 + h] = mx + __logf(lsum);
    }
    __syncthreads();
}
__device__ __forceinline__ void att_merge(int item) {
    FRAME_SETUP;
    WS_PTRS;
    const int tid = F.tid; const size_t tok = (size_t)item * 64 + (tid >> 3); const int sub = tid & 7, h = sub >> 1, c0 = h * 64 + (sub & 1) * 32;
    const float l0 = ATTL[tok * 4 + h], l1 = ATTL[((size_t)T + tok) * 4 + h], l2 = ATTL[((size_t)2 * T + tok) * 4 + h];
    const float M = fmaxf(l0, fmaxf(l1, l2)); float w0 = __expf(l0 - M), w1 = __expf(l1 - M), w2 = __expf(l2 - M); const float inv = 1.0f / (w0 + w1 + w2); w0 *= inv; w1 *= inv; w2 *= inv;
    const float* o0 = ATTO + tok * 256 + c0; const float* o1 = ATTO + ((size_t)T + tok) * 256 + c0; const float* o2 = ATTO + ((size_t)2 * T + tok) * 256 + c0;
    bf16* yp = YS + tok * D + 256 + c0;
#pragma unroll
    for (int q = 0; q < 4; ++q) { const f32x4 a0 = *(const f32x4*)(o0 + q * 8), a1 = *(const f32x4*)(o0 + q * 8 + 4), b0 = *(const f32x4*)(o1 + q * 8), b1 = *(const f32x4*)(o1 + q * 8 + 4), c0v = *(const f32x4*)(o2 + q * 8), c1v = *(const f32x4*)(o2 + q * 8 + 4);
        const f32x4 y0 = a0 * w0 + b0 * w1 + c0v * w2, y1 = a1 * w0 + b1 * w1 + c1v * w2;
        u32x4 w; w.x = pk2(y0[0], y0[1]); w.y = pk2(y0[2], y0[3]); w.z = pk2(y1[0], y1[1]); w.w = pk2(y1[2], y1[3]);
        *(u32x4*)(yp + q * 8) = w; }
}

__device__ __forceinline__ void ln1_router(int l) {
    FRAME_SETUP;
    WS_PTRS; const float* w_router = inp(I_WR); const float* ln1_g = inp(I_LN1G); const float* ln1_b = inp(I_LN1B);
    LAS float* wrl = (LAS float*)F.lds;
    for (int i = F.tid; i < D * NE; i += NTHREADS) { const int d = i >> 4, e = i & 15; wrl[e * D + d] = w_router[(size_t)l * D * NE + i]; }
    __syncthreads();
    const int lane = F.lane;
    const float* g1 = ln1_g + l * D; const float* b1 = ln1_b + l * D;
    for (int tok = F.bid * NWAVES + F.wave; tok < T; tok += F.G * NWAVES) {
        const f32x4* rr = (const f32x4*)(MGF + (size_t)tok * D) + lane;
        f32x4 v[4]; float s = 0.f;
#pragma unroll
        for (int j = 0; j < 4; ++j) { v[j] = rr[64 * j]; s += (v[j].x + v[j].y) + (v[j].z + v[j].w); }
        const float mean = wave_sum(s, lane) * (1.f / D); float s2 = 0.f;
#pragma unroll
        for (int j = 0; j < 4; ++j) { v[j] = v[j] - mean; s2 += (v[j].x * v[j].x + v[j].y * v[j].y) + (v[j].z * v[j].z + v[j].w * v[j].w); }
        const float rstd = 1.f / sqrtf(wave_sum(s2, lane) * (1.f / D) + LN_EPS);
        f32x4 xv[4];
#pragma unroll
        for (int j = 0; j < 4; ++j) { const int d = 4 * lane + 256 * j;
            const f32x4 gg = *(const f32x4*)(g1 + d), bb = *(const f32x4*)(b1 + d);
            xv[j] = v[j] * rstd * gg + bb;
            *((f32x4*)(XF + (size_t)tok * D + d)) = xv[j];
            u32x2 w; w.x = pk2(xv[j].x, xv[j].y); w.y = pk2(xv[j].z, xv[j].w); *((u32x2*)(XB + (size_t)tok * D + d)) = w; }
        float lg[16];
#pragma unroll
        for (int e = 0; e < 16; ++e) { float p = 0.f;
#pragma unroll
            for (int j = 0; j < 4; ++j) { const f32x4 wv = *(const LAS f32x4*)(wrl + e * D + 4 * lane + 256 * j); p += (xv[j].x * wv.x + xv[j].y * wv.y) + (xv[j].z * wv.z + xv[j].w * wv.w); }
            lg[e] = p; __builtin_amdgcn_sched_barrier(0); }
        float mx = -3.0e38f;
#pragma unroll
        for (int e = 0; e < 16; ++e) { lg[e] = wave_sum(lg[e], lane); mx = fmaxf(mx, lg[e]); }
        float se = 0.f;
#pragma unroll
        for (int e = 0; e < 16; ++e) { lg[e] = __expf(lg[e] - mx); se += lg[e]; }
        const float inv = 1.0f / se; float mine = 0.f;
#pragma unroll
        for (int e = 0; e < 16; ++e) mine = (lane == e) ? lg[e] * inv : mine;
        const int b = tok >> 13, sp = tok & (SEQ - 1);
        if (lane < 16) AFF[((size_t)(b * NE + lane)) * SEQ + sp] = mine;
    }
    __syncthreads();
}
__device__ __forceinline__ unsigned block_excl_scan(LAS unsigned* sc, unsigned val, int tid) {
    sc[tid] = val; __syncthreads();
    for (int off = 1; off < NTHREADS; off <<= 1) { const unsigned v = tid >= off ? sc[tid - off] : 0u; __syncthreads(); sc[tid] += v; __syncthreads(); }
    const unsigned r = sc[tid] - val; __syncthreads(); return r;
}
__device__ __forceinline__ void topk_item(int be) {
    FRAME_SETUP;
    WS_PTRS;
    const int tid = F.tid, b = be >> 4;
    const float* aff = AFF + (size_t)be * SEQ;
    LAS unsigned* hist = (LAS unsigned*)F.lds; LAS unsigned* sfx = hist + 256; LAS unsigned* sc = sfx + 256; LAS unsigned* misc = sc + 512; LAS int* idxl = (LAS int*)(misc + 4);
    unsigned key[16];
    { const u32x4* ap = (const u32x4*)(aff + tid * 16);
#pragma unroll
        for (int q = 0; q < 4; ++q) { const u32x4 w = ap[q]; key[q * 4] = w.x; key[q * 4 + 1] = w.y; key[q * 4 + 2] = w.z; key[q * 4 + 3] = w.w; } }
    unsigned prefix = 0u, kth = CAP;
#pragma unroll
    for (int pass = 0; pass < 4; ++pass) { const int shift = 24 - 8 * pass;
        if (tid < 256) hist[tid] = 0u;
        __syncthreads();
#pragma unroll
        for (int i = 0; i < 16; ++i) { const bool in = pass == 0 ? true : ((key[i] >> (shift + 8)) == (prefix >> (shift + 8))); if (in) __hip_atomic_fetch_add(&hist[(key[i] >> shift) & 255u], 1u, __ATOMIC_RELAXED, __HIP_MEMORY_SCOPE_WORKGROUP); }
        __syncthreads();
        if (tid < 256) sfx[tid] = hist[tid];
        __syncthreads();
        for (int off = 1; off < 256; off <<= 1) { unsigned v = 0u; if (tid < 256 && tid + off < 256) v = sfx[tid + off]; __syncthreads(); if (tid < 256) sfx[tid] += v; __syncthreads(); }
        if (tid < 256) { const unsigned incl = sfx[tid], excl = incl - hist[tid]; if (excl < kth && kth <= incl) { misc[0] = (unsigned)tid; misc[1] = kth - excl; } }
        __syncthreads();
        prefix |= misc[0] << shift; kth = misc[1];
        __syncthreads();
    }
    unsigned ceq = 0u;
#pragma unroll
    for (int i = 0; i < 16; ++i) ceq += (key[i] == prefix) ? 1u : 0u;
    unsigned eqrank = block_excl_scan(sc, ceq, tid);
    unsigned selmask = 0u, csel = 0u;
#pragma unroll
    for (int i = 0; i < 16; ++i) { bool sel = key[i] > prefix; if (key[i] == prefix) { sel = eqrank < kth; ++eqrank; } if (sel) { selmask |= 1u << i; ++csel; } }
    unsigned slot = block_excl_scan(sc, csel, tid);
#pragma unroll
    for (int i = 0; i < 16; ++i) { const int s = tid * 16 + i;
        if (selmask & (1u << i)) { if (slot < (unsigned)CAP) { IDX[be * CAP + slot] = s; GATE[be * CAP + slot] = __uint_as_float(key[i]); idxl[slot] = s; } SLOT[(size_t)be * SEQ + s] = (int)slot; ++slot; }
        else SLOT[(size_t)be * SEQ + s] = -1; }
    __syncthreads();
    for (int sl = F.wave; sl < CAP; sl += NWAVES) { const u32x4* src = (const u32x4*)(XB + ((size_t)b * SEQ + idxl[sl]) * D); u32x4* dst = (u32x4*)(XS + ((size_t)be * CAP + sl) * D);
        dst[F.lane] = src[F.lane]; dst[F.lane + 64] = src[F.lane + 64]; }
    __syncthreads();
}
__device__ __forceinline__ void combine_ln2(int l) {
    FRAME_SETUP;
    WS_PTRS; const float* ln2_g = inp(I_LN2G); const float* ln2_b = inp(I_LN2B); float* out = outp();
    const int lane = F.lane;
    const float* g2 = ln2_g + l * D; const float* b2 = ln2_b + l * D;
    for (int tok = F.bid * NWAVES + F.wave; tok < T; tok += F.G * NWAVES) {
        const int b = tok >> 13, sp = tok & (SEQ - 1);
        f32x4 v[4];
#pragma unroll
        for (int j = 0; j < 4; ++j) v[j] = *((const f32x4*)(XF + (size_t)tok * D + 4 * lane + 256 * j)) * ALPHA;
        for (int e = 0; e < NE; ++e) { const int slot = SLOT[((size_t)(b * NE + e)) * SEQ + sp];
            if (slot >= 0) { const bf16* yr = YE + ((size_t)(b * NE + e) * CAP + slot) * D;
#pragma unroll
                for (int j = 0; j < 4; ++j) { const u32x2 w = *(const u32x2*)(yr + 4 * lane + 256 * j);
                    v[j] += (f32x4){__uint_as_float(w.x << 16), __uint_as_float(w.x & 0xffff0000u), __uint_as_float(w.y << 16), __uint_as_float(w.y & 0xffff0000u)}; } } }
        float s = 0.f;
#pragma unroll
        for (int j = 0; j < 4; ++j) s += (v[j].x + v[j].y) + (v[j].z + v[j].w);
        const float mean = wave_sum(s, lane) * (1.f / D); float s2 = 0.f;
#pragma unroll
        for (int j = 0; j < 4; ++j) { v[j] = v[j] - mean; s2 += (v[j].x * v[j].x + v[j].y * v[j].y) + (v[j].z * v[j].z + v[j].w * v[j].w); }
        const float rstd = 1.f / sqrtf(wave_sum(s2, lane) * (1.f / D) + LN_EPS);
#pragma unroll
        for (int j = 0; j < 4; ++j) { const int d = 4 * lane + 256 * j;
            const f32x4 xv = v[j] * rstd * *(const f32x4*)(g2 + d) + *(const f32x4*)(b2 + d);
            *((f32x4*)(XF + (size_t)tok * D + d)) = xv;
            u32x2 w; w.x = pk2(xv.x, xv.y); w.y = pk2(xv.z, xv.w); *((u32x2*)(XB + (size_t)tok * D + d)) = w;
            if (l == DEPTH - 1) *((f32x4*)(out + (size_t)tok * D + d)) = xv; }
    }
}

constexpr int PH_PER_LAYER = 11, N_PHASES = 1 + DEPTH * PH_PER_LAYER;
struct Args { const float* in[22]; float* out; unsigned char* ws; int ph_lo, ph_hi; };
__device__ __forceinline__ void phase_mix1(int l) { FRAME_SETUP;
    for (int it = F.bid; it < 1024 + 512 + 1024; it += F.G) { if (it < 1024) mlstm_c1(l, it); else if (it < 1536) gmlp_item(l, it - 1024); else pool_item(l, it - 1536); } }
__device__ __forceinline__ void phase_mix2(int l) { FRAME_SETUP;
    for (int it = F.bid; it < 130 + 3072; it += F.G) { if (it < 130) mlstm_scan(it); else att_item(it - 130); } }
__device__ __forceinline__ void phase_mix3(int l) { FRAME_SETUP;
    for (int it = F.bid; it < 1024 + 256; it += F.G) { if (it < 1024) mlstm_c3(l, it); else att_merge(it - 1024); } }
__device__ __forceinline__ void phase_topk() { FRAME_SETUP; for (int it = F.bid; it < BATCH * NE; it += F.G) topk_item(it); }
__device__ __forceinline__ void phase_g1(int l) { FRAME_SETUP; WS_PTRS;
    pg8::GemmP g{D, D, D}; SchedG1 S{F.G, F.bid, (const char*)XB, (const char*)wl(ws, l, OW_IN)}; EpiG1 E{H, GI, BIN + (size_t)l * NINP};
    pg8::gemm_phase<EpiG1, SchedG1, true>(F.lds, F.tid, g, S, E); }
__device__ __forceinline__ void phase_g2(int l) { FRAME_SETUP; WS_PTRS;
    pg8::GemmP g{256, D, 256}; SchedG2 S{F.G, F.bid, (const char*)YS, (const char*)wl(ws, l, OW_B)}; EpiG2 E{H, MGF, MGB};
    pg8::gemm_phase<EpiG2, SchedG2, true>(F.lds, F.tid, g, S, E); }
__device__ __forceinline__ void phase_g3(int l) { FRAME_SETUP; WS_PTRS;
    pg8::GemmP g{D, D, D}; SchedG3 S{F.G, F.bid, (const char*)MGB, (const char*)wl(ws, l, OW_O)}; EpiG3 E{XF, MGF};
    pg8::gemm_phase<EpiG3, SchedG3, true>(F.lds, F.tid, g, S, E); }
__device__ __forceinline__ void phase_g4(int l) { FRAME_SETUP; WS_PTRS;
    pg8::GemmP g{D, D, D}; SchedG4 S{F.G, F.bid, (const char*)XS, (const char*)wl(ws, l, OW_13)}; EpiG4 E{HID};
    pg8::gemm_phase<EpiG4, SchedG4, true>(F.lds, F.tid, g, S, E); }
__device__ __forceinline__ void phase_g5(int l) { FRAME_SETUP; WS_PTRS;
    pg8::GemmP g{FF, FF, FF}; SchedG5 S{F.G, F.bid, (const char*)HID, (const char*)wl(ws, l, OW_2)}; EpiG5 E{GATE, YE};
    pg8::gemm_phase<EpiG5, SchedG5, true>(F.lds, F.tid, g, S, E); }

__global__ void __launch_bounds__(NTHREADS, 2) fwd_kernel(Args args) {
    { LAS unsigned char* l0 = lds_base(); for (int u = threadIdx.x; u < (LDS_BYTES - LDSCTL_OFF) / 4; u += NTHREADS) ((LAS unsigned*)(l0 + LDSCTL_OFF))[u] = 0u; }
    __syncthreads();
    XcdBarrier bar; bar.bar = (unsigned*)(args.ws + WS_CTL) + CW_BAR; bar.x = 0; bar.st = nullptr;
#if !MK_PER_PHASE
    bar = xcd_barrier_post((unsigned*)(args.ws + WS_CTL) + CW_BAR, (volatile LAS unsigned*)(lds_base() + MISC_OFF) + 8);
#endif
    const int lo = args.ph_lo, hi = args.ph_hi;
    for (int ph = lo; ph < hi; ++ph) {
        if (ph == 0) { if (PHEN(15)) p0_prologue(); }
        else {
            const int l = (ph - 1) / PH_PER_LAYER, sp = (ph - 1) % PH_PER_LAYER;
            if (sp == 0) { if (PHEN(0)) phase_g1(l); }
            else if (sp == 1) { if (PHEN(1)) phase_mix1(l); }
            else if (sp == 2) { if (PHEN(2)) phase_mix2(l); }
            else if (sp == 3) { if (PHEN(3)) phase_mix3(l); }
            else if (sp == 4) { if (PHEN(4)) phase_g2(l); }
            else if (sp == 5) { if (PHEN(5)) phase_g3(l); }
            else if (sp == 6) { if (PHEN(6)) ln1_router(l); }
            else if (sp == 7) { if (PHEN(7)) phase_topk(); }
            else if (sp == 8) { if (PHEN(8)) phase_g4(l); }
            else if (sp == 9) { if (PHEN(9)) phase_g5(l); }
            else { if (PHEN(10)) combine_ln2(l); }
        }
        if (ph + 1 < hi) {
#if !MK_PER_PHASE
            xcd_barrier(bar);
#endif
        }
    }
}

extern "C" void kernel_launch(void* const* d_in, const int* in_sizes, int n_in, void* d_out, int out_size, void* d_ws, size_t ws_size, hipStream_t stream) {
    static int grid = 0;
    if (grid == 0) {
        if (n_in != 22 || in_sizes[0] != T * D || out_size != T * D || ws_size < WS_END) {
            fprintf(stderr, "kernel_launch: unexpected shapes: n_in %d in0 %d out %d ws %zu (need %zu); nothing launched\n", n_in, n_in > 0 ? in_sizes[0] : -1, out_size, ws_size, (size_t)WS_END); grid = -1; return; }
        int dev = 0, cus = 0;
        if (hipGetDevice(&dev) != hipSuccess || hipDeviceGetAttribute(&cus, hipDeviceAttributeMultiprocessorCount, dev) != hipSuccess) { grid = -1; return; }
        if (hipFuncSetAttribute((const void*)fwd_kernel, hipFuncAttributeMaxDynamicSharedMemorySize, LDS_BYTES) != hipSuccess) { fprintf(stderr, "kernel_launch: hipFuncSetAttribute failed\n"); grid = -1; return; }
        int per_cu = 0;
        if (hipOccupancyMaxActiveBlocksPerMultiprocessor(&per_cu, (const void*)fwd_kernel, NTHREADS, LDS_BYTES) != hipSuccess || per_cu < 1)
            fprintf(stderr, "kernel_launch: note: occupancy query reports %d workgroups per CU\n", per_cu);
        (void)hipGetLastError();
        grid = cus;
    }
    if (grid < 0) return;
    (void)hipMemsetAsync((char*)d_ws + WS_CTL, 0, CTL_ZERO_BYTES, stream);
    Args a{};
    for (int i = 0; i < 22; ++i) a.in[i] = (const float*)d_in[i];
    a.out = (float*)d_out; a.ws = (unsigned char*)d_ws;
#if MK_PER_PHASE
    for (int ph = 0; ph < N_PHASES; ++ph) { a.ph_lo = ph; a.ph_hi = ph + 1; hipLaunchKernelGGL(fwd_kernel, dim3(grid), dim3(NTHREADS), LDS_BYTES, stream, a); }
#else
    a.ph_lo = 0; a.ph_hi = N_PHASES; hipLaunchKernelGGL(fwd_kernel, dim3(grid), dim3(NTHREADS), LDS_BYTES, stream, a);
#endif
}
```

```cpp
#include <hip/hip_runtime.h>
#include <cstdio>
#include <cstdint>

#ifndef PH_MASK
#define PH_MASK 0xFFFF
#endif
#define PHEN(k) ((PH_MASK >> (k)) & 1)
#ifndef PROBE_MASK
#define PROBE_MASK 0
#endif
#ifndef MK_PER_PHASE
#define MK_PER_PHASE 0
#endif

#define GAS __attribute__((address_space(1)))
#define LAS __attribute__((address_space(3)))
typedef unsigned short bf16;
typedef short bf16x8 __attribute__((ext_vector_type(8)));
typedef float f32x4 __attribute__((ext_vector_type(4)));
typedef float f32x2 __attribute__((ext_vector_type(2)));
typedef unsigned u32x4 __attribute__((ext_vector_type(4)));
typedef unsigned u32x2 __attribute__((ext_vector_type(2)));
typedef GAS unsigned gu32;
#define RLX_AGENT __ATOMIC_RELAXED, __HIP_MEMORY_SCOPE_AGENT
#define LDS_WAIT() asm volatile("s_waitcnt lgkmcnt(0)" ::: "memory")
#define VM_WAIT() asm volatile("s_waitcnt vmcnt(0)" ::: "memory")

constexpr int BATCH = 2, SEQ = 8192, D = 1024, T = BATCH * SEQ, DEPTH = 4;
constexpr int NIN = 6672;
constexpr int NH = 6656;
constexpr int NINP = 6912;
constexpr int NE = 16, CAP = 1024, FF = 1024, NSLOT = BATCH * NE * CAP;
constexpr float ALPHA = 1.6817928305074292f;
constexpr float LN_EPS = 1e-5f;
constexpr int HU = 0, HV = 256, HAQ = 512, HAK = 768, HAV = 1024, HCQ = 1280, HCK = 1536, HCV = 1792, HCO = 2048, HDX = 2304, HG = 2560;

constexpr size_t MiB = 1u << 20;
constexpr size_t WS_CTL = 0, CTL_ZERO_BYTES = 64 * 1024;
constexpr size_t WS_BIN = 1 * MiB;
constexpr size_t WS_WSB = 1 * MiB + 512 * 1024;
constexpr size_t WS_PWT = 1 * MiB + 256 * 1024;
constexpr size_t WS_W = 2 * MiB, LW = 114 * MiB;
constexpr size_t OW_IN = 0, OW_B = 14 * MiB, OW_O = 16 * MiB, OW_13 = 18 * MiB, OW_2 = 82 * MiB;
constexpr size_t WS_XF = 458 * MiB;
constexpr size_t WS_STAT = WS_XF;
constexpr size_t WS_WRT = 1 * MiB + 128 * 1024;
constexpr size_t WS_XB = 522 * MiB;
constexpr size_t WS_BIG = 554 * MiB;
constexpr size_t WS_XS = WS_BIG, WS_HID = WS_BIG + 64 * MiB, WS_YE = WS_BIG + 128 * MiB;
constexpr size_t WS_GI = 762 * MiB;
constexpr size_t WS_ATTO = 763 * MiB;
constexpr size_t WS_ATTL = 811 * MiB;
constexpr size_t WS_YS = 812 * MiB;
constexpr size_t WS_MGF = 844 * MiB;
constexpr size_t WS_MGB = 908 * MiB;
constexpr size_t WS_QC = 940 * MiB, WS_KC = 956 * MiB;
constexpr size_t WS_DC = 972 * MiB;
constexpr size_t WS_DG = 1005 * MiB;
constexpr size_t WS_AFF = 1006 * MiB;
constexpr size_t WS_IDX = 1007 * MiB;
constexpr size_t WS_GATE = 1007 * MiB + 512 * 1024;
constexpr size_t WS_SLOT = 1008 * MiB;
constexpr size_t WS_END = 1009 * MiB;

constexpr int CW_BAR = 4096;

constexpr int RING_BYTES = 131072;
constexpr int LDSCTL_OFF = RING_BYTES, MISC_OFF = LDSCTL_OFF + 320;
constexpr int LDS_BYTES = 147456;
constexpr int NWAVES = 8, NTHREADS = 512;

__device__ __forceinline__ float bf2f(unsigned v) { return __uint_as_float(v << 16); }
__device__ __forceinline__ unsigned f2bf(float f) { unsigned u = __float_as_uint(f); return (u + 0x7fffu + ((u >> 16) & 1u)) >> 16; }
typedef __bf16 bf16x2_t_ __attribute__((ext_vector_type(2)));
__device__ __forceinline__ unsigned pk2(float lo, float hi) { f32x2 v = {lo, hi}; bf16x2_t_ b = __builtin_convertvector(v, bf16x2_t_); return __builtin_bit_cast(unsigned, b); }
__device__ __forceinline__ float rcpf_(float x) { return __builtin_amdgcn_rcpf(x); }
__device__ __forceinline__ void unpack8(const u32x4 w, float (&o)[8]) {
    o[0] = __uint_as_float(w.x << 16); o[1] = __uint_as_float(w.x & 0xffff0000u);
    o[2] = __uint_as_float(w.y << 16); o[3] = __uint_as_float(w.y & 0xffff0000u);
    o[4] = __uint_as_float(w.z << 16); o[5] = __uint_as_float(w.z & 0xffff0000u);
    o[6] = __uint_as_float(w.w << 16); o[7] = __uint_as_float(w.w & 0xffff0000u);
}
__device__ __forceinline__ float sigmoidf_(float x) { return rcpf_(1.0f + __expf(-x)); }
__device__ __forceinline__ float siluf_(float x) { return x * rcpf_(1.0f + __expf(-x)); }
__device__ __forceinline__ float gelu_tanh(float x) { const float u = 1.5957691216057308f * (x + 0.044715f * x * x * x); return x * rcpf_(1.0f + __expf(-u)); }
__device__ __forceinline__ float logsigmoidf_(float z) { return fminf(z, 0.f) - log1pf(__expf(-fabsf(z))); }
__device__ __forceinline__ float shx(float v, int o, int lane) { return __int_as_float(__builtin_amdgcn_ds_bpermute((lane ^ o) << 2, __float_as_int(v))); }
template <int CTRL> __device__ __forceinline__ float dpp_mov(float v) { return __int_as_float(__builtin_amdgcn_update_dpp(0, __float_as_int(v), CTRL, 0xF, 0xF, false)); }
__device__ __forceinline__ float wave_sum(float v, int lane) { (void)lane;
    v += dpp_mov<0xB1>(v); v += dpp_mov<0x4E>(v); v += dpp_mov<0x141>(v); v += dpp_mov<0x140>(v);
    const int iv = __float_as_int(v);
    return (__int_as_float(__builtin_amdgcn_readlane(iv, 0)) + __int_as_float(__builtin_amdgcn_readlane(iv, 16))) + (__int_as_float(__builtin_amdgcn_readlane(iv, 32)) + __int_as_float(__builtin_amdgcn_readlane(iv, 48)));
}

#define XB_TMO      128
#define XB_XCNT(j)  (256  + 64 * (j))
#define XB_XSUB(j)  (1280 + 64 * (j))
#define XB_XGEN(j)  (2304 + 64 * (j))
#define XB_TOP      3328
#define XB_TOPGEN   3392
#define XCD_BAR_WORDS 3456
#define XB_SPIN_CAP (1u << 18)
__device__ __forceinline__ unsigned xb_ld(unsigned* p)              { return __hip_atomic_load(p, __ATOMIC_RELAXED, __HIP_MEMORY_SCOPE_AGENT); }
__device__ __forceinline__ unsigned xb_add(unsigned* p, unsigned v) { return __hip_atomic_fetch_add(p, v, __ATOMIC_RELAXED, __HIP_MEMORY_SCOPE_AGENT); }
__device__ __forceinline__ unsigned xb_xcc_id() { return (unsigned)__builtin_amdgcn_s_getreg((3 << 11) | 20) & 0xFu; }
#define XB_SPIN(cond, bar) do { unsigned _sp = 0; while (cond) { __builtin_amdgcn_s_sleep(1); \
    if ((++_sp & 255u) == 0u) { if (xb_ld(&(bar)[XB_TMO])) break; if (_sp > XB_SPIN_CAP) { atomicAdd(&(bar)[XB_TMO], 1u); break; } } } } while (0)
struct XcdBarrier { unsigned* bar; unsigned x; volatile LAS unsigned* st; };
__device__ __forceinline__ XcdBarrier xcd_barrier_post(unsigned* bar, volatile LAS unsigned* st) {
    XcdBarrier b; b.bar = bar; b.x = xb_xcc_id(); b.st = st;
    if (threadIdx.x == 0) (void)xb_add(&bar[XB_XCNT(b.x)], 1u);
    return b;
}
__device__ __forceinline__ void xcd_barrier_complete(unsigned* bar, unsigned x, unsigned& nloc, unsigned& nx) {
    const unsigned G = gridDim.x * gridDim.y * gridDim.z;
    unsigned sum, cnt, mine, sp = 0u;
    for (;;) {
        sum = 0u; cnt = 0u; mine = 0u;
#pragma unroll
        for (unsigned j = 0; j < 16; ++j) { const unsigned c = xb_ld(&bar[XB_XCNT(j)]); sum += c; cnt += (c > 0u) ? 1u : 0u; mine = (j == x) ? c : mine; }
        if (sum == G) break;
        __builtin_amdgcn_s_sleep(1);
        if ((++sp & 255u) == 0u) { if (xb_ld(&bar[XB_TMO])) break; if (sp > XB_SPIN_CAP) { atomicAdd(&bar[XB_TMO], 1u); break; } }
    }
    nloc = mine > 0u ? mine : 1u; nx = cnt > 0u ? cnt : 1u;
}
__device__ __forceinline__ void xcd_barrier(const XcdBarrier& b) {
    asm volatile("s_waitcnt vmcnt(0)" ::: "memory");
    __syncthreads();
    if (threadIdx.x == 0) {
        unsigned* bar = b.bar;
        __builtin_amdgcn_s_waitcnt(0);
        unsigned nloc = b.st[0], nx = b.st[1];
        if (nloc == 0u) { xcd_barrier_complete(bar, b.x, nloc, nx); b.st[0] = nloc; b.st[1] = nx; }
        const unsigned old = xb_add(&bar[XB_XSUB(b.x)], 1u);
        const unsigned gen = old / nloc;
        if (old + 1u == (gen + 1u) * nloc) {
            __builtin_amdgcn_fence(__ATOMIC_RELEASE, "agent");
            asm volatile("s_waitcnt vmcnt(0)" ::: "memory");
            const unsigned og = xb_add(&bar[XB_TOP], 1u);
            const unsigned tg = og / nx;
            if (og + 1u == (tg + 1u) * nx) xb_add(&bar[XB_TOPGEN], 1u);
            else XB_SPIN(xb_ld(&bar[XB_TOPGEN]) == tg, bar);
            __builtin_amdgcn_fence(__ATOMIC_ACQUIRE, "agent");
            xb_add(&bar[XB_XGEN(b.x)], 1u);
            asm volatile("s_waitcnt vmcnt(0)" ::: "memory");
        } else {
            XB_SPIN(xb_ld(&bar[XB_XGEN(b.x)]) == gen, bar);
            __builtin_amdgcn_fence(__ATOMIC_ACQUIRE, "agent");
            asm volatile("s_waitcnt vmcnt(0)" ::: "memory");
        }
    }
    __syncthreads();
}

namespace pg8 {
constexpr int BM = 256, BK = 64, HALF = 128, HTB = HALF * BK * 2, STAGE_BYTES = 8 * HTB, NXCD = 8, WGM = 8;
__host__ __device__ __forceinline__ int lds_byte(int r, int c) { const int st = (r >> 4) * 2 + (c >> 5), rr = r & 15, cc = c & 31, ob = rr * 64 + cc * 2; return st * 1024 + (ob ^ (((ob >> 9) & 1) << 5)); }
__host__ __device__ __forceinline__ void stage_rc(int b, int& R, int& C) { const int st = b / 1024, sb = b % 1024, swz = sb ^ (((sb >> 9) & 1) << 5); R = (st >> 1) * 16 + swz / 64; C = (st & 1) * 32 + (swz % 64) / 2; }
__host__ __device__ __forceinline__ int perm32(int rho) { const int n = rho >> 4, i = rho & 15; return 8 * (i >> 2) + 4 * n + (i & 3); }

struct Unit { int pm, pn, aux; const char* A; const char* B; };
struct GemmP { int K, lda, ldb; };

__device__ __forceinline__ bool tile_of(int i, int G, int c, int nM, int nN, int& pm, int& pn) {
    const int nwg = nM * nN; const int L = i * G + c; if (L >= nwg) return false;
    int wgid = L; { const int q = nwg / NXCD, r = nwg % NXCD, xcd = wgid % NXCD, off = wgid / NXCD; wgid = (xcd < r ? xcd * (q + 1) : r * (q + 1) + (xcd - r) * q) + off; }
    const int nig = WGM * nN, gid = wgid / nig, fm = gid * WGM, gsz = (nM - fm) < WGM ? (nM - fm) : WGM;
    pm = fm + ((wgid % nig) % gsz); pn = (wgid % nig) / gsz; return true;
}

__device__ __forceinline__ unsigned cvt_pk_bf16(float lo, float hi) { unsigned r; asm volatile("v_cvt_pk_bf16_f32 %0, %1, %2" : "=v"(r) : "v"(lo), "v"(hi)); return r; }

template <class Epi, class Sched, bool ALIGN_EPI>
__device__ __forceinline__ void gemm_phase(LAS unsigned char* lds, const int tid, const GemmP g, const Sched& S, const Epi& E) {
    const int wid = __builtin_amdgcn_readfirstlane(tid >> 6), lane = tid & 63, wr = wid >> 2, wc = wid & 3, fr = lane & 15, fq = lane >> 4;
    const int K = g.K, nt = K / BK;
    unsigned voffB[2]; int Ri[2], Ci[2];
#pragma unroll
    for (int i = 0; i < 2; ++i) { int R, C; stage_rc(tid * 16 + i * 8192, R, C); const int Rb = Epi::PERM ? ((R & ~31) + perm32(R & 31)) : R;
        Ri[i] = R; Ci[i] = C; voffB[i] = (unsigned)(Rb * g.ldb + C) * 2u; }
    const size_t kstep = (size_t)(BK * 2);
    const size_t hstepB = (size_t)HALF * g.ldb * 2;
    unsigned vA0[2], vA1[2], nvA0[2], nvA1[2];
    const unsigned ldsw = (unsigned)wid * 1024u;
    const int aoff = lds_byte(wr * 64 + fr, fq * 8), boff = lds_byte(wc * 32 + fr, fq * 8);
#define PG8_SA(b, h) (((b) * 2 + (h)) * HTB)
#define PG8_SB(b, h) ((4 + (b) * 2 + (h)) * HTB)
#define PG8_STAGE(bufoff, gbase, voff) do { _Pragma("unroll") for (int _i = 0; _i < 2; ++_i) \
        __builtin_amdgcn_global_load_lds((const unsigned*)((const char*)(gbase) + (voff)[_i]), (LAS unsigned*)(lds + (bufoff) + ldsw + _i * 8192), 16, 0, 0); } while (0)
#define PG8_LDA(dst, b, h) do { _Pragma("unroll") for (int m = 0; m < 4; ++m) _Pragma("unroll") for (int k = 0; k < 2; ++k) dst[m][k] = *(const LAS bf16x8*)(lds + PG8_SA(b, h) + aoff + m * 2048 + k * 1024); } while (0)
#define PG8_LDB(dst, b, h) do { _Pragma("unroll") for (int n = 0; n < 2; ++n) _Pragma("unroll") for (int k = 0; k < 2; ++k) dst[n][k] = *(const LAS bf16x8*)(lds + PG8_SB(b, h) + boff + n * 2048 + k * 1024); } while (0)
#define PG8_MMA(ai, bj, At, Bt) do { __builtin_amdgcn_s_setprio(1); _Pragma("unroll") for (int m = 0; m < 4; ++m) _Pragma("unroll") for (int n = 0; n < 2; ++n) _Pragma("unroll") for (int k = 0; k < 2; ++k) \
        acc[ai][bj][m][n] = __builtin_amdgcn_mfma_f32_16x16x32_bf16(Bt[n][k], At[m][k], acc[ai][bj][m][n], 0, 0, 0); __builtin_amdgcn_s_setprio(0); } while (0)
#define PG8_WAIT_V(n) asm volatile("s_waitcnt vmcnt(" #n ")" ::: "memory")
#define PG8_WAIT_L(n) asm volatile("s_waitcnt lgkmcnt(" #n ")" ::: "memory")
#define PG8_BAR __builtin_amdgcn_s_barrier()
#define PG8_SCHED __builtin_amdgcn_sched_barrier(0)
    Unit cur, nxt; int ui = 0;
    if (!S.next(0, cur)) return;
    float zf = 0.f; asm volatile("" : "+v"(zf));
    f32x4 acc[2][2][4][2];
#pragma unroll
    for (int a = 0; a < 2; ++a)
#pragma unroll
        for (int b = 0; b < 2; ++b)
#pragma unroll
            for (int m = 0; m < 4; ++m)
#pragma unroll
                for (int n = 0; n < 2; ++n) acc[a][b][m][n] = (f32x4){zf, zf, zf, zf};
    bf16x8 At[4][2], B0[2][2], B1[2][2];
    typename Epi::Pre pre;
    const char* cA = cur.A; const char* cB = cur.B;
    S.a_off(cur, g.lda, Ri, Ci, vA0, vA1);
    PG8_STAGE(PG8_SB(0, 0), cB, voffB); PG8_STAGE(PG8_SB(0, 1), cB + hstepB, voffB); PG8_STAGE(PG8_SA(0, 0), cA, vA0); PG8_STAGE(PG8_SA(0, 1), cA, vA1);
    if (wr == 1) PG8_BAR;
    PG8_WAIT_V(2); PG8_BAR;
    PG8_STAGE(PG8_SB(1, 0), cB + kstep, voffB); PG8_STAGE(PG8_SA(1, 0), cA + kstep, vA0); PG8_STAGE(PG8_SB(1, 1), cB + hstepB + kstep, voffB);
    PG8_WAIT_V(6); PG8_BAR;
    for (;;) {
        const bool has_next = S.next(ui + 1, nxt);
        const char* nA = has_next ? nxt.A : cA; const char* nB = has_next ? nxt.B : cB;
        if (has_next) S.a_off(nxt, g.lda, Ri, Ci, nvA0, nvA1); else { nvA0[0] = vA0[0]; nvA0[1] = vA0[1]; nvA1[0] = vA1[0]; nvA1[1] = vA1[1]; }
        for (int t = 0; t < nt; t += 2) {
            if constexpr (Epi::HOOK) { if (t != 0 && (t & 3) == 0) E.hook(acc, cur, t >> 2, wr, wc, fr, fq); }
            const bool last = (t == nt - 2);
            if (last) E.prefetch(cur, wr, wc, fr, fq, pre);
            const char* a1 = cA + (size_t)(t + 1) * kstep;
            const char* a2 = last ? nA : cA + (size_t)(t + 2) * kstep; const char* b2 = last ? nB : cB + (size_t)(t + 2) * kstep;
            const char* a3 = a2 + kstep; const char* b3 = b2 + kstep;
            unsigned w0[2], w1[2];
            w0[0] = last ? nvA0[0] : vA0[0]; w0[1] = last ? nvA0[1] : vA0[1]; w1[0] = last ? nvA1[0] : vA1[0]; w1[1] = last ? nvA1[1] : vA1[1];
            PG8_LDB(B0, 0, 0); PG8_LDB(B1, 0, 1); PG8_SCHED; PG8_LDA(At, 0, 0); PG8_STAGE(PG8_SA(1, 1), a1, vA1);
            PG8_WAIT_V(8); PG8_WAIT_L(0); PG8_BAR; PG8_MMA(0, 0, At, B0); PG8_MMA(0, 1, At, B1); PG8_BAR; PG8_SCHED;
            PG8_LDA(At, 0, 1); PG8_STAGE(PG8_SB(0, 0), b2, voffB); PG8_STAGE(PG8_SB(0, 1), b2 + hstepB, voffB); PG8_STAGE(PG8_SA(0, 0), a2, w0);
            PG8_WAIT_V(8); PG8_WAIT_L(0); PG8_BAR; PG8_MMA(1, 0, At, B0); PG8_MMA(1, 1, At, B1); PG8_BAR; PG8_SCHED;
            PG8_LDB(B0, 1, 0); PG8_LDB(B1, 1, 1); PG8_SCHED; PG8_LDA(At, 1, 0); PG8_STAGE(PG8_SA(0, 1), a2, w1);
            PG8_WAIT_V(8); PG8_WAIT_L(0); PG8_BAR; PG8_MMA(0, 0, At, B0); PG8_MMA(0, 1, At, B1); PG8_BAR; PG8_SCHED;
            PG8_LDA(At, 1, 1); PG8_STAGE(PG8_SB(1, 0), b3, voffB); PG8_STAGE(PG8_SB(1, 1), b3 + hstepB, voffB); PG8_STAGE(PG8_SA(1, 0), a3, w0);
            PG8_WAIT_V(8); PG8_WAIT_L(0); PG8_BAR; PG8_MMA(1, 0, At, B0); PG8_MMA(1, 1, At, B1); PG8_BAR; PG8_SCHED;
        }
        if constexpr (ALIGN_EPI) { if (wr == 0) PG8_BAR; }
        E(acc, cur, wr, wc, fr, fq, pre);
        if (!has_next) break;
#pragma unroll
        for (int a = 0; a < 2; ++a)
#pragma unroll
            for (int b = 0; b < 2; ++b)
#pragma unroll
                for (int m = 0; m < 4; ++m)
#pragma unroll
                    for (int n = 0; n < 2; ++n) acc[a][b][m][n] = (f32x4){zf, zf, zf, zf};
        cur = nxt; cA = nA; cB = nB; ++ui; vA0[0] = nvA0[0]; vA0[1] = nvA0[1]; vA1[0] = nvA1[0]; vA1[1] = nvA1[1];
        if constexpr (ALIGN_EPI) { if (wr == 1) PG8_BAR; }
    }
    PG8_WAIT_V(0);
    if constexpr (!ALIGN_EPI) { if (wr == 0) PG8_BAR; }
    PG8_BAR;
#undef PG8_SA
#undef PG8_SB
#undef PG8_STAGE
#undef PG8_LDA
#undef PG8_LDB
#undef PG8_MMA
#undef PG8_WAIT_V
#undef PG8_WAIT_L
#undef PG8_BAR
#undef PG8_SCHED
}
}

struct Frame { LAS unsigned char* lds; int tid, lane, wave, G, bid; float zf; unsigned zu; };
#define FRAME_SETUP Frame F; { int t_ = threadIdx.x, b_ = blockIdx.x, g_ = gridDim.x; float z_ = 0.f; unsigned zu_ = 0u; asm volatile("" : "+v"(t_), "+s"(b_), "+s"(g_), "+v"(z_), "+v"(zu_)); \
    F.lds = lds_base(); F.tid = t_; F.lane = t_ & 63; F.wave = __builtin_amdgcn_readfirstlane(t_ >> 6); F.G = g_; F.bid = b_; F.zf = z_; F.zu = zu_; }
extern __shared__ __attribute__((aligned(16))) unsigned char lds_dyn[];
__device__ __forceinline__ LAS unsigned char* lds_base() { return (LAS unsigned char*)lds_dyn; }
typedef const __attribute__((address_space(4))) unsigned long long karg_t;
__device__ __forceinline__ unsigned long long karg(int k) { asm volatile("" : "+s"(k)); return ((karg_t*)__builtin_amdgcn_kernarg_segment_ptr())[k]; }
__device__ __forceinline__ const float* inp(int k) { return (const float*)(const GAS float*)karg(k); }
__device__ __forceinline__ float* outp() { return (float*)(GAS float*)karg(22); }
__device__ __forceinline__ unsigned char* wsp() { return (unsigned char*)(GAS unsigned char*)karg(23); }
enum { I_X = 0, I_WIN, I_BIN, I_GMLNG, I_GMWS, I_GMBS, I_RELB, I_MLCONV, I_MLFB, I_MLNG, I_POOLW, I_POOLS, I_WBR, I_WOUT, I_LN1G, I_LN1B, I_WR, I_WE1, I_WE3, I_WE2, I_LN2G, I_LN2B };
__device__ __forceinline__ bf16* wl(unsigned char* ws, int l, size_t off) { return (bf16*)(ws + WS_W + (size_t)l * LW + off); }

#define WS_PTRS unsigned char* ws = wsp(); float* BIN = (float*)(ws + WS_BIN); float* XF = (float*)(ws + WS_XF); bf16* XB = (bf16*)(ws + WS_XB); bf16* H = (bf16*)(ws + WS_BIG); bf16* XS = (bf16*)(ws + WS_XS); \
    bf16* HID = (bf16*)(ws + WS_HID); bf16* YE = (bf16*)(ws + WS_YE); float* GI = (float*)(ws + WS_GI); bf16* ATTO = (bf16*)(ws + WS_ATTO); float* ATTL = (float*)(ws + WS_ATTL); bf16* YS = (bf16*)(ws + WS_YS); \
    float* MGF = (float*)(ws + WS_MGF); bf16* MGB = (bf16*)(ws + WS_MGB); bf16* QC = (bf16*)(ws + WS_QC); bf16* KC = (bf16*)(ws + WS_KC); bf16* DC = (bf16*)(ws + WS_DC); float* DG = (float*)(ws + WS_DG); \
    float* AFF = (float*)(ws + WS_AFF); float* GATE = (float*)(ws + WS_GATE); int* IDX = (int*)(ws + WS_IDX); int* SLOT = (int*)(ws + WS_SLOT); \
    (void)BIN; (void)XF; (void)XB; (void)H; (void)XS; (void)HID; (void)YE; (void)GI; (void)ATTO; (void)ATTL; (void)YS; (void)MGF; (void)MGB; (void)QC; (void)KC; (void)DC; (void)DG; (void)AFF; (void)GATE; (void)IDX; (void)SLOT
__device__ __forceinline__ void tr_item(const float* W, int ldw, int k0, int n0, int ncols, bf16* WT, int ldt, int trow0, LAS float* scr, int lane) {
    const int c4 = lane & 7, r = lane >> 3; const bool cv = 4 * c4 < ncols;
    f32x4 tv[8];
#pragma unroll
    for (int i = 0; i < 8; ++i) tv[i] = cv ? __builtin_nontemporal_load((const f32x4*)(W + (size_t)(k0 + r + 8 * i) * ldw + n0 + 4 * c4)) : (f32x4){0.f, 0.f, 0.f, 0.f};
#pragma unroll
    for (int i = 0; i < 8; ++i) { LAS float* d = scr + (r + 8 * i) * 33 + 4 * c4; d[0] = tv[i][0]; d[1] = tv[i][1]; d[2] = tv[i][2]; d[3] = tv[i][3]; }
    LDS_WAIT(); asm volatile("" ::: "memory");
    const int ch = lane & 7;
#pragma unroll
    for (int j = 0; j < 4; ++j) { const int n = (lane >> 3) + 8 * j; const LAS float* s = scr + (8 * ch) * 33 + n;
        u32x4 o; o.x = pk2(s[0 * 33], s[1 * 33]); o.y = pk2(s[2 * 33], s[3 * 33]); o.z = pk2(s[4 * 33], s[5 * 33]); o.w = pk2(s[6 * 33], s[7 * 33]);
        if (n < ncols) *(GAS u32x4*)(WT + (size_t)(trow0 + n) * ldt + k0 + 8 * ch) = o; }
    LDS_WAIT(); asm volatile("" ::: "memory");
}
constexpr int IT_IN = 16 * 209, IT_B = 512, IT_O = 512, IT_13 = 16384, IT_2 = 8192, IT_LAYER = IT_IN + IT_B + IT_O + IT_13 + IT_2;
__device__ __forceinline__ void convert_layer(int l, int gw, int NGW) {
    FRAME_SETUP;
    WS_PTRS; const float* w_in = inp(I_WIN); const float* w_branch = inp(I_WBR); const float* w_out = inp(I_WOUT); const float* w_e1 = inp(I_WE1); const float* w_e3 = inp(I_WE3); const float* w_e2 = inp(I_WE2);
    LAS float* scr = (LAS float*)(F.lds + F.wave * 16384);
    const int lane = F.lane;
    for (int it = gw; it < IT_LAYER; it += NGW) {
        int r = it; const float* W; int ldw, k0, n0, nc = 32, ldt, trow; bf16* WT;
        if (r < IT_IN) { const int kb = r / 209, cb = r % 209; k0 = 64 * kb;
            if (cb < 72) { n0 = 32 * cb; trow = n0; } else if (cb < 208) { n0 = 2320 + 32 * (cb - 72); trow = 2304 + 32 * (cb - 72); } else { n0 = 2304; trow = 6656; nc = 16; }
            W = w_in + (size_t)l * D * NIN; ldw = NIN; WT = wl(ws, l, OW_IN); ldt = D; }
        else if ((r -= IT_IN) < IT_B) { const int n = r / 128, q = r % 128, kb = q / 32, nb = q % 32;
            W = w_branch + ((size_t)(l * 4 + n) * 256) * D; ldw = D; k0 = 64 * kb; n0 = 32 * nb; WT = wl(ws, l, OW_B) + (size_t)n * 256; ldt = D; trow = 32 * nb; }
        else if ((r -= IT_B) < IT_O) { const int kb = r / 32, nb = r % 32;
            W = w_out + (size_t)l * D * D; ldw = D; k0 = 64 * kb; n0 = 32 * nb; WT = wl(ws, l, OW_O); ldt = D; trow = 32 * nb; }
        else if ((r -= IT_O) < IT_13) { const int e = r / 1024, q = r % 1024, which = q / 512, q2 = q % 512, kb = q2 / 32, nb = q2 % 32, f0 = 32 * nb;
            W = (which ? w_e3 : w_e1) + ((size_t)(l * NE + e) * D) * FF; ldw = FF; k0 = 64 * kb; n0 = f0; WT = wl(ws, l, OW_13) + (size_t)e * 2048 * D; ldt = D; trow = (f0 / 128) * 256 + (f0 % 128) + which * 128; }
        else { r -= IT_13; const int e = r / 512, q = r % 512, kb = q / 32, nb = q % 32;
            W = w_e2 + ((size_t)(l * NE + e) * FF) * D; ldw = D; k0 = 64 * kb; n0 = 32 * nb; WT = wl(ws, l, OW_2) + (size_t)e * D * FF; ldt = FF; trow = 32 * nb; }
        tr_item(W, ldw, k0, n0, nc, WT, ldt, trow, scr, lane);
    }
}
__device__ __forceinline__ void p0_prologue() {
    FRAME_SETUP;
    WS_PTRS; const float* x = inp(I_X); const float* b_in = inp(I_BIN);
    convert_layer(0, F.bid * NWAVES + F.wave, F.G * NWAVES);
    const int gt = F.bid * NTHREADS + F.tid, NGT = F.G * NTHREADS;
    for (int i = gt; i < DEPTH * 240 * (D / 8); i += NGT) { const int l = i / (240 * (D / 8)), r = i % (240 * (D / 8));
        *(GAS u32x4*)(wl(ws, l, OW_IN) + (size_t)NIN * D + (size_t)r * 8) = (u32x4){F.zu, F.zu, F.zu, F.zu}; }
    for (int i = gt; i < DEPTH * NINP; i += NGT) { const int l = i / NINP, c = i % NINP;
        float v = 0.f; if (c < 2304) v = b_in[l * NIN + c]; else if (c < NH) v = b_in[l * NIN + c + 16]; else if (c < NH + 16) v = b_in[l * NIN + c - NH + 2304];
        BIN[i] = v; }
    { const float* gm_ws = inp(I_GMWS); bf16* WSB = (bf16*)(ws + WS_WSB);
      for (int i = gt; i < DEPTH * 4 * 128 * 128 / 4; i += NGT) { const f32x4 v = ((const GAS f32x4*)gm_ws)[i]; u32x2 w; w.x = pk2(v.x, v.y); w.y = pk2(v.z, v.w); ((GAS u32x2*)WSB)[i] = w; } }
    { const float* pool_w = inp(I_POOLW); bf16* PWT = (bf16*)(ws + WS_PWT);
      for (int i = gt; i < DEPTH * 4 * 64 * 64; i += NGT) { const int lg = i >> 12, o = (i >> 6) & 63, ii = i & 63; PWT[i] = (bf16)f2bf(pool_w[(size_t)lg * 4096 + ii * 64 + o]); } }
    { const float* w_router = inp(I_WR); bf16* WRT = (bf16*)(ws + WS_WRT);
      for (int i = gt; i < DEPTH * NE * D; i += NGT) { const int ll = i / (NE * D), e = (i / D) % NE, d = i % D; WRT[i] = (bf16)f2bf(w_router[((size_t)ll * D + d) * NE + e]); } }
    for (int i = gt; i < T * D / 8; i += NGT) { const f32x4 v0 = __builtin_nontemporal_load((const GAS f32x4*)x + 2 * i), v1 = __builtin_nontemporal_load((const GAS f32x4*)x + 2 * i + 1);
        u32x4 w; w.x = pk2(v0.x, v0.y); w.y = pk2(v0.z, v0.w); w.z = pk2(v1.x, v1.y); w.w = pk2(v1.z, v1.w); ((GAS u32x4*)XB)[i] = w; }
}

typedef f32x4 Acc[2][2][4][2];
struct SchedG1 { int G, c; const char* A; const char* B;
    __device__ __forceinline__ void a_off(const pg8::Unit&, int lda, const int (&Ri)[2], const int (&Ci)[2], unsigned (&v0)[2], unsigned (&v1)[2]) const {
#pragma unroll
        for (int i = 0; i < 2; ++i) { v0[i] = (unsigned)(Ri[i] * lda + Ci[i]) * 2u; v1[i] = v0[i] + (unsigned)(128 * lda * 2); } }
    __device__ __forceinline__ bool next(int i, pg8::Unit& u) const { int pm, pn; if (!pg8::tile_of(i, G, c, T / 256, NINP / 256, pm, pn)) return false;
        u.pm = pm; u.pn = pn; u.aux = 0; u.A = A + (size_t)pm * 256 * D * 2; u.B = B + (size_t)pn * 256 * D * 2; return true; } };
struct EpiG1 { static constexpr bool PERM = true, HOOK = false; bf16* H; float* GI; const float* bias;
    struct Pre { f32x4 bv[2][2]; };
    __device__ __forceinline__ void prefetch(const pg8::Unit& u, int wr, int wc, int fr, int fq, Pre& p) const { const int col0 = u.pn * 256 + wc * 32 + 8 * fq;
#pragma unroll
        for (int bj = 0; bj < 2; ++bj)
#pragma unroll
            for (int n = 0; n < 2; ++n) { f32x4 t = *(const f32x4*)(bias + col0 + bj * 128 + 4 * n); if (u.pn >= 10 && u.pn < 26) t = t * (-1.4426950408889634f); p.bv[bj][n] = t; } }
    __device__ __forceinline__ void operator()(const Acc& acc, const pg8::Unit& u, int wr, int wc, int fr, int fq, const Pre& pre) const {
        const int row0 = u.pm * 256 + wr * 64 + fr;
        if (u.pn < 26) {
            const int col0 = u.pn * 256 + wc * 32 + 8 * fq; const bool act = u.pn < 2, sg = u.pn >= 10;
#pragma unroll
            for (int ai = 0; ai < 2; ++ai)
#pragma unroll
                for (int m = 0; m < 4; ++m) { bf16* rowp = H + (size_t)(row0 + ai * 128 + m * 16) * NH + col0;
#pragma unroll
                    for (int bj = 0; bj < 2; ++bj) { f32x4 v0 = sg ? acc[ai][bj][m][0] * (-1.4426950408889634f) + pre.bv[bj][0] : acc[ai][bj][m][0] + pre.bv[bj][0], v1 = sg ? acc[ai][bj][m][1] * (-1.4426950408889634f) + pre.bv[bj][1] : acc[ai][bj][m][1] + pre.bv[bj][1];
                        if (act) { v0 = (f32x4){gelu_tanh(v0[0]), gelu_tanh(v0[1]), gelu_tanh(v0[2]), gelu_tanh(v0[3])}; v1 = (f32x4){gelu_tanh(v1[0]), gelu_tanh(v1[1]), gelu_tanh(v1[2]), gelu_tanh(v1[3])}; }
                        if (sg) {
                            u32x2 qb; qb.x = 0u; qb.y = 0u;
#pragma unroll
                            for (int j = 0; j < 4; ++j) { qb.x = __builtin_amdgcn_cvt_pk_u8_f32(rcpf_(1.0f + __builtin_amdgcn_exp2f(v0[j])) * 256.0f - 0.5f, j, qb.x); qb.y = __builtin_amdgcn_cvt_pk_u8_f32(rcpf_(1.0f + __builtin_amdgcn_exp2f(v1[j])) * 256.0f - 0.5f, j, qb.y); }
                            *(u32x2*)((unsigned char*)(H + (size_t)(row0 + ai * 128 + m * 16) * NH + HG) + (col0 + bj * 128 - HG)) = qb;
                        } else {
                        u32x4 w; w.x = pk2(v0[0], v0[1]); w.y = pk2(v0[2], v0[3]); w.z = pk2(v1[0], v1[1]); w.w = pk2(v1[2], v1[3]);
                        *(u32x4*)(rowp + bj * 128) = w; } } }
        } else if (wc == 0 && fq < 2) {
#pragma unroll
            for (int ai = 0; ai < 2; ++ai)
#pragma unroll
                for (int m = 0; m < 4; ++m) { float* rowp = GI + (size_t)(row0 + ai * 128 + m * 16) * 16 + 8 * fq;
#pragma unroll
                    for (int n = 0; n < 2; ++n) *(f32x4*)(rowp + 4 * n) = acc[ai][0][m][n] + pre.bv[0][n]; }
        }
    } };
struct SchedG2 { int G, c; const char* A; const char* B;
    __device__ __forceinline__ void a_off(const pg8::Unit&, int lda, const int (&Ri)[2], const int (&Ci)[2], unsigned (&v0)[2], unsigned (&v1)[2]) const {
#pragma unroll
        for (int i = 0; i < 2; ++i) { v0[i] = (unsigned)(Ri[i] * lda + Ci[i]) * 2u; v1[i] = v0[i] + (unsigned)(128 * lda * 2); } }
    __device__ __forceinline__ bool next(int i, pg8::Unit& u) const { int pm, pn; if (!pg8::tile_of(i, G, c, T / 256, D / 256, pm, pn)) return false;
        u.pm = pm; u.pn = pn; u.aux = 0; u.A = A + (size_t)pm * 256 * D * 2; u.B = B + (size_t)pn * 256 * D * 2; return true; } };
__device__ __forceinline__ void unq8(const u32x2 w, float (&o)[8]) {
    o[0] = ((float)(w.x & 255u) + 0.5f) * (1.0f / 256.0f); o[1] = ((float)((w.x >> 8) & 255u) + 0.5f) * (1.0f / 256.0f); o[2] = ((float)((w.x >> 16) & 255u) + 0.5f) * (1.0f / 256.0f); o[3] = ((float)(w.x >> 24) + 0.5f) * (1.0f / 256.0f);
    o[4] = ((float)(w.y & 255u) + 0.5f) * (1.0f / 256.0f); o[5] = ((float)((w.y >> 8) & 255u) + 0.5f) * (1.0f / 256.0f); o[6] = ((float)((w.y >> 16) & 255u) + 0.5f) * (1.0f / 256.0f); o[7] = ((float)(w.y >> 24) + 0.5f) * (1.0f / 256.0f); }
__device__ __forceinline__ void unq8r(const u32x2 w, float (&o)[8]) {
    o[0] = (float)(w.x & 255u) + 0.5f; o[1] = (float)((w.x >> 8) & 255u) + 0.5f; o[2] = (float)((w.x >> 16) & 255u) + 0.5f; o[3] = (float)(w.x >> 24) + 0.5f;
    o[4] = (float)(w.y & 255u) + 0.5f; o[5] = (float)((w.y >> 8) & 255u) + 0.5f; o[6] = (float)((w.y >> 16) & 255u) + 0.5f; o[7] = (float)(w.y >> 24) + 0.5f; }
struct EpiG2 { static constexpr bool PERM = true, HOOK = true; struct Pre {}; __device__ __forceinline__ void prefetch(const pg8::Unit&, int, int, int, int, Pre&) const {} const bf16* H; bf16* MGB;
    __device__ __forceinline__ void hook(Acc& acc, const pg8::Unit& u, int n, int wr, int wc, int fr, int fq) const {
        const size_t rowb = (size_t)(u.pm * 256 + wr * 64 + fr); const int col0 = u.pn * 256 + wc * 32 + 8 * fq;
        const unsigned char* hp = (const unsigned char*)(H + rowb * NH + HG) + (n - 1) * D + col0;
        u32x2 ga[2][4][2], gb[2][4][2];
#pragma unroll
        for (int ai = 0; ai < 2; ++ai)
#pragma unroll
            for (int m = 0; m < 4; ++m)
#pragma unroll
                for (int bj = 0; bj < 2; ++bj) { const unsigned char* p = hp + (size_t)(ai * 128 + m * 16) * NH * 2 + bj * 128; ga[ai][m][bj] = *(const u32x2*)p; gb[ai][m][bj] = *(const u32x2*)(p + D); }
#pragma unroll
        for (int ai = 0; ai < 2; ++ai)
#pragma unroll
            for (int m = 0; m < 4; ++m)
#pragma unroll
                for (int bj = 0; bj < 2; ++bj) { float sa[8], sb[8]; unq8r(ga[ai][m][bj], sa); unq8r(gb[ai][m][bj], sb);
                    float r[8];
#pragma unroll
                    for (int j = 0; j < 8; ++j) r[j] = sa[j] * __builtin_amdgcn_rcpf(sb[j]);
                    acc[ai][bj][m][0] *= (f32x4){r[0], r[1], r[2], r[3]}; acc[ai][bj][m][1] *= (f32x4){r[4], r[5], r[6], r[7]}; }
        asm volatile("" ::: "memory");
    }
    __device__ __forceinline__ void operator()(const Acc& acc, const pg8::Unit& u, int wr, int wc, int fr, int fq, const Pre& pre) const {
        const size_t rowb = (size_t)(u.pm * 256 + wr * 64 + fr); const int col0 = u.pn * 256 + wc * 32 + 8 * fq;
        const unsigned char* hp = (const unsigned char*)(H + rowb * NH + HG) + 3 * D + col0; bf16* bp = MGB + rowb * D + col0;
        u32x2 gv[2][4][2];
#pragma unroll
        for (int ai = 0; ai < 2; ++ai)
#pragma unroll
            for (int m = 0; m < 4; ++m)
#pragma unroll
                for (int bj = 0; bj < 2; ++bj) gv[ai][m][bj] = *(const u32x2*)(hp + (size_t)(ai * 128 + m * 16) * NH * 2 + bj * 128);
#pragma unroll
        for (int ai = 0; ai < 2; ++ai)
#pragma unroll
            for (int m = 0; m < 4; ++m)
#pragma unroll
                for (int bj = 0; bj < 2; ++bj) { const int ro = ai * 128 + m * 16; float sv[8]; unq8(gv[ai][m][bj], sv);
                    const f32x4 a0 = acc[ai][bj][m][0], a1 = acc[ai][bj][m][1];
                    u32x4 w; w.x = pk2(a0[0] * sv[0], a0[1] * sv[1]); w.y = pk2(a0[2] * sv[2], a0[3] * sv[3]); w.z = pk2(a1[0] * sv[4], a1[1] * sv[5]); w.w = pk2(a1[2] * sv[6], a1[3] * sv[7]);
                    *(u32x4*)(bp + (size_t)ro * D + bj * 128) = w; }
    } };
struct SchedG3 { int G, c; const char* A; const char* B;
    __device__ __forceinline__ void a_off(const pg8::Unit&, int lda, const int (&Ri)[2], const int (&Ci)[2], unsigned (&v0)[2], unsigned (&v1)[2]) const {
#pragma unroll
        for (int i = 0; i < 2; ++i) { v0[i] = (unsigned)(Ri[i] * lda + Ci[i]) * 2u; v1[i] = v0[i] + (unsigned)(128 * lda * 2); } }
    __device__ __forceinline__ bool next(int i, pg8::Unit& u) const { int pm, pn; if (!pg8::tile_of(i, G, c, T / 256, D / 256, pm, pn)) return false;
        u.pm = pm; u.pn = pn; u.aux = 0; u.A = A + (size_t)pm * 256 * D * 2; u.B = B + (size_t)pn * 256 * D * 2; return true; } };
struct EpiG3 { static constexpr bool PERM = true, HOOK = false; struct Pre {}; __device__ __forceinline__ void prefetch(const pg8::Unit&, int, int, int, int, Pre&) const {} const bf16* XB; float* R; float* STAT;
    __device__ __forceinline__ void operator()(const Acc& acc, const pg8::Unit& u, int wr, int wc, int fr, int fq, const Pre& pre) const {
        const int row0 = u.pm * 256 + wr * 64 + fr, col0 = u.pn * 256 + wc * 32 + 8 * fq, lane = fq * 16 + fr;
#pragma unroll
        for (int ai = 0; ai < 2; ++ai) { u32x4 xr[4][2];
#pragma unroll
            for (int m = 0; m < 4; ++m)
#pragma unroll
                for (int bj = 0; bj < 2; ++bj) xr[m][bj] = *(const u32x4*)(XB + (size_t)(row0 + ai * 128 + m * 16) * D + col0 + bj * 128);
#pragma unroll
            for (int m = 0; m < 4; ++m) { const size_t row = (size_t)(row0 + ai * 128 + m * 16); float s1 = 0.f, s2 = 0.f;
#pragma unroll
                for (int bj = 0; bj < 2; ++bj) { const size_t o = row * D + col0 + bj * 128; float x8[8]; unpack8(xr[m][bj], x8);
                    const f32x4 r0 = (f32x4){x8[0], x8[1], x8[2], x8[3]} * ALPHA + acc[ai][bj][m][0], r1 = (f32x4){x8[4], x8[5], x8[6], x8[7]} * ALPHA + acc[ai][bj][m][1];
                    *(f32x4*)(R + o) = r0; *(f32x4*)(R + o + 4) = r1;
                    s1 += ((r0[0] + r0[1]) + (r0[2] + r0[3])) + ((r1[0] + r1[1]) + (r1[2] + r1[3]));
                    s2 += ((r0[0] * r0[0] + r0[1] * r0[1]) + (r0[2] * r0[2] + r0[3] * r0[3])) + ((r1[0] * r1[0] + r1[1] * r1[1]) + (r1[2] * r1[2] + r1[3] * r1[3])); }
                s1 += shx(s1, 16, lane); s1 += shx(s1, 32, lane); s2 += shx(s2, 16, lane); s2 += shx(s2, 32, lane);
                if (fq == 0) *(f32x2*)(STAT + (row * 16 + u.pn * 4 + wc) * 2) = (f32x2){s1, s2}; } }
    } };
struct SchedG4 { int G, c; const char* A; const char* B; const int* IDX;
    __device__ __forceinline__ bool next(int i, pg8::Unit& u) const { int pm, pn; if (!pg8::tile_of(i, G, c, NSLOT / 256, 2048 / 256, pm, pn)) return false; const int e = (pm >> 2) & 15;
        u.pm = pm; u.pn = pn; u.aux = e; u.A = A + (size_t)(pm >> 6) * SEQ * D * 2; u.B = B + (size_t)e * 2048 * D * 2 + (size_t)pn * 256 * D * 2; return true; }
    __device__ __forceinline__ void a_off(const pg8::Unit& u, int lda, const int (&Ri)[2], const int (&Ci)[2], unsigned (&v0)[2], unsigned (&v1)[2]) const {
#pragma unroll
        for (int i = 0; i < 2; ++i) { const int r0 = IDX[u.pm * 256 + Ri[i]], r1 = IDX[u.pm * 256 + 128 + Ri[i]]; v0[i] = (unsigned)(r0 * lda + Ci[i]) * 2u; v1[i] = (unsigned)(r1 * lda + Ci[i]) * 2u; } } };
struct EpiG4 { static constexpr bool PERM = true, HOOK = false; struct Pre {}; __device__ __forceinline__ void prefetch(const pg8::Unit&, int, int, int, int, Pre&) const {} bf16* HID;
    __device__ __forceinline__ void operator()(const Acc& acc, const pg8::Unit& u, int wr, int wc, int fr, int fq, const Pre& pre) const {
        const int row0 = u.pm * 256 + wr * 64 + fr, col0 = u.pn * 128 + wc * 32 + 8 * fq;
#pragma unroll
        for (int ai = 0; ai < 2; ++ai)
#pragma unroll
            for (int m = 0; m < 4; ++m) { const size_t row = (size_t)(row0 + ai * 128 + m * 16);
                const f32x4 a0 = acc[ai][0][m][0], a1 = acc[ai][0][m][1], g0 = acc[ai][1][m][0], g1 = acc[ai][1][m][1];
                u32x4 w; w.x = pk2(siluf_(a0[0]) * g0[0], siluf_(a0[1]) * g0[1]); w.y = pk2(siluf_(a0[2]) * g0[2], siluf_(a0[3]) * g0[3]);
                w.z = pk2(siluf_(a1[0]) * g1[0], siluf_(a1[1]) * g1[1]); w.w = pk2(siluf_(a1[2]) * g1[2], siluf_(a1[3]) * g1[3]);
                *(u32x4*)(HID + row * FF + col0) = w; }
    } };
struct SchedG5 { int G, c; const char* A; const char* B;
    __device__ __forceinline__ void a_off(const pg8::Unit&, int lda, const int (&Ri)[2], const int (&Ci)[2], unsigned (&v0)[2], unsigned (&v1)[2]) const {
#pragma unroll
        for (int i = 0; i < 2; ++i) { v0[i] = (unsigned)(Ri[i] * lda + Ci[i]) * 2u; v1[i] = v0[i] + (unsigned)(128 * lda * 2); } }
    __device__ __forceinline__ bool next(int i, pg8::Unit& u) const { int pm, pn; if (!pg8::tile_of(i, G, c, NSLOT / 256, D / 256, pm, pn)) return false; const int e = (pm >> 2) & 15;
        u.pm = pm; u.pn = pn; u.aux = e; u.A = A + (size_t)pm * 256 * FF * 2; u.B = B + (size_t)e * D * FF * 2 + (size_t)pn * 256 * FF * 2; return true; } };
struct EpiG5 { static constexpr bool PERM = true, HOOK = false; const float* GATE; bf16* YE;
    struct Pre { float g[2][4]; };
    __device__ __forceinline__ void prefetch(const pg8::Unit& u, int wr, int wc, int fr, int fq, Pre& p) const { const int row0 = u.pm * 256 + wr * 64 + fr;
#pragma unroll
        for (int ai = 0; ai < 2; ++ai)
#pragma unroll
            for (int m = 0; m < 4; ++m) p.g[ai][m] = GATE[row0 + ai * 128 + m * 16]; }
    __device__ __forceinline__ void operator()(const Acc& acc, const pg8::Unit& u, int wr, int wc, int fr, int fq, const Pre& pre) const {
        const int row0 = u.pm * 256 + wr * 64 + fr, col0 = u.pn * 256 + wc * 32 + 8 * fq;
#pragma unroll
        for (int ai = 0; ai < 2; ++ai)
#pragma unroll
            for (int m = 0; m < 4; ++m) { const size_t row = (size_t)(row0 + ai * 128 + m * 16); const float gt = pre.g[ai][m];
#pragma unroll
                for (int bj = 0; bj < 2; ++bj) { const f32x4 v0 = acc[ai][bj][m][0] * gt, v1 = acc[ai][bj][m][1] * gt;
                    u32x4 w; w.x = pk2(v0[0], v0[1]); w.y = pk2(v0[2], v0[3]); w.z = pk2(v1[0], v1[1]); w.w = pk2(v1[2], v1[3]);
                    *(u32x4*)(YE + row * D + col0 + bj * 128) = w; } }
    } };

typedef float f32x16 __attribute__((ext_vector_type(16)));
typedef short s16x4 __attribute__((ext_vector_type(4)));
typedef __bf16 bf16x2_t __attribute__((ext_vector_type(2)));
#define MFMA32(a, b, c) __builtin_amdgcn_mfma_f32_32x32x16_bf16((a), (b), (c), 0, 0, 0)
__device__ __forceinline__ int crow(int reg, int h) { return (reg & 3) + 8 * (reg >> 2) + 4 * h; }
__device__ __forceinline__ unsigned cvtpk(float lo, float hi) { f32x2 v = {lo, hi}; bf16x2_t b = __builtin_convertvector(v, bf16x2_t); return __builtin_bit_cast(unsigned, b); }
__device__ __forceinline__ bf16x8 pack8(float a0, float a1, float a2, float a3, float a4, float a5, float a6, float a7) {
    u32x4 p; p.x = cvtpk(a0, a1); p.y = cvtpk(a2, a3); p.z = cvtpk(a4, a5); p.w = cvtpk(a6, a7); return __builtin_bit_cast(bf16x8, p); }
typedef short v4i16_t __attribute__((ext_vector_type(4)));
__device__ __forceinline__ s16x4 tr_rd(const LAS unsigned char* p) { return __builtin_bit_cast(s16x4, __builtin_amdgcn_ds_read_tr16_b64_v4i16((LAS v4i16_t*)p)); }
__device__ __forceinline__ bf16x8 tr_frag(const LAS unsigned char* img, int pitch, int k0, int k1, int col0, int lane) {
    const int i16 = lane & 15, qd = i16 >> 2, p = i16 & 3, blk = (lane >> 4) & 1;
    const s16x4 lo = tr_rd(img + (k0 + qd) * pitch + (col0 + 16 * blk + 4 * p) * 2), hi = tr_rd(img + (k1 + qd) * pitch + (col0 + 16 * blk + 4 * p) * 2);
    return __builtin_shufflevector(lo, hi, 0, 1, 2, 3, 4, 5, 6, 7); }
constexpr int C1_ITEM_LDS = 3 * 64 * 144 + 2048;
__device__ __forceinline__ void mlstm_c1m(int l, int bi) {
    FRAME_SETUP; WS_PTRS; const float* ml_conv = inp(I_MLCONV); const float* ml_fbias = inp(I_MLFB);
    const int tid = F.tid, lane = F.lane, w = F.wave, dir = w & 1, jj = w >> 1, tp = tid & 127;
    const int item = bi * 4 + jj, c = item & 127, h = (item >> 7) & 3, b = item >> 9;
    const int p0 = b * SEQ + c * 64, hc = h * 64;
    LAS unsigned char* base = F.lds + jj * C1_ITEM_LDS;
    LAS unsigned char* Vt = base; LAS unsigned char* K0 = base + 64 * 144; LAS unsigned char* K1 = base + 2 * 64 * 144; LAS float* wT = (LAS float*)(base + 3 * 64 * 144);
    const int chain = ((dir * 2 + b) * 4 + h) * 128 + c; bf16* dc = DC + (size_t)chain * 4160;
    u32x4 cq[4][3], ck[4][3], cv[4]; bool rok[4][3];
    const int cg = (tp & 7) * 8, r0 = tp >> 3;
#pragma unroll
    for (int i = 0; i < 4; ++i) { const int row = r0 + 16 * i, sq = c * 64 + row;
#pragma unroll
        for (int dr = 0; dr < 3; ++dr) { rok[i][dr] = (sq + dr - 1 >= 0) && (sq + dr - 1 < SEQ); const int sc = min(max(sq + dr - 1, 0), SEQ - 1); const bf16* r2 = H + (size_t)(b * SEQ + sc) * NH;
            cq[i][dr] = *(const u32x4*)(r2 + HCQ + hc + cg); ck[i][dr] = *(const u32x4*)(r2 + HCK + hc + cg); }
        cv[i] = *(const u32x4*)(H + (size_t)(p0 + row) * NH + HCV + hc + cg); }
    f32x4 cwq[3][2], cwk[3][2];
    { const float* cw = ml_conv + (size_t)l * 3 * 512;
#pragma unroll
      for (int dr = 0; dr < 3; ++dr) { cwq[dr][0] = *(const f32x4*)(cw + dr * 512 + hc + cg); cwq[dr][1] = *(const f32x4*)(cw + dr * 512 + hc + cg + 4); cwk[dr][0] = *(const f32x4*)(cw + dr * 512 + 256 + hc + cg); cwk[dr][1] = *(const f32x4*)(cw + dr * 512 + 256 + hc + cg + 4); } }
    { const float* gi = GI + (size_t)(p0 + lane) * 16; const float li = gi[dir * 4 + h]; float cum = logsigmoidf_(gi[8 + dir * 4 + h] + ml_fbias[l * 8 + dir * 4 + h]);
#pragma unroll
        for (int off = 1; off < 64; off <<= 1) { const int src = dir ? lane + off : lane - off; const float v = __int_as_float(__builtin_amdgcn_ds_bpermute((src & 63) << 2, __float_as_int(cum))); if (src >= 0 && src < 64) cum += v; }
        const float g = __int_as_float(__builtin_amdgcn_ds_bpermute((dir ? 0 : 63) << 2, __float_as_int(cum)));
        wT[dir * 64 + lane] = __expf(g - cum + li); if (lane == 0) DG[chain] = g; }
    __syncthreads();
    {
#pragma unroll
        for (int i = 0; i < 4; ++i) { const int row = r0 + 16 * i; const float w0 = wT[row], w1 = wT[64 + row];
            float qv[8], kv[8];
#pragma unroll
            for (int j = 0; j < 8; ++j) { qv[j] = 0.f; kv[j] = 0.f; }
#pragma unroll
            for (int dr = 0; dr < 3; ++dr) { const float m = rok[i][dr] ? 1.f : 0.f; float q8[8], k8[8]; unpack8(cq[i][dr], q8); unpack8(ck[i][dr], k8);
#pragma unroll
                for (int j = 0; j < 8; ++j) { qv[j] += m * cwq[dr][j >> 2][j & 3] * q8[j]; kv[j] += m * cwk[dr][j >> 2][j & 3] * k8[j]; } }
#pragma unroll
            for (int j = 0; j < 8; ++j) { qv[j] = siluf_(qv[j]); kv[j] = siluf_(kv[j]) * 0.125f; }
            u32x4 wq, wk, wk0, wk1; wq.x = pk2(qv[0], qv[1]); wq.y = pk2(qv[2], qv[3]); wq.z = pk2(qv[4], qv[5]); wq.w = pk2(qv[6], qv[7]); wk.x = pk2(kv[0], kv[1]); wk.y = pk2(kv[2], kv[3]); wk.z = pk2(kv[4], kv[5]); wk.w = pk2(kv[6], kv[7]);
            wk0.x = pk2(kv[0] * w0, kv[1] * w0); wk0.y = pk2(kv[2] * w0, kv[3] * w0); wk0.z = pk2(kv[4] * w0, kv[5] * w0); wk0.w = pk2(kv[6] * w0, kv[7] * w0);
            wk1.x = pk2(kv[0] * w1, kv[1] * w1); wk1.y = pk2(kv[2] * w1, kv[3] * w1); wk1.z = pk2(kv[4] * w1, kv[5] * w1); wk1.w = pk2(kv[6] * w1, kv[7] * w1);
            *(u32x4*)(QC + (size_t)(p0 + row) * 256 + hc + cg) = wq; *(u32x4*)(KC + (size_t)(p0 + row) * 256 + hc + cg) = wk;
            *(LAS u32x4*)(K0 + row * 144 + cg * 2) = wk0; *(LAS u32x4*)(K1 + row * 144 + cg * 2) = wk1; *(LAS u32x4*)(Vt + row * 144 + cg * 2) = cv[i]; }
    }
    __syncthreads();
    {
        const int tl = lane & 31, hh = lane >> 5; const LAS unsigned char* Kimg = dir ? K1 : K0;
#pragma unroll
        for (int kt = 0; kt < 2; ++kt) { bf16x8 kf[4]; float dn = 0.f;
#pragma unroll
            for (int ks = 0; ks < 4; ++ks) { kf[ks] = tr_frag(Kimg, 144, 16 * ks + 8 * hh, 16 * ks + 8 * hh + 4, 32 * kt, lane); float k8[8]; unpack8(__builtin_bit_cast(u32x4, kf[ks]), k8);
#pragma unroll
                for (int j = 0; j < 8; ++j) dn += k8[j]; }
            dn += shx(dn, 32, lane); if (hh == 0) dc[4096 + 32 * kt + tl] = (bf16)f2bf(dn);
#pragma unroll
            for (int vt = 0; vt < 2; ++vt) { f32x16 acc;
#pragma unroll
                for (int i = 0; i < 16; ++i) acc[i] = F.zf;
#pragma unroll
                for (int ks = 0; ks < 4; ++ks) { const bf16x8 vf = tr_frag(Vt, 144, 16 * ks + 8 * hh, 16 * ks + 8 * hh + 4, 32 * vt, lane); acc = MFMA32(kf[ks], vf, acc); }
#pragma unroll
                for (int g4 = 0; g4 < 4; ++g4) { u32x2 wv; wv.x = pk2(acc[4 * g4], acc[4 * g4 + 1]); wv.y = pk2(acc[4 * g4 + 2], acc[4 * g4 + 3]); *(u32x2*)(dc + (32 * vt + tl) * 64 + 32 * kt + 8 * g4 + 4 * hh) = wv; } } }
    }
    __syncthreads();
}
constexpr int GM_PITCH = 576;
__device__ __forceinline__ void gmlp_m(int l, int item) {
    FRAME_SETUP; WS_PTRS; const float* gm_ln_g = inp(I_GMLNG); const float* gm_bs = inp(I_GMBS); const bf16* WSB = (const bf16*)(ws + WS_WSB);
    const int tid = F.tid, lane = F.lane, w = F.wave;
    const int b = item >> 6, ch = item & 63, p0 = b * SEQ + ch * 128;
    LAS unsigned char* vn = F.lds;
    {
        const int part = tid & 7; const float* lgp = gm_ln_g + l * 256;
        u32x4 raw[2][4];
#pragma unroll
        for (int rr = 0; rr < 2; ++rr)
#pragma unroll
            for (int q = 0; q < 4; ++q) raw[rr][q] = *(const u32x4*)(H + (size_t)(p0 + (tid >> 3) + 64 * rr) * NH + HV + (part + 8 * q) * 8);
#pragma unroll
        for (int rr = 0; rr < 2; ++rr) { const int row = (tid >> 3) + 64 * rr; float s = 0.f, s2 = 0.f;
#pragma unroll
            for (int q = 0; q < 4; ++q) { float v8[8]; unpack8(raw[rr][q], v8);
#pragma unroll
                for (int j = 0; j < 8; ++j) { s += v8[j]; s2 += v8[j] * v8[j]; } }
            s += shx(s, 1, lane); s += shx(s, 2, lane); s += shx(s, 4, lane); s2 += shx(s2, 1, lane); s2 += shx(s2, 2, lane); s2 += shx(s2, 4, lane);
            const float mean = s * (1.0f / 256.0f), var = fmaxf(s2 * (1.0f / 256.0f) - mean * mean, 0.f), rstd = 1.0f / sqrtf(var + LN_EPS);
#pragma unroll
            for (int q = 0; q < 4; ++q) { const int c0 = (part + 8 * q) * 8; float v8[8]; unpack8(raw[rr][q], v8); const f32x4 g0 = *(const f32x4*)(lgp + c0), g1 = *(const f32x4*)(lgp + c0 + 4);
                u32x4 o; o.x = pk2((v8[0] - mean) * rstd * g0[0], (v8[1] - mean) * rstd * g0[1]); o.y = pk2((v8[2] - mean) * rstd * g0[2], (v8[3] - mean) * rstd * g0[3]);
                o.z = pk2((v8[4] - mean) * rstd * g1[0], (v8[5] - mean) * rstd * g1[1]); o.w = pk2((v8[6] - mean) * rstd * g1[2], (v8[7] - mean) * rstd * g1[3]);
                *(LAS u32x4*)(vn + row * GM_PITCH + c0 * 2) = o; } }
    }
    __syncthreads();
    {
        const int g = w >> 1, ph = w & 1, tl = lane & 31, hh = lane >> 5;
#pragma unroll 1
        for (int pt = 0; pt < 2; ++pt) { const int p = 64 * ph + 32 * pt + tl; const size_t tok = (size_t)p0 + p;
            f32x16 M[2];
#pragma unroll
            for (int dt = 0; dt < 2; ++dt)
#pragma unroll
                for (int i = 0; i < 16; ++i) M[dt][i] = F.zf;
            const bf16* wrow = WSB + ((size_t)(l * 4 + g) * 128 + p) * 128 + 8 * hh;
#pragma unroll
            for (int ks = 0; ks < 8; ++ks) { const bf16x8 wf = *(const bf16x8*)(wrow + 16 * ks);
#pragma unroll
                for (int dt = 0; dt < 2; ++dt) { const bf16x8 vf = tr_frag(vn, GM_PITCH, 16 * ks + 8 * hh, 16 * ks + 8 * hh + 4, g * 64 + 32 * dt, lane); M[dt] = MFMA32(vf, wf, M[dt]); } }
            const float bsv = gm_bs[(size_t)(l * 4 + g) * 128 + p];
#pragma unroll
            for (int dt = 0; dt < 2; ++dt)
#pragma unroll
                for (int gg = 0; gg < 4; ++gg) { const int d = g * 64 + 32 * dt + 8 * gg + 4 * hh; const u32x2 uw = *(const u32x2*)(H + tok * NH + HU + d);
                    const float u0 = __uint_as_float(uw.x << 16), u1 = __uint_as_float(uw.x & 0xffff0000u), u2 = __uint_as_float(uw.y << 16), u3 = __uint_as_float(uw.y & 0xffff0000u);
                    u32x2 o; o.x = pk2(u0 * (M[dt][4 * gg] + bsv), u1 * (M[dt][4 * gg + 1] + bsv)); o.y = pk2(u2 * (M[dt][4 * gg + 2] + bsv), u3 * (M[dt][4 * gg + 3] + bsv));
                    *(u32x2*)(YS + tok * D + d) = o; } }
    }
    __syncthreads();
}
__device__ __forceinline__ void mlstm_scan(int wi) {
    FRAME_SETUP;
    WS_PTRS;
    const int lane = F.lane, chain = wi / 17, quad = (wi % 17) * 64 + lane, dir = chain >> 3, base = chain * 128;
    const bool on = quad < 1040;
    const int e = on ? 4 * quad : 0;
    const float d0 = __expf(DG[base + (dir ? 127 - lane : lane)]), d1 = __expf(DG[base + (dir ? 63 - lane : 64 + lane)]);
    f32x4 S = {0.f, 0.f, 0.f, 0.f};
#pragma unroll 1
    for (int i0 = 0; i0 < 128; i0 += 32) {
        u32x2 tmp[32];
#pragma unroll
        for (int j = 0; j < 32; ++j) { const int c = dir ? 127 - (i0 + j) : (i0 + j); tmp[j] = *(const u32x2*)(DC + (size_t)(base + c) * 4160 + e); }
#pragma unroll
        for (int j = 0; j < 32; ++j) { const int c = dir ? 127 - (i0 + j) : (i0 + j);
            const float dec = (i0 < 64) ? __int_as_float(__builtin_amdgcn_readlane(__float_as_int(d0), (i0 & 63) + j)) : __int_as_float(__builtin_amdgcn_readlane(__float_as_int(d1), (i0 & 63) + j));
            if (on) { u32x2 wv; wv.x = pk2(S[0], S[1]); wv.y = pk2(S[2], S[3]); *(u32x2*)(DC + (size_t)(base + c) * 4160 + e) = wv; }
            const f32x4 t = (f32x4){__uint_as_float(tmp[j].x << 16), __uint_as_float(tmp[j].x & 0xffff0000u), __uint_as_float(tmp[j].y << 16), __uint_as_float(tmp[j].y & 0xffff0000u)};
            S = S * dec + t; }
    }
}
constexpr int C3_ITEM_LDS = 20480, C3_PITCH = 144;
__device__ __forceinline__ void mlstm_c3m(int l, int bi) {
    FRAME_SETUP; WS_PTRS; const float* ml_fbias = inp(I_MLFB); const float* ml_norm_g = inp(I_MLNG);
    const int tid = F.tid, lane = F.lane, w = F.wave, dir = w & 1, jj = w >> 1, tp = tid & 127;
    const int item = bi * 4 + jj, c = item & 127, h = (item >> 7) & 3, b = item >> 9;
    const int p0 = b * SEQ + c * 64, hc = h * 64;
    LAS unsigned char* base = F.lds + jj * C3_ITEM_LDS;
    LAS unsigned char* Kt = base; LAS unsigned char* Vt = base + 64 * C3_PITCH;
    LAS float* tab = (LAS float*)(base + 2 * 64 * C3_PITCH);
    LAS float* cumT = tab + dir * 64; LAS float* liT = tab + 128 + dir * 64; LAS float* nsT = tab + 256 + dir * 64;
    LAS float* hbuf = (LAS float*)base;
    const int chain = ((dir * 2 + b) * 4 + h) * 128 + c; const bf16* dc = DC + (size_t)chain * 4160;
    { u32x4 k8[4], v8[4];
#pragma unroll
        for (int u = 0; u < 4; ++u) { const int i = tp + 128 * u, row = i >> 3, cg = (i & 7) * 8; k8[u] = *(const u32x4*)(KC + (size_t)(p0 + row) * 256 + hc + cg); v8[u] = *(const u32x4*)(H + (size_t)(p0 + row) * NH + HCV + hc + cg); }
#pragma unroll
        for (int u = 0; u < 4; ++u) { const int i = tp + 128 * u, row = i >> 3, cg = (i & 7) * 8; *(LAS u32x4*)(Kt + row * C3_PITCH + cg * 2) = k8[u]; *(LAS u32x4*)(Vt + row * C3_PITCH + cg * 2) = v8[u]; } }
    { const float* gi = GI + (size_t)(p0 + lane) * 16; const float li = gi[dir * 4 + h]; float cum = logsigmoidf_(gi[8 + dir * 4 + h] + ml_fbias[l * 8 + dir * 4 + h]);
#pragma unroll
        for (int off = 1; off < 64; off <<= 1) { const int src = dir ? lane + off : lane - off; const float v = __int_as_float(__builtin_amdgcn_ds_bpermute((src & 63) << 2, __float_as_int(cum))); if (src >= 0 && src < 64) cum += v; }
        cumT[lane] = cum; liT[lane] = li - cum; nsT[lane] = bf2f(dc[4096 + lane]); }
    __syncthreads();
    const int tl = lane & 31, hh = lane >> 5;
    f32x16 Hh[2][2];
#pragma unroll
    for (int tt = 0; tt < 2; ++tt) {
        const int t = 32 * tt + tl; const size_t tok = (size_t)p0 + t;
        const float ct = cumT[t], ewt = __expf(ct);
        bf16x8 qf[4], qf2[4]; float nqp = 0.f;
#pragma unroll
        for (int ks = 0; ks < 4; ++ks) { const u32x4 raw = *(const u32x4*)(QC + tok * 256 + hc + 16 * ks + 8 * hh); qf[ks] = __builtin_bit_cast(bf16x8, raw);
            float q8[8]; unpack8(raw, q8);
#pragma unroll
            for (int j = 0; j < 8; ++j) { q8[j] *= ewt; nqp += nsT[16 * ks + 8 * hh + j] * q8[j]; }
            qf2[ks] = pack8(q8[0], q8[1], q8[2], q8[3], q8[4], q8[5], q8[6], q8[7]); }
        f32x16 S[2]; float denp = 0.f;
#pragma unroll
        for (int st = 0; st < 2; ++st) {
#pragma unroll
            for (int i = 0; i < 16; ++i) S[st][i] = F.zf;
#pragma unroll
            for (int ks = 0; ks < 4; ++ks) { const bf16x8 kf = *(const LAS bf16x8*)(Kt + (32 * st + tl) * C3_PITCH + (16 * ks + 8 * hh) * 2); S[st] = MFMA32(kf, qf[ks], S[st]); }
#pragma unroll
            for (int i = 0; i < 16; ++i) { const int sidx = 32 * st + crow(i, hh); const bool valid = dir ? (sidx >= t) : (sidx <= t);
                const float arg = ct + liT[sidx]; const float wgt = __expf(valid ? arg : -1e30f); const float pv = S[st][i] * wgt; S[st][i] = pv; denp += pv; }
            __builtin_amdgcn_sched_barrier(0); }
        const float dn = (denp + shx(denp, 32, lane)) + (nqp + shx(nqp, 32, lane));
        const float inv = 1.0f / fmaxf(fabsf(dn), 1.0f);
#pragma unroll
        for (int vt = 0; vt < 2; ++vt) { f32x16 N;
#pragma unroll
            for (int i = 0; i < 16; ++i) N[i] = F.zf;
#pragma unroll
            for (int st = 0; st < 2; ++st)
#pragma unroll
                for (int s2 = 0; s2 < 2; ++s2) { const bf16x8 pf = pack8(S[st][8 * s2], S[st][8 * s2 + 1], S[st][8 * s2 + 2], S[st][8 * s2 + 3], S[st][8 * s2 + 4], S[st][8 * s2 + 5], S[st][8 * s2 + 6], S[st][8 * s2 + 7]);
                    const int k0 = 32 * st + 16 * s2 + 4 * hh; const bf16x8 vf = tr_frag(Vt, C3_PITCH, k0, k0 + 8, 32 * vt, lane); N = MFMA32(vf, pf, N); }
#pragma unroll
            for (int ks = 0; ks < 4; ++ks) { const bf16x8 cf = *(const bf16x8*)(dc + (32 * vt + tl) * 64 + 16 * ks + 8 * hh); N = MFMA32(cf, qf2[ks], N); }
#pragma unroll
            for (int i = 0; i < 16; ++i) Hh[tt][vt][i] = N[i] * inv; }
    }
    __syncthreads();
    if (dir == 1) {
#pragma unroll
        for (int tt = 0; tt < 2; ++tt)
#pragma unroll
            for (int vt = 0; vt < 2; ++vt)
#pragma unroll
                for (int i = 0; i < 16; ++i) hbuf[(32 * tt + tl) * 65 + 32 * vt + crow(i, hh)] = Hh[tt][vt][i]; }
    __syncthreads();
    if (dir == 0) {
#pragma unroll
        for (int tt = 0; tt < 2; ++tt) { const int t = 32 * tt + tl; const size_t tok = (size_t)p0 + t; float s1 = 0.f;
#pragma unroll
            for (int vt = 0; vt < 2; ++vt)
#pragma unroll
                for (int i = 0; i < 16; ++i) { const float x = Hh[tt][vt][i] + hbuf[t * 65 + 32 * vt + crow(i, hh)]; Hh[tt][vt][i] = x; s1 += x; }
            const float mu = (s1 + shx(s1, 32, lane)) * (1.0f / 64.0f); float s2 = 0.f;
#pragma unroll
            for (int vt = 0; vt < 2; ++vt)
#pragma unroll
                for (int i = 0; i < 16; ++i) { const float dv = Hh[tt][vt][i] - mu; s2 += dv * dv; }
            const float rstd = 1.0f / sqrtf((s2 + shx(s2, 32, lane)) * (1.0f / 64.0f) + LN_EPS);
#pragma unroll
            for (int vt = 0; vt < 2; ++vt)
#pragma unroll
                for (int g = 0; g < 4; ++g) { const int v = 32 * vt + 8 * g + 4 * hh;
                    const u32x2 cw = *(const u32x2*)(H + tok * NH + HCO + hc + v); const f32x4 ng = *(const f32x4*)(ml_norm_g + l * 256 + hc + v);
                    const float o0 = __uint_as_float(cw.x << 16), o1 = __uint_as_float(cw.x & 0xffff0000u), o2 = __uint_as_float(cw.y << 16), o3 = __uint_as_float(cw.y & 0xffff0000u);
                    u32x2 wv; wv.x = pk2((Hh[tt][vt][4 * g] - mu) * rstd * ng[0] * sigmoidf_(o0), (Hh[tt][vt][4 * g + 1] - mu) * rstd * ng[1] * sigmoidf_(o1));
                    wv.y = pk2((Hh[tt][vt][4 * g + 2] - mu) * rstd * ng[2] * sigmoidf_(o2), (Hh[tt][vt][4 * g + 3] - mu) * rstd * ng[3] * sigmoidf_(o3));
                    *(u32x2*)(YS + tok * D + 512 + hc + v) = wv; } }
    }
    __syncthreads();
}
__device__ __forceinline__ void pool_m(int l, int witem) {
    FRAME_SETUP; WS_PTRS; const float* pool_scale = inp(I_POOLS); const bf16* PWT = (const bf16*)(ws + WS_PWT);
    const int lane = F.lane, tl = lane & 31, hh = lane >> 5;
    const int g = witem & 3, tb = witem >> 2, tok0 = tb * 32, b = tok0 >> 13, s = (tok0 & (SEQ - 1)) + tl, half = 1 << g, W = 2 * half;
    const int lo = max(s - half, 0), hi = min(s + half, SEQ); const float inv = 1.0f / (float)(hi - lo);
    const bf16* hb = H + (size_t)b * SEQ * NH + HDX + g * 64 + 8 * hh;
    const size_t tok = (size_t)tok0 + tl;
    f32x16 acc[2];
#pragma unroll
    for (int ot = 0; ot < 2; ++ot)
#pragma unroll
        for (int i = 0; i < 16; ++i) acc[ot][i] = F.zf;
    float a8[4][8];
#pragma unroll
    for (int ks = 0; ks < 4; ++ks)
#pragma unroll
        for (int q = 0; q < 8; ++q) a8[ks][q] = 0.f;
    u32x4 xs[4];
#pragma unroll
    for (int ks = 0; ks < 4; ++ks) xs[ks] = *(const u32x4*)(hb + (size_t)s * NH + 16 * ks);
#pragma unroll 1
    for (int j0 = 0; j0 < W; j0 += 4) { u32x4 raw[4][4];
#pragma unroll
        for (int j = 0; j < 4; ++j) { const int sp = min(max(s - half + j0 + j, 0), SEQ - 1);
#pragma unroll
            for (int ks = 0; ks < 4; ++ks) raw[j][ks] = *(const u32x4*)(hb + (size_t)sp * NH + 16 * ks); }
#pragma unroll
        for (int j = 0; j < 4; ++j) { const int sp = s - half + j0 + j; const float m = (j0 + j < W && sp >= 0 && sp < SEQ) ? 1.f : 0.f;
#pragma unroll
            for (int ks = 0; ks < 4; ++ks) { float v8[8]; unpack8(raw[j][ks], v8);
#pragma unroll
                for (int q = 0; q < 8; ++q) a8[ks][q] += m * v8[q]; } } }
#pragma unroll
    for (int ks = 0; ks < 4; ++ks) { float x8[8]; unpack8(xs[ks], x8);
        const bf16x8 pf = pack8(a8[ks][0] * inv - x8[0], a8[ks][1] * inv - x8[1], a8[ks][2] * inv - x8[2], a8[ks][3] * inv - x8[3], a8[ks][4] * inv - x8[4], a8[ks][5] * inv - x8[5], a8[ks][6] * inv - x8[6], a8[ks][7] * inv - x8[7]);
#pragma unroll
        for (int ot = 0; ot < 2; ++ot) { const bf16x8 wf = *(const bf16x8*)(PWT + ((size_t)(l * 4 + g) * 64 + 32 * ot + tl) * 64 + 16 * ks + 8 * hh); acc[ot] = MFMA32(wf, pf, acc[ot]); } }
#pragma unroll
    for (int ot = 0; ot < 2; ++ot)
#pragma unroll
        for (int gg = 0; gg < 4; ++gg) { const int o = g * 64 + 32 * ot + 8 * gg + 4 * hh; const f32x4 sc = *(const f32x4*)(pool_scale + l * 256 + o);
            u32x2 w; w.x = pk2(acc[ot][4 * gg] * sc[0], acc[ot][4 * gg + 1] * sc[1]); w.y = pk2(acc[ot][4 * gg + 2] * sc[2], acc[ot][4 * gg + 3] * sc[3]);
            *(u32x2*)(YS + tok * D + 768 + o) = w; }
}
constexpr int ATT_PITCH = 144;
__device__ __forceinline__ void att2_item(int item) {
    FRAME_SETUP;
    WS_PTRS; const float* rel_bias = inp(I_RELB);
    const int tid = F.tid, lane = F.lane, w = F.wave;
    const int pat = item >> 8, idx = item & 255, dil = 1 << (2 * pat), L = SEQ / dil, nqb = L >> 8;
    const int jr = idx & 31, h = (idx >> 5) & 3, b = idx >> 7, r = jr / nqb, Q0 = (jr % nqb) * 256;
    LAS unsigned char* Kt = F.lds; LAS unsigned char* Vt = F.lds + 384 * ATT_PITCH; LAS float* bt = (LAS float*)(F.lds + 2 * 384 * ATT_PITCH);
    { u32x4 k8[6], v8[6];
#pragma unroll
        for (int u = 0; u < 6; ++u) { const int i = tid + u * NTHREADS, kk = i >> 3, cg = (i & 7) * 8, kidx = min(max(Q0 - 64 + kk, 0), L - 1);
            const bf16* row = H + (size_t)(b * SEQ + r + dil * kidx) * NH; k8[u] = *(const u32x4*)(row + HAK + h * 64 + cg); v8[u] = *(const u32x4*)(row + HAV + h * 64 + cg); }
#pragma unroll
        for (int u = 0; u < 6; ++u) { const int i = tid + u * NTHREADS, kk = i >> 3, cg = (i & 7) * 8;
            *(LAS u32x4*)(Kt + kk * ATT_PITCH + cg * 2) = k8[u]; *(LAS u32x4*)(Vt + kk * ATT_PITCH + cg * 2) = v8[u]; } }
    if (tid < 192) { const int u = tid - 32, j = u - 64, rel = dil * j, na = rel < 0 ? -rel : rel;
        int bucket = na < 8 ? na : 8 + (na >= 15) + (na >= 27) + (na >= 50) + (na >= 91) + (na >= 166) + (na >= 305) + (na >= 559);
        if (rel > 0) bucket += 16;
        bt[tid] = (u >= 0 && u <= 128) ? rel_bias[min(bucket, 31) * 4 + h] * 1.4426950408889634f : -1e30f; }
    const int ql = lane & 31, hh = lane >> 5;
    const int qi = Q0 + 32 * w + ql; const size_t tok = (size_t)b * SEQ + r + dil * qi;
    bf16x8 qf[4];
#pragma unroll
    for (int ks = 0; ks < 4; ++ks) qf[ks] = *(const bf16x8*)(H + tok * NH + HAQ + h * 64 + 16 * ks + 8 * hh);
    __syncthreads();
    f32x16 S[5];
#pragma unroll
    for (int tk = 0; tk < 5; ++tk) {
#pragma unroll
        for (int i = 0; i < 16; ++i) S[tk][i] = F.zf;
#pragma unroll
        for (int ks = 0; ks < 4; ++ks) { const bf16x8 kf = *(const LAS bf16x8*)(Kt + (32 * w + 32 * tk + ql) * ATT_PITCH + (16 * ks + 8 * hh) * 2); S[tk] = MFMA32(kf, qf[ks], S[tk]); } }
    const LAS float* btl = bt + 32 + 4 * hh - ql;
    float mx = -3.0e38f;
#pragma unroll
    for (int tk = 0; tk < 5; ++tk) {
#pragma unroll
        for (int i = 0; i < 16; ++i) { const float sc = S[tk][i] * (0.125f * 1.4426950408889634f) + btl[32 * tk + (i & 3) + 8 * (i >> 2)]; S[tk][i] = sc; mx = fmaxf(mx, sc); }
        __builtin_amdgcn_sched_barrier(0); }
    const int e0 = Q0 - 64 + 32 * w;
    if (e0 < 0 || e0 + 160 > L) {
        mx = -3.0e38f;
#pragma unroll
        for (int tk = 0; tk < 5; ++tk)
#pragma unroll
            for (int i = 0; i < 16; ++i) { const int kidx = e0 + 32 * tk + crow(i, hh); const float sc = (kidx >= 0 && kidx < L) ? S[tk][i] : -1e30f; S[tk][i] = sc; mx = fmaxf(mx, sc); }
    }
    mx = fmaxf(mx, shx(mx, 32, lane));
    float lsum = 0.f;
#pragma unroll
    for (int tk = 0; tk < 5; ++tk)
#pragma unroll
        for (int i = 0; i < 16; ++i) { const float p = __builtin_amdgcn_exp2f(S[tk][i] - mx); S[tk][i] = p; lsum += p; }
    lsum += shx(lsum, 32, lane);
    f32x16 O[2];
#pragma unroll
    for (int dt = 0; dt < 2; ++dt)
#pragma unroll
        for (int i = 0; i < 16; ++i) O[dt][i] = F.zf;
#pragma unroll
    for (int tk = 0; tk < 5; ++tk)
#pragma unroll
        for (int s2 = 0; s2 < 2; ++s2) { const bf16x8 pf = pack8(S[tk][8 * s2], S[tk][8 * s2 + 1], S[tk][8 * s2 + 2], S[tk][8 * s2 + 3], S[tk][8 * s2 + 4], S[tk][8 * s2 + 5], S[tk][8 * s2 + 6], S[tk][8 * s2 + 7]);
            const int k0 = 32 * w + 32 * tk + 16 * s2 + 4 * hh;
#pragma unroll
            for (int dt = 0; dt < 2; ++dt) { const bf16x8 vf = tr_frag(Vt, ATT_PITCH, k0, k0 + 8, 32 * dt, lane); O[dt] = MFMA32(vf, pf, O[dt]); } }
    const float inv = 1.0f / lsum;
    bf16* op = ATTO + ((size_t)pat * T + tok) * 256 + h * 64 + 4 * hh;
#pragma unroll
    for (int dt = 0; dt < 2; ++dt)
#pragma unroll
        for (int g = 0; g < 4; ++g) { u32x2 wv; wv.x = pk2(O[dt][4 * g] * inv, O[dt][4 * g + 1] * inv); wv.y = pk2(O[dt][4 * g + 2] * inv, O[dt][4 * g + 3] * inv); *(u32x2*)(op + 32 * dt + 8 * g) = wv; }
    if (hh == 0) ATTL[((size_t)pat * T + tok) * 4 + h] = (mx + __builtin_amdgcn_logf(lsum)) * 0.6931471805599453f;
    __syncthreads();
}
__device__ __forceinline__ void att_merge(int item) {
    FRAME_SETUP;
    WS_PTRS;
    const int tid = F.tid; const size_t tok = (size_t)item * 64 + (tid >> 3); const int sub = tid & 7, h = sub >> 1, c0 = h * 64 + (sub & 1) * 32;
    const float l0 = ATTL[tok * 4 + h], l1 = ATTL[((size_t)T + tok) * 4 + h], l2 = ATTL[((size_t)2 * T + tok) * 4 + h];
    const float M = fmaxf(l0, fmaxf(l1, l2)); float w0 = __expf(l0 - M), w1 = __expf(l1 - M), w2 = __expf(l2 - M); const float inv = 1.0f / (w0 + w1 + w2); w0 *= inv; w1 *= inv; w2 *= inv;
    const bf16* o0 = ATTO + tok * 256 + c0; const bf16* o1 = ATTO + ((size_t)T + tok) * 256 + c0; const bf16* o2 = ATTO + ((size_t)2 * T + tok) * 256 + c0;
    bf16* yp = YS + tok * D + 256 + c0;
#pragma unroll
    for (int q = 0; q < 4; ++q) { float a8[8], b8[8], c8[8]; unpack8(*(const u32x4*)(o0 + q * 8), a8); unpack8(*(const u32x4*)(o1 + q * 8), b8); unpack8(*(const u32x4*)(o2 + q * 8), c8);
        u32x4 w; w.x = pk2(a8[0] * w0 + b8[0] * w1 + c8[0] * w2, a8[1] * w0 + b8[1] * w1 + c8[1] * w2); w.y = pk2(a8[2] * w0 + b8[2] * w1 + c8[2] * w2, a8[3] * w0 + b8[3] * w1 + c8[3] * w2);
        w.z = pk2(a8[4] * w0 + b8[4] * w1 + c8[4] * w2, a8[5] * w0 + b8[5] * w1 + c8[5] * w2); w.w = pk2(a8[6] * w0 + b8[6] * w1 + c8[6] * w2, a8[7] * w0 + b8[7] * w1 + c8[7] * w2);
        *(u32x4*)(yp + q * 8) = w; }
}

template <int CTRL> __device__ __forceinline__ float dpp_max(float v) { return fmaxf(v, dpp_mov<CTRL>(v)); }
__device__ __forceinline__ void ln1_router(int l) {
    FRAME_SETUP;
    WS_PTRS; const float* ln1_g = inp(I_LN1G); const float* ln1_b = inp(I_LN1B); const bf16* WRT = (const bf16*)(ws + WS_WRT) + (size_t)l * NE * D; const float* STAT = (const float*)(ws + WS_STAT);
    LAS float* gl = (LAS float*)F.lds; LAS float* bl = gl + D;
    { const int i = F.tid * 2; *(LAS f32x2*)(gl + i) = *(const f32x2*)(ln1_g + l * D + i); *(LAS f32x2*)(bl + i) = *(const f32x2*)(ln1_b + l * D + i); }
    __syncthreads();
    const int lane = F.lane, r = lane & 15, kg = lane >> 4;
    for (int item = F.bid * 4 + F.wave; item < T / 16 && F.wave < 4; item += F.G * 4) {
        const size_t tok = (size_t)item * 16 + r;
        float s1 = 0.f, s2 = 0.f;
        { const f32x4 a = *(const f32x4*)(STAT + (tok * 16 + 4 * kg) * 2), c = *(const f32x4*)(STAT + (tok * 16 + 4 * kg) * 2 + 4); s1 = (a[0] + a[2]) + (c[0] + c[2]); s2 = (a[1] + a[3]) + (c[1] + c[3]); }
        s1 += shx(s1, 16, lane); s1 += shx(s1, 32, lane); s2 += shx(s2, 16, lane); s2 += shx(s2, 32, lane);
        const float mean = s1 * (1.0f / D), var = fmaxf(s2 * (1.0f / D) - mean * mean, 0.f), rstd = 1.0f / sqrtf(var + LN_EPS);
        const float* rp = MGF + tok * D + 8 * kg; bf16* xp = XB + tok * D + 8 * kg; const bf16* wp = WRT + (size_t)r * D + 8 * kg;
        f32x4 acc = (f32x4){F.zf, F.zf, F.zf, F.zf};
#pragma unroll 4
        for (int ks = 0; ks < 32; ++ks) {
            const f32x4 x0 = *(const f32x4*)(rp + 32 * ks), x1 = *(const f32x4*)(rp + 32 * ks + 4);
            const f32x4 g0 = *(const LAS f32x4*)(gl + 32 * ks + 8 * kg), g1 = *(const LAS f32x4*)(gl + 32 * ks + 8 * kg + 4), b0 = *(const LAS f32x4*)(bl + 32 * ks + 8 * kg), b1 = *(const LAS f32x4*)(bl + 32 * ks + 8 * kg + 4);
            const f32x4 y0 = (x0 - mean) * rstd * g0 + b0, y1 = (x1 - mean) * rstd * g1 + b1;
            u32x4 yw; yw.x = pk2(y0[0], y0[1]); yw.y = pk2(y0[2], y0[3]); yw.z = pk2(y1[0], y1[1]); yw.w = pk2(y1[2], y1[3]);
            *(u32x4*)(xp + 32 * ks) = yw;
            const bf16x8 wf = *(const bf16x8*)(wp + 32 * ks);
            acc = __builtin_amdgcn_mfma_f32_16x16x32_bf16(__builtin_bit_cast(bf16x8, yw), wf, acc, 0, 0, 0);
        }
        f32x4 aff;
#pragma unroll
        for (int i = 0; i < 4; ++i) { float m = acc[i]; m = dpp_max<0xB1>(m); m = dpp_max<0x4E>(m); m = dpp_max<0x141>(m); m = dpp_max<0x140>(m);
            const float e = __expf(acc[i] - m); float se = e; se += dpp_mov<0xB1>(se); se += dpp_mov<0x4E>(se); se += dpp_mov<0x141>(se); se += dpp_mov<0x140>(se);
            aff[i] = e * rcpf_(se); }
        { const size_t t0 = (size_t)item * 16 + 4 * kg; const int b = (int)(t0 >> 13), sp = (int)(t0 & (SEQ - 1)); *(f32x4*)(AFF + ((size_t)(b * NE + r)) * SEQ + sp) = aff; }
    }
    __syncthreads();
}
__device__ __forceinline__ unsigned block_excl_scan(LAS unsigned* sc, unsigned val, int tid) {
    sc[tid] = val; __syncthreads();
#pragma unroll 1
    for (int off = 1; off < NTHREADS; off <<= 1) { const unsigned v = tid >= off ? sc[tid - off] : 0u; __syncthreads(); sc[tid] += v; __syncthreads(); }
    const unsigned r = sc[tid] - val; __syncthreads(); return r;
}
__device__ __forceinline__ void topk_item(int be) {
    FRAME_SETUP;
    WS_PTRS;
    const int tid = F.tid, b = be >> 4;
    const float* aff = AFF + (size_t)be * SEQ;
    LAS unsigned* hist = (LAS unsigned*)F.lds; LAS unsigned* sfx = hist + 256; LAS unsigned* sc = sfx + 256; LAS unsigned* misc = sc + 512; LAS int* idxl = (LAS int*)(misc + 4);
    unsigned key[16];
    { const u32x4* ap = (const u32x4*)(aff + tid * 16);
#pragma unroll
        for (int q = 0; q < 4; ++q) { const u32x4 w = ap[q]; key[q * 4] = w.x; key[q * 4 + 1] = w.y; key[q * 4 + 2] = w.z; key[q * 4 + 3] = w.w; } }
    unsigned prefix = 0u, kth = CAP, hmask = 0u;
#pragma unroll 1
    for (int shift = 24; shift >= 0; shift -= 8) {
        if (tid < 256) hist[tid] = 0u;
        __syncthreads();
#pragma unroll
        for (int i = 0; i < 16; ++i) { if (((key[i] ^ prefix) & hmask) == 0u) __hip_atomic_fetch_add(&hist[(key[i] >> shift) & 255u], 1u, __ATOMIC_RELAXED, __HIP_MEMORY_SCOPE_WORKGROUP); }
        __syncthreads();
        if (tid < 256) sfx[tid] = hist[tid];
        __syncthreads();
#pragma unroll 1
        for (int off = 1; off < 256; off <<= 1) { unsigned v = 0u; if (tid < 256 && tid + off < 256) v = sfx[tid + off]; __syncthreads(); if (tid < 256) sfx[tid] += v; __syncthreads(); }
        if (tid < 256) { const unsigned incl = sfx[tid], excl = incl - hist[tid]; if (excl < kth && kth <= incl) { misc[0] = (unsigned)tid; misc[1] = kth - excl; } }
        __syncthreads();
        prefix |= misc[0] << shift; kth = misc[1]; hmask |= 255u << shift;
        __syncthreads();
    }
    unsigned ceq = 0u;
#pragma unroll
    for (int i = 0; i < 16; ++i) ceq += (key[i] == prefix) ? 1u : 0u;
    unsigned eqrank = block_excl_scan(sc, ceq, tid);
    unsigned selmask = 0u, csel = 0u;
#pragma unroll
    for (int i = 0; i < 16; ++i) { bool sel = key[i] > prefix; if (key[i] == prefix) { sel = eqrank < kth; ++eqrank; } if (sel) { selmask |= 1u << i; ++csel; } }
    unsigned slot = block_excl_scan(sc, csel, tid);
#pragma unroll
    for (int i = 0; i < 16; ++i) { const int s = tid * 16 + i;
        if (selmask & (1u << i)) { if (slot < (unsigned)CAP) { IDX[be * CAP + slot] = s; GATE[be * CAP + slot] = __uint_as_float(key[i]); idxl[slot] = s; } SLOT[(size_t)be * SEQ + s] = (int)slot; ++slot; }
        else SLOT[(size_t)be * SEQ + s] = -1; }
    __syncthreads();
    __syncthreads();
}
__device__ __forceinline__ void combine_ln2(int l) {
    FRAME_SETUP;
    WS_PTRS; const float* ln2_g = inp(I_LN2G); const float* ln2_b = inp(I_LN2B); float* out = outp();
    const int lane = F.lane;
    const float* g2 = ln2_g + l * D; const float* b2 = ln2_b + l * D;
    f32x4 gg4[4], bb4[4];
#pragma unroll
    for (int j = 0; j < 4; ++j) { const int d = 8 * lane + 512 * (j >> 1) + 4 * (j & 1); gg4[j] = *(const f32x4*)(g2 + d); bb4[j] = *(const f32x4*)(b2 + d); }
    for (int tok = (F.bid * NWAVES + F.wave) * 2; tok < T; tok += F.G * NWAVES * 2) {
        const int b = tok >> 13, sp = tok & (SEQ - 1);
        int slotv[2]; unsigned mask[2]; f32x4 v[2][4]; u32x4 xr[2][2];
        { const u32x2 sl2 = lane < NE ? *(const u32x2*)(SLOT + ((size_t)(b * NE + lane)) * SEQ + sp) : (u32x2){0xffffffffu, 0xffffffffu}; slotv[0] = (int)sl2.x; slotv[1] = (int)sl2.y; }
#pragma unroll
        for (int u = 0; u < 2; ++u)
#pragma unroll
            for (int jj = 0; jj < 2; ++jj) xr[u][jj] = *(const u32x4*)(XB + (size_t)(tok + u) * D + 8 * lane + 512 * jj);
        __builtin_amdgcn_sched_barrier(0);
#pragma unroll
        for (int u = 0; u < 2; ++u) mask[u] = (unsigned)__ballot(slotv[u] >= 0);
#pragma unroll
        for (int u = 0; u < 2; ++u)
#pragma unroll
            for (int jj = 0; jj < 2; ++jj) { float x8[8]; unpack8(xr[u][jj], x8); v[u][2 * jj] = (f32x4){x8[0], x8[1], x8[2], x8[3]} * ALPHA; v[u][2 * jj + 1] = (f32x4){x8[4], x8[5], x8[6], x8[7]} * ALPHA; }
        while (mask[0] | mask[1]) {
            u32x4 r[2][3][2]; bool on[2][3];
#pragma unroll
            for (int u = 0; u < 2; ++u)
#pragma unroll
                for (int k = 0; k < 3; ++k) { on[u][k] = mask[u] != 0u; const int e = on[u][k] ? __builtin_ctz(mask[u]) : 0; mask[u] &= mask[u] - 1u;
                    const int sl = __builtin_amdgcn_readlane(slotv[u], e);
                    if (on[u][k]) { const bf16* yr = YE + ((size_t)(b * NE + e) * CAP + sl) * D;
#pragma unroll
                        for (int jj = 0; jj < 2; ++jj) r[u][k][jj] = *(const u32x4*)(yr + 8 * lane + 512 * jj); } }
#pragma unroll
            for (int u = 0; u < 2; ++u)
#pragma unroll
                for (int k = 0; k < 3; ++k) if (on[u][k]) {
#pragma unroll
                    for (int jj = 0; jj < 2; ++jj) { float y8[8]; unpack8(r[u][k][jj], y8); v[u][2 * jj] += (f32x4){y8[0], y8[1], y8[2], y8[3]}; v[u][2 * jj + 1] += (f32x4){y8[4], y8[5], y8[6], y8[7]}; } }
        }
        float s[2], s2[2];
#pragma unroll
        for (int u = 0; u < 2; ++u) { s[u] = 0.f;
#pragma unroll
            for (int j = 0; j < 4; ++j) s[u] += (v[u][j].x + v[u][j].y) + (v[u][j].z + v[u][j].w); }
        s[0] = wave_sum(s[0], lane); s[1] = wave_sum(s[1], lane);
#pragma unroll
        for (int u = 0; u < 2; ++u) { const float mean = s[u] * (1.f / D); s2[u] = 0.f;
#pragma unroll
            for (int j = 0; j < 4; ++j) { v[u][j] = v[u][j] - mean; s2[u] += (v[u][j].x * v[u][j].x + v[u][j].y * v[u][j].y) + (v[u][j].z * v[u][j].z + v[u][j].w * v[u][j].w); } }
        s2[0] = wave_sum(s2[0], lane); s2[1] = wave_sum(s2[1], lane);
#pragma unroll
        for (int u = 0; u < 2; ++u) { const float rstd = 1.f / sqrtf(s2[u] * (1.f / D) + LN_EPS);
#pragma unroll
            for (int jj = 0; jj < 2; ++jj) { const int d = 8 * lane + 512 * jj;
                const f32x4 x0 = v[u][2 * jj] * rstd * gg4[2 * jj] + bb4[2 * jj], x1 = v[u][2 * jj + 1] * rstd * gg4[2 * jj + 1] + bb4[2 * jj + 1];
                u32x4 w; w.x = pk2(x0.x, x0.y); w.y = pk2(x0.z, x0.w); w.z = pk2(x1.x, x1.y); w.w = pk2(x1.z, x1.w); *((u32x4*)(XB + (size_t)(tok + u) * D + d)) = w;
                if (l == DEPTH - 1) { *((f32x4*)(out + (size_t)(tok + u) * D + d)) = x0; *((f32x4*)(out + (size_t)(tok + u) * D + d + 4)) = x1; } } }
    }
}

constexpr int PH_PER_LAYER = 11, N_PHASES = 1 + DEPTH * PH_PER_LAYER;
struct Args { const float* in[22]; float* out; unsigned char* ws; int ph_lo, ph_hi; };
__device__ __forceinline__ void phase_mix1(int l) { FRAME_SETUP;
    for (int it = F.bid; it < 256 + 128; it += F.G) { if (it < 256) mlstm_c1m(l, it); else gmlp_m(l, it - 256); }
    { const int nw = F.G * NWAVES; int first = (F.bid >= 128 ? F.bid - 128 : F.bid + F.G - 128) * NWAVES + F.wave;
      for (int wi = first; wi < 2048; wi += nw) pool_m(l, wi); } }
__device__ __forceinline__ void phase_mix2(int l) { FRAME_SETUP;
    for (int wi = F.bid * 2 + F.wave; wi < 272 && F.wave < 2; wi += F.G * 2) mlstm_scan(wi);
    const bool g256 = F.G == 256, sc = F.bid < 130;
    const int n = g256 ? (sc ? (F.bid < 4 ? 3 : 2) : 4) : (768 - F.bid + F.G - 1) / F.G, first = g256 ? (sc ? 2 * F.bid : 260 + 4 * (F.bid - 130)) : F.bid, stride = g256 ? 1 : F.G;
    for (int k = 0; k < n; ++k) att2_item((g256 && sc && k == 2) ? 764 + F.bid : first + k * stride); }
__device__ __forceinline__ void phase_mix3(int l) { FRAME_SETUP;
    for (int it = F.bid; it < 256 + 256; it += F.G) { if (it < 256) mlstm_c3m(l, it); else att_merge(it - 256); } }
__device__ __forceinline__ void phase_topk(int l) { FRAME_SETUP;
    const bool wide = F.G > 2 * BATCH * NE;
    for (int it = F.bid; it < BATCH * NE; it += F.G) topk_item(it);
    if (l + 1 < DEPTH && (!wide || F.bid >= BATCH * NE)) convert_layer(l + 1, ((wide ? F.bid - BATCH * NE : F.bid)) * NWAVES + F.wave, (wide ? F.G - BATCH * NE : F.G) * NWAVES); }
__device__ __forceinline__ void phase_g1(int l) { FRAME_SETUP; WS_PTRS;
    pg8::GemmP g{D, D, D}; SchedG1 S{F.G, F.bid, (const char*)XB, (const char*)wl(ws, l, OW_IN)}; EpiG1 E{H, GI, BIN + (size_t)l * NINP};
    pg8::gemm_phase<EpiG1, SchedG1, true>(F.lds, F.tid, g, S, E); }
__device__ __forceinline__ void phase_g2(int l) { FRAME_SETUP; WS_PTRS;
    pg8::GemmP g{D, D, D}; SchedG2 S{F.G, F.bid, (const char*)YS, (const char*)wl(ws, l, OW_B)}; EpiG2 E{H, MGB};
    pg8::gemm_phase<EpiG2, SchedG2, true>(F.lds, F.tid, g, S, E); }
__device__ __forceinline__ void phase_g3(int l) { FRAME_SETUP; WS_PTRS;
    pg8::GemmP g{D, D, D}; SchedG3 S{F.G, F.bid, (const char*)MGB, (const char*)wl(ws, l, OW_O)}; EpiG3 E{XB, MGF, (float*)(ws + WS_STAT)};
    pg8::gemm_phase<EpiG3, SchedG3, true>(F.lds, F.tid, g, S, E); }
__device__ __forceinline__ void phase_g4(int l) { FRAME_SETUP; WS_PTRS;
    pg8::GemmP g{D, D, D}; SchedG4 S{F.G, F.bid, (const char*)XB, (const char*)wl(ws, l, OW_13), IDX}; EpiG4 E{HID};
    pg8::gemm_phase<EpiG4, SchedG4, true>(F.lds, F.tid, g, S, E); }
__device__ __forceinline__ void phase_g5(int l) { FRAME_SETUP; WS_PTRS;
    pg8::GemmP g{FF, FF, FF}; SchedG5 S{F.G, F.bid, (const char*)HID, (const char*)wl(ws, l, OW_2)}; EpiG5 E{GATE, YE};
    pg8::gemm_phase<EpiG5, SchedG5, true>(F.lds, F.tid, g, S, E); }

__global__ void __launch_bounds__(NTHREADS, 2) fwd_kernel(Args args) {
    { LAS unsigned char* l0 = lds_base(); for (int u = threadIdx.x; u < (LDS_BYTES - LDSCTL_OFF) / 4; u += NTHREADS) ((LAS unsigned*)(l0 + LDSCTL_OFF))[u] = 0u; }
    __syncthreads();
#if !MK_PER_PHASE
    (void)xcd_barrier_post((unsigned*)(args.ws + WS_CTL) + CW_BAR, (volatile LAS unsigned*)(lds_base() + MISC_OFF) + 8);
#endif
    const int lo = args.ph_lo, hi = args.ph_hi;
#if PROBE_MASK
    volatile LAS unsigned long long* pacc = (volatile LAS unsigned long long*)(lds_base() + MISC_OFF + 64);
#endif
    for (int ph = lo; ph < hi; ++ph) {
#if PROBE_MASK
        const unsigned long long pt0 = __builtin_amdgcn_s_memrealtime();
#endif
        if (ph == 0) { if (PHEN(15)) p0_prologue(); }
        else {
            const int l = (ph - 1) / PH_PER_LAYER, sp = (ph - 1) % PH_PER_LAYER;
            if (sp == 0) { if (PHEN(0)) phase_g1(l); }
            else if (sp == 1) { if (PHEN(1)) phase_mix1(l); }
            else if (sp == 2) { if (PHEN(2)) phase_mix2(l); }
            else if (sp == 3) { if (PHEN(3)) phase_mix3(l); }
            else if (sp == 4) { if (PHEN(4)) phase_g2(l); }
            else if (sp == 5) { if (PHEN(5)) phase_g3(l); }
            else if (sp == 6) { if (PHEN(6)) ln1_router(l); }
            else if (sp == 7) { if (PHEN(7)) phase_topk(l); }
            else if (sp == 8) { if (PHEN(8)) phase_g4(l); }
            else if (sp == 9) { if (PHEN(9)) phase_g5(l); }
            else { if (PHEN(10)) combine_ln2(l); }
        }
#if PROBE_MASK && defined(PROBE_MODE) && PROBE_MODE == 1
        { const int sp_ = ph == 0 ? 15 : (ph - 1) % PH_PER_LAYER; asm volatile("s_waitcnt vmcnt(0)" ::: "memory"); __syncthreads(); const unsigned long long pt1 = __builtin_amdgcn_s_memrealtime();
          if (threadIdx.x == 0 && ((PROBE_MASK >> sp_) & 1)) pacc[0] = pacc[0] + (pt1 - pt0); }
#endif
        if (ph + 1 < hi) {
#if !MK_PER_PHASE
            { XcdBarrier bar; bar.bar = (unsigned*)(wsp() + WS_CTL) + CW_BAR; bar.x = xb_xcc_id(); bar.st = (volatile LAS unsigned*)(lds_base() + MISC_OFF) + 8; xcd_barrier(bar); }
#endif
        }
#if PROBE_MASK && !(defined(PROBE_MODE) && PROBE_MODE == 1)
        { const int sp_ = ph == 0 ? 15 : (ph - 1) % PH_PER_LAYER; const unsigned long long pt1 = __builtin_amdgcn_s_memrealtime();
          if (threadIdx.x == 0 && ((PROBE_MASK >> sp_) & 1)) pacc[0] = pacc[0] + (pt1 - pt0); }
#endif
    }
#if PROBE_MASK
    if (threadIdx.x == 0 && blockIdx.x == 0) { const unsigned long long t0 = __builtin_amdgcn_s_memrealtime(), need = pacc[0]; while (__builtin_amdgcn_s_memrealtime() - t0 < need) __builtin_amdgcn_s_sleep(8); }
#endif
}

extern "C" void kernel_launch(void* const* d_in, const int* in_sizes, int n_in, void* d_out, int out_size, void* d_ws, size_t ws_size, hipStream_t stream) {
    static int grid = 0;
    if (grid == 0) {
        if (n_in != 22 || in_sizes[0] != T * D || out_size != T * D || ws_size < WS_END) {
            fprintf(stderr, "kernel_launch: unexpected shapes: n_in %d in0 %d out %d ws %zu (need %zu); nothing launched\n", n_in, n_in > 0 ? in_sizes[0] : -1, out_size, ws_size, (size_t)WS_END); grid = -1; return; }
        int dev = 0, cus = 0;
        if (hipGetDevice(&dev) != hipSuccess || hipDeviceGetAttribute(&cus, hipDeviceAttributeMultiprocessorCount, dev) != hipSuccess) { grid = -1; return; }
        if (hipFuncSetAttribute((const void*)fwd_kernel, hipFuncAttributeMaxDynamicSharedMemorySize, LDS_BYTES) != hipSuccess) { fprintf(stderr, "kernel_launch: hipFuncSetAttribute failed\n"); grid = -1; return; }
        int per_cu = 0;
        if (hipOccupancyMaxActiveBlocksPerMultiprocessor(&per_cu, (const void*)fwd_kernel, NTHREADS, LDS_BYTES) != hipSuccess || per_cu < 1)
            fprintf(stderr, "kernel_launch: note: occupancy query reports %d workgroups per CU\n", per_cu);
        (void)hipGetLastError();
        grid = cus;
    }
    if (grid < 0) return;
    (void)hipMemsetAsync((char*)d_ws + WS_CTL, 0, CTL_ZERO_BYTES, stream);
    Args a{};
    for (int i = 0; i < 22; ++i) a.in[i] = (const float*)d_in[i];
    a.out = (float*)d_out; a.ws = (unsigned char*)d_ws;
#if MK_PER_PHASE
    for (int ph = 0; ph < N_PHASES; ++ph) { a.ph_lo = ph; a.ph_hi = ph + 1; hipLaunchKernelGGL(fwd_kernel, dim3(grid), dim3(NTHREADS), LDS_BYTES, stream, a); }
#else
    a.ph_lo = 0; a.ph_hi = N_PHASES; hipLaunchKernelGGL(fwd_kernel, dim3(grid), dim3(NTHREADS), LDS_BYTES, stream, a);
#endif
}
```

```cpp
#include <hip/hip_runtime.h>
#include <cstdio>
#include <cstdint>

#ifndef PH_MASK
#define PH_MASK 0xFFFF
#endif
#define PHEN(k) ((PH_MASK >> (k)) & 1)
#ifndef PROBE_MASK
#define PROBE_MASK 0
#endif
#ifndef MK_PER_PHASE
#define MK_PER_PHASE 0
#endif

#define GAS __attribute__((address_space(1)))
#define LAS __attribute__((address_space(3)))
typedef unsigned short bf16;
typedef short bf16x8 __attribute__((ext_vector_type(8)));
typedef float f32x4 __attribute__((ext_vector_type(4)));
typedef float f32x2 __attribute__((ext_vector_type(2)));
typedef unsigned u32x4 __attribute__((ext_vector_type(4)));
typedef unsigned u32x2 __attribute__((ext_vector_type(2)));
typedef GAS unsigned gu32;
#define RLX_AGENT __ATOMIC_RELAXED, __HIP_MEMORY_SCOPE_AGENT
#define LDS_WAIT() asm volatile("s_waitcnt lgkmcnt(0)" ::: "memory")
#define VM_WAIT() asm volatile("s_waitcnt vmcnt(0)" ::: "memory")

constexpr int BATCH = 2, SEQ = 8192, D = 1024, T = BATCH * SEQ, DEPTH = 4;
constexpr int NIN = 6672;
constexpr int NH = 6656;
constexpr int NINP = 6912;
constexpr int NE = 16, CAP = 1024, FF = 1024, NSLOT = BATCH * NE * CAP;
constexpr float ALPHA = 1.6817928305074292f;
constexpr float LN_EPS = 1e-5f;
constexpr int HU = 0, HV = 256, HAQ = 512, HAK = 768, HAV = 1024, HCQ = 1280, HCK = 1536, HCV = 1792, HCO = 2048, HDX = 2304, HG = 2560;

constexpr size_t MiB = 1u << 20;
constexpr size_t WS_CTL = 0, CTL_ZERO_BYTES = 64 * 1024;
constexpr size_t WS_BIN = 1 * MiB;
constexpr size_t WS_WSB = 1 * MiB + 512 * 1024;
constexpr size_t WS_PWT = 1 * MiB + 256 * 1024;
constexpr size_t WS_W = 2 * MiB, LW = 114 * MiB;
constexpr size_t OW_IN = 0, OW_B = 14 * MiB, OW_O = 16 * MiB, OW_13 = 18 * MiB, OW_2 = 82 * MiB;
constexpr size_t WS_XF = 458 * MiB;
constexpr size_t WS_STAT = WS_XF;
constexpr size_t WS_WRT = 1 * MiB + 128 * 1024;
constexpr size_t WS_XB = 522 * MiB;
constexpr size_t WS_BIG = 554 * MiB;
constexpr size_t WS_XS = WS_BIG, WS_HID = WS_BIG + 64 * MiB, WS_YE = WS_BIG + 128 * MiB;
constexpr size_t WS_GI = 762 * MiB;
constexpr size_t WS_ATTO = 763 * MiB;
constexpr size_t WS_ATTL = 811 * MiB;
constexpr size_t WS_YS = 812 * MiB;
constexpr size_t WS_MGF = 844 * MiB;
constexpr size_t WS_MGB = 908 * MiB;
constexpr size_t WS_QC = 940 * MiB, WS_KC = 956 * MiB;
constexpr size_t WS_DC = 972 * MiB;
constexpr size_t WS_DG = 1005 * MiB;
constexpr size_t WS_AFF = 1006 * MiB;
constexpr size_t WS_IDX = 1007 * MiB;
constexpr size_t WS_GATE = 1007 * MiB + 512 * 1024;
constexpr size_t WS_SLOT = 1008 * MiB;
constexpr size_t WS_END = 1009 * MiB;

constexpr int CW_BAR = 4096;

constexpr int RING_BYTES = 131072;
constexpr int LDSCTL_OFF = RING_BYTES, MISC_OFF = LDSCTL_OFF + 320;
constexpr int LDS_BYTES = 147456;
constexpr int NWAVES = 8, NTHREADS = 512;

__device__ __forceinline__ float bf2f(unsigned v) { return __uint_as_float(v << 16); }
__device__ __forceinline__ unsigned f2bf(float f) { unsigned u = __float_as_uint(f); return (u + 0x7fffu + ((u >> 16) & 1u)) >> 16; }
typedef __bf16 bf16x2_t_ __attribute__((ext_vector_type(2)));
__device__ __forceinline__ unsigned pk2(float lo, float hi) { f32x2 v = {lo, hi}; bf16x2_t_ b = __builtin_convertvector(v, bf16x2_t_); return __builtin_bit_cast(unsigned, b); }
__device__ __forceinline__ float rcpf_(float x) { return __builtin_amdgcn_rcpf(x); }
__device__ __forceinline__ void unpack8(const u32x4 w, float (&o)[8]) {
    o[0] = __uint_as_float(w.x << 16); o[1] = __uint_as_float(w.x & 0xffff0000u);
    o[2] = __uint_as_float(w.y << 16); o[3] = __uint_as_float(w.y & 0xffff0000u);
    o[4] = __uint_as_float(w.z << 16); o[5] = __uint_as_float(w.z & 0xffff0000u);
    o[6] = __uint_as_float(w.w << 16); o[7] = __uint_as_float(w.w & 0xffff0000u);
}
__device__ __forceinline__ float sigmoidf_(float x) { return rcpf_(1.0f + __expf(-x)); }
__device__ __forceinline__ float siluf_(float x) { return x * rcpf_(1.0f + __expf(-x)); }
__device__ __forceinline__ float gelu_tanh(float x) { const float u = 1.5957691216057308f * (x + 0.044715f * x * x * x); return x * rcpf_(1.0f + __expf(-u)); }
__device__ __forceinline__ float logsigmoidf_(float z) { return fminf(z, 0.f) - log1pf(__expf(-fabsf(z))); }
__device__ __forceinline__ float shx(float v, int o, int lane) { return __int_as_float(__builtin_amdgcn_ds_bpermute((lane ^ o) << 2, __float_as_int(v))); }
template <int CTRL> __device__ __forceinline__ float dpp_mov(float v) { return __int_as_float(__builtin_amdgcn_update_dpp(0, __float_as_int(v), CTRL, 0xF, 0xF, false)); }
__device__ __forceinline__ float wave_sum(float v, int lane) { (void)lane;
    v += dpp_mov<0xB1>(v); v += dpp_mov<0x4E>(v); v += dpp_mov<0x141>(v); v += dpp_mov<0x140>(v);
    const int iv = __float_as_int(v);
    return (__int_as_float(__builtin_amdgcn_readlane(iv, 0)) + __int_as_float(__builtin_amdgcn_readlane(iv, 16))) + (__int_as_float(__builtin_amdgcn_readlane(iv, 32)) + __int_as_float(__builtin_amdgcn_readlane(iv, 48)));
}

#define XB_TMO      128
#define XB_XCNT(j)  (256  + 64 * (j))
#define XB_XSUB(j)  (1280 + 64 * (j))
#define XB_XGEN(j)  (2304 + 64 * (j))
#define XB_TOP      3328
#define XB_TOPGEN   3392
#define XCD_BAR_WORDS 3456
#define XB_SPIN_CAP (1u << 18)
__device__ __forceinline__ unsigned xb_ld(unsigned* p)              { return __hip_atomic_load(p, __ATOMIC_RELAXED, __HIP_MEMORY_SCOPE_AGENT); }
__device__ __forceinline__ unsigned xb_add(unsigned* p, unsigned v) { return __hip_atomic_fetch_add(p, v, __ATOMIC_RELAXED, __HIP_MEMORY_SCOPE_AGENT); }
__device__ __forceinline__ unsigned xb_xcc_id() { return (unsigned)__builtin_amdgcn_s_getreg((3 << 11) | 20) & 0xFu; }
#define XB_SPIN(cond, bar) do { unsigned _sp = 0; while (cond) { __builtin_amdgcn_s_sleep(1); \
    if ((++_sp & 255u) == 0u) { if (xb_ld(&(bar)[XB_TMO])) break; if (_sp > XB_SPIN_CAP) { atomicAdd(&(bar)[XB_TMO], 1u); break; } } } } while (0)
struct XcdBarrier { unsigned* bar; unsigned x; volatile LAS unsigned* st; };
__device__ __forceinline__ XcdBarrier xcd_barrier_post(unsigned* bar, volatile LAS unsigned* st) {
    XcdBarrier b; b.bar = bar; b.x = xb_xcc_id(); b.st = st;
    if (threadIdx.x == 0) (void)xb_add(&bar[XB_XCNT(b.x)], 1u);
    return b;
}
__device__ __forceinline__ void xcd_barrier_complete(unsigned* bar, unsigned x, unsigned& nloc, unsigned& nx) {
    const unsigned G = gridDim.x * gridDim.y * gridDim.z;
    unsigned sum, cnt, mine, sp = 0u;
    for (;;) {
        sum = 0u; cnt = 0u; mine = 0u;
#pragma unroll
        for (unsigned j = 0; j < 16; ++j) { const unsigned c = xb_ld(&bar[XB_XCNT(j)]); sum += c; cnt += (c > 0u) ? 1u : 0u; mine = (j == x) ? c : mine; }
        if (sum == G) break;
        __builtin_amdgcn_s_sleep(1);
        if ((++sp & 255u) == 0u) { if (xb_ld(&bar[XB_TMO])) break; if (sp > XB_SPIN_CAP) { atomicAdd(&bar[XB_TMO], 1u); break; } }
    }
    nloc = mine > 0u ? mine : 1u; nx = cnt > 0u ? cnt : 1u;
}
__device__ __forceinline__ void xcd_barrier(const XcdBarrier& b) {
    asm volatile("s_waitcnt vmcnt(0)" ::: "memory");
    __syncthreads();
    if (threadIdx.x == 0) {
        unsigned* bar = b.bar;
        __builtin_amdgcn_s_waitcnt(0);
        unsigned nloc = b.st[0], nx = b.st[1];
        if (nloc == 0u) { xcd_barrier_complete(bar, b.x, nloc, nx); b.st[0] = nloc; b.st[1] = nx; }
        const unsigned old = xb_add(&bar[XB_XSUB(b.x)], 1u);
        const unsigned gen = old / nloc;
        if (old + 1u == (gen + 1u) * nloc) {
            __builtin_amdgcn_fence(__ATOMIC_RELEASE, "agent");
            asm volatile("s_waitcnt vmcnt(0)" ::: "memory");
            const unsigned og = xb_add(&bar[XB_TOP], 1u);
            const unsigned tg = og / nx;
            if (og + 1u == (tg + 1u) * nx) xb_add(&bar[XB_TOPGEN], 1u);
            else XB_SPIN(xb_ld(&bar[XB_TOPGEN]) == tg, bar);
            __builtin_amdgcn_fence(__ATOMIC_ACQUIRE, "agent");
            xb_add(&bar[XB_XGEN(b.x)], 1u);
            asm volatile("s_waitcnt vmcnt(0)" ::: "memory");
        } else {
            XB_SPIN(xb_ld(&bar[XB_XGEN(b.x)]) == gen, bar);
            __builtin_amdgcn_fence(__ATOMIC_ACQUIRE, "agent");
            asm volatile("s_waitcnt vmcnt(0)" ::: "memory");
        }
    }
    __syncthreads();
}

namespace pg8 {
constexpr int BM = 256, BK = 64, HALF = 128, HTB = HALF * BK * 2, STAGE_BYTES = 8 * HTB, NXCD = 8, WGM = 8;
__host__ __device__ __forceinline__ int lds_byte(int r, int c) { const int st = (r >> 4) * 2 + (c >> 5), rr = r & 15, cc = c & 31, ob = rr * 64 + cc * 2; return st * 1024 + (ob ^ (((ob >> 9) & 1) << 5)); }
__host__ __device__ __forceinline__ void stage_rc(int b, int& R, int& C) { const int st = b / 1024, sb = b % 1024, swz = sb ^ (((sb >> 9) & 1) << 5); R = (st >> 1) * 16 + swz / 64; C = (st & 1) * 32 + (swz % 64) / 2; }
__host__ __device__ __forceinline__ int perm32(int rho) { const int n = rho >> 4, i = rho & 15; return 8 * (i >> 2) + 4 * n + (i & 3); }

struct Unit { int pm, pn, aux; const char* A; const char* B; };
struct GemmP { int K, lda, ldb; };

__device__ __forceinline__ bool tile_of(int i, int G, int c, int nM, int nN, int& pm, int& pn) {
    const int nwg = nM * nN; const int L = i * G + c; if (L >= nwg) return false;
    int wgid = L; { const int q = nwg / NXCD, r = nwg % NXCD, xcd = wgid % NXCD, off = wgid / NXCD; wgid = (xcd < r ? xcd * (q + 1) : r * (q + 1) + (xcd - r) * q) + off; }
    const int nig = WGM * nN, gid = wgid / nig, fm = gid * WGM, gsz = (nM - fm) < WGM ? (nM - fm) : WGM;
    pm = fm + ((wgid % nig) % gsz); pn = (wgid % nig) / gsz; return true;
}

__device__ __forceinline__ unsigned cvt_pk_bf16(float lo, float hi) { unsigned r; asm volatile("v_cvt_pk_bf16_f32 %0, %1, %2" : "=v"(r) : "v"(lo), "v"(hi)); return r; }

template <class Epi, class Sched, bool ALIGN_EPI>
__device__ __forceinline__ void gemm_phase(LAS unsigned char* lds, const int tid, const GemmP g, const Sched& S, const Epi& E) {
    const int wid = __builtin_amdgcn_readfirstlane(tid >> 6), lane = tid & 63, wr = wid >> 2, wc = wid & 3, fr = lane & 15, fq = lane >> 4;
    const int K = g.K, nt = K / BK;
    unsigned voffB[2]; int Ri[2], Ci[2];
#pragma unroll
    for (int i = 0; i < 2; ++i) { int R, C; stage_rc(tid * 16 + i * 8192, R, C); const int Rb = Epi::PERM ? ((R & ~31) + perm32(R & 31)) : R;
        Ri[i] = R; Ci[i] = C; voffB[i] = (unsigned)(Rb * g.ldb + C) * 2u; }
    const size_t kstep = (size_t)(BK * 2);
    const size_t hstepB = (size_t)HALF * g.ldb * 2;
    unsigned vA0[2], vA1[2], nvA0[2], nvA1[2];
    const unsigned ldsw = (unsigned)wid * 1024u;
    const int aoff = lds_byte(wr * 64 + fr, fq * 8), boff = lds_byte(wc * 32 + fr, fq * 8);
#define PG8_SA(b, h) (((b) * 2 + (h)) * HTB)
#define PG8_SB(b, h) ((4 + (b) * 2 + (h)) * HTB)
#define PG8_STAGE(bufoff, gbase, voff) do { _Pragma("unroll") for (int _i = 0; _i < 2; ++_i) \
        __builtin_amdgcn_global_load_lds((const unsigned*)((const char*)(gbase) + (voff)[_i]), (LAS unsigned*)(lds + (bufoff) + ldsw + _i * 8192), 16, 0, 0); } while (0)
#define PG8_LDA(dst, b, h) do { _Pragma("unroll") for (int m = 0; m < 4; ++m) _Pragma("unroll") for (int k = 0; k < 2; ++k) dst[m][k] = *(const LAS bf16x8*)(lds + PG8_SA(b, h) + aoff + m * 2048 + k * 1024); } while (0)
#define PG8_LDB(dst, b, h) do { _Pragma("unroll") for (int n = 0; n < 2; ++n) _Pragma("unroll") for (int k = 0; k < 2; ++k) dst[n][k] = *(const LAS bf16x8*)(lds + PG8_SB(b, h) + boff + n * 2048 + k * 1024); } while (0)
#define PG8_MMA(ai, bj, At, Bt) do { __builtin_amdgcn_s_setprio(1); _Pragma("unroll") for (int m = 0; m < 4; ++m) _Pragma("unroll") for (int n = 0; n < 2; ++n) _Pragma("unroll") for (int k = 0; k < 2; ++k) \
        acc[ai][bj][m][n] = __builtin_amdgcn_mfma_f32_16x16x32_bf16(Bt[n][k], At[m][k], acc[ai][bj][m][n], 0, 0, 0); __builtin_amdgcn_s_setprio(0); } while (0)
#define PG8_WAIT_V(n) asm volatile("s_waitcnt vmcnt(" #n ")" ::: "memory")
#define PG8_WAIT_L(n) asm volatile("s_waitcnt lgkmcnt(" #n ")" ::: "memory")
#define PG8_BAR __builtin_amdgcn_s_barrier()
#define PG8_SCHED __builtin_amdgcn_sched_barrier(0)
    Unit cur, nxt; int ui = 0;
    if (!S.next(0, cur)) return;
    float zf = 0.f; asm volatile("" : "+v"(zf));
    f32x4 acc[2][2][4][2];
#pragma unroll
    for (int a = 0; a < 2; ++a)
#pragma unroll
        for (int b = 0; b < 2; ++b)
#pragma unroll
            for (int m = 0; m < 4; ++m)
#pragma unroll
                for (int n = 0; n < 2; ++n) acc[a][b][m][n] = (f32x4){zf, zf, zf, zf};
    bf16x8 At[4][2], B0[2][2], B1[2][2];
    typename Epi::Pre pre;
    const char* cA = cur.A; const char* cB = cur.B;
    S.a_off(cur, g.lda, Ri, Ci, vA0, vA1);
    PG8_STAGE(PG8_SB(0, 0), cB, voffB); PG8_STAGE(PG8_SB(0, 1), cB + hstepB, voffB); PG8_STAGE(PG8_SA(0, 0), cA, vA0); PG8_STAGE(PG8_SA(0, 1), cA, vA1);
    if (wr == 1) PG8_BAR;
    PG8_WAIT_V(2); PG8_BAR;
    PG8_STAGE(PG8_SB(1, 0), cB + kstep, voffB); PG8_STAGE(PG8_SA(1, 0), cA + kstep, vA0); PG8_STAGE(PG8_SB(1, 1), cB + hstepB + kstep, voffB);
    PG8_WAIT_V(6); PG8_BAR;
    for (;;) {
        const bool has_next = S.next(ui + 1, nxt);
        const char* nA = has_next ? nxt.A : cA; const char* nB = has_next ? nxt.B : cB;
        if (has_next) S.a_off(nxt, g.lda, Ri, Ci, nvA0, nvA1); else { nvA0[0] = vA0[0]; nvA0[1] = vA0[1]; nvA1[0] = vA1[0]; nvA1[1] = vA1[1]; }
        for (int t = 0; t < nt; t += 2) {
            if constexpr (Epi::HOOK) { if (t != 0 && (t & 3) == 0) E.hook(acc, cur, t >> 2, wr, wc, fr, fq); }
            const bool last = (t == nt - 2);
            if (last) E.prefetch(cur, wr, wc, fr, fq, pre);
            const char* a1 = cA + (size_t)(t + 1) * kstep;
            const char* a2 = last ? nA : cA + (size_t)(t + 2) * kstep; const char* b2 = last ? nB : cB + (size_t)(t + 2) * kstep;
            const char* a3 = a2 + kstep; const char* b3 = b2 + kstep;
            unsigned w0[2], w1[2];
            w0[0] = last ? nvA0[0] : vA0[0]; w0[1] = last ? nvA0[1] : vA0[1]; w1[0] = last ? nvA1[0] : vA1[0]; w1[1] = last ? nvA1[1] : vA1[1];
            PG8_LDB(B0, 0, 0); PG8_LDB(B1, 0, 1); PG8_SCHED; PG8_LDA(At, 0, 0); PG8_STAGE(PG8_SA(1, 1), a1, vA1);
            PG8_WAIT_V(8); PG8_WAIT_L(0); PG8_BAR; PG8_MMA(0, 0, At, B0); PG8_MMA(0, 1, At, B1); PG8_BAR; PG8_SCHED;
            PG8_LDA(At, 0, 1); PG8_STAGE(PG8_SB(0, 0), b2, voffB); PG8_STAGE(PG8_SB(0, 1), b2 + hstepB, voffB); PG8_STAGE(PG8_SA(0, 0), a2, w0);
            PG8_WAIT_V(8); PG8_WAIT_L(0); PG8_BAR; PG8_MMA(1, 0, At, B0); PG8_MMA(1, 1, At, B1); PG8_BAR; PG8_SCHED;
            PG8_LDB(B0, 1, 0); PG8_LDB(B1, 1, 1); PG8_SCHED; PG8_LDA(At, 1, 0); PG8_STAGE(PG8_SA(0, 1), a2, w1);
            PG8_WAIT_V(8); PG8_WAIT_L(0); PG8_BAR; PG8_MMA(0, 0, At, B0); PG8_MMA(0, 1, At, B1); PG8_BAR; PG8_SCHED;
            PG8_LDA(At, 1, 1); PG8_STAGE(PG8_SB(1, 0), b3, voffB); PG8_STAGE(PG8_SB(1, 1), b3 + hstepB, voffB); PG8_STAGE(PG8_SA(1, 0), a3, w0);
            PG8_WAIT_V(8); PG8_WAIT_L(0); PG8_BAR; PG8_MMA(1, 0, At, B0); PG8_MMA(1, 1, At, B1); PG8_BAR; PG8_SCHED;
        }
        if constexpr (ALIGN_EPI) { if (wr == 0) PG8_BAR; }
        E(acc, cur, wr, wc, fr, fq, pre);
        if (!has_next) break;
#pragma unroll
        for (int a = 0; a < 2; ++a)
#pragma unroll
            for (int b = 0; b < 2; ++b)
#pragma unroll
                for (int m = 0; m < 4; ++m)
#pragma unroll
                    for (int n = 0; n < 2; ++n) acc[a][b][m][n] = (f32x4){zf, zf, zf, zf};
        cur = nxt; cA = nA; cB = nB; ++ui; vA0[0] = nvA0[0]; vA0[1] = nvA0[1]; vA1[0] = nvA1[0]; vA1[1] = nvA1[1];
        if constexpr (ALIGN_EPI) { if (wr == 1) PG8_BAR; }
    }
    PG8_WAIT_V(0);
    if constexpr (!ALIGN_EPI) { if (wr == 0) PG8_BAR; }
    PG8_BAR;
#undef PG8_SA
#undef PG8_SB
#undef PG8_STAGE
#undef PG8_LDA
#undef PG8_LDB
#undef PG8_MMA
#undef PG8_WAIT_V
#undef PG8_WAIT_L
#undef PG8_BAR
#undef PG8_SCHED
}
}

struct Frame { LAS unsigned char* lds; int tid, lane, wave, G, bid; float zf; unsigned zu; };
#define FRAME_SETUP Frame F; { int t_ = threadIdx.x, b_ = blockIdx.x, g_ = gridDim.x; float z_ = 0.f; unsigned zu_ = 0u; asm volatile("" : "+v"(t_), "+s"(b_), "+s"(g_), "+v"(z_), "+v"(zu_)); \
    F.lds = lds_base(); F.tid = t_; F.lane = t_ & 63; F.wave = __builtin_amdgcn_readfirstlane(t_ >> 6); F.G = g_; F.bid = b_; F.zf = z_; F.zu = zu_; }
extern __shared__ __attribute__((aligned(16))) unsigned char lds_dyn[];
__device__ __forceinline__ LAS unsigned char* lds_base() { return (LAS unsigned char*)lds_dyn; }
typedef const __attribute__((address_space(4))) unsigned long long karg_t;
__device__ __forceinline__ unsigned long long karg(int k) { asm volatile("" : "+s"(k)); return ((karg_t*)__builtin_amdgcn_kernarg_segment_ptr())[k]; }
__device__ __forceinline__ const float* inp(int k) { return (const float*)(const GAS float*)karg(k); }
__device__ __forceinline__ float* outp() { return (float*)(GAS float*)karg(22); }
__device__ __forceinline__ unsigned char* wsp() { return (unsigned char*)(GAS unsigned char*)karg(23); }
enum { I_X = 0, I_WIN, I_BIN, I_GMLNG, I_GMWS, I_GMBS, I_RELB, I_MLCONV, I_MLFB, I_MLNG, I_POOLW, I_POOLS, I_WBR, I_WOUT, I_LN1G, I_LN1B, I_WR, I_WE1, I_WE3, I_WE2, I_LN2G, I_LN2B };
__device__ __forceinline__ bf16* wl(unsigned char* ws, int l, size_t off) { return (bf16*)(ws + WS_W + (size_t)l * LW + off); }

#define WS_PTRS unsigned char* ws = wsp(); float* BIN = (float*)(ws + WS_BIN); float* XF = (float*)(ws + WS_XF); bf16* XB = (bf16*)(ws + WS_XB); bf16* H = (bf16*)(ws + WS_BIG); bf16* XS = (bf16*)(ws + WS_XS); \
    bf16* HID = (bf16*)(ws + WS_HID); bf16* YE = (bf16*)(ws + WS_YE); float* GI = (float*)(ws + WS_GI); bf16* ATTO = (bf16*)(ws + WS_ATTO); float* ATTL = (float*)(ws + WS_ATTL); bf16* YS = (bf16*)(ws + WS_YS); \
    float* MGF = (float*)(ws + WS_MGF); bf16* MGB = (bf16*)(ws + WS_MGB); bf16* QC = (bf16*)(ws + WS_QC); bf16* KC = (bf16*)(ws + WS_KC); bf16* DC = (bf16*)(ws + WS_DC); float* DG = (float*)(ws + WS_DG); \
    float* AFF = (float*)(ws + WS_AFF); float* GATE = (float*)(ws + WS_GATE); int* IDX = (int*)(ws + WS_IDX); int* SLOT = (int*)(ws + WS_SLOT); \
    (void)BIN; (void)XF; (void)XB; (void)H; (void)XS; (void)HID; (void)YE; (void)GI; (void)ATTO; (void)ATTL; (void)YS; (void)MGF; (void)MGB; (void)QC; (void)KC; (void)DC; (void)DG; (void)AFF; (void)GATE; (void)IDX; (void)SLOT
__device__ __forceinline__ void tr_item(const float* W, int ldw, int k0, int n0, int ncols, bf16* WT, int ldt, int trow0, LAS float* scr, int lane) {
    const int c4 = lane & 7, r = lane >> 3; const bool cv = 4 * c4 < ncols;
    f32x4 tv[8];
#pragma unroll
    for (int i = 0; i < 8; ++i) tv[i] = cv ? __builtin_nontemporal_load((const f32x4*)(W + (size_t)(k0 + r + 8 * i) * ldw + n0 + 4 * c4)) : (f32x4){0.f, 0.f, 0.f, 0.f};
#pragma unroll
    for (int i = 0; i < 8; ++i) { LAS float* d = scr + (r + 8 * i) * 33 + 4 * c4; d[0] = tv[i][0]; d[1] = tv[i][1]; d[2] = tv[i][2]; d[3] = tv[i][3]; }
    LDS_WAIT(); asm volatile("" ::: "memory");
    const int ch = lane & 7;
#pragma unroll
    for (int j = 0; j < 4; ++j) { const int n = (lane >> 3) + 8 * j; const LAS float* s = scr + (8 * ch) * 33 + n;
        u32x4 o; o.x = pk2(s[0 * 33], s[1 * 33]); o.y = pk2(s[2 * 33], s[3 * 33]); o.z = pk2(s[4 * 33], s[5 * 33]); o.w = pk2(s[6 * 33], s[7 * 33]);
        if (n < ncols) *(GAS u32x4*)(WT + (size_t)(trow0 + n) * ldt + k0 + 8 * ch) = o; }
    LDS_WAIT(); asm volatile("" ::: "memory");
}
constexpr int IT_IN = 16 * 209, IT_B = 512, IT_O = 512, IT_13 = 16384, IT_2 = 8192, IT_LAYER = IT_IN + IT_B + IT_O + IT_13 + IT_2;
__device__ __forceinline__ void convert_layer(int l, int gw, int NGW) {
    FRAME_SETUP;
    WS_PTRS; const float* w_in = inp(I_WIN); const float* w_branch = inp(I_WBR); const float* w_out = inp(I_WOUT); const float* w_e1 = inp(I_WE1); const float* w_e3 = inp(I_WE3); const float* w_e2 = inp(I_WE2);
    LAS float* scr = (LAS float*)(F.lds + F.wave * 16384);
    const int lane = F.lane;
    for (int it = gw; it < IT_LAYER; it += NGW) {
        int r = it; const float* W; int ldw, k0, n0, nc = 32, ldt, trow; bf16* WT;
        if (r < IT_IN) { const int kb = r / 209, cb = r % 209; k0 = 64 * kb;
            if (cb < 72) { n0 = 32 * cb; trow = n0; } else if (cb < 208) { n0 = 2320 + 32 * (cb - 72); trow = 2304 + 32 * (cb - 72); } else { n0 = 2304; trow = 6656; nc = 16; }
            W = w_in + (size_t)l * D * NIN; ldw = NIN; WT = wl(ws, l, OW_IN); ldt = D; }
        else if ((r -= IT_IN) < IT_B) { const int n = r / 128, q = r % 128, kb = q / 32, nb = q % 32;
            W = w_branch + ((size_t)(l * 4 + n) * 256) * D; ldw = D; k0 = 64 * kb; n0 = 32 * nb; WT = wl(ws, l, OW_B) + (size_t)n * 256; ldt = D; trow = 32 * nb; }
        else if ((r -= IT_B) < IT_O) { const int kb = r / 32, nb = r % 32;
            W = w_out + (size_t)l * D * D; ldw = D; k0 = 64 * kb; n0 = 32 * nb; WT = wl(ws, l, OW_O); ldt = D; trow = 32 * nb; }
        else if ((r -= IT_O) < IT_13) { const int e = r / 1024, q = r % 1024, which = q / 512, q2 = q % 512, kb = q2 / 32, nb = q2 % 32, f0 = 32 * nb;
            W = (which ? w_e3 : w_e1) + ((size_t)(l * NE + e) * D) * FF; ldw = FF; k0 = 64 * kb; n0 = f0; WT = wl(ws, l, OW_13) + (size_t)e * 2048 * D; ldt = D; trow = (f0 / 128) * 256 + (f0 % 128) + which * 128; }
        else { r -= IT_13; const int e = r / 512, q = r % 512, kb = q / 32, nb = q % 32;
            W = w_e2 + ((size_t)(l * NE + e) * FF) * D; ldw = D; k0 = 64 * kb; n0 = 32 * nb; WT = wl(ws, l, OW_2) + (size_t)e * D * FF; ldt = FF; trow = 32 * nb; }
        tr_item(W, ldw, k0, n0, nc, WT, ldt, trow, scr, lane);
    }
}
__device__ __forceinline__ void p0_prologue() {
    FRAME_SETUP;
    WS_PTRS; const float* x = inp(I_X); const float* b_in = inp(I_BIN);
    convert_layer(0, F.bid * NWAVES + F.wave, F.G * NWAVES);
    const int gt = F.bid * NTHREADS + F.tid, NGT = F.G * NTHREADS;
    for (int i = gt; i < DEPTH * 240 * (D / 8); i += NGT) { const int l = i / (240 * (D / 8)), r = i % (240 * (D / 8));
        *(GAS u32x4*)(wl(ws, l, OW_IN) + (size_t)NIN * D + (size_t)r * 8) = (u32x4){F.zu, F.zu, F.zu, F.zu}; }
    for (int i = gt; i < DEPTH * NINP; i += NGT) { const int l = i / NINP, c = i % NINP;
        float v = 0.f; if (c < 2304) v = b_in[l * NIN + c]; else if (c < NH) v = b_in[l * NIN + c + 16]; else if (c < NH + 16) v = b_in[l * NIN + c - NH + 2304];
        BIN[i] = v; }
    { const float* gm_ws = inp(I_GMWS); bf16* WSB = (bf16*)(ws + WS_WSB);
      for (int i = gt; i < DEPTH * 4 * 128 * 128 / 4; i += NGT) { const f32x4 v = ((const GAS f32x4*)gm_ws)[i]; u32x2 w; w.x = pk2(v.x, v.y); w.y = pk2(v.z, v.w); ((GAS u32x2*)WSB)[i] = w; } }
    { const float* pool_w = inp(I_POOLW); bf16* PWT = (bf16*)(ws + WS_PWT);
      for (int i = gt; i < DEPTH * 4 * 64 * 64; i += NGT) { const int lg = i >> 12, o = (i >> 6) & 63, ii = i & 63; PWT[i] = (bf16)f2bf(pool_w[(size_t)lg * 4096 + ii * 64 + o]); } }
    { const float* w_router = inp(I_WR); bf16* WRT = (bf16*)(ws + WS_WRT);
      for (int i = gt; i < DEPTH * NE * D; i += NGT) { const int ll = i / (NE * D), e = (i / D) % NE, d = i % D; WRT[i] = (bf16)f2bf(w_router[((size_t)ll * D + d) * NE + e]); } }
    for (int i = gt; i < T * D / 8; i += NGT) { const f32x4 v0 = __builtin_nontemporal_load((const GAS f32x4*)x + 2 * i), v1 = __builtin_nontemporal_load((const GAS f32x4*)x + 2 * i + 1);
        u32x4 w; w.x = pk2(v0.x, v0.y); w.y = pk2(v0.z, v0.w); w.z = pk2(v1.x, v1.y); w.w = pk2(v1.z, v1.w); ((GAS u32x4*)XB)[i] = w; }
}

typedef f32x4 Acc[2][2][4][2];
struct SchedG1 { int G, c; const char* A; const char* B;
    __device__ __forceinline__ void a_off(const pg8::Unit&, int lda, const int (&Ri)[2], const int (&Ci)[2], unsigned (&v0)[2], unsigned (&v1)[2]) const {
#pragma unroll
        for (int i = 0; i < 2; ++i) { v0[i] = (unsigned)(Ri[i] * lda + Ci[i]) * 2u; v1[i] = v0[i] + (unsigned)(128 * lda * 2); } }
    __device__ __forceinline__ bool next(int i, pg8::Unit& u) const { int pm, pn; if (!pg8::tile_of(i, G, c, T / 256, NINP / 256, pm, pn)) return false;
        u.pm = pm; u.pn = pn; u.aux = 0; u.A = A + (size_t)pm * 256 * D * 2; u.B = B + (size_t)pn * 256 * D * 2; return true; } };
struct EpiG1 { static constexpr bool PERM = true, HOOK = false; bf16* H; float* GI; const float* bias;
    struct Pre { f32x4 bv[2][2]; };
    __device__ __forceinline__ void prefetch(const pg8::Unit& u, int wr, int wc, int fr, int fq, Pre& p) const { const int col0 = u.pn * 256 + wc * 32 + 8 * fq;
#pragma unroll
        for (int bj = 0; bj < 2; ++bj)
#pragma unroll
            for (int n = 0; n < 2; ++n) { f32x4 t = *(const f32x4*)(bias + col0 + bj * 128 + 4 * n); if (u.pn >= 10 && u.pn < 26) t = t * (-1.4426950408889634f); p.bv[bj][n] = t; } }
    __device__ __forceinline__ void operator()(const Acc& acc, const pg8::Unit& u, int wr, int wc, int fr, int fq, const Pre& pre) const {
        const int row0 = u.pm * 256 + wr * 64 + fr;
        if (u.pn < 26) {
            const int col0 = u.pn * 256 + wc * 32 + 8 * fq; const bool act = u.pn < 2, sg = u.pn >= 10;
#pragma unroll
            for (int ai = 0; ai < 2; ++ai)
#pragma unroll
                for (int m = 0; m < 4; ++m) { bf16* rowp = H + (size_t)(row0 + ai * 128 + m * 16) * NH + col0;
#pragma unroll
                    for (int bj = 0; bj < 2; ++bj) { f32x4 v0 = sg ? acc[ai][bj][m][0] * (-1.4426950408889634f) + pre.bv[bj][0] : acc[ai][bj][m][0] + pre.bv[bj][0], v1 = sg ? acc[ai][bj][m][1] * (-1.4426950408889634f) + pre.bv[bj][1] : acc[ai][bj][m][1] + pre.bv[bj][1];
                        if (act) { v0 = (f32x4){gelu_tanh(v0[0]), gelu_tanh(v0[1]), gelu_tanh(v0[2]), gelu_tanh(v0[3])}; v1 = (f32x4){gelu_tanh(v1[0]), gelu_tanh(v1[1]), gelu_tanh(v1[2]), gelu_tanh(v1[3])}; }
                        if (sg) {
                            u32x2 qb; qb.x = 0u; qb.y = 0u;
#pragma unroll
                            for (int j = 0; j < 4; ++j) { qb.x = __builtin_amdgcn_cvt_pk_u8_f32(rcpf_(1.0f + __builtin_amdgcn_exp2f(v0[j])) * 256.0f - 0.5f, j, qb.x); qb.y = __builtin_amdgcn_cvt_pk_u8_f32(rcpf_(1.0f + __builtin_amdgcn_exp2f(v1[j])) * 256.0f - 0.5f, j, qb.y); }
                            *(u32x2*)((unsigned char*)(H + (size_t)(row0 + ai * 128 + m * 16) * NH + HG) + (col0 + bj * 128 - HG)) = qb;
                        } else {
                        u32x4 w; w.x = pk2(v0[0], v0[1]); w.y = pk2(v0[2], v0[3]); w.z = pk2(v1[0], v1[1]); w.w = pk2(v1[2], v1[3]);
                        *(u32x4*)(rowp + bj * 128) = w; } } }
        } else if (wc == 0 && fq < 2) {
#pragma unroll
            for (int ai = 0; ai < 2; ++ai)
#pragma unroll
                for (int m = 0; m < 4; ++m) { float* rowp = GI + (size_t)(row0 + ai * 128 + m * 16) * 16 + 8 * fq;
#pragma unroll
                    for (int n = 0; n < 2; ++n) *(f32x4*)(rowp + 4 * n) = acc[ai][0][m][n] + pre.bv[0][n]; }
        }
    } };
struct SchedG2 { int G, c; const char* A; const char* B;
    __device__ __forceinline__ void a_off(const pg8::Unit&, int lda, const int (&Ri)[2], const int (&Ci)[2], unsigned (&v0)[2], unsigned (&v1)[2]) const {
#pragma unroll
        for (int i = 0; i < 2; ++i) { v0[i] = (unsigned)(Ri[i] * lda + Ci[i]) * 2u; v1[i] = v0[i] + (unsigned)(128 * lda * 2); } }
    __device__ __forceinline__ bool next(int i, pg8::Unit& u) const { int pm, pn; if (!pg8::tile_of(i, G, c, T / 256, D / 256, pm, pn)) return false;
        u.pm = pm; u.pn = pn; u.aux = 0; u.A = A + (size_t)pm * 256 * D * 2; u.B = B + (size_t)pn * 256 * D * 2; return true; } };
__device__ __forceinline__ void unq8(const u32x2 w, float (&o)[8]) {
    o[0] = ((float)(w.x & 255u) + 0.5f) * (1.0f / 256.0f); o[1] = ((float)((w.x >> 8) & 255u) + 0.5f) * (1.0f / 256.0f); o[2] = ((float)((w.x >> 16) & 255u) + 0.5f) * (1.0f / 256.0f); o[3] = ((float)(w.x >> 24) + 0.5f) * (1.0f / 256.0f);
    o[4] = ((float)(w.y & 255u) + 0.5f) * (1.0f / 256.0f); o[5] = ((float)((w.y >> 8) & 255u) + 0.5f) * (1.0f / 256.0f); o[6] = ((float)((w.y >> 16) & 255u) + 0.5f) * (1.0f / 256.0f); o[7] = ((float)(w.y >> 24) + 0.5f) * (1.0f / 256.0f); }
__device__ __forceinline__ void unq8r(const u32x2 w, float (&o)[8]) {
    o[0] = (float)(w.x & 255u) + 0.5f; o[1] = (float)((w.x >> 8) & 255u) + 0.5f; o[2] = (float)((w.x >> 16) & 255u) + 0.5f; o[3] = (float)(w.x >> 24) + 0.5f;
    o[4] = (float)(w.y & 255u) + 0.5f; o[5] = (float)((w.y >> 8) & 255u) + 0.5f; o[6] = (float)((w.y >> 16) & 255u) + 0.5f; o[7] = (float)(w.y >> 24) + 0.5f; }
struct EpiG2 { static constexpr bool PERM = true, HOOK = true; struct Pre {}; __device__ __forceinline__ void prefetch(const pg8::Unit&, int, int, int, int, Pre&) const {} const bf16* H; bf16* MGB;
    __device__ __forceinline__ void hook(Acc& acc, const pg8::Unit& u, int n, int wr, int wc, int fr, int fq) const {
        const size_t rowb = (size_t)(u.pm * 256 + wr * 64 + fr); const int col0 = u.pn * 256 + wc * 32 + 8 * fq;
        const unsigned char* hp = (const unsigned char*)(H + rowb * NH + HG) + (n - 1) * D + col0;
        u32x2 ga[2][4][2], gb[2][4][2];
#pragma unroll
        for (int ai = 0; ai < 2; ++ai)
#pragma unroll
            for (int m = 0; m < 4; ++m)
#pragma unroll
                for (int bj = 0; bj < 2; ++bj) { const unsigned char* p = hp + (size_t)(ai * 128 + m * 16) * NH * 2 + bj * 128; ga[ai][m][bj] = *(const u32x2*)p; gb[ai][m][bj] = *(const u32x2*)(p + D); }
#pragma unroll
        for (int ai = 0; ai < 2; ++ai)
#pragma unroll
            for (int m = 0; m < 4; ++m)
#pragma unroll
                for (int bj = 0; bj < 2; ++bj) { float sa[8], sb[8]; unq8r(ga[ai][m][bj], sa); unq8r(gb[ai][m][bj], sb);
                    float r[8];
#pragma unroll
                    for (int j = 0; j < 8; ++j) r[j] = sa[j] * __builtin_amdgcn_rcpf(sb[j]);
                    acc[ai][bj][m][0] *= (f32x4){r[0], r[1], r[2], r[3]}; acc[ai][bj][m][1] *= (f32x4){r[4], r[5], r[6], r[7]}; }
        asm volatile("" ::: "memory");
    }
    __device__ __forceinline__ void operator()(const Acc& acc, const pg8::Unit& u, int wr, int wc, int fr, int fq, const Pre& pre) const {
        const size_t rowb = (size_t)(u.pm * 256 + wr * 64 + fr); const int col0 = u.pn * 256 + wc * 32 + 8 * fq;
        const unsigned char* hp = (const unsigned char*)(H + rowb * NH + HG) + 3 * D + col0; bf16* bp = MGB + rowb * D + col0;
        u32x2 gv[2][4][2];
#pragma unroll
        for (int ai = 0; ai < 2; ++ai)
#pragma unroll
            for (int m = 0; m < 4; ++m)
#pragma unroll
                for (int bj = 0; bj < 2; ++bj) gv[ai][m][bj] = *(const u32x2*)(hp + (size_t)(ai * 128 + m * 16) * NH * 2 + bj * 128);
#pragma unroll
        for (int ai = 0; ai < 2; ++ai)
#pragma unroll
            for (int m = 0; m < 4; ++m)
#pragma unroll
                for (int bj = 0; bj < 2; ++bj) { const int ro = ai * 128 + m * 16; float sv[8]; unq8(gv[ai][m][bj], sv);
                    const f32x4 a0 = acc[ai][bj][m][0], a1 = acc[ai][bj][m][1];
                    u32x4 w; w.x = pk2(a0[0] * sv[0], a0[1] * sv[1]); w.y = pk2(a0[2] * sv[2], a0[3] * sv[3]); w.z = pk2(a1[0] * sv[4], a1[1] * sv[5]); w.w = pk2(a1[2] * sv[6], a1[3] * sv[7]);
                    *(u32x4*)(bp + (size_t)ro * D + bj * 128) = w; }
    } };
struct SchedG3 { int G, c; const char* A; const char* B;
    __device__ __forceinline__ void a_off(const pg8::Unit&, int lda, const int (&Ri)[2], const int (&Ci)[2], unsigned (&v0)[2], unsigned (&v1)[2]) const {
#pragma unroll
        for (int i = 0; i < 2; ++i) { v0[i] = (unsigned)(Ri[i] * lda + Ci[i]) * 2u; v1[i] = v0[i] + (unsigned)(128 * lda * 2); } }
    __device__ __forceinline__ bool next(int i, pg8::Unit& u) const { int pm, pn; if (!pg8::tile_of(i, G, c, T / 256, D / 256, pm, pn)) return false;
        u.pm = pm; u.pn = pn; u.aux = 0; u.A = A + (size_t)pm * 256 * D * 2; u.B = B + (size_t)pn * 256 * D * 2; return true; } };
struct EpiG3 { static constexpr bool PERM = true, HOOK = false; struct Pre {}; __device__ __forceinline__ void prefetch(const pg8::Unit&, int, int, int, int, Pre&) const {} const bf16* XB; float* R; float* STAT;
    __device__ __forceinline__ void operator()(const Acc& acc, const pg8::Unit& u, int wr, int wc, int fr, int fq, const Pre& pre) const {
        const int row0 = u.pm * 256 + wr * 64 + fr, col0 = u.pn * 256 + wc * 32 + 8 * fq, lane = fq * 16 + fr;
#pragma unroll
        for (int ai = 0; ai < 2; ++ai) { u32x4 xr[4][2];
#pragma unroll
            for (int m = 0; m < 4; ++m)
#pragma unroll
                for (int bj = 0; bj < 2; ++bj) xr[m][bj] = *(const u32x4*)(XB + (size_t)(row0 + ai * 128 + m * 16) * D + col0 + bj * 128);
#pragma unroll
            for (int m = 0; m < 4; ++m) { const size_t row = (size_t)(row0 + ai * 128 + m * 16); float s1 = 0.f, s2 = 0.f;
#pragma unroll
                for (int bj = 0; bj < 2; ++bj) { const size_t o = row * D + col0 + bj * 128; float x8[8]; unpack8(xr[m][bj], x8);
                    const f32x4 r0 = (f32x4){x8[0], x8[1], x8[2], x8[3]} * ALPHA + acc[ai][bj][m][0], r1 = (f32x4){x8[4], x8[5], x8[6], x8[7]} * ALPHA + acc[ai][bj][m][1];
                    *(f32x4*)(R + o) = r0; *(f32x4*)(R + o + 4) = r1;
                    s1 += ((r0[0] + r0[1]) + (r0[2] + r0[3])) + ((r1[0] + r1[1]) + (r1[2] + r1[3]));
                    s2 += ((r0[0] * r0[0] + r0[1] * r0[1]) + (r0[2] * r0[2] + r0[3] * r0[3])) + ((r1[0] * r1[0] + r1[1] * r1[1]) + (r1[2] * r1[2] + r1[3] * r1[3])); }
                s1 += shx(s1, 16, lane); s1 += shx(s1, 32, lane); s2 += shx(s2, 16, lane); s2 += shx(s2, 32, lane);
                if (fq == 0) *(f32x2*)(STAT + (row * 16 + u.pn * 4 + wc) * 2) = (f32x2){s1, s2}; } }
    } };
struct SchedG4 { int G, c; const char* A; const char* B; const int* IDX;
    __device__ __forceinline__ bool next(int i, pg8::Unit& u) const { int pm, pn; if (!pg8::tile_of(i, G, c, NSLOT / 256, 2048 / 256, pm, pn)) return false; const int e = (pm >> 2) & 15;
        u.pm = pm; u.pn = pn; u.aux = e; u.A = A + (size_t)(pm >> 6) * SEQ * D * 2; u.B = B + (size_t)e * 2048 * D * 2 + (size_t)pn * 256 * D * 2; return true; }
    __device__ __forceinline__ void a_off(const pg8::Unit& u, int lda, const int (&Ri)[2], const int (&Ci)[2], unsigned (&v0)[2], unsigned (&v1)[2]) const {
#pragma unroll
        for (int i = 0; i < 2; ++i) { const int r0 = IDX[u.pm * 256 + Ri[i]], r1 = IDX[u.pm * 256 + 128 + Ri[i]]; v0[i] = (unsigned)(r0 * lda + Ci[i]) * 2u; v1[i] = (unsigned)(r1 * lda + Ci[i]) * 2u; } } };
struct EpiG4 { static constexpr bool PERM = true, HOOK = false; struct Pre {}; __device__ __forceinline__ void prefetch(const pg8::Unit&, int, int, int, int, Pre&) const {} bf16* HID;
    __device__ __forceinline__ void operator()(const Acc& acc, const pg8::Unit& u, int wr, int wc, int fr, int fq, const Pre& pre) const {
        const int row0 = u.pm * 256 + wr * 64 + fr, col0 = u.pn * 128 + wc * 32 + 8 * fq;
#pragma unroll
        for (int ai = 0; ai < 2; ++ai)
#pragma unroll
            for (int m = 0; m < 4; ++m) { const size_t row = (size_t)(row0 + ai * 128 + m * 16);
                const f32x4 a0 = acc[ai][0][m][0], a1 = acc[ai][0][m][1], g0 = acc[ai][1][m][0], g1 = acc[ai][1][m][1];
                u32x4 w; w.x = pk2(siluf_(a0[0]) * g0[0], siluf_(a0[1]) * g0[1]); w.y = pk2(siluf_(a0[2]) * g0[2], siluf_(a0[3]) * g0[3]);
                w.z = pk2(siluf_(a1[0]) * g1[0], siluf_(a1[1]) * g1[1]); w.w = pk2(siluf_(a1[2]) * g1[2], siluf_(a1[3]) * g1[3]);
                *(u32x4*)(HID + row * FF + col0) = w; }
    } };
struct SchedG5 { int G, c; const char* A; const char* B;
    __device__ __forceinline__ void a_off(const pg8::Unit&, int lda, const int (&Ri)[2], const int (&Ci)[2], unsigned (&v0)[2], unsigned (&v1)[2]) const {
#pragma unroll
        for (int i = 0; i < 2; ++i) { v0[i] = (unsigned)(Ri[i] * lda + Ci[i]) * 2u; v1[i] = v0[i] + (unsigned)(128 * lda * 2); } }
    __device__ __forceinline__ bool next(int i, pg8::Unit& u) const { int pm, pn; if (!pg8::tile_of(i, G, c, NSLOT / 256, D / 256, pm, pn)) return false; const int e = (pm >> 2) & 15;
        u.pm = pm; u.pn = pn; u.aux = e; u.A = A + (size_t)pm * 256 * FF * 2; u.B = B + (size_t)e * D * FF * 2 + (size_t)pn * 256 * FF * 2; return true; } };
struct EpiG5 { static constexpr bool PERM = true, HOOK = false; const float* GATE; bf16* YE;
    struct Pre { float g[2][4]; };
    __device__ __forceinline__ void prefetch(const pg8::Unit& u, int wr, int wc, int fr, int fq, Pre& p) const { const int row0 = u.pm * 256 + wr * 64 + fr;
#pragma unroll
        for (int ai = 0; ai < 2; ++ai)
#pragma unroll
            for (int m = 0; m < 4; ++m) p.g[ai][m] = GATE[row0 + ai * 128 + m * 16]; }
    __device__ __forceinline__ void operator()(const Acc& acc, const pg8::Unit& u, int wr, int wc, int fr, int fq, const Pre& pre) const {
        const int row0 = u.pm * 256 + wr * 64 + fr, col0 = u.pn * 256 + wc * 32 + 8 * fq;
#pragma unroll
        for (int ai = 0; ai < 2; ++ai)
#pragma unroll
            for (int m = 0; m < 4; ++m) { const size_t row = (size_t)(row0 + ai * 128 + m * 16); const float gt = pre.g[ai][m];
#pragma unroll
                for (int bj = 0; bj < 2; ++bj) { const f32x4 v0 = acc[ai][bj][m][0] * gt, v1 = acc[ai][bj][m][1] * gt;
                    u32x4 w; w.x = pk2(v0[0], v0[1]); w.y = pk2(v0[2], v0[3]); w.z = pk2(v1[0], v1[1]); w.w = pk2(v1[2], v1[3]);
                    *(u32x4*)(YE + row * D + col0 + bj * 128) = w; } }
    } };

typedef float f32x16 __attribute__((ext_vector_type(16)));
typedef short s16x4 __attribute__((ext_vector_type(4)));
typedef __bf16 bf16x2_t __attribute__((ext_vector_type(2)));
#define MFMA32(a, b, c) __builtin_amdgcn_mfma_f32_32x32x16_bf16((a), (b), (c), 0, 0, 0)
__device__ __forceinline__ int crow(int reg, int h) { return (reg & 3) + 8 * (reg >> 2) + 4 * h; }
__device__ __forceinline__ unsigned cvtpk(float lo, float hi) { f32x2 v = {lo, hi}; bf16x2_t b = __builtin_convertvector(v, bf16x2_t); return __builtin_bit_cast(unsigned, b); }
__device__ __forceinline__ bf16x8 pack8(float a0, float a1, float a2, float a3, float a4, float a5, float a6, float a7) {
    u32x4 p; p.x = cvtpk(a0, a1); p.y = cvtpk(a2, a3); p.z = cvtpk(a4, a5); p.w = cvtpk(a6, a7); return __builtin_bit_cast(bf16x8, p); }
typedef short v4i16_t __attribute__((ext_vector_type(4)));
__device__ __forceinline__ s16x4 tr_rd(const LAS unsigned char* p) { return __builtin_bit_cast(s16x4, __builtin_amdgcn_ds_read_tr16_b64_v4i16((LAS v4i16_t*)p)); }
__device__ __forceinline__ bf16x8 tr_frag(const LAS unsigned char* img, int pitch, int k0, int k1, int col0, int lane) {
    const int i16 = lane & 15, qd = i16 >> 2, p = i16 & 3, blk = (lane >> 4) & 1;
    const s16x4 lo = tr_rd(img + (k0 + qd) * pitch + (col0 + 16 * blk + 4 * p) * 2), hi = tr_rd(img + (k1 + qd) * pitch + (col0 + 16 * blk + 4 * p) * 2);
    return __builtin_shufflevector(lo, hi, 0, 1, 2, 3, 4, 5, 6, 7); }
constexpr int C1_ITEM_LDS = 3 * 64 * 144 + 2048;
__device__ __forceinline__ void mlstm_c1m(int l, int bi) {
    FRAME_SETUP; WS_PTRS; const float* ml_conv = inp(I_MLCONV); const float* ml_fbias = inp(I_MLFB);
    const int tid = F.tid, lane = F.lane, w = F.wave, dir = w & 1, jj = w >> 1, tp = tid & 127;
    const int item = bi * 4 + jj, c = item & 127, h = (item >> 7) & 3, b = item >> 9;
    const int p0 = b * SEQ + c * 64, hc = h * 64;
    LAS unsigned char* base = F.lds + jj * C1_ITEM_LDS;
    LAS unsigned char* Vt = base; LAS unsigned char* K0 = base + 64 * 144; LAS unsigned char* K1 = base + 2 * 64 * 144; LAS float* wT = (LAS float*)(base + 3 * 64 * 144);
    const int chain = ((dir * 2 + b) * 4 + h) * 128 + c; bf16* dc = DC + (size_t)chain * 4160;
    u32x4 cq[4][3], ck[4][3], cv[4]; bool rok[4][3];
    const int cg = (tp & 7) * 8, r0 = tp >> 3;
#pragma unroll
    for (int i = 0; i < 4; ++i) { const int row = r0 + 16 * i, sq = c * 64 + row;
#pragma unroll
        for (int dr = 0; dr < 3; ++dr) { rok[i][dr] = (sq + dr - 1 >= 0) && (sq + dr - 1 < SEQ); const int sc = min(max(sq + dr - 1, 0), SEQ - 1); const bf16* r2 = H + (size_t)(b * SEQ + sc) * NH;
            cq[i][dr] = *(const u32x4*)(r2 + HCQ + hc + cg); ck[i][dr] = *(const u32x4*)(r2 + HCK + hc + cg); }
        cv[i] = *(const u32x4*)(H + (size_t)(p0 + row) * NH + HCV + hc + cg); }
    f32x4 cwq[3][2], cwk[3][2];
    { const float* cw = ml_conv + (size_t)l * 3 * 512;
#pragma unroll
      for (int dr = 0; dr < 3; ++dr) { cwq[dr][0] = *(const f32x4*)(cw + dr * 512 + hc + cg); cwq[dr][1] = *(const f32x4*)(cw + dr * 512 + hc + cg + 4); cwk[dr][0] = *(const f32x4*)(cw + dr * 512 + 256 + hc + cg); cwk[dr][1] = *(const f32x4*)(cw + dr * 512 + 256 + hc + cg + 4); } }
    { const float* gi = GI + (size_t)(p0 + lane) * 16; const float li = gi[dir * 4 + h]; float cum = logsigmoidf_(gi[8 + dir * 4 + h] + ml_fbias[l * 8 + dir * 4 + h]);
#pragma unroll
        for (int off = 1; off < 64; off <<= 1) { const int src = dir ? lane + off : lane - off; const float v = __int_as_float(__builtin_amdgcn_ds_bpermute((src & 63) << 2, __float_as_int(cum))); if (src >= 0 && src < 64) cum += v; }
        const float g = __int_as_float(__builtin_amdgcn_ds_bpermute((dir ? 0 : 63) << 2, __float_as_int(cum)));
        wT[dir * 64 + lane] = __expf(g - cum + li); if (lane == 0) DG[chain] = g; }
    __syncthreads();
    {
#pragma unroll
        for (int i = 0; i < 4; ++i) { const int row = r0 + 16 * i; const float w0 = wT[row], w1 = wT[64 + row];
            float qv[8], kv[8];
#pragma unroll
            for (int j = 0; j < 8; ++j) { qv[j] = 0.f; kv[j] = 0.f; }
#pragma unroll
            for (int dr = 0; dr < 3; ++dr) { const float m = rok[i][dr] ? 1.f : 0.f; float q8[8], k8[8]; unpack8(cq[i][dr], q8); unpack8(ck[i][dr], k8);
#pragma unroll
                for (int j = 0; j < 8; ++j) { qv[j] += m * cwq[dr][j >> 2][j & 3] * q8[j]; kv[j] += m * cwk[dr][j >> 2][j & 3] * k8[j]; } }
#pragma unroll
            for (int j = 0; j < 8; ++j) { qv[j] = siluf_(qv[j]); kv[j] = siluf_(kv[j]) * 0.125f; }
            u32x4 wq, wk, wk0, wk1; wq.x = pk2(qv[0], qv[1]); wq.y = pk2(qv[2], qv[3]); wq.z = pk2(qv[4], qv[5]); wq.w = pk2(qv[6], qv[7]); wk.x = pk2(kv[0], kv[1]); wk.y = pk2(kv[2], kv[3]); wk.z = pk2(kv[4], kv[5]); wk.w = pk2(kv[6], kv[7]);
            wk0.x = pk2(kv[0] * w0, kv[1] * w0); wk0.y = pk2(kv[2] * w0, kv[3] * w0); wk0.z = pk2(kv[4] * w0, kv[5] * w0); wk0.w = pk2(kv[6] * w0, kv[7] * w0);
            wk1.x = pk2(kv[0] * w1, kv[1] * w1); wk1.y = pk2(kv[2] * w1, kv[3] * w1); wk1.z = pk2(kv[4] * w1, kv[5] * w1); wk1.w = pk2(kv[6] * w1, kv[7] * w1);
            *(u32x4*)(QC + (size_t)(p0 + row) * 256 + hc + cg) = wq; *(u32x4*)(KC + (size_t)(p0 + row) * 256 + hc + cg) = wk;
            *(LAS u32x4*)(K0 + row * 144 + cg * 2) = wk0; *(LAS u32x4*)(K1 + row * 144 + cg * 2) = wk1; *(LAS u32x4*)(Vt + row * 144 + cg * 2) = cv[i]; }
    }
    __syncthreads();
    {
        const int tl = lane & 31, hh = lane >> 5; const LAS unsigned char* Kimg = dir ? K1 : K0;
#pragma unroll
        for (int kt = 0; kt < 2; ++kt) { bf16x8 kf[4]; float dn = 0.f;
#pragma unroll
            for (int ks = 0; ks < 4; ++ks) { kf[ks] = tr_frag(Kimg, 144, 16 * ks + 8 * hh, 16 * ks + 8 * hh + 4, 32 * kt, lane); float k8[8]; unpack8(__builtin_bit_cast(u32x4, kf[ks]), k8);
#pragma unroll
                for (int j = 0; j < 8; ++j) dn += k8[j]; }
            dn += shx(dn, 32, lane); if (hh == 0) dc[4096 + 32 * kt + tl] = (bf16)f2bf(dn);
#pragma unroll
            for (int vt = 0; vt < 2; ++vt) { f32x16 acc;
#pragma unroll
                for (int i = 0; i < 16; ++i) acc[i] = F.zf;
#pragma unroll
                for (int ks = 0; ks < 4; ++ks) { const bf16x8 vf = tr_frag(Vt, 144, 16 * ks + 8 * hh, 16 * ks + 8 * hh + 4, 32 * vt, lane); acc = MFMA32(kf[ks], vf, acc); }
#pragma unroll
                for (int g4 = 0; g4 < 4; ++g4) { u32x2 wv; wv.x = pk2(acc[4 * g4], acc[4 * g4 + 1]); wv.y = pk2(acc[4 * g4 + 2], acc[4 * g4 + 3]); *(u32x2*)(dc + (32 * vt + tl) * 64 + 32 * kt + 8 * g4 + 4 * hh) = wv; } } }
    }
    __syncthreads();
}
constexpr int GM_PITCH = 576;
__device__ __forceinline__ void gmlp_m(int l, int item) {
    FRAME_SETUP; WS_PTRS; const float* gm_ln_g = inp(I_GMLNG); const float* gm_bs = inp(I_GMBS); const bf16* WSB = (const bf16*)(ws + WS_WSB);
    const int tid = F.tid, lane = F.lane, w = F.wave;
    const int b = item >> 6, ch = item & 63, p0 = b * SEQ + ch * 128;
    LAS unsigned char* vn = F.lds;
    {
        const int part = tid & 7; const float* lgp = gm_ln_g + l * 256;
        u32x4 raw[2][4];
#pragma unroll
        for (int rr = 0; rr < 2; ++rr)
#pragma unroll
            for (int q = 0; q < 4; ++q) raw[rr][q] = *(const u32x4*)(H + (size_t)(p0 + (tid >> 3) + 64 * rr) * NH + HV + (part + 8 * q) * 8);
#pragma unroll
        for (int rr = 0; rr < 2; ++rr) { const int row = (tid >> 3) + 64 * rr; float s = 0.f, s2 = 0.f;
#pragma unroll
            for (int q = 0; q < 4; ++q) { float v8[8]; unpack8(raw[rr][q], v8);
#pragma unroll
                for (int j = 0; j < 8; ++j) { s += v8[j]; s2 += v8[j] * v8[j]; } }
            s += shx(s, 1, lane); s += shx(s, 2, lane); s += shx(s, 4, lane); s2 += shx(s2, 1, lane); s2 += shx(s2, 2, lane); s2 += shx(s2, 4, lane);
            const float mean = s * (1.0f / 256.0f), var = fmaxf(s2 * (1.0f / 256.0f) - mean * mean, 0.f), rstd = 1.0f / sqrtf(var + LN_EPS);
#pragma unroll
            for (int q = 0; q < 4; ++q) { const int c0 = (part + 8 * q) * 8; float v8[8]; unpack8(raw[rr][q], v8); const f32x4 g0 = *(const f32x4*)(lgp + c0), g1 = *(const f32x4*)(lgp + c0 + 4);
                u32x4 o; o.x = pk2((v8[0] - mean) * rstd * g0[0], (v8[1] - mean) * rstd * g0[1]); o.y = pk2((v8[2] - mean) * rstd * g0[2], (v8[3] - mean) * rstd * g0[3]);
                o.z = pk2((v8[4] - mean) * rstd * g1[0], (v8[5] - mean) * rstd * g1[1]); o.w = pk2((v8[6] - mean) * rstd * g1[2], (v8[7] - mean) * rstd * g1[3]);
                *(LAS u32x4*)(vn + row * GM_PITCH + c0 * 2) = o; } }
    }
    __syncthreads();
    {
        const int g = w >> 1, ph = w & 1, tl = lane & 31, hh = lane >> 5;
#pragma unroll 1
        for (int pt = 0; pt < 2; ++pt) { const int p = 64 * ph + 32 * pt + tl; const size_t tok = (size_t)p0 + p;
            f32x16 M[2];
#pragma unroll
            for (int dt = 0; dt < 2; ++dt)
#pragma unroll
                for (int i = 0; i < 16; ++i) M[dt][i] = F.zf;
            const bf16* wrow = WSB + ((size_t)(l * 4 + g) * 128 + p) * 128 + 8 * hh;
#pragma unroll
            for (int ks = 0; ks < 8; ++ks) { const bf16x8 wf = *(const bf16x8*)(wrow + 16 * ks);
#pragma unroll
                for (int dt = 0; dt < 2; ++dt) { const bf16x8 vf = tr_frag(vn, GM_PITCH, 16 * ks + 8 * hh, 16 * ks + 8 * hh + 4, g * 64 + 32 * dt, lane); M[dt] = MFMA32(vf, wf, M[dt]); } }
            const float bsv = gm_bs[(size_t)(l * 4 + g) * 128 + p];
#pragma unroll
            for (int dt = 0; dt < 2; ++dt)
#pragma unroll
                for (int gg = 0; gg < 4; ++gg) { const int d = g * 64 + 32 * dt + 8 * gg + 4 * hh; const u32x2 uw = *(const u32x2*)(H + tok * NH + HU + d);
                    const float u0 = __uint_as_float(uw.x << 16), u1 = __uint_as_float(uw.x & 0xffff0000u), u2 = __uint_as_float(uw.y << 16), u3 = __uint_as_float(uw.y & 0xffff0000u);
                    u32x2 o; o.x = pk2(u0 * (M[dt][4 * gg] + bsv), u1 * (M[dt][4 * gg + 1] + bsv)); o.y = pk2(u2 * (M[dt][4 * gg + 2] + bsv), u3 * (M[dt][4 * gg + 3] + bsv));
                    *(u32x2*)(YS + tok * D + d) = o; } }
    }
    __syncthreads();
}
__device__ __forceinline__ void mlstm_scan(int wi) {
    FRAME_SETUP;
    WS_PTRS;
    const int lane = F.lane, chain = wi / 17, quad = (wi % 17) * 64 + lane, dir = chain >> 3, base = chain * 128;
    const bool on = quad < 1040;
    const int e = on ? 4 * quad : 0;
    const float d0 = __expf(DG[base + (dir ? 127 - lane : lane)]), d1 = __expf(DG[base + (dir ? 63 - lane : 64 + lane)]);
    f32x4 S = {0.f, 0.f, 0.f, 0.f};
#pragma unroll 1
    for (int i0 = 0; i0 < 128; i0 += 32) {
        u32x2 tmp[32];
#pragma unroll
        for (int j = 0; j < 32; ++j) { const int c = dir ? 127 - (i0 + j) : (i0 + j); tmp[j] = *(const u32x2*)(DC + (size_t)(base + c) * 4160 + e); }
#pragma unroll
        for (int j = 0; j < 32; ++j) { const int c = dir ? 127 - (i0 + j) : (i0 + j);
            const float dec = (i0 < 64) ? __int_as_float(__builtin_amdgcn_readlane(__float_as_int(d0), (i0 & 63) + j)) : __int_as_float(__builtin_amdgcn_readlane(__float_as_int(d1), (i0 & 63) + j));
            if (on) { u32x2 wv; wv.x = pk2(S[0], S[1]); wv.y = pk2(S[2], S[3]); *(u32x2*)(DC + (size_t)(base + c) * 4160 + e) = wv; }
            const f32x4 t = (f32x4){__uint_as_float(tmp[j].x << 16), __uint_as_float(tmp[j].x & 0xffff0000u), __uint_as_float(tmp[j].y << 16), __uint_as_float(tmp[j].y & 0xffff0000u)};
            S = S * dec + t; }
    }
}
constexpr int C3_ITEM_LDS = 20480, C3_PITCH = 144;
__device__ __forceinline__ void mlstm_c3m(int l, int bi) {
    FRAME_SETUP; WS_PTRS; const float* ml_fbias = inp(I_MLFB); const float* ml_norm_g = inp(I_MLNG);
    const int tid = F.tid, lane = F.lane, w = F.wave, dir = w & 1, jj = w >> 1, tp = tid & 127;
    const int item = bi * 4 + jj, c = item & 127, h = (item >> 7) & 3, b = item >> 9;
    const int p0 = b * SEQ + c * 64, hc = h * 64;
    LAS unsigned char* base = F.lds + jj * C3_ITEM_LDS;
    LAS unsigned char* Kt = base; LAS unsigned char* Vt = base + 64 * C3_PITCH;
    LAS float* tab = (LAS float*)(base + 2 * 64 * C3_PITCH);
    LAS float* cumT = tab + dir * 64; LAS float* liT = tab + 128 + dir * 64; LAS float* nsT = tab + 256 + dir * 64;
    LAS float* hbuf = (LAS float*)base;
    const int chain = ((dir * 2 + b) * 4 + h) * 128 + c; const bf16* dc = DC + (size_t)chain * 4160;
    { u32x4 k8[4], v8[4];
#pragma unroll
        for (int u = 0; u < 4; ++u) { const int i = tp + 128 * u, row = i >> 3, cg = (i & 7) * 8; k8[u] = *(const u32x4*)(KC + (size_t)(p0 + row) * 256 + hc + cg); v8[u] = *(const u32x4*)(H + (size_t)(p0 + row) * NH + HCV + hc + cg); }
#pragma unroll
        for (int u = 0; u < 4; ++u) { const int i = tp + 128 * u, row = i >> 3, cg = (i & 7) * 8; *(LAS u32x4*)(Kt + row * C3_PITCH + cg * 2) = k8[u]; *(LAS u32x4*)(Vt + row * C3_PITCH + cg * 2) = v8[u]; } }
    { const float* gi = GI + (size_t)(p0 + lane) * 16; const float li = gi[dir * 4 + h]; float cum = logsigmoidf_(gi[8 + dir * 4 + h] + ml_fbias[l * 8 + dir * 4 + h]);
#pragma unroll
        for (int off = 1; off < 64; off <<= 1) { const int src = dir ? lane + off : lane - off; const float v = __int_as_float(__builtin_amdgcn_ds_bpermute((src & 63) << 2, __float_as_int(cum))); if (src >= 0 && src < 64) cum += v; }
        cumT[lane] = cum; liT[lane] = li - cum; nsT[lane] = bf2f(dc[4096 + lane]); }
    __syncthreads();
    const int tl = lane & 31, hh = lane >> 5;
    f32x16 Hh[2][2];
#pragma unroll
    for (int tt = 0; tt < 2; ++tt) {
        const int t = 32 * tt + tl; const size_t tok = (size_t)p0 + t;
        const float ct = cumT[t], ewt = __expf(ct);
        bf16x8 qf[4], qf2[4]; float nqp = 0.f;
#pragma unroll
        for (int ks = 0; ks < 4; ++ks) { const u32x4 raw = *(const u32x4*)(QC + tok * 256 + hc + 16 * ks + 8 * hh); qf[ks] = __builtin_bit_cast(bf16x8, raw);
            float q8[8]; unpack8(raw, q8);
#pragma unroll
            for (int j = 0; j < 8; ++j) { q8[j] *= ewt; nqp += nsT[16 * ks + 8 * hh + j] * q8[j]; }
            qf2[ks] = pack8(q8[0], q8[1], q8[2], q8[3], q8[4], q8[5], q8[6], q8[7]); }
        f32x16 S[2]; float denp = 0.f;
#pragma unroll
        for (int st = 0; st < 2; ++st) {
#pragma unroll
            for (int i = 0; i < 16; ++i) S[st][i] = F.zf;
#pragma unroll
            for (int ks = 0; ks < 4; ++ks) { const bf16x8 kf = *(const LAS bf16x8*)(Kt + (32 * st + tl) * C3_PITCH + (16 * ks + 8 * hh) * 2); S[st] = MFMA32(kf, qf[ks], S[st]); }
#pragma unroll
            for (int i = 0; i < 16; ++i) { const int sidx = 32 * st + crow(i, hh); const bool valid = dir ? (sidx >= t) : (sidx <= t);
                const float arg = ct + liT[sidx]; const float wgt = __expf(valid ? arg : -1e30f); const float pv = S[st][i] * wgt; S[st][i] = pv; denp += pv; }
            __builtin_amdgcn_sched_barrier(0); }
        const float dn = (denp + shx(denp, 32, lane)) + (nqp + shx(nqp, 32, lane));
        const float inv = 1.0f / fmaxf(fabsf(dn), 1.0f);
#pragma unroll
        for (int vt = 0; vt < 2; ++vt) { f32x16 N;
#pragma unroll
            for (int i = 0; i < 16; ++i) N[i] = F.zf;
#pragma unroll
            for (int st = 0; st < 2; ++st)
#pragma unroll
                for (int s2 = 0; s2 < 2; ++s2) { const bf16x8 pf = pack8(S[st][8 * s2], S[st][8 * s2 + 1], S[st][8 * s2 + 2], S[st][8 * s2 + 3], S[st][8 * s2 + 4], S[st][8 * s2 + 5], S[st][8 * s2 + 6], S[st][8 * s2 + 7]);
                    const int k0 = 32 * st + 16 * s2 + 4 * hh; const bf16x8 vf = tr_frag(Vt, C3_PITCH, k0, k0 + 8, 32 * vt, lane); N = MFMA32(vf, pf, N); }
#pragma unroll
            for (int ks = 0; ks < 4; ++ks) { const bf16x8 cf = *(const bf16x8*)(dc + (32 * vt + tl) * 64 + 16 * ks + 8 * hh); N = MFMA32(cf, qf2[ks], N); }
#pragma unroll
            for (int i = 0; i < 16; ++i) Hh[tt][vt][i] = N[i] * inv; }
    }
    __syncthreads();
    if (dir == 1) {
#pragma unroll
        for (int tt = 0; tt < 2; ++tt)
#pragma unroll
            for (int vt = 0; vt < 2; ++vt)
#pragma unroll
                for (int i = 0; i < 16; ++i) hbuf[(32 * tt + tl) * 65 + 32 * vt + crow(i, hh)] = Hh[tt][vt][i]; }
    __syncthreads();
    if (dir == 0) {
#pragma unroll
        for (int tt = 0; tt < 2; ++tt) { const int t = 32 * tt + tl; const size_t tok = (size_t)p0 + t; float s1 = 0.f;
#pragma unroll
            for (int vt = 0; vt < 2; ++vt)
#pragma unroll
                for (int i = 0; i < 16; ++i) { const float x = Hh[tt][vt][i] + hbuf[t * 65 + 32 * vt + crow(i, hh)]; Hh[tt][vt][i] = x; s1 += x; }
            const float mu = (s1 + shx(s1, 32, lane)) * (1.0f / 64.0f); float s2 = 0.f;
#pragma unroll
            for (int vt = 0; vt < 2; ++vt)
#pragma unroll
                for (int i = 0; i < 16; ++i) { const float dv = Hh[tt][vt][i] - mu; s2 += dv * dv; }
            const float rstd = 1.0f / sqrtf((s2 + shx(s2, 32, lane)) * (1.0f / 64.0f) + LN_EPS);
#pragma unroll
            for (int vt = 0; vt < 2; ++vt)
#pragma unroll
                for (int g = 0; g < 4; ++g) { const int v = 32 * vt + 8 * g + 4 * hh;
                    const u32x2 cw = *(const u32x2*)(H + tok * NH + HCO + hc + v); const f32x4 ng = *(const f32x4*)(ml_norm_g + l * 256 + hc + v);
                    const float o0 = __uint_as_float(cw.x << 16), o1 = __uint_as_float(cw.x & 0xffff0000u), o2 = __uint_as_float(cw.y << 16), o3 = __uint_as_float(cw.y & 0xffff0000u);
                    u32x2 wv; wv.x = pk2((Hh[tt][vt][4 * g] - mu) * rstd * ng[0] * sigmoidf_(o0), (Hh[tt][vt][4 * g + 1] - mu) * rstd * ng[1] * sigmoidf_(o1));
                    wv.y = pk2((Hh[tt][vt][4 * g + 2] - mu) * rstd * ng[2] * sigmoidf_(o2), (Hh[tt][vt][4 * g + 3] - mu) * rstd * ng[3] * sigmoidf_(o3));
                    *(u32x2*)(YS + tok * D + 512 + hc + v) = wv; } }
    }
    __syncthreads();
}
__device__ __forceinline__ void pool_m(int l, int witem) {
    FRAME_SETUP; WS_PTRS; const float* pool_scale = inp(I_POOLS); const bf16* PWT = (const bf16*)(ws + WS_PWT);
    const int lane = F.lane, tl = lane & 31, hh = lane >> 5;
    const int g = witem & 3, tb = witem >> 2, tok0 = tb * 32, b = tok0 >> 13, s = (tok0 & (SEQ - 1)) + tl, half = 1 << g, W = 2 * half;
    const int lo = max(s - half, 0), hi = min(s + half, SEQ); const float inv = 1.0f / (float)(hi - lo);
    const bf16* hb = H + (size_t)b * SEQ * NH + HDX + g * 64 + 8 * hh;
    const size_t tok = (size_t)tok0 + tl;
    f32x16 acc[2];
#pragma unroll
    for (int ot = 0; ot < 2; ++ot)
#pragma unroll
        for (int i = 0; i < 16; ++i) acc[ot][i] = F.zf;
#pragma unroll 1
    for (int ks = 0; ks < 4; ++ks) { float a8[8];
#pragma unroll
        for (int q = 0; q < 8; ++q) a8[q] = 0.f;
#pragma unroll 1
        for (int j0 = 0; j0 < W; j0 += 4) { u32x4 raw[4];
#pragma unroll
            for (int j = 0; j < 4; ++j) { const int sp = min(max(s - half + j0 + j, 0), SEQ - 1); raw[j] = *(const u32x4*)(hb + (size_t)sp * NH + 16 * ks); }
#pragma unroll
            for (int j = 0; j < 4; ++j) { const int sp = s - half + j0 + j; const float m = (j0 + j < W && sp >= 0 && sp < SEQ) ? 1.f : 0.f; float v8[8]; unpack8(raw[j], v8);
#pragma unroll
                for (int q = 0; q < 8; ++q) a8[q] += m * v8[q]; } }
        float x8[8]; unpack8(*(const u32x4*)(hb + (size_t)s * NH + 16 * ks), x8);
        const bf16x8 pf = pack8(a8[0] * inv - x8[0], a8[1] * inv - x8[1], a8[2] * inv - x8[2], a8[3] * inv - x8[3], a8[4] * inv - x8[4], a8[5] * inv - x8[5], a8[6] * inv - x8[6], a8[7] * inv - x8[7]);
#pragma unroll
        for (int ot = 0; ot < 2; ++ot) { const bf16x8 wf = *(const bf16x8*)(PWT + ((size_t)(l * 4 + g) * 64 + 32 * ot + tl) * 64 + 16 * ks + 8 * hh); acc[ot] = MFMA32(wf, pf, acc[ot]); } }
#pragma unroll
    for (int ot = 0; ot < 2; ++ot)
#pragma unroll
        for (int gg = 0; gg < 4; ++gg) { const int o = g * 64 + 32 * ot + 8 * gg + 4 * hh; const f32x4 sc = *(const f32x4*)(pool_scale + l * 256 + o);
            u32x2 w; w.x = pk2(acc[ot][4 * gg] * sc[0], acc[ot][4 * gg + 1] * sc[1]); w.y = pk2(acc[ot][4 * gg + 2] * sc[2], acc[ot][4 * gg + 3] * sc[3]);
            *(u32x2*)(YS + tok * D + 768 + o) = w; }
}
constexpr int ATT_PITCH = 144;
__device__ __forceinline__ void att2_item(int item) {
    FRAME_SETUP;
    WS_PTRS; const float* rel_bias = inp(I_RELB);
    const int tid = F.tid, lane = F.lane, w = F.wave;
    const int pat = item >> 8, idx = item & 255, dil = 1 << (2 * pat), L = SEQ / dil, nqb = L >> 8;
    const int jr = idx & 31, h = (idx >> 5) & 3, b = idx >> 7, r = jr / nqb, Q0 = (jr % nqb) * 256;
    LAS unsigned char* Kt = F.lds; LAS unsigned char* Vt = F.lds + 384 * ATT_PITCH; LAS float* bt = (LAS float*)(F.lds + 2 * 384 * ATT_PITCH);
    { u32x4 k8[6], v8[6];
#pragma unroll
        for (int u = 0; u < 6; ++u) { const int i = tid + u * NTHREADS, kk = i >> 3, cg = (i & 7) * 8, kidx = min(max(Q0 - 64 + kk, 0), L - 1);
            const bf16* row = H + (size_t)(b * SEQ + r + dil * kidx) * NH; k8[u] = *(const u32x4*)(row + HAK + h * 64 + cg); v8[u] = *(const u32x4*)(row + HAV + h * 64 + cg); }
#pragma unroll
        for (int u = 0; u < 6; ++u) { const int i = tid + u * NTHREADS, kk = i >> 3, cg = (i & 7) * 8;
            *(LAS u32x4*)(Kt + kk * ATT_PITCH + cg * 2) = k8[u]; *(LAS u32x4*)(Vt + kk * ATT_PITCH + cg * 2) = v8[u]; } }
    if (tid < 192) { const int u = tid - 32, j = u - 64, rel = dil * j, na = rel < 0 ? -rel : rel;
        int bucket = na < 8 ? na : 8 + (na >= 15) + (na >= 27) + (na >= 50) + (na >= 91) + (na >= 166) + (na >= 305) + (na >= 559);
        if (rel > 0) bucket += 16;
        bt[tid] = (u >= 0 && u <= 128) ? rel_bias[min(bucket, 31) * 4 + h] * 1.4426950408889634f : -1e30f; }
    const int ql = lane & 31, hh = lane >> 5;
    const int qi = Q0 + 32 * w + ql; const size_t tok = (size_t)b * SEQ + r + dil * qi;
    bf16x8 qf[4];
#pragma unroll
    for (int ks = 0; ks < 4; ++ks) qf[ks] = *(const bf16x8*)(H + tok * NH + HAQ + h * 64 + 16 * ks + 8 * hh);
    __syncthreads();
    f32x16 S[5];
#pragma unroll
    for (int tk = 0; tk < 5; ++tk) {
#pragma unroll
        for (int i = 0; i < 16; ++i) S[tk][i] = F.zf;
#pragma unroll
        for (int ks = 0; ks < 4; ++ks) { const bf16x8 kf = *(const LAS bf16x8*)(Kt + (32 * w + 32 * tk + ql) * ATT_PITCH + (16 * ks + 8 * hh) * 2); S[tk] = MFMA32(kf, qf[ks], S[tk]); } }
    const LAS float* btl = bt + 32 + 4 * hh - ql;
    float mx = -3.0e38f;
#pragma unroll
    for (int tk = 0; tk < 5; ++tk) {
#pragma unroll
        for (int i = 0; i < 16; ++i) { const float sc = S[tk][i] * (0.125f * 1.4426950408889634f) + btl[32 * tk + (i & 3) + 8 * (i >> 2)]; S[tk][i] = sc; mx = fmaxf(mx, sc); }
        __builtin_amdgcn_sched_barrier(0); }
    const int e0 = Q0 - 64 + 32 * w;
    if (e0 < 0 || e0 + 160 > L) {
        mx = -3.0e38f;
#pragma unroll
        for (int tk = 0; tk < 5; ++tk)
#pragma unroll
            for (int i = 0; i < 16; ++i) { const int kidx = e0 + 32 * tk + crow(i, hh); const float sc = (kidx >= 0 && kidx < L) ? S[tk][i] : -1e30f; S[tk][i] = sc; mx = fmaxf(mx, sc); }
    }
    mx = fmaxf(mx, shx(mx, 32, lane));
    float lsum = 0.f;
#pragma unroll
    for (int tk = 0; tk < 5; ++tk)
#pragma unroll
        for (int i = 0; i < 16; ++i) { const float p = __builtin_amdgcn_exp2f(S[tk][i] - mx); S[tk][i] = p; lsum += p; }
    lsum += shx(lsum, 32, lane);
    f32x16 O[2];
#pragma unroll
    for (int dt = 0; dt < 2; ++dt)
#pragma unroll
        for (int i = 0; i < 16; ++i) O[dt][i] = F.zf;
#pragma unroll
    for (int tk = 0; tk < 5; ++tk)
#pragma unroll
        for (int s2 = 0; s2 < 2; ++s2) { const bf16x8 pf = pack8(S[tk][8 * s2], S[tk][8 * s2 + 1], S[tk][8 * s2 + 2], S[tk][8 * s2 + 3], S[tk][8 * s2 + 4], S[tk][8 * s2 + 5], S[tk][8 * s2 + 6], S[tk][8 * s2 + 7]);
            const int k0 = 32 * w + 32 * tk + 16 * s2 + 4 * hh;
#pragma unroll
            for (int dt = 0; dt < 2; ++dt) { const bf16x8 vf = tr_frag(Vt, ATT_PITCH, k0, k0 + 8, 32 * dt, lane); O[dt] = MFMA32(vf, pf, O[dt]); } }
    const float inv = 1.0f / lsum;
    bf16* op = ATTO + ((size_t)pat * T + tok) * 256 + h * 64 + 4 * hh;
#pragma unroll
    for (int dt = 0; dt < 2; ++dt)
#pragma unroll
        for (int g = 0; g < 4; ++g) { u32x2 wv; wv.x = pk2(O[dt][4 * g] * inv, O[dt][4 * g + 1] * inv); wv.y = pk2(O[dt][4 * g + 2] * inv, O[dt][4 * g + 3] * inv); *(u32x2*)(op + 32 * dt + 8 * g) = wv; }
    if (hh == 0) ATTL[((size_t)pat * T + tok) * 4 + h] = (mx + __builtin_amdgcn_logf(lsum)) * 0.6931471805599453f;
    __syncthreads();
}
__device__ __forceinline__ void att_merge(int item) {
    FRAME_SETUP;
    WS_PTRS;
    const int tid = F.tid; const size_t tok = (size_t)item * 64 + (tid >> 3); const int sub = tid & 7, h = sub >> 1, c0 = h * 64 + (sub & 1) * 32;
    const float l0 = ATTL[tok * 4 + h], l1 = ATTL[((size_t)T + tok) * 4 + h], l2 = ATTL[((size_t)2 * T + tok) * 4 + h];
    const float M = fmaxf(l0, fmaxf(l1, l2)); float w0 = __expf(l0 - M), w1 = __expf(l1 - M), w2 = __expf(l2 - M); const float inv = 1.0f / (w0 + w1 + w2); w0 *= inv; w1 *= inv; w2 *= inv;
    const bf16* o0 = ATTO + tok * 256 + c0; const bf16* o1 = ATTO + ((size_t)T + tok) * 256 + c0; const bf16* o2 = ATTO + ((size_t)2 * T + tok) * 256 + c0;
    bf16* yp = YS + tok * D + 256 + c0;
#pragma unroll
    for (int q = 0; q < 4; ++q) { float a8[8], b8[8], c8[8]; unpack8(*(const u32x4*)(o0 + q * 8), a8); unpack8(*(const u32x4*)(o1 + q * 8), b8); unpack8(*(const u32x4*)(o2 + q * 8), c8);
        u32x4 w; w.x = pk2(a8[0] * w0 + b8[0] * w1 + c8[0] * w2, a8[1] * w0 + b8[1] * w1 + c8[1] * w2); w.y = pk2(a8[2] * w0 + b8[2] * w1 + c8[2] * w2, a8[3] * w0 + b8[3] * w1 + c8[3] * w2);
        w.z = pk2(a8[4] * w0 + b8[4] * w1 + c8[4] * w2, a8[5] * w0 + b8[5] * w1 + c8[5] * w2); w.w = pk2(a8[6] * w0 + b8[6] * w1 + c8[6] * w2, a8[7] * w0 + b8[7] * w1 + c8[7] * w2);
        *(u32x4*)(yp + q * 8) = w; }
}

template <int CTRL> __device__ __forceinline__ float dpp_max(float v) { return fmaxf(v, dpp_mov<CTRL>(v)); }
__device__ __forceinline__ void ln1_router(int l) {
    FRAME_SETUP;
    WS_PTRS; const float* ln1_g = inp(I_LN1G); const float* ln1_b = inp(I_LN1B); const bf16* WRT = (const bf16*)(ws + WS_WRT) + (size_t)l * NE * D; const float* STAT = (const float*)(ws + WS_STAT);
    LAS float* gl = (LAS float*)F.lds; LAS float* bl = gl + D;
    { const int i = F.tid * 2; *(LAS f32x2*)(gl + i) = *(const f32x2*)(ln1_g + l * D + i); *(LAS f32x2*)(bl + i) = *(const f32x2*)(ln1_b + l * D + i); }
    __syncthreads();
    const int lane = F.lane, r = lane & 15, kg = lane >> 4;
    for (int item = F.bid * 4 + F.wave; item < T / 16 && F.wave < 4; item += F.G * 4) {
        const size_t tok = (size_t)item * 16 + r;
        float s1 = 0.f, s2 = 0.f;
        { const f32x4 a = *(const f32x4*)(STAT + (tok * 16 + 4 * kg) * 2), c = *(const f32x4*)(STAT + (tok * 16 + 4 * kg) * 2 + 4); s1 = (a[0] + a[2]) + (c[0] + c[2]); s2 = (a[1] + a[3]) + (c[1] + c[3]); }
        s1 += shx(s1, 16, lane); s1 += shx(s1, 32, lane); s2 += shx(s2, 16, lane); s2 += shx(s2, 32, lane);
        const float mean = s1 * (1.0f / D), var = fmaxf(s2 * (1.0f / D) - mean * mean, 0.f), rstd = 1.0f / sqrtf(var + LN_EPS);
        const float* rp = MGF + tok * D + 8 * kg; bf16* xp = XB + tok * D + 8 * kg; const bf16* wp = WRT + (size_t)r * D + 8 * kg;
        f32x4 acc = (f32x4){F.zf, F.zf, F.zf, F.zf};
#pragma unroll 4
        for (int ks = 0; ks < 32; ++ks) {
            const f32x4 x0 = *(const f32x4*)(rp + 32 * ks), x1 = *(const f32x4*)(rp + 32 * ks + 4);
            const f32x4 g0 = *(const LAS f32x4*)(gl + 32 * ks + 8 * kg), g1 = *(const LAS f32x4*)(gl + 32 * ks + 8 * kg + 4), b0 = *(const LAS f32x4*)(bl + 32 * ks + 8 * kg), b1 = *(const LAS f32x4*)(bl + 32 * ks + 8 * kg + 4);
            const f32x4 y0 = (x0 - mean) * rstd * g0 + b0, y1 = (x1 - mean) * rstd * g1 + b1;
            u32x4 yw; yw.x = pk2(y0[0], y0[1]); yw.y = pk2(y0[2], y0[3]); yw.z = pk2(y1[0], y1[1]); yw.w = pk2(y1[2], y1[3]);
            *(u32x4*)(xp + 32 * ks) = yw;
            const bf16x8 wf = *(const bf16x8*)(wp + 32 * ks);
            acc = __builtin_amdgcn_mfma_f32_16x16x32_bf16(__builtin_bit_cast(bf16x8, yw), wf, acc, 0, 0, 0);
        }
        f32x4 aff;
#pragma unroll
        for (int i = 0; i < 4; ++i) { float m = acc[i]; m = dpp_max<0xB1>(m); m = dpp_max<0x4E>(m); m = dpp_max<0x141>(m); m = dpp_max<0x140>(m);
            const float e = __expf(acc[i] - m); float se = e; se += dpp_mov<0xB1>(se); se += dpp_mov<0x4E>(se); se += dpp_mov<0x141>(se); se += dpp_mov<0x140>(se);
            aff[i] = e * rcpf_(se); }
        { const size_t t0 = (size_t)item * 16 + 4 * kg; const int b = (int)(t0 >> 13), sp = (int)(t0 & (SEQ - 1)); *(f32x4*)(AFF + ((size_t)(b * NE + r)) * SEQ + sp) = aff; }
    }
    __syncthreads();
}
__device__ __forceinline__ unsigned block_excl_scan(LAS unsigned* sc, unsigned val, int tid) {
    sc[tid] = val; __syncthreads();
#pragma unroll 1
    for (int off = 1; off < NTHREADS; off <<= 1) { const unsigned v = tid >= off ? sc[tid - off] : 0u; __syncthreads(); sc[tid] += v; __syncthreads(); }
    const unsigned r = sc[tid] - val; __syncthreads(); return r;
}
__device__ __forceinline__ void topk_item(int be) {
    FRAME_SETUP;
    WS_PTRS;
    const int tid = F.tid, b = be >> 4;
    const float* aff = AFF + (size_t)be * SEQ;
    LAS unsigned* hist = (LAS unsigned*)F.lds; LAS unsigned* sfx = hist + 256; LAS unsigned* sc = sfx + 256; LAS unsigned* misc = sc + 512; LAS int* idxl = (LAS int*)(misc + 4);
    unsigned key[16];
    { const u32x4* ap = (const u32x4*)(aff + tid * 16);
#pragma unroll
        for (int q = 0; q < 4; ++q) { const u32x4 w = ap[q]; key[q * 4] = w.x; key[q * 4 + 1] = w.y; key[q * 4 + 2] = w.z; key[q * 4 + 3] = w.w; } }
    unsigned prefix = 0u, kth = CAP, hmask = 0u;
#pragma unroll 1
    for (int shift = 24; shift >= 0; shift -= 8) {
        if (tid < 256) hist[tid] = 0u;
        __syncthreads();
#pragma unroll
        for (int i = 0; i < 16; ++i) { if (((key[i] ^ prefix) & hmask) == 0u) __hip_atomic_fetch_add(&hist[(key[i] >> shift) & 255u], 1u, __ATOMIC_RELAXED, __HIP_MEMORY_SCOPE_WORKGROUP); }
        __syncthreads();
        if (tid < 256) sfx[tid] = hist[tid];
        __syncthreads();
#pragma unroll 1
        for (int off = 1; off < 256; off <<= 1) { unsigned v = 0u; if (tid < 256 && tid + off < 256) v = sfx[tid + off]; __syncthreads(); if (tid < 256) sfx[tid] += v; __syncthreads(); }
        if (tid < 256) { const unsigned incl = sfx[tid], excl = incl - hist[tid]; if (excl < kth && kth <= incl) { misc[0] = (unsigned)tid; misc[1] = kth - excl; } }
        __syncthreads();
        prefix |= misc[0] << shift; kth = misc[1]; hmask |= 255u << shift;
        __syncthreads();
    }
    unsigned ceq = 0u;
#pragma unroll
    for (int i = 0; i < 16; ++i) ceq += (key[i] == prefix) ? 1u : 0u;
    unsigned eqrank = block_excl_scan(sc, ceq, tid);
    unsigned selmask = 0u, csel = 0u;
#pragma unroll
    for (int i = 0; i < 16; ++i) { bool sel = key[i] > prefix; if (key[i] == prefix) { sel = eqrank < kth; ++eqrank; } if (sel) { selmask |= 1u << i; ++csel; } }
    unsigned slot = block_excl_scan(sc, csel, tid);
#pragma unroll
    for (int i = 0; i < 16; ++i) { const int s = tid * 16 + i;
        if (selmask & (1u << i)) { if (slot < (unsigned)CAP) { IDX[be * CAP + slot] = s; GATE[be * CAP + slot] = __uint_as_float(key[i]); idxl[slot] = s; } SLOT[(size_t)be * SEQ + s] = (int)slot; ++slot; }
        else SLOT[(size_t)be * SEQ + s] = -1; }
    __syncthreads();
    __syncthreads();
}
__device__ __forceinline__ void combine_ln2(int l) {
    FRAME_SETUP;
    WS_PTRS; const float* ln2_g = inp(I_LN2G); const float* ln2_b = inp(I_LN2B); float* out = outp();
    const int lane = F.lane;
    const float* g2 = ln2_g + l * D; const float* b2 = ln2_b + l * D;
    f32x4 gg4[4], bb4[4];
#pragma unroll
    for (int j = 0; j < 4; ++j) { const int d = 8 * lane + 512 * (j >> 1) + 4 * (j & 1); gg4[j] = *(const f32x4*)(g2 + d); bb4[j] = *(const f32x4*)(b2 + d); }
    for (int tok = (F.bid * NWAVES + F.wave) * 2; tok < T; tok += F.G * NWAVES * 2) {
        const int b = tok >> 13, sp = tok & (SEQ - 1);
        int slotv[2]; unsigned mask[2]; f32x4 v[2][4]; u32x4 xr[2][2];
        { const u32x2 sl2 = lane < NE ? *(const u32x2*)(SLOT + ((size_t)(b * NE + lane)) * SEQ + sp) : (u32x2){0xffffffffu, 0xffffffffu}; slotv[0] = (int)sl2.x; slotv[1] = (int)sl2.y; }
#pragma unroll
        for (int u = 0; u < 2; ++u)
#pragma unroll
            for (int jj = 0; jj < 2; ++jj) xr[u][jj] = *(const u32x4*)(XB + (size_t)(tok + u) * D + 8 * lane + 512 * jj);
        __builtin_amdgcn_sched_barrier(0);
#pragma unroll
        for (int u = 0; u < 2; ++u) mask[u] = (unsigned)__ballot(slotv[u] >= 0);
#pragma unroll
        for (int u = 0; u < 2; ++u)
#pragma unroll
            for (int jj = 0; jj < 2; ++jj) { float x8[8]; unpack8(xr[u][jj], x8); v[u][2 * jj] = (f32x4){x8[0], x8[1], x8[2], x8[3]} * ALPHA; v[u][2 * jj + 1] = (f32x4){x8[4], x8[5], x8[6], x8[7]} * ALPHA; }
        while (mask[0] | mask[1]) {
            u32x4 r[2][3][2]; bool on[2][3];
#pragma unroll
            for (int u = 0; u < 2; ++u)
#pragma unroll
                for (int k = 0; k < 3; ++k) { on[u][k] = mask[u] != 0u; const int e = on[u][k] ? __builtin_ctz(mask[u]) : 0; mask[u] &= mask[u] - 1u;
                    const int sl = __builtin_amdgcn_readlane(slotv[u], e);
                    if (on[u][k]) { const bf16* yr = YE + ((size_t)(b * NE + e) * CAP + sl) * D;
#pragma unroll
                        for (int jj = 0; jj < 2; ++jj) r[u][k][jj] = *(const u32x4*)(yr + 8 * lane + 512 * jj); } }
#pragma unroll
            for (int u = 0; u < 2; ++u)
#pragma unroll
                for (int k = 0; k < 3; ++k) if (on[u][k]) {
#pragma unroll
                    for (int jj = 0; jj < 2; ++jj) { float y8[8]; unpack8(r[u][k][jj], y8); v[u][2 * jj] += (f32x4){y8[0], y8[1], y8[2], y8[3]}; v[u][2 * jj + 1] += (f32x4){y8[4], y8[5], y8[6], y8[7]}; } }
        }
        float s[2], s2[2];
#pragma unroll
        for (int u = 0; u < 2; ++u) { s[u] = 0.f;
#pragma unroll
            for (int j = 0; j < 4; ++j) s[u] += (v[u][j].x + v[u][j].y) + (v[u][j].z + v[u][j].w); }
        s[0] = wave_sum(s[0], lane); s[1] = wave_sum(s[1], lane);
#pragma unroll
        for (int u = 0; u < 2; ++u) { const float mean = s[u] * (1.f / D); s2[u] = 0.f;
#pragma unroll
            for (int j = 0; j < 4; ++j) { v[u][j] = v[u][j] - mean; s2[u] += (v[u][j].x * v[u][j].x + v[u][j].y * v[u][j].y) + (v[u][j].z * v[u][j].z + v[u][j].w * v[u][j].w); } }
        s2[0] = wave_sum(s2[0], lane); s2[1] = wave_sum(s2[1], lane);
#pragma unroll
        for (int u = 0; u < 2; ++u) { const float rstd = 1.f / sqrtf(s2[u] * (1.f / D) + LN_EPS);
#pragma unroll
            for (int jj = 0; jj < 2; ++jj) { const int d = 8 * lane + 512 * jj;
                const f32x4 x0 = v[u][2 * jj] * rstd * gg4[2 * jj] + bb4[2 * jj], x1 = v[u][2 * jj + 1] * rstd * gg4[2 * jj + 1] + bb4[2 * jj + 1];
                u32x4 w; w.x = pk2(x0.x, x0.y); w.y = pk2(x0.z, x0.w); w.z = pk2(x1.x, x1.y); w.w = pk2(x1.z, x1.w); *((u32x4*)(XB + (size_t)(tok + u) * D + d)) = w;
                if (l == DEPTH - 1) { *((f32x4*)(out + (size_t)(tok + u) * D + d)) = x0; *((f32x4*)(out + (size_t)(tok + u) * D + d + 4)) = x1; } } }
    }
}

constexpr int PH_PER_LAYER = 11, N_PHASES = 1 + DEPTH * PH_PER_LAYER;
struct Args { const float* in[22]; float* out; unsigned char* ws; int ph_lo, ph_hi; };
__device__ __forceinline__ void phase_mix1(int l) { FRAME_SETUP;
    for (int it = F.bid; it < 256 + 128; it += F.G) { if (it < 256) mlstm_c1m(l, it); else gmlp_m(l, it - 256); }
    { const int nw = F.G * NWAVES; int first = (F.bid >= 128 ? F.bid - 128 : F.bid + F.G - 128) * NWAVES + F.wave;
      for (int wi = first; wi < 2048; wi += nw) pool_m(l, wi); } }
__device__ __forceinline__ void phase_mix2(int l) { FRAME_SETUP;
    for (int wi = F.bid * 2 + F.wave; wi < 272 && F.wave < 2; wi += F.G * 2) mlstm_scan(wi);
    const bool g256 = F.G == 256, sc = F.bid < 130;
    const int n = g256 ? (sc ? (F.bid < 4 ? 3 : 2) : 4) : (768 - F.bid + F.G - 1) / F.G, first = g256 ? (sc ? 2 * F.bid : 260 + 4 * (F.bid - 130)) : F.bid, stride = g256 ? 1 : F.G;
    for (int k = 0; k < n; ++k) att2_item((g256 && sc && k == 2) ? 764 + F.bid : first + k * stride); }
__device__ __forceinline__ void phase_mix3(int l) { FRAME_SETUP;
    for (int it = F.bid; it < 256 + 256; it += F.G) { if (it < 256) mlstm_c3m(l, it); else att_merge(it - 256); } }
__device__ __forceinline__ void phase_topk(int l) { FRAME_SETUP;
    const bool wide = F.G > 2 * BATCH * NE;
    for (int it = F.bid; it < BATCH * NE; it += F.G) topk_item(it);
    if (l + 1 < DEPTH && (!wide || F.bid >= BATCH * NE)) convert_layer(l + 1, ((wide ? F.bid - BATCH * NE : F.bid)) * NWAVES + F.wave, (wide ? F.G - BATCH * NE : F.G) * NWAVES); }
__device__ __forceinline__ void phase_g1(int l) { FRAME_SETUP; WS_PTRS;
    pg8::GemmP g{D, D, D}; SchedG1 S{F.G, F.bid, (const char*)XB, (const char*)wl(ws, l, OW_IN)}; EpiG1 E{H, GI, BIN + (size_t)l * NINP};
    pg8::gemm_phase<EpiG1, SchedG1, true>(F.lds, F.tid, g, S, E); }
__device__ __forceinline__ void phase_g2(int l) { FRAME_SETUP; WS_PTRS;
    pg8::GemmP g{D, D, D}; SchedG2 S{F.G, F.bid, (const char*)YS, (const char*)wl(ws, l, OW_B)}; EpiG2 E{H, MGB};
    pg8::gemm_phase<EpiG2, SchedG2, true>(F.lds, F.tid, g, S, E); }
__device__ __forceinline__ void phase_g3(int l) { FRAME_SETUP; WS_PTRS;
    pg8::GemmP g{D, D, D}; SchedG3 S{F.G, F.bid, (const char*)MGB, (const char*)wl(ws, l, OW_O)}; EpiG3 E{XB, MGF, (float*)(ws + WS_STAT)};
    pg8::gemm_phase<EpiG3, SchedG3, true>(F.lds, F.tid, g, S, E); }
__device__ __forceinline__ void phase_g4(int l) { FRAME_SETUP; WS_PTRS;
    pg8::GemmP g{D, D, D}; SchedG4 S{F.G, F.bid, (const char*)XB, (const char*)wl(ws, l, OW_13), IDX}; EpiG4 E{HID};
    pg8::gemm_phase<EpiG4, SchedG4, true>(F.lds, F.tid, g, S, E); }
__device__ __forceinline__ void phase_g5(int l) { FRAME_SETUP; WS_PTRS;
    pg8::GemmP g{FF, FF, FF}; SchedG5 S{F.G, F.bid, (const char*)HID, (const char*)wl(ws, l, OW_2)}; EpiG5 E{GATE, YE};
    pg8::gemm_phase<EpiG5, SchedG5, true>(F.lds, F.tid, g, S, E); }

__global__ void __launch_bounds__(NTHREADS, 2) fwd_kernel(Args args) {
    { LAS unsigned char* l0 = lds_base(); for (int u = threadIdx.x; u < (LDS_BYTES - LDSCTL_OFF) / 4; u += NTHREADS) ((LAS unsigned*)(l0 + LDSCTL_OFF))[u] = 0u; }
    __syncthreads();
#if !MK_PER_PHASE
    (void)xcd_barrier_post((unsigned*)(args.ws + WS_CTL) + CW_BAR, (volatile LAS unsigned*)(lds_base() + MISC_OFF) + 8);
#endif
    const int lo = args.ph_lo, hi = args.ph_hi;
#if PROBE_MASK
    volatile LAS unsigned long long* pacc = (volatile LAS unsigned long long*)(lds_base() + MISC_OFF + 64);
#endif
    for (int ph = lo; ph < hi; ++ph) {
#if PROBE_MASK
        const unsigned long long pt0 = __builtin_amdgcn_s_memrealtime();
#endif
        if (ph == 0) { if (PHEN(15)) p0_prologue(); }
        else {
            const int l = (ph - 1) / PH_PER_LAYER, sp = (ph - 1) % PH_PER_LAYER;
            if (sp == 0) { if (PHEN(0)) phase_g1(l); }
            else if (sp == 1) { if (PHEN(1)) phase_mix1(l); }
            else if (sp == 2) { if (PHEN(2)) phase_mix2(l); }
            else if (sp == 3) { if (PHEN(3)) phase_mix3(l); }
            else if (sp == 4) { if (PHEN(4)) phase_g2(l); }
            else if (sp == 5) { if (PHEN(5)) phase_g3(l); }
            else if (sp == 6) { if (PHEN(6)) ln1_router(l); }
            else if (sp == 7) { if (PHEN(7)) phase_topk(l); }
            else if (sp == 8) { if (PHEN(8)) phase_g4(l); }
            else if (sp == 9) { if (PHEN(9)) phase_g5(l); }
            else { if (PHEN(10)) combine_ln2(l); }
        }
#if PROBE_MASK && defined(PROBE_MODE) && PROBE_MODE == 1
        { const int sp_ = ph == 0 ? 15 : (ph - 1) % PH_PER_LAYER; asm volatile("s_waitcnt vmcnt(0)" ::: "memory"); __syncthreads(); const unsigned long long pt1 = __builtin_amdgcn_s_memrealtime();
          if (threadIdx.x == 0 && ((PROBE_MASK >> sp_) & 1)) pacc[0] = pacc[0] + (pt1 - pt0); }
#endif
        if (ph + 1 < hi) {
#if !MK_PER_PHASE
            { XcdBarrier bar; bar.bar = (unsigned*)(wsp() + WS_CTL) + CW_BAR; bar.x = xb_xcc_id(); bar.st = (volatile LAS unsigned*)(lds_base() + MISC_OFF) + 8; xcd_barrier(bar); }
#endif
        }
#if PROBE_MASK && !(defined(PROBE_MODE) && PROBE_MODE == 1)
        { const int sp_ = ph == 0 ? 15 : (ph - 1) % PH_PER_LAYER; const unsigned long long pt1 = __builtin_amdgcn_s_memrealtime();
          if (threadIdx.x == 0 && ((PROBE_MASK >> sp_) & 1)) pacc[0] = pacc[0] + (pt1 - pt0); }
#endif
    }
#if PROBE_MASK
    if (threadIdx.x == 0 && blockIdx.x == 0) { const unsigned long long t0 = __builtin_amdgcn_s_memrealtime(), need = pacc[0]; while (__builtin_amdgcn_s_memrealtime() - t0 < need) __builtin_amdgcn_s_sleep(8); }
#endif
}

extern "C" void kernel_launch(void* const* d_in, const int* in_sizes, int n_in, void* d_out, int out_size, void* d_ws, size_t ws_size, hipStream_t stream) {
    static int grid = 0;
    if (grid == 0) {
        if (n_in != 22 || in_sizes[0] != T * D || out_size != T * D || ws_size < WS_END) {
            fprintf(stderr, "kernel_launch: unexpected shapes: n_in %d in0 %d out %d ws %zu (need %zu); nothing launched\n", n_in, n_in > 0 ? in_sizes[0] : -1, out_size, ws_size, (size_t)WS_END); grid = -1; return; }
        int dev = 0, cus = 0;
        if (hipGetDevice(&dev) != hipSuccess || hipDeviceGetAttribute(&cus, hipDeviceAttributeMultiprocessorCount, dev) != hipSuccess) { grid = -1; return; }
        if (hipFuncSetAttribute((const void*)fwd_kernel, hipFuncAttributeMaxDynamicSharedMemorySize, LDS_BYTES) != hipSuccess) { fprintf(stderr, "kernel_launch: hipFuncSetAttribute failed\n"); grid = -1; return; }
        int per_cu = 0;
        if (hipOccupancyMaxActiveBlocksPerMultiprocessor(&per_cu, (const void*)fwd_kernel, NTHREADS, LDS_BYTES) != hipSuccess || per_cu < 1)
            fprintf(stderr, "kernel_launch: note: occupancy query reports %d workgroups per CU\n", per_cu);
        (void)hipGetLastError();
        grid = cus;
    }
    if (grid < 0) return;
    (void)hipMemsetAsync((char*)d_ws + WS_CTL, 0, CTL_ZERO_BYTES, stream);
    Args a{};
    for (int i = 0; i < 22; ++i) a.in[i] = (const float*)d_in[i];
    a.out = (float*)d_out; a.ws = (unsigned char*)d_ws;
#if MK_PER_PHASE
    for (int ph = 0; ph < N_PHASES; ++ph) { a.ph_lo = ph; a.ph_hi = ph + 1; hipLaunchKernelGGL(fwd_kernel, dim3(grid), dim3(NTHREADS), LDS_BYTES, stream, a); }
#else
    a.ph_lo = 0; a.ph_hi = N_PHASES; hipLaunchKernelGGL(fwd_kernel, dim3(grid), dim3(NTHREADS), LDS_BYTES, stream, a);
#endif
}
```

```cpp
#include <hip/hip_runtime.h>
#include <cstdio>
#include <cstdint>

#ifndef PH_MASK
#define PH_MASK 0xFFFF
#endif
#define PHEN(k) ((PH_MASK >> (k)) & 1)
#ifndef PROBE_MASK
#define PROBE_MASK 0
#endif
#ifndef MK_PER_PHASE
#define MK_PER_PHASE 0
#endif

#define GAS __attribute__((address_space(1)))
#define LAS __attribute__((address_space(3)))
typedef unsigned short bf16;
typedef short bf16x8 __attribute__((ext_vector_type(8)));
typedef float f32x4 __attribute__((ext_vector_type(4)));
typedef float f32x2 __attribute__((ext_vector_type(2)));
typedef unsigned u32x4 __attribute__((ext_vector_type(4)));
typedef unsigned u32x2 __attribute__((ext_vector_type(2)));
typedef GAS unsigned gu32;
#define RLX_AGENT __ATOMIC_RELAXED, __HIP_MEMORY_SCOPE_AGENT
#define LDS_WAIT() asm volatile("s_waitcnt lgkmcnt(0)" ::: "memory")
#define VM_WAIT() asm volatile("s_waitcnt vmcnt(0)" ::: "memory")

constexpr int BATCH = 2, SEQ = 8192, D = 1024, T = BATCH * SEQ, DEPTH = 4;
constexpr int NIN = 6672;
constexpr int NH = 6656;
constexpr int NINP = 6912;
constexpr int NE = 16, CAP = 1024, FF = 1024, NSLOT = BATCH * NE * CAP;
constexpr float ALPHA = 1.6817928305074292f;
constexpr float LN_EPS = 1e-5f;
constexpr int HU = 0, HV = 256, HAQ = 512, HAK = 768, HAV = 1024, HCQ = 1280, HCK = 1536, HCV = 1792, HCO = 2048, HDX = 2304, HG = 2560;

constexpr size_t MiB = 1u << 20;
constexpr size_t WS_CTL = 0, CTL_ZERO_BYTES = 64 * 1024;
constexpr size_t WS_BIN = 1 * MiB;
constexpr size_t WS_WSB = 1 * MiB + 512 * 1024;
constexpr size_t WS_PWT = 1 * MiB + 256 * 1024;
constexpr size_t WS_W = 2 * MiB, LW = 114 * MiB;
constexpr size_t OW_IN = 0, OW_B = 14 * MiB, OW_O = 16 * MiB, OW_13 = 18 * MiB, OW_2 = 82 * MiB;
constexpr size_t WS_XF = 458 * MiB;
constexpr size_t WS_STAT = WS_XF;
constexpr size_t WS_WRT = 1 * MiB + 128 * 1024;
constexpr size_t WS_XB = 522 * MiB;
constexpr size_t WS_BIG = 554 * MiB;
constexpr size_t WS_XS = WS_BIG, WS_HID = WS_BIG + 64 * MiB, WS_YE = WS_BIG + 128 * MiB;
constexpr size_t WS_GI = 762 * MiB;
constexpr size_t WS_ATTO = 763 * MiB;
constexpr size_t WS_ATTL = 811 * MiB;
constexpr size_t WS_YS = 812 * MiB;
constexpr size_t WS_MGF = 844 * MiB;
constexpr size_t WS_MGB = 908 * MiB;
constexpr size_t WS_QC = 940 * MiB, WS_KC = 956 * MiB;
constexpr size_t WS_DC = 972 * MiB;
constexpr size_t WS_DG = 1005 * MiB;
constexpr size_t WS_AFF = 1006 * MiB;
constexpr size_t WS_IDX = 1007 * MiB;
constexpr size_t WS_GATE = 1007 * MiB + 512 * 1024;
constexpr size_t WS_SLOT = 1008 * MiB;
constexpr size_t WS_END = 1009 * MiB;

constexpr int CW_BAR = 4096;

constexpr int RING_BYTES = 131072;
constexpr int LDSCTL_OFF = RING_BYTES, MISC_OFF = LDSCTL_OFF + 320;
constexpr int LDS_BYTES = 147456;
constexpr int NWAVES = 8, NTHREADS = 512;

__device__ __forceinline__ float bf2f(unsigned v) { return __uint_as_float(v << 16); }
__device__ __forceinline__ unsigned f2bf(float f) { unsigned u = __float_as_uint(f); return (u + 0x7fffu + ((u >> 16) & 1u)) >> 16; }
typedef __bf16 bf16x2_t_ __attribute__((ext_vector_type(2)));
__device__ __forceinline__ unsigned pk2(float lo, float hi) { f32x2 v = {lo, hi}; bf16x2_t_ b = __builtin_convertvector(v, bf16x2_t_); return __builtin_bit_cast(unsigned, b); }
__device__ __forceinline__ float rcpf_(float x) { return __builtin_amdgcn_rcpf(x); }
__device__ __forceinline__ void unpack8(const u32x4 w, float (&o)[8]) {
    o[0] = __uint_as_float(w.x << 16); o[1] = __uint_as_float(w.x & 0xffff0000u);
    o[2] = __uint_as_float(w.y << 16); o[3] = __uint_as_float(w.y & 0xffff0000u);
    o[4] = __uint_as_float(w.z << 16); o[5] = __uint_as_float(w.z & 0xffff0000u);
    o[6] = __uint_as_float(w.w << 16); o[7] = __uint_as_float(w.w & 0xffff0000u);
}
__device__ __forceinline__ float sigmoidf_(float x) { return rcpf_(1.0f + __expf(-x)); }
__device__ __forceinline__ float siluf_(float x) { return x * rcpf_(1.0f + __expf(-x)); }
__device__ __forceinline__ float gelu_tanh(float x) { const float u = 1.5957691216057308f * (x + 0.044715f * x * x * x); return x * rcpf_(1.0f + __expf(-u)); }
__device__ __forceinline__ float logsigmoidf_(float z) { return fminf(z, 0.f) - log1pf(__expf(-fabsf(z))); }
__device__ __forceinline__ float shx(float v, int o, int lane) { return __int_as_float(__builtin_amdgcn_ds_bpermute((lane ^ o) << 2, __float_as_int(v))); }
template <int CTRL> __device__ __forceinline__ float dpp_mov(float v) { return __int_as_float(__builtin_amdgcn_update_dpp(0, __float_as_int(v), CTRL, 0xF, 0xF, false)); }
__device__ __forceinline__ float wave_sum(float v, int lane) { (void)lane;
    v += dpp_mov<0xB1>(v); v += dpp_mov<0x4E>(v); v += dpp_mov<0x141>(v); v += dpp_mov<0x140>(v);
    const int iv = __float_as_int(v);
    return (__int_as_float(__builtin_amdgcn_readlane(iv, 0)) + __int_as_float(__builtin_amdgcn_readlane(iv, 16))) + (__int_as_float(__builtin_amdgcn_readlane(iv, 32)) + __int_as_float(__builtin_amdgcn_readlane(iv, 48)));
}

#define XB_TMO      128
#define XB_XCNT(j)  (256  + 64 * (j))
#define XB_XSUB(j)  (1280 + 64 * (j))
#define XB_XGEN(j)  (2304 + 64 * (j))
#define XB_TOP      3328
#define XB_TOPGEN   3392
#define XCD_BAR_WORDS 3456
#define XB_SPIN_CAP (1u << 18)
__device__ __forceinline__ unsigned xb_ld(unsigned* p)              { return __hip_atomic_load(p, __ATOMIC_RELAXED, __HIP_MEMORY_SCOPE_AGENT); }
__device__ __forceinline__ unsigned xb_add(unsigned* p, unsigned v) { return __hip_atomic_fetch_add(p, v, __ATOMIC_RELAXED, __HIP_MEMORY_SCOPE_AGENT); }
__device__ __forceinline__ unsigned xb_xcc_id() { return (unsigned)__builtin_amdgcn_s_getreg((3 << 11) | 20) & 0xFu; }
#define XB_SPIN(cond, bar) do { unsigned _sp = 0; while (cond) { __builtin_amdgcn_s_sleep(1); \
    if ((++_sp & 255u) == 0u) { if (xb_ld(&(bar)[XB_TMO])) break; if (_sp > XB_SPIN_CAP) { atomicAdd(&(bar)[XB_TMO], 1u); break; } } } } while (0)
struct XcdBarrier { unsigned* bar; unsigned x; volatile LAS unsigned* st; };
__device__ __forceinline__ XcdBarrier xcd_barrier_post(unsigned* bar, volatile LAS unsigned* st) {
    XcdBarrier b; b.bar = bar; b.x = xb_xcc_id(); b.st = st;
    if (threadIdx.x == 0) (void)xb_add(&bar[XB_XCNT(b.x)], 1u);
    return b;
}
__device__ __forceinline__ void xcd_barrier_complete(unsigned* bar, unsigned x, unsigned& nloc, unsigned& nx) {
    const unsigned G = gridDim.x * gridDim.y * gridDim.z;
    unsigned sum, cnt, mine, sp = 0u;
    for (;;) {
        sum = 0u; cnt = 0u; mine = 0u;
#pragma unroll
        for (unsigned j = 0; j < 16; ++j) { const unsigned c = xb_ld(&bar[XB_XCNT(j)]); sum += c; cnt += (c > 0u) ? 1u : 0u; mine = (j == x) ? c : mine; }
        if (sum == G) break;
        __builtin_amdgcn_s_sleep(1);
        if ((++sp & 255u) == 0u) { if (xb_ld(&bar[XB_TMO])) break; if (sp > XB_SPIN_CAP) { atomicAdd(&bar[XB_TMO], 1u); break; } }
    }
    nloc = mine > 0u ? mine : 1u; nx = cnt > 0u ? cnt : 1u;
}
__device__ __forceinline__ void xcd_barrier(const XcdBarrier& b) {
    asm volatile("s_waitcnt vmcnt(0)" ::: "memory");
    __syncthreads();
    if (threadIdx.x == 0) {
        unsigned* bar = b.bar;
        __builtin_amdgcn_s_waitcnt(0);
        unsigned nloc = b.st[0], nx = b.st[1];
        if (nloc == 0u) { xcd_barrier_complete(bar, b.x, nloc, nx); b.st[0] = nloc; b.st[1] = nx; }
        const unsigned old = xb_add(&bar[XB_XSUB(b.x)], 1u);
        const unsigned gen = old / nloc;
        if (old + 1u == (gen + 1u) * nloc) {
            __builtin_amdgcn_fence(__ATOMIC_RELEASE, "agent");
            asm volatile("s_waitcnt vmcnt(0)" ::: "memory");
            const unsigned og = xb_add(&bar[XB_TOP], 1u);
            const unsigned tg = og / nx;
            if (og + 1u == (tg + 1u) * nx) xb_add(&bar[XB_TOPGEN], 1u);
            else XB_SPIN(xb_ld(&bar[XB_TOPGEN]) == tg, bar);
            __builtin_amdgcn_fence(__ATOMIC_ACQUIRE, "agent");
            xb_add(&bar[XB_XGEN(b.x)], 1u);
            asm volatile("s_waitcnt vmcnt(0)" ::: "memory");
        } else {
            XB_SPIN(xb_ld(&bar[XB_XGEN(b.x)]) == gen, bar);
            __builtin_amdgcn_fence(__ATOMIC_ACQUIRE, "agent");
            asm volatile("s_waitcnt vmcnt(0)" ::: "memory");
        }
    }
    __syncthreads();
}

namespace pg8 {
constexpr int BM = 256, BK = 64, HALF = 128, HTB = HALF * BK * 2, STAGE_BYTES = 8 * HTB, NXCD = 8, WGM = 8;
__host__ __device__ __forceinline__ int lds_byte(int r, int c) { const int st = (r >> 4) * 2 + (c >> 5), rr = r & 15, cc = c & 31, ob = rr * 64 + cc * 2; return st * 1024 + (ob ^ (((ob >> 9) & 1) << 5)); }
__host__ __device__ __forceinline__ void stage_rc(int b, int& R, int& C) { const int st = b / 1024, sb = b % 1024, swz = sb ^ (((sb >> 9) & 1) << 5); R = (st >> 1) * 16 + swz / 64; C = (st & 1) * 32 + (swz % 64) / 2; }
__host__ __device__ __forceinline__ int perm32(int rho) { const int n = rho >> 4, i = rho & 15; return 8 * (i >> 2) + 4 * n + (i & 3); }

struct Unit { int pm, pn, aux; const char* A; const char* B; };
struct GemmP { int K, lda, ldb; };

__device__ __forceinline__ bool tile_of(int i, int G, int c, int nM, int nN, int& pm, int& pn) {
    const int nwg = nM * nN; const int L = i * G + c; if (L >= nwg) return false;
    int wgid = L; { const int q = nwg / NXCD, r = nwg % NXCD, xcd = wgid % NXCD, off = wgid / NXCD; wgid = (xcd < r ? xcd * (q + 1) : r * (q + 1) + (xcd - r) * q) + off; }
    const int nig = WGM * nN, gid = wgid / nig, fm = gid * WGM, gsz = (nM - fm) < WGM ? (nM - fm) : WGM;
    pm = fm + ((wgid % nig) % gsz); pn = (wgid % nig) / gsz; return true;
}

__device__ __forceinline__ unsigned cvt_pk_bf16(float lo, float hi) { unsigned r; asm volatile("v_cvt_pk_bf16_f32 %0, %1, %2" : "=v"(r) : "v"(lo), "v"(hi)); return r; }

template <class Epi, class Sched, bool ALIGN_EPI>
__device__ __forceinline__ void gemm_phase(LAS unsigned char* lds, const int tid, const GemmP g, const Sched& S, const Epi& E) {
    const int wid = __builtin_amdgcn_readfirstlane(tid >> 6), lane = tid & 63, wr = wid >> 2, wc = wid & 3, fr = lane & 15, fq = lane >> 4;
    const int K = g.K, nt = K / BK;
    unsigned voffB[2]; int Ri[2], Ci[2];
#pragma unroll
    for (int i = 0; i < 2; ++i) { int R, C; stage_rc(tid * 16 + i * 8192, R, C); const int Rb = Epi::PERM ? ((R & ~31) + perm32(R & 31)) : R;
        Ri[i] = R; Ci[i] = C; voffB[i] = (unsigned)(Rb * g.ldb + C) * 2u; }
    const size_t kstep = (size_t)(BK * 2);
    const size_t hstepB = (size_t)HALF * g.ldb * 2;
    unsigned vA0[2], vA1[2], nvA0[2], nvA1[2];
    const unsigned ldsw = (unsigned)wid * 1024u;
    const int aoff = lds_byte(wr * 64 + fr, fq * 8), boff = lds_byte(wc * 32 + fr, fq * 8);
#define PG8_SA(b, h) (((b) * 2 + (h)) * HTB)
#define PG8_SB(b, h) ((4 + (b) * 2 + (h)) * HTB)
#define PG8_STAGE(bufoff, gbase, voff) do { _Pragma("unroll") for (int _i = 0; _i < 2; ++_i) \
        __builtin_amdgcn_global_load_lds((const unsigned*)((const char*)(gbase) + (voff)[_i]), (LAS unsigned*)(lds + (bufoff) + ldsw + _i * 8192), 16, 0, 0); } while (0)
#define PG8_LDA(dst, b, h) do { _Pragma("unroll") for (int m = 0; m < 4; ++m) _Pragma("unroll") for (int k = 0; k < 2; ++k) dst[m][k] = *(const LAS bf16x8*)(lds + PG8_SA(b, h) + aoff + m * 2048 + k * 1024); } while (0)
#define PG8_LDB(dst, b, h) do { _Pragma("unroll") for (int n = 0; n < 2; ++n) _Pragma("unroll") for (int k = 0; k < 2; ++k) dst[n][k] = *(const LAS bf16x8*)(lds + PG8_SB(b, h) + boff + n * 2048 + k * 1024); } while (0)
#define PG8_MMA(ai, bj, At, Bt) do { __builtin_amdgcn_s_setprio(1); _Pragma("unroll") for (int m = 0; m < 4; ++m) _Pragma("unroll") for (int n = 0; n < 2; ++n) _Pragma("unroll") for (int k = 0; k < 2; ++k) \
        acc[ai][bj][m][n] = __builtin_amdgcn_mfma_f32_16x16x32_bf16(Bt[n][k], At[m][k], acc[ai][bj][m][n], 0, 0, 0); __builtin_amdgcn_s_setprio(0); } while (0)
#define PG8_WAIT_V(n) asm volatile("s_waitcnt vmcnt(" #n ")" ::: "memory")
#define PG8_WAIT_L(n) asm volatile("s_waitcnt lgkmcnt(" #n ")" ::: "memory")
#define PG8_BAR __builtin_amdgcn_s_barrier()
#define PG8_SCHED __builtin_amdgcn_sched_barrier(0)
    Unit cur, nxt; int ui = 0;
    if (!S.next(0, cur)) return;
    float zf = 0.f; asm volatile("" : "+v"(zf));
    f32x4 acc[2][2][4][2];
#pragma unroll
    for (int a = 0; a < 2; ++a)
#pragma unroll
        for (int b = 0; b < 2; ++b)
#pragma unroll
            for (int m = 0; m < 4; ++m)
#pragma unroll
                for (int n = 0; n < 2; ++n) acc[a][b][m][n] = (f32x4){zf, zf, zf, zf};
    bf16x8 At[4][2], B0[2][2], B1[2][2];
    typename Epi::Pre pre;
    const char* cA = cur.A; const char* cB = cur.B;
    S.a_off(cur, g.lda, Ri, Ci, vA0, vA1);
    PG8_STAGE(PG8_SB(0, 0), cB, voffB); PG8_STAGE(PG8_SB(0, 1), cB + hstepB, voffB); PG8_STAGE(PG8_SA(0, 0), cA, vA0); PG8_STAGE(PG8_SA(0, 1), cA, vA1);
    if (wr == 1) PG8_BAR;
    PG8_WAIT_V(2); PG8_BAR;
    PG8_STAGE(PG8_SB(1, 0), cB + kstep, voffB); PG8_STAGE(PG8_SA(1, 0), cA + kstep, vA0); PG8_STAGE(PG8_SB(1, 1), cB + hstepB + kstep, voffB);
    PG8_WAIT_V(6); PG8_BAR;
    for (;;) {
        const bool has_next = S.next(ui + 1, nxt);
        const char* nA = has_next ? nxt.A : cA; const char* nB = has_next ? nxt.B : cB;
        if (has_next) S.a_off(nxt, g.lda, Ri, Ci, nvA0, nvA1); else { nvA0[0] = vA0[0]; nvA0[1] = vA0[1]; nvA1[0] = vA1[0]; nvA1[1] = vA1[1]; }
        for (int t = 0; t < nt; t += 2) {
            if constexpr (Epi::HOOK) { if (t != 0 && (t & 3) == 0) E.hook(acc, cur, t >> 2, wr, wc, fr, fq); }
            const bool last = (t == nt - 2);
            if (last) E.prefetch(cur, wr, wc, fr, fq, pre);
            const char* a1 = cA + (size_t)(t + 1) * kstep;
            const char* a2 = last ? nA : cA + (size_t)(t + 2) * kstep; const char* b2 = last ? nB : cB + (size_t)(t + 2) * kstep;
            const char* a3 = a2 + kstep; const char* b3 = b2 + kstep;
            unsigned w0[2], w1[2];
            w0[0] = last ? nvA0[0] : vA0[0]; w0[1] = last ? nvA0[1] : vA0[1]; w1[0] = last ? nvA1[0] : vA1[0]; w1[1] = last ? nvA1[1] : vA1[1];
            PG8_LDB(B0, 0, 0); PG8_LDB(B1, 0, 1); PG8_SCHED; PG8_LDA(At, 0, 0); PG8_STAGE(PG8_SA(1, 1), a1, vA1);
            PG8_WAIT_V(8); PG8_WAIT_L(0); PG8_BAR; PG8_MMA(0, 0, At, B0); PG8_MMA(0, 1, At, B1); PG8_BAR; PG8_SCHED;
            PG8_LDA(At, 0, 1); PG8_STAGE(PG8_SB(0, 0), b2, voffB); PG8_STAGE(PG8_SB(0, 1), b2 + hstepB, voffB); PG8_STAGE(PG8_SA(0, 0), a2, w0);
            PG8_WAIT_V(8); PG8_WAIT_L(0); PG8_BAR; PG8_MMA(1, 0, At, B0); PG8_MMA(1, 1, At, B1); PG8_BAR; PG8_SCHED;
            PG8_LDB(B0, 1, 0); PG8_LDB(B1, 1, 1); PG8_SCHED; PG8_LDA(At, 1, 0); PG8_STAGE(PG8_SA(0, 1), a2, w1);
            PG8_WAIT_V(8); PG8_WAIT_L(0); PG8_BAR; PG8_MMA(0, 0, At, B0); PG8_MMA(0, 1, At, B1); PG8_BAR; PG8_SCHED;
            PG8_LDA(At, 1, 1); PG8_STAGE(PG8_SB(1, 0), b3, voffB); PG8_STAGE(PG8_SB(1, 1), b3 + hstepB, voffB); PG8_STAGE(PG8_SA(1, 0), a3, w0);
            PG8_WAIT_V(8); PG8_WAIT_L(0); PG8_BAR; PG8_MMA(1, 0, At, B0); PG8_MMA(1, 1, At, B1); PG8_BAR; PG8_SCHED;
        }
        if constexpr (ALIGN_EPI) { if (wr == 0) PG8_BAR; }
        E(acc, cur, wr, wc, fr, fq, pre);
        if (!has_next) break;
#pragma unroll
        for (int a = 0; a < 2; ++a)
#pragma unroll
            for (int b = 0; b < 2; ++b)
#pragma unroll
                for (int m = 0; m < 4; ++m)
#pragma unroll
                    for (int n = 0; n < 2; ++n) acc[a][b][m][n] = (f32x4){zf, zf, zf, zf};
        cur = nxt; cA = nA; cB = nB; ++ui; vA0[0] = nvA0[0]; vA0[1] = nvA0[1]; vA1[0] = nvA1[0]; vA1[1] = nvA1[1];
        if constexpr (ALIGN_EPI) { if (wr == 1) PG8_BAR; }
    }
    PG8_WAIT_V(0);
    if constexpr (!ALIGN_EPI) { if (wr == 0) PG8_BAR; }
    PG8_BAR;
#undef PG8_SA
#undef PG8_SB
#undef PG8_STAGE
#undef PG8_LDA
#undef PG8_LDB
#undef PG8_MMA
#undef PG8_WAIT_V
#undef PG8_WAIT_L
#undef PG8_BAR
#undef PG8_SCHED
}
}

struct Frame { LAS unsigned char* lds; int tid, lane, wave, G, bid; float zf; unsigned zu; };
#define FRAME_SETUP Frame F; { int t_ = threadIdx.x, b_ = blockIdx.x, g_ = gridDim.x; float z_ = 0.f; unsigned zu_ = 0u; asm volatile("" : "+v"(t_), "+s"(b_), "+s"(g_), "+v"(z_), "+v"(zu_)); \
    F.lds = lds_base(); F.tid = t_; F.lane = t_ & 63; F.wave = __builtin_amdgcn_readfirstlane(t_ >> 6); F.G = g_; F.bid = b_; F.zf = z_; F.zu = zu_; }
extern __shared__ __attribute__((aligned(16))) unsigned char lds_dyn[];
__device__ __forceinline__ LAS unsigned char* lds_base() { return (LAS unsigned char*)lds_dyn; }
typedef const __attribute__((address_space(4))) unsigned long long karg_t;
__device__ __forceinline__ unsigned long long karg(int k) { asm volatile("" : "+s"(k)); return ((karg_t*)__builtin_amdgcn_kernarg_segment_ptr())[k]; }
__device__ __forceinline__ const float* inp(int k) { return (const float*)(const GAS float*)karg(k); }
__device__ __forceinline__ float* outp() { return (float*)(GAS float*)karg(22); }
__device__ __forceinline__ unsigned char* wsp() { return (unsigned char*)(GAS unsigned char*)karg(23); }
enum { I_X = 0, I_WIN, I_BIN, I_GMLNG, I_GMWS, I_GMBS, I_RELB, I_MLCONV, I_MLFB, I_MLNG, I_POOLW, I_POOLS, I_WBR, I_WOUT, I_LN1G, I_LN1B, I_WR, I_WE1, I_WE3, I_WE2, I_LN2G, I_LN2B };
__device__ __forceinline__ bf16* wl(unsigned char* ws, int l, size_t off) { return (bf16*)(ws + WS_W + (size_t)l * LW + off); }

#define WS_PTRS unsigned char* ws = wsp(); float* BIN = (float*)(ws + WS_BIN); float* XF = (float*)(ws + WS_XF); bf16* XB = (bf16*)(ws + WS_XB); bf16* H = (bf16*)(ws + WS_BIG); bf16* XS = (bf16*)(ws + WS_XS); \
    bf16* HID = (bf16*)(ws + WS_HID); bf16* YE = (bf16*)(ws + WS_YE); float* GI = (float*)(ws + WS_GI); bf16* ATTO = (bf16*)(ws + WS_ATTO); float* ATTL = (float*)(ws + WS_ATTL); bf16* YS = (bf16*)(ws + WS_YS); \
    float* MGF = (float*)(ws + WS_MGF); bf16* MGB = (bf16*)(ws + WS_MGB); bf16* QC = (bf16*)(ws + WS_QC); bf16* KC = (bf16*)(ws + WS_KC); bf16* DC = (bf16*)(ws + WS_DC); float* DG = (float*)(ws + WS_DG); \
    float* AFF = (float*)(ws + WS_AFF); float* GATE = (float*)(ws + WS_GATE); int* IDX = (int*)(ws + WS_IDX); int* SLOT = (int*)(ws + WS_SLOT); \
    (void)BIN; (void)XF; (void)XB; (void)H; (void)XS; (void)HID; (void)YE; (void)GI; (void)ATTO; (void)ATTL; (void)YS; (void)MGF; (void)MGB; (void)QC; (void)KC; (void)DC; (void)DG; (void)AFF; (void)GATE; (void)IDX; (void)SLOT
__device__ __forceinline__ void tr_item(const float* W, int ldw, int k0, int n0, int ncols, bf16* WT, int ldt, int trow0, LAS float* scr, int lane) {
    const int c4 = lane & 7, r = lane >> 3; const bool cv = 4 * c4 < ncols;
    f32x4 tv[8];
#pragma unroll
    for (int i = 0; i < 8; ++i) tv[i] = cv ? __builtin_nontemporal_load((const f32x4*)(W + (size_t)(k0 + r + 8 * i) * ldw + n0 + 4 * c4)) : (f32x4){0.f, 0.f, 0.f, 0.f};
#pragma unroll
    for (int i = 0; i < 8; ++i) { LAS float* d = scr + (r + 8 * i) * 33 + 4 * c4; d[0] = tv[i][0]; d[1] = tv[i][1]; d[2] = tv[i][2]; d[3] = tv[i][3]; }
    LDS_WAIT(); asm volatile("" ::: "memory");
    const int ch = lane & 7;
#pragma unroll
    for (int j = 0; j < 4; ++j) { const int n = (lane >> 3) + 8 * j; const LAS float* s = scr + (8 * ch) * 33 + n;
        u32x4 o; o.x = pk2(s[0 * 33], s[1 * 33]); o.y = pk2(s[2 * 33], s[3 * 33]); o.z = pk2(s[4 * 33], s[5 * 33]); o.w = pk2(s[6 * 33], s[7 * 33]);
        if (n < ncols) *(GAS u32x4*)(WT + (size_t)(trow0 + n) * ldt + k0 + 8 * ch) = o; }
    LDS_WAIT(); asm volatile("" ::: "memory");
}
constexpr int IT_IN = 16 * 209, IT_B = 512, IT_O = 512, IT_13 = 16384, IT_2 = 8192, IT_LAYER = IT_IN + IT_B + IT_O + IT_13 + IT_2;
__device__ __forceinline__ void convert_layer(int l, int gw, int NGW) {
    FRAME_SETUP;
    WS_PTRS; const float* w_in = inp(I_WIN); const float* w_branch = inp(I_WBR); const float* w_out = inp(I_WOUT); const float* w_e1 = inp(I_WE1); const float* w_e3 = inp(I_WE3); const float* w_e2 = inp(I_WE2);
    LAS float* scr = (LAS float*)(F.lds + F.wave * 16384);
    const int lane = F.lane;
    for (int it = gw; it < IT_LAYER; it += NGW) {
        int r = it; const float* W; int ldw, k0, n0, nc = 32, ldt, trow; bf16* WT;
        if (r < IT_IN) { const int kb = r / 209, cb = r % 209; k0 = 64 * kb;
            if (cb < 72) { n0 = 32 * cb; trow = n0; } else if (cb < 208) { n0 = 2320 + 32 * (cb - 72); trow = 2304 + 32 * (cb - 72); } else { n0 = 2304; trow = 6656; nc = 16; }
            W = w_in + (size_t)l * D * NIN; ldw = NIN; WT = wl(ws, l, OW_IN); ldt = D; }
        else if ((r -= IT_IN) < IT_B) { const int n = r / 128, q = r % 128, kb = q / 32, nb = q % 32;
            W = w_branch + ((size_t)(l * 4 + n) * 256) * D; ldw = D; k0 = 64 * kb; n0 = 32 * nb; WT = wl(ws, l, OW_B) + (size_t)n * 256; ldt = D; trow = 32 * nb; }
        else if ((r -= IT_B) < IT_O) { const int kb = r / 32, nb = r % 32;
            W = w_out + (size_t)l * D * D; ldw = D; k0 = 64 * kb; n0 = 32 * nb; WT = wl(ws, l, OW_O); ldt = D; trow = 32 * nb; }
        else if ((r -= IT_O) < IT_13) { const int e = r / 1024, q = r % 1024, which = q / 512, q2 = q % 512, kb = q2 / 32, nb = q2 % 32, f0 = 32 * nb;
            W = (which ? w_e3 : w_e1) + ((size_t)(l * NE + e) * D) * FF; ldw = FF; k0 = 64 * kb; n0 = f0; WT = wl(ws, l, OW_13) + (size_t)e * 2048 * D; ldt = D; trow = (f0 / 128) * 256 + (f0 % 128) + which * 128; }
        else { r -= IT_13; const int e = r / 512, q = r % 512, kb = q / 32, nb = q % 32;
            W = w_e2 + ((size_t)(l * NE + e) * FF) * D; ldw = D; k0 = 64 * kb; n0 = 32 * nb; WT = wl(ws, l, OW_2) + (size_t)e * D * FF; ldt = FF; trow = 32 * nb; }
        tr_item(W, ldw, k0, n0, nc, WT, ldt, trow, scr, lane);
    }
}
__device__ __forceinline__ void p0_prologue() {
    FRAME_SETUP;
    WS_PTRS; const float* x = inp(I_X); const float* b_in = inp(I_BIN);
    convert_layer(0, F.bid * NWAVES + F.wave, F.G * NWAVES);
    const int gt = F.bid * NTHREADS + F.tid, NGT = F.G * NTHREADS;
    for (int i = gt; i < DEPTH * 240 * (D / 8); i += NGT) { const int l = i / (240 * (D / 8)), r = i % (240 * (D / 8));
        *(GAS u32x4*)(wl(ws, l, OW_IN) + (size_t)NIN * D + (size_t)r * 8) = (u32x4){F.zu, F.zu, F.zu, F.zu}; }
    for (int i = gt; i < DEPTH * NINP; i += NGT) { const int l = i / NINP, c = i % NINP;
        float v = 0.f; if (c < 2304) v = b_in[l * NIN + c]; else if (c < NH) v = b_in[l * NIN + c + 16]; else if (c < NH + 16) v = b_in[l * NIN + c - NH + 2304];
        BIN[i] = v; }
    { const float* gm_ws = inp(I_GMWS); bf16* WSB = (bf16*)(ws + WS_WSB);
      for (int i = gt; i < DEPTH * 4 * 128 * 128 / 4; i += NGT) { const f32x4 v = ((const GAS f32x4*)gm_ws)[i]; u32x2 w; w.x = pk2(v.x, v.y); w.y = pk2(v.z, v.w); ((GAS u32x2*)WSB)[i] = w; } }
    { const float* pool_w = inp(I_POOLW); bf16* PWT = (bf16*)(ws + WS_PWT);
      for (int i = gt; i < DEPTH * 4 * 64 * 64; i += NGT) { const int lg = i >> 12, o = (i >> 6) & 63, ii = i & 63; PWT[i] = (bf16)f2bf(pool_w[(size_t)lg * 4096 + ii * 64 + o]); } }
    { const float* w_router = inp(I_WR); bf16* WRT = (bf16*)(ws + WS_WRT);
      for (int i = gt; i < DEPTH * NE * D; i += NGT) { const int ll = i / (NE * D), e = (i / D) % NE, d = i % D; WRT[i] = (bf16)f2bf(w_router[((size_t)ll * D + d) * NE + e]); } }
    for (int i = gt; i < T * D / 4; i += NGT) { const f32x4 v = ((const GAS f32x4*)x)[i];
        u32x2 w; w.x = pk2(v.x, v.y); w.y = pk2(v.z, v.w); ((GAS u32x2*)XB)[i] = w; }
}

typedef f32x4 Acc[2][2][4][2];
struct SchedG1 { int G, c; const char* A; const char* B;
    __device__ __forceinline__ void a_off(const pg8::Unit&, int lda, const int (&Ri)[2], const int (&Ci)[2], unsigned (&v0)[2], unsigned (&v1)[2]) const {
#pragma unroll
        for (int i = 0; i < 2; ++i) { v0[i] = (unsigned)(Ri[i] * lda + Ci[i]) * 2u; v1[i] = v0[i] + (unsigned)(128 * lda * 2); } }
    __device__ __forceinline__ bool next(int i, pg8::Unit& u) const { int pm, pn; if (!pg8::tile_of(i, G, c, T / 256, NINP / 256, pm, pn)) return false;
        u.pm = pm; u.pn = pn; u.aux = 0; u.A = A + (size_t)pm * 256 * D * 2; u.B = B + (size_t)pn * 256 * D * 2; return true; } };
struct EpiG1 { static constexpr bool PERM = true, HOOK = false; bf16* H; float* GI; const float* bias;
    struct Pre { f32x4 bv[2][2]; };
    __device__ __forceinline__ void prefetch(const pg8::Unit& u, int wr, int wc, int fr, int fq, Pre& p) const { const int col0 = u.pn * 256 + wc * 32 + 8 * fq;
#pragma unroll
        for (int bj = 0; bj < 2; ++bj)
#pragma unroll
            for (int n = 0; n < 2; ++n) p.bv[bj][n] = *(const f32x4*)(bias + col0 + bj * 128 + 4 * n); }
    __device__ __forceinline__ void operator()(const Acc& acc, const pg8::Unit& u, int wr, int wc, int fr, int fq, const Pre& pre) const {
        const int row0 = u.pm * 256 + wr * 64 + fr;
        if (u.pn < 26) {
            const int col0 = u.pn * 256 + wc * 32 + 8 * fq; const bool act = u.pn < 2, sg = u.pn >= 10;
#pragma unroll
            for (int ai = 0; ai < 2; ++ai)
#pragma unroll
                for (int m = 0; m < 4; ++m) { bf16* rowp = H + (size_t)(row0 + ai * 128 + m * 16) * NH + col0;
#pragma unroll
                    for (int bj = 0; bj < 2; ++bj) { f32x4 v0 = acc[ai][bj][m][0] + pre.bv[bj][0], v1 = acc[ai][bj][m][1] + pre.bv[bj][1];
                        if (act) { v0 = (f32x4){gelu_tanh(v0[0]), gelu_tanh(v0[1]), gelu_tanh(v0[2]), gelu_tanh(v0[3])}; v1 = (f32x4){gelu_tanh(v1[0]), gelu_tanh(v1[1]), gelu_tanh(v1[2]), gelu_tanh(v1[3])}; }
                        if (sg) {
                            u32x2 qb; qb.x = 0u; qb.y = 0u;
#pragma unroll
                            for (int j = 0; j < 4; ++j) { qb.x = __builtin_amdgcn_cvt_pk_u8_f32(sigmoidf_(v0[j]) * 256.0f - 0.5f, j, qb.x); qb.y = __builtin_amdgcn_cvt_pk_u8_f32(sigmoidf_(v1[j]) * 256.0f - 0.5f, j, qb.y); }
                            *(u32x2*)((unsigned char*)(H + (size_t)(row0 + ai * 128 + m * 16) * NH + HG) + (col0 + bj * 128 - HG)) = qb;
                        } else {
                        u32x4 w; w.x = pk2(v0[0], v0[1]); w.y = pk2(v0[2], v0[3]); w.z = pk2(v1[0], v1[1]); w.w = pk2(v1[2], v1[3]);
                        *(u32x4*)(rowp + bj * 128) = w; } } }
        } else if (wc == 0 && fq < 2) {
#pragma unroll
            for (int ai = 0; ai < 2; ++ai)
#pragma unroll
                for (int m = 0; m < 4; ++m) { float* rowp = GI + (size_t)(row0 + ai * 128 + m * 16) * 16 + 8 * fq;
#pragma unroll
                    for (int n = 0; n < 2; ++n) *(f32x4*)(rowp + 4 * n) = acc[ai][0][m][n] + pre.bv[0][n]; }
        }
    } };
struct SchedG2 { int G, c; const char* A; const char* B;
    __device__ __forceinline__ void a_off(const pg8::Unit&, int lda, const int (&Ri)[2], const int (&Ci)[2], unsigned (&v0)[2], unsigned (&v1)[2]) const {
#pragma unroll
        for (int i = 0; i < 2; ++i) { v0[i] = (unsigned)(Ri[i] * lda + Ci[i]) * 2u; v1[i] = v0[i] + (unsigned)(128 * lda * 2); } }
    __device__ __forceinline__ bool next(int i, pg8::Unit& u) const { int pm, pn; if (!pg8::tile_of(i, G, c, T / 256, D / 256, pm, pn)) return false;
        u.pm = pm; u.pn = pn; u.aux = 0; u.A = A + (size_t)pm * 256 * D * 2; u.B = B + (size_t)pn * 256 * D * 2; return true; } };
__device__ __forceinline__ void unq8(const u32x2 w, float (&o)[8]) {
    o[0] = ((float)(w.x & 255u) + 0.5f) * (1.0f / 256.0f); o[1] = ((float)((w.x >> 8) & 255u) + 0.5f) * (1.0f / 256.0f); o[2] = ((float)((w.x >> 16) & 255u) + 0.5f) * (1.0f / 256.0f); o[3] = ((float)(w.x >> 24) + 0.5f) * (1.0f / 256.0f);
    o[4] = ((float)(w.y & 255u) + 0.5f) * (1.0f / 256.0f); o[5] = ((float)((w.y >> 8) & 255u) + 0.5f) * (1.0f / 256.0f); o[6] = ((float)((w.y >> 16) & 255u) + 0.5f) * (1.0f / 256.0f); o[7] = ((float)(w.y >> 24) + 0.5f) * (1.0f / 256.0f); }
struct EpiG2 { static constexpr bool PERM = true, HOOK = true; struct Pre {}; __device__ __forceinline__ void prefetch(const pg8::Unit&, int, int, int, int, Pre&) const {} const bf16* H; bf16* MGB;
    __device__ __forceinline__ void hook(Acc& acc, const pg8::Unit& u, int n, int wr, int wc, int fr, int fq) const {
        const size_t rowb = (size_t)(u.pm * 256 + wr * 64 + fr); const int col0 = u.pn * 256 + wc * 32 + 8 * fq;
        const unsigned char* hp = (const unsigned char*)(H + rowb * NH + HG) + (n - 1) * D + col0;
        u32x2 ga[2][4][2], gb[2][4][2];
#pragma unroll
        for (int ai = 0; ai < 2; ++ai)
#pragma unroll
            for (int m = 0; m < 4; ++m)
#pragma unroll
                for (int bj = 0; bj < 2; ++bj) { const unsigned char* p = hp + (size_t)(ai * 128 + m * 16) * NH * 2 + bj * 128; ga[ai][m][bj] = *(const u32x2*)p; gb[ai][m][bj] = *(const u32x2*)(p + D); }
#pragma unroll
        for (int ai = 0; ai < 2; ++ai)
#pragma unroll
            for (int m = 0; m < 4; ++m)
#pragma unroll
                for (int bj = 0; bj < 2; ++bj) { float sa[8], sb[8]; unq8(ga[ai][m][bj], sa); unq8(gb[ai][m][bj], sb);
                    float r[8];
#pragma unroll
                    for (int j = 0; j < 8; ++j) r[j] = sa[j] * __builtin_amdgcn_rcpf(sb[j]);
                    acc[ai][bj][m][0] *= (f32x4){r[0], r[1], r[2], r[3]}; acc[ai][bj][m][1] *= (f32x4){r[4], r[5], r[6], r[7]}; }
        asm volatile("" ::: "memory");
    }
    __device__ __forceinline__ void operator()(const Acc& acc, const pg8::Unit& u, int wr, int wc, int fr, int fq, const Pre& pre) const {
        const size_t rowb = (size_t)(u.pm * 256 + wr * 64 + fr); const int col0 = u.pn * 256 + wc * 32 + 8 * fq;
        const unsigned char* hp = (const unsigned char*)(H + rowb * NH + HG) + 3 * D + col0; bf16* bp = MGB + rowb * D + col0;
        u32x2 gv[2][4][2];
#pragma unroll
        for (int ai = 0; ai < 2; ++ai)
#pragma unroll
            for (int m = 0; m < 4; ++m)
#pragma unroll
                for (int bj = 0; bj < 2; ++bj) gv[ai][m][bj] = *(const u32x2*)(hp + (size_t)(ai * 128 + m * 16) * NH * 2 + bj * 128);
#pragma unroll
        for (int ai = 0; ai < 2; ++ai)
#pragma unroll
            for (int m = 0; m < 4; ++m)
#pragma unroll
                for (int bj = 0; bj < 2; ++bj) { const int ro = ai * 128 + m * 16; float sv[8]; unq8(gv[ai][m][bj], sv);
                    const f32x4 a0 = acc[ai][bj][m][0], a1 = acc[ai][bj][m][1];
                    u32x4 w; w.x = pk2(a0[0] * sv[0], a0[1] * sv[1]); w.y = pk2(a0[2] * sv[2], a0[3] * sv[3]); w.z = pk2(a1[0] * sv[4], a1[1] * sv[5]); w.w = pk2(a1[2] * sv[6], a1[3] * sv[7]);
                    *(u32x4*)(bp + (size_t)ro * D + bj * 128) = w; }
    } };
struct SchedG3 { int G, c; const char* A; const char* B;
    __device__ __forceinline__ void a_off(const pg8::Unit&, int lda, const int (&Ri)[2], const int (&Ci)[2], unsigned (&v0)[2], unsigned (&v1)[2]) const {
#pragma unroll
        for (int i = 0; i < 2; ++i) { v0[i] = (unsigned)(Ri[i] * lda + Ci[i]) * 2u; v1[i] = v0[i] + (unsigned)(128 * lda * 2); } }
    __device__ __forceinline__ bool next(int i, pg8::Unit& u) const { int pm, pn; if (!pg8::tile_of(i, G, c, T / 256, D / 256, pm, pn)) return false;
        u.pm = pm; u.pn = pn; u.aux = 0; u.A = A + (size_t)pm * 256 * D * 2; u.B = B + (size_t)pn * 256 * D * 2; return true; } };
struct EpiG3 { static constexpr bool PERM = true, HOOK = false; struct Pre {}; __device__ __forceinline__ void prefetch(const pg8::Unit&, int, int, int, int, Pre&) const {} const bf16* XB; bf16* R; float* STAT;
    __device__ __forceinline__ void operator()(const Acc& acc, const pg8::Unit& u, int wr, int wc, int fr, int fq, const Pre& pre) const {
        const int row0 = u.pm * 256 + wr * 64 + fr, col0 = u.pn * 256 + wc * 32 + 8 * fq, lane = fq * 16 + fr;
#pragma unroll
        for (int ai = 0; ai < 2; ++ai) { u32x4 xr[4][2];
#pragma unroll
            for (int m = 0; m < 4; ++m)
#pragma unroll
                for (int bj = 0; bj < 2; ++bj) xr[m][bj] = *(const u32x4*)(XB + (size_t)(row0 + ai * 128 + m * 16) * D + col0 + bj * 128);
#pragma unroll
            for (int m = 0; m < 4; ++m) { const size_t row = (size_t)(row0 + ai * 128 + m * 16); float s1 = 0.f, s2 = 0.f;
#pragma unroll
                for (int bj = 0; bj < 2; ++bj) { const size_t o = row * D + col0 + bj * 128; float x8[8]; unpack8(xr[m][bj], x8);
                    const f32x4 r0 = (f32x4){x8[0], x8[1], x8[2], x8[3]} * ALPHA + acc[ai][bj][m][0], r1 = (f32x4){x8[4], x8[5], x8[6], x8[7]} * ALPHA + acc[ai][bj][m][1];
                    { u32x4 w; w.x = pk2(r0[0], r0[1]); w.y = pk2(r0[2], r0[3]); w.z = pk2(r1[0], r1[1]); w.w = pk2(r1[2], r1[3]); *(u32x4*)(R + o) = w; }
                    s1 += ((r0[0] + r0[1]) + (r0[2] + r0[3])) + ((r1[0] + r1[1]) + (r1[2] + r1[3]));
                    s2 += ((r0[0] * r0[0] + r0[1] * r0[1]) + (r0[2] * r0[2] + r0[3] * r0[3])) + ((r1[0] * r1[0] + r1[1] * r1[1]) + (r1[2] * r1[2] + r1[3] * r1[3])); }
                s1 += shx(s1, 16, lane); s1 += shx(s1, 32, lane); s2 += shx(s2, 16, lane); s2 += shx(s2, 32, lane);
                if (fq == 0) *(f32x2*)(STAT + (row * 16 + u.pn * 4 + wc) * 2) = (f32x2){s1, s2}; } }
    } };
struct SchedG4 { int G, c; const char* A; const char* B; const int* IDX;
    __device__ __forceinline__ bool next(int i, pg8::Unit& u) const { int pm, pn; if (!pg8::tile_of(i, G, c, NSLOT / 256, 2048 / 256, pm, pn)) return false; const int e = (pm >> 2) & 15;
        u.pm = pm; u.pn = pn; u.aux = e; u.A = A + (size_t)(pm >> 6) * SEQ * D * 2; u.B = B + (size_t)e * 2048 * D * 2 + (size_t)pn * 256 * D * 2; return true; }
    __device__ __forceinline__ void a_off(const pg8::Unit& u, int lda, const int (&Ri)[2], const int (&Ci)[2], unsigned (&v0)[2], unsigned (&v1)[2]) const {
#pragma unroll
        for (int i = 0; i < 2; ++i) { const int r0 = IDX[u.pm * 256 + Ri[i]], r1 = IDX[u.pm * 256 + 128 + Ri[i]]; v0[i] = (unsigned)(r0 * lda + Ci[i]) * 2u; v1[i] = (unsigned)(r1 * lda + Ci[i]) * 2u; } } };
struct EpiG4 { static constexpr bool PERM = true, HOOK = false; struct Pre {}; __device__ __forceinline__ void prefetch(const pg8::Unit&, int, int, int, int, Pre&) const {} bf16* HID;
    __device__ __forceinline__ void operator()(const Acc& acc, const pg8::Unit& u, int wr, int wc, int fr, int fq, const Pre& pre) const {
        const int row0 = u.pm * 256 + wr * 64 + fr, col0 = u.pn * 128 + wc * 32 + 8 * fq;
#pragma unroll
        for (int ai = 0; ai < 2; ++ai)
#pragma unroll
            for (int m = 0; m < 4; ++m) { const size_t row = (size_t)(row0 + ai * 128 + m * 16);
                const f32x4 a0 = acc[ai][0][m][0], a1 = acc[ai][0][m][1], g0 = acc[ai][1][m][0], g1 = acc[ai][1][m][1];
                u32x4 w; w.x = pk2(siluf_(a0[0]) * g0[0], siluf_(a0[1]) * g0[1]); w.y = pk2(siluf_(a0[2]) * g0[2], siluf_(a0[3]) * g0[3]);
                w.z = pk2(siluf_(a1[0]) * g1[0], siluf_(a1[1]) * g1[1]); w.w = pk2(siluf_(a1[2]) * g1[2], siluf_(a1[3]) * g1[3]);
                *(u32x4*)(HID + row * FF + col0) = w; }
    } };
struct SchedG5 { int G, c; const char* A; const char* B;
    __device__ __forceinline__ void a_off(const pg8::Unit&, int lda, const int (&Ri)[2], const int (&Ci)[2], unsigned (&v0)[2], unsigned (&v1)[2]) const {
#pragma unroll
        for (int i = 0; i < 2; ++i) { v0[i] = (unsigned)(Ri[i] * lda + Ci[i]) * 2u; v1[i] = v0[i] + (unsigned)(128 * lda * 2); } }
    __device__ __forceinline__ bool next(int i, pg8::Unit& u) const { int pm, pn; if (!pg8::tile_of(i, G, c, NSLOT / 256, D / 256, pm, pn)) return false; const int e = (pm >> 2) & 15;
        u.pm = pm; u.pn = pn; u.aux = e; u.A = A + (size_t)pm * 256 * FF * 2; u.B = B + (size_t)e * D * FF * 2 + (size_t)pn * 256 * FF * 2; return true; } };
struct EpiG5 { static constexpr bool PERM = true, HOOK = false; const float* GATE; bf16* YE;
    struct Pre { float g[2][4]; };
    __device__ __forceinline__ void prefetch(const pg8::Unit& u, int wr, int wc, int fr, int fq, Pre& p) const { const int row0 = u.pm * 256 + wr * 64 + fr;
#pragma unroll
        for (int ai = 0; ai < 2; ++ai)
#pragma unroll
            for (int m = 0; m < 4; ++m) p.g[ai][m] = GATE[row0 + ai * 128 + m * 16]; }
    __device__ __forceinline__ void operator()(const Acc& acc, const pg8::Unit& u, int wr, int wc, int fr, int fq, const Pre& pre) const {
        const int row0 = u.pm * 256 + wr * 64 + fr, col0 = u.pn * 256 + wc * 32 + 8 * fq;
#pragma unroll
        for (int ai = 0; ai < 2; ++ai)
#pragma unroll
            for (int m = 0; m < 4; ++m) { const size_t row = (size_t)(row0 + ai * 128 + m * 16); const float gt = pre.g[ai][m];
#pragma unroll
                for (int bj = 0; bj < 2; ++bj) { const f32x4 v0 = acc[ai][bj][m][0] * gt, v1 = acc[ai][bj][m][1] * gt;
                    u32x4 w; w.x = pk2(v0[0], v0[1]); w.y = pk2(v0[2], v0[3]); w.z = pk2(v1[0], v1[1]); w.w = pk2(v1[2], v1[3]);
                    *(u32x4*)(YE + row * D + col0 + bj * 128) = w; } }
    } };

typedef float f32x16 __attribute__((ext_vector_type(16)));
typedef short s16x4 __attribute__((ext_vector_type(4)));
typedef __bf16 bf16x2_t __attribute__((ext_vector_type(2)));
#define MFMA32(a, b, c) __builtin_amdgcn_mfma_f32_32x32x16_bf16((a), (b), (c), 0, 0, 0)
__device__ __forceinline__ int crow(int reg, int h) { return (reg & 3) + 8 * (reg >> 2) + 4 * h; }
__device__ __forceinline__ unsigned cvtpk(float lo, float hi) { f32x2 v = {lo, hi}; bf16x2_t b = __builtin_convertvector(v, bf16x2_t); return __builtin_bit_cast(unsigned, b); }
__device__ __forceinline__ bf16x8 pack8(float a0, float a1, float a2, float a3, float a4, float a5, float a6, float a7) {
    u32x4 p; p.x = cvtpk(a0, a1); p.y = cvtpk(a2, a3); p.z = cvtpk(a4, a5); p.w = cvtpk(a6, a7); return __builtin_bit_cast(bf16x8, p); }
typedef short v4i16_t __attribute__((ext_vector_type(4)));
__device__ __forceinline__ s16x4 tr_rd(const LAS unsigned char* p) { return __builtin_bit_cast(s16x4, __builtin_amdgcn_ds_read_tr16_b64_v4i16((LAS v4i16_t*)p)); }
__device__ __forceinline__ bf16x8 tr_frag(const LAS unsigned char* img, int pitch, int k0, int k1, int col0, int lane) {
    const int i16 = lane & 15, qd = i16 >> 2, p = i16 & 3, blk = (lane >> 4) & 1;
    const s16x4 lo = tr_rd(img + (k0 + qd) * pitch + (col0 + 16 * blk + 4 * p) * 2), hi = tr_rd(img + (k1 + qd) * pitch + (col0 + 16 * blk + 4 * p) * 2);
    return __builtin_shufflevector(lo, hi, 0, 1, 2, 3, 4, 5, 6, 7); }
constexpr int C1_ITEM_LDS = 3 * 64 * 144 + 2048;
__device__ __forceinline__ void mlstm_c1m(int l, int bi) {
    FRAME_SETUP; WS_PTRS; const float* ml_conv = inp(I_MLCONV); const float* ml_fbias = inp(I_MLFB);
    const int tid = F.tid, lane = F.lane, w = F.wave, dir = w & 1, jj = w >> 1, tp = tid & 127;
    const int item = bi * 4 + jj, c = item & 127, h = (item >> 7) & 3, b = item >> 9;
    const int p0 = b * SEQ + c * 64, hc = h * 64;
    LAS unsigned char* base = F.lds + jj * C1_ITEM_LDS;
    LAS unsigned char* Vt = base; LAS unsigned char* K0 = base + 64 * 144; LAS unsigned char* K1 = base + 2 * 64 * 144; LAS float* wT = (LAS float*)(base + 3 * 64 * 144);
    const int chain = ((dir * 2 + b) * 4 + h) * 128 + c; bf16* dc = DC + (size_t)chain * 4160;
    u32x4 cq[4][3], ck[4][3], cv[4]; bool rok[4][3];
    const int cg = (tp & 7) * 8, r0 = tp >> 3;
#pragma unroll
    for (int i = 0; i < 4; ++i) { const int row = r0 + 16 * i, sq = c * 64 + row;
#pragma unroll
        for (int dr = 0; dr < 3; ++dr) { rok[i][dr] = (sq + dr - 1 >= 0) && (sq + dr - 1 < SEQ); const int sc = min(max(sq + dr - 1, 0), SEQ - 1); const bf16* r2 = H + (size_t)(b * SEQ + sc) * NH;
            cq[i][dr] = *(const u32x4*)(r2 + HCQ + hc + cg); ck[i][dr] = *(const u32x4*)(r2 + HCK + hc + cg); }
        cv[i] = *(const u32x4*)(H + (size_t)(p0 + row) * NH + HCV + hc + cg); }
    f32x4 cwq[3][2], cwk[3][2];
    { const float* cw = ml_conv + (size_t)l * 3 * 512;
#pragma unroll
      for (int dr = 0; dr < 3; ++dr) { cwq[dr][0] = *(const f32x4*)(cw + dr * 512 + hc + cg); cwq[dr][1] = *(const f32x4*)(cw + dr * 512 + hc + cg + 4); cwk[dr][0] = *(const f32x4*)(cw + dr * 512 + 256 + hc + cg); cwk[dr][1] = *(const f32x4*)(cw + dr * 512 + 256 + hc + cg + 4); } }
    { const float* gi = GI + (size_t)(p0 + lane) * 16; const float li = gi[dir * 4 + h]; float cum = logsigmoidf_(gi[8 + dir * 4 + h] + ml_fbias[l * 8 + dir * 4 + h]);
#pragma unroll
        for (int off = 1; off < 64; off <<= 1) { const int src = dir ? lane + off : lane - off; const float v = __int_as_float(__builtin_amdgcn_ds_bpermute((src & 63) << 2, __float_as_int(cum))); if (src >= 0 && src < 64) cum += v; }
        const float g = __int_as_float(__builtin_amdgcn_ds_bpermute((dir ? 0 : 63) << 2, __float_as_int(cum)));
        wT[dir * 64 + lane] = __expf(g - cum + li); if (lane == 0) DG[chain] = g; }
    __syncthreads();
    {
#pragma unroll
        for (int i = 0; i < 4; ++i) { const int row = r0 + 16 * i; const float w0 = wT[row], w1 = wT[64 + row];
            float qv[8], kv[8];
#pragma unroll
            for (int j = 0; j < 8; ++j) { qv[j] = 0.f; kv[j] = 0.f; }
#pragma unroll
            for (int dr = 0; dr < 3; ++dr) { const float m = rok[i][dr] ? 1.f : 0.f; float q8[8], k8[8]; unpack8(cq[i][dr], q8); unpack8(ck[i][dr], k8);
#pragma unroll
                for (int j = 0; j < 8; ++j) { qv[j] += m * cwq[dr][j >> 2][j & 3] * q8[j]; kv[j] += m * cwk[dr][j >> 2][j & 3] * k8[j]; } }
#pragma unroll
            for (int j = 0; j < 8; ++j) { qv[j] = siluf_(qv[j]); kv[j] = siluf_(kv[j]) * 0.125f; }
            u32x4 wq, wk, wk0, wk1; wq.x = pk2(qv[0], qv[1]); wq.y = pk2(qv[2], qv[3]); wq.z = pk2(qv[4], qv[5]); wq.w = pk2(qv[6], qv[7]); wk.x = pk2(kv[0], kv[1]); wk.y = pk2(kv[2], kv[3]); wk.z = pk2(kv[4], kv[5]); wk.w = pk2(kv[6], kv[7]);
            wk0.x = pk2(kv[0] * w0, kv[1] * w0); wk0.y = pk2(kv[2] * w0, kv[3] * w0); wk0.z = pk2(kv[4] * w0, kv[5] * w0); wk0.w = pk2(kv[6] * w0, kv[7] * w0);
            wk1.x = pk2(kv[0] * w1, kv[1] * w1); wk1.y = pk2(kv[2] * w1, kv[3] * w1); wk1.z = pk2(kv[4] * w1, kv[5] * w1); wk1.w = pk2(kv[6] * w1, kv[7] * w1);
            *(u32x4*)(QC + (size_t)(p0 + row) * 256 + hc + cg) = wq; *(u32x4*)(KC + (size_t)(p0 + row) * 256 + hc + cg) = wk;
            *(LAS u32x4*)(K0 + row * 144 + cg * 2) = wk0; *(LAS u32x4*)(K1 + row * 144 + cg * 2) = wk1; *(LAS u32x4*)(Vt + row * 144 + cg * 2) = cv[i]; }
    }
    __syncthreads();
    {
        const int tl = lane & 31, hh = lane >> 5; const LAS unsigned char* Kimg = dir ? K1 : K0;
#pragma unroll
        for (int kt = 0; kt < 2; ++kt) { bf16x8 kf[4]; float dn = 0.f;
#pragma unroll
            for (int ks = 0; ks < 4; ++ks) { kf[ks] = tr_frag(Kimg, 144, 16 * ks + 8 * hh, 16 * ks + 8 * hh + 4, 32 * kt, lane); float k8[8]; unpack8(__builtin_bit_cast(u32x4, kf[ks]), k8);
#pragma unroll
                for (int j = 0; j < 8; ++j) dn += k8[j]; }
            dn += shx(dn, 32, lane); if (hh == 0) dc[4096 + 32 * kt + tl] = (bf16)f2bf(dn);
#pragma unroll
            for (int vt = 0; vt < 2; ++vt) { f32x16 acc;
#pragma unroll
                for (int i = 0; i < 16; ++i) acc[i] = F.zf;
#pragma unroll
                for (int ks = 0; ks < 4; ++ks) { const bf16x8 vf = tr_frag(Vt, 144, 16 * ks + 8 * hh, 16 * ks + 8 * hh + 4, 32 * vt, lane); acc = MFMA32(kf[ks], vf, acc); }
#pragma unroll
                for (int g4 = 0; g4 < 4; ++g4) { u32x2 wv; wv.x = pk2(acc[4 * g4], acc[4 * g4 + 1]); wv.y = pk2(acc[4 * g4 + 2], acc[4 * g4 + 3]); *(u32x2*)(dc + (32 * vt + tl) * 64 + 32 * kt + 8 * g4 + 4 * hh) = wv; } } }
    }
    __syncthreads();
}
constexpr int GM_PITCH = 576;
__device__ __forceinline__ void gmlp_m(int l, int item) {
    FRAME_SETUP; WS_PTRS; const float* gm_ln_g = inp(I_GMLNG); const float* gm_bs = inp(I_GMBS); const bf16* WSB = (const bf16*)(ws + WS_WSB);
    const int tid = F.tid, lane = F.lane, w = F.wave;
    const int b = item >> 6, ch = item & 63, p0 = b * SEQ + ch * 128;
    LAS unsigned char* vn = F.lds;
    {
        const int part = tid & 7; const float* lgp = gm_ln_g + l * 256;
        u32x4 raw[2][4];
#pragma unroll
        for (int rr = 0; rr < 2; ++rr)
#pragma unroll
            for (int q = 0; q < 4; ++q) raw[rr][q] = *(const u32x4*)(H + (size_t)(p0 + (tid >> 3) + 64 * rr) * NH + HV + (part + 8 * q) * 8);
#pragma unroll
        for (int rr = 0; rr < 2; ++rr) { const int row = (tid >> 3) + 64 * rr; float s = 0.f, s2 = 0.f;
#pragma unroll
            for (int q = 0; q < 4; ++q) { float v8[8]; unpack8(raw[rr][q], v8);
#pragma unroll
                for (int j = 0; j < 8; ++j) { s += v8[j]; s2 += v8[j] * v8[j]; } }
            s += shx(s, 1, lane); s += shx(s, 2, lane); s += shx(s, 4, lane); s2 += shx(s2, 1, lane); s2 += shx(s2, 2, lane); s2 += shx(s2, 4, lane);
            const float mean = s * (1.0f / 256.0f), var = fmaxf(s2 * (1.0f / 256.0f) - mean * mean, 0.f), rstd = 1.0f / sqrtf(var + LN_EPS);
#pragma unroll
            for (int q = 0; q < 4; ++q) { const int c0 = (part + 8 * q) * 8; float v8[8]; unpack8(raw[rr][q], v8); const f32x4 g0 = *(const f32x4*)(lgp + c0), g1 = *(const f32x4*)(lgp + c0 + 4);
                u32x4 o; o.x = pk2((v8[0] - mean) * rstd * g0[0], (v8[1] - mean) * rstd * g0[1]); o.y = pk2((v8[2] - mean) * rstd * g0[2], (v8[3] - mean) * rstd * g0[3]);
                o.z = pk2((v8[4] - mean) * rstd * g1[0], (v8[5] - mean) * rstd * g1[1]); o.w = pk2((v8[6] - mean) * rstd * g1[2], (v8[7] - mean) * rstd * g1[3]);
                *(LAS u32x4*)(vn + row * GM_PITCH + c0 * 2) = o; } }
    }
    __syncthreads();
    {
        const int g = w >> 1, ph = w & 1, tl = lane & 31, hh = lane >> 5;
#pragma unroll 1
        for (int pt = 0; pt < 2; ++pt) { const int p = 64 * ph + 32 * pt + tl; const size_t tok = (size_t)p0 + p;
            f32x16 M[2];
#pragma unroll
            for (int dt = 0; dt < 2; ++dt)
#pragma unroll
                for (int i = 0; i < 16; ++i) M[dt][i] = F.zf;
            const bf16* wrow = WSB + ((size_t)(l * 4 + g) * 128 + p) * 128 + 8 * hh;
#pragma unroll
            for (int ks = 0; ks < 8; ++ks) { const bf16x8 wf = *(const bf16x8*)(wrow + 16 * ks);
#pragma unroll
                for (int dt = 0; dt < 2; ++dt) { const bf16x8 vf = tr_frag(vn, GM_PITCH, 16 * ks + 8 * hh, 16 * ks + 8 * hh + 4, g * 64 + 32 * dt, lane); M[dt] = MFMA32(vf, wf, M[dt]); } }
            const float bsv = gm_bs[(size_t)(l * 4 + g) * 128 + p];
#pragma unroll
            for (int dt = 0; dt < 2; ++dt)
#pragma unroll
                for (int gg = 0; gg < 4; ++gg) { const int d = g * 64 + 32 * dt + 8 * gg + 4 * hh; const u32x2 uw = *(const u32x2*)(H + tok * NH + HU + d);
                    const float u0 = __uint_as_float(uw.x << 16), u1 = __uint_as_float(uw.x & 0xffff0000u), u2 = __uint_as_float(uw.y << 16), u3 = __uint_as_float(uw.y & 0xffff0000u);
                    u32x2 o; o.x = pk2(u0 * (M[dt][4 * gg] + bsv), u1 * (M[dt][4 * gg + 1] + bsv)); o.y = pk2(u2 * (M[dt][4 * gg + 2] + bsv), u3 * (M[dt][4 * gg + 3] + bsv));
                    *(u32x2*)(YS + tok * D + d) = o; } }
    }
    __syncthreads();
}
__device__ __forceinline__ void mlstm_scan(int wi) {
    FRAME_SETUP;
    WS_PTRS;
    const int lane = F.lane, chain = wi / 17, quad = (wi % 17) * 64 + lane, dir = chain >> 3, base = chain * 128;
    const bool on = quad < 1040;
    const int e = on ? 4 * quad : 0;
    const float d0 = __expf(DG[base + (dir ? 127 - lane : lane)]), d1 = __expf(DG[base + (dir ? 63 - lane : 64 + lane)]);
    f32x4 S = {0.f, 0.f, 0.f, 0.f};
#pragma unroll 1
    for (int i0 = 0; i0 < 128; i0 += 32) {
        u32x2 tmp[32];
#pragma unroll
        for (int j = 0; j < 32; ++j) { const int c = dir ? 127 - (i0 + j) : (i0 + j); tmp[j] = *(const u32x2*)(DC + (size_t)(base + c) * 4160 + e); }
#pragma unroll
        for (int j = 0; j < 32; ++j) { const int c = dir ? 127 - (i0 + j) : (i0 + j);
            const float dec = (i0 < 64) ? __int_as_float(__builtin_amdgcn_readlane(__float_as_int(d0), (i0 & 63) + j)) : __int_as_float(__builtin_amdgcn_readlane(__float_as_int(d1), (i0 & 63) + j));
            if (on) { u32x2 wv; wv.x = pk2(S[0], S[1]); wv.y = pk2(S[2], S[3]); *(u32x2*)(DC + (size_t)(base + c) * 4160 + e) = wv; }
            const f32x4 t = (f32x4){__uint_as_float(tmp[j].x << 16), __uint_as_float(tmp[j].x & 0xffff0000u), __uint_as_float(tmp[j].y << 16), __uint_as_float(tmp[j].y & 0xffff0000u)};
            S = S * dec + t; }
    }
}
constexpr int C3_ITEM_LDS = 20480, C3_PITCH = 144;
__device__ __forceinline__ void mlstm_c3m(int l, int bi) {
    FRAME_SETUP; WS_PTRS; const float* ml_fbias = inp(I_MLFB); const float* ml_norm_g = inp(I_MLNG);
    const int tid = F.tid, lane = F.lane, w = F.wave, dir = w & 1, jj = w >> 1, tp = tid & 127;
    const int item = bi * 4 + jj, c = item & 127, h = (item >> 7) & 3, b = item >> 9;
    const int p0 = b * SEQ + c * 64, hc = h * 64;
    LAS unsigned char* base = F.lds + jj * C3_ITEM_LDS;
    LAS unsigned char* Kt = base; LAS unsigned char* Vt = base + 64 * C3_PITCH;
    LAS float* tab = (LAS float*)(base + 2 * 64 * C3_PITCH);
    LAS float* cumT = tab + dir * 64; LAS float* liT = tab + 128 + dir * 64; LAS float* nsT = tab + 256 + dir * 64;
    LAS float* hbuf = (LAS float*)base;
    const int chain = ((dir * 2 + b) * 4 + h) * 128 + c; const bf16* dc = DC + (size_t)chain * 4160;
    { u32x4 k8[4], v8[4];
#pragma unroll
        for (int u = 0; u < 4; ++u) { const int i = tp + 128 * u, row = i >> 3, cg = (i & 7) * 8; k8[u] = *(const u32x4*)(KC + (size_t)(p0 + row) * 256 + hc + cg); v8[u] = *(const u32x4*)(H + (size_t)(p0 + row) * NH + HCV + hc + cg); }
#pragma unroll
        for (int u = 0; u < 4; ++u) { const int i = tp + 128 * u, row = i >> 3, cg = (i & 7) * 8; *(LAS u32x4*)(Kt + row * C3_PITCH + cg * 2) = k8[u]; *(LAS u32x4*)(Vt + row * C3_PITCH + cg * 2) = v8[u]; } }
    { const float* gi = GI + (size_t)(p0 + lane) * 16; const float li = gi[dir * 4 + h]; float cum = logsigmoidf_(gi[8 + dir * 4 + h] + ml_fbias[l * 8 + dir * 4 + h]);
#pragma unroll
        for (int off = 1; off < 64; off <<= 1) { const int src = dir ? lane + off : lane - off; const float v = __int_as_float(__builtin_amdgcn_ds_bpermute((src & 63) << 2, __float_as_int(cum))); if (src >= 0 && src < 64) cum += v; }
        cumT[lane] = cum; liT[lane] = li - cum; nsT[lane] = bf2f(dc[4096 + lane]); }
    __syncthreads();
    const int tl = lane & 31, hh = lane >> 5;
    f32x16 Hh[2][2];
#pragma unroll
    for (int tt = 0; tt < 2; ++tt) {
        const int t = 32 * tt + tl; const size_t tok = (size_t)p0 + t;
        const float ct = cumT[t], ewt = __expf(ct);
        bf16x8 qf[4], qf2[4]; float nqp = 0.f;
#pragma unroll
        for (int ks = 0; ks < 4; ++ks) { const u32x4 raw = *(const u32x4*)(QC + tok * 256 + hc + 16 * ks + 8 * hh); qf[ks] = __builtin_bit_cast(bf16x8, raw);
            float q8[8]; unpack8(raw, q8);
#pragma unroll
            for (int j = 0; j < 8; ++j) { q8[j] *= ewt; nqp += nsT[16 * ks + 8 * hh + j] * q8[j]; }
            qf2[ks] = pack8(q8[0], q8[1], q8[2], q8[3], q8[4], q8[5], q8[6], q8[7]); }
        f32x16 S[2]; float denp = 0.f;
#pragma unroll
        for (int st = 0; st < 2; ++st) {
#pragma unroll
            for (int i = 0; i < 16; ++i) S[st][i] = F.zf;
#pragma unroll
            for (int ks = 0; ks < 4; ++ks) { const bf16x8 kf = *(const LAS bf16x8*)(Kt + (32 * st + tl) * C3_PITCH + (16 * ks + 8 * hh) * 2); S[st] = MFMA32(kf, qf[ks], S[st]); }
#pragma unroll
            for (int i = 0; i < 16; ++i) { const int sidx = 32 * st + crow(i, hh); const bool valid = dir ? (sidx >= t) : (sidx <= t);
                const float arg = ct + liT[sidx]; const float wgt = __expf(valid ? arg : -1e30f); const float pv = S[st][i] * wgt; S[st][i] = pv; denp += pv; }
            __builtin_amdgcn_sched_barrier(0); }
        const float dn = (denp + shx(denp, 32, lane)) + (nqp + shx(nqp, 32, lane));
        const float inv = 1.0f / fmaxf(fabsf(dn), 1.0f);
#pragma unroll
        for (int vt = 0; vt < 2; ++vt) { f32x16 N;
#pragma unroll
            for (int i = 0; i < 16; ++i) N[i] = F.zf;
#pragma unroll
            for (int st = 0; st < 2; ++st)
#pragma unroll
                for (int s2 = 0; s2 < 2; ++s2) { const bf16x8 pf = pack8(S[st][8 * s2], S[st][8 * s2 + 1], S[st][8 * s2 + 2], S[st][8 * s2 + 3], S[st][8 * s2 + 4], S[st][8 * s2 + 5], S[st][8 * s2 + 6], S[st][8 * s2 + 7]);
                    const int k0 = 32 * st + 16 * s2 + 4 * hh; const bf16x8 vf = tr_frag(Vt, C3_PITCH, k0, k0 + 8, 32 * vt, lane); N = MFMA32(vf, pf, N); }
#pragma unroll
            for (int ks = 0; ks < 4; ++ks) { const bf16x8 cf = *(const bf16x8*)(dc + (32 * vt + tl) * 64 + 16 * ks + 8 * hh); N = MFMA32(cf, qf2[ks], N); }
#pragma unroll
            for (int i = 0; i < 16; ++i) Hh[tt][vt][i] = N[i] * inv; }
    }
    __syncthreads();
    if (dir == 1) {
#pragma unroll
        for (int tt = 0; tt < 2; ++tt)
#pragma unroll
            for (int vt = 0; vt < 2; ++vt)
#pragma unroll
                for (int i = 0; i < 16; ++i) hbuf[(32 * tt + tl) * 65 + 32 * vt + crow(i, hh)] = Hh[tt][vt][i]; }
    __syncthreads();
    if (dir == 0) {
#pragma unroll
        for (int tt = 0; tt < 2; ++tt) { const int t = 32 * tt + tl; const size_t tok = (size_t)p0 + t; float s1 = 0.f;
#pragma unroll
            for (int vt = 0; vt < 2; ++vt)
#pragma unroll
                for (int i = 0; i < 16; ++i) { const float x = Hh[tt][vt][i] + hbuf[t * 65 + 32 * vt + crow(i, hh)]; Hh[tt][vt][i] = x; s1 += x; }
            const float mu = (s1 + shx(s1, 32, lane)) * (1.0f / 64.0f); float s2 = 0.f;
#pragma unroll
            for (int vt = 0; vt < 2; ++vt)
#pragma unroll
                for (int i = 0; i < 16; ++i) { const float dv = Hh[tt][vt][i] - mu; s2 += dv * dv; }
            const float rstd = 1.0f / sqrtf((s2 + shx(s2, 32, lane)) * (1.0f / 64.0f) + LN_EPS);
#pragma unroll
            for (int vt = 0; vt < 2; ++vt)
#pragma unroll
                for (int g = 0; g < 4; ++g) { const int v = 32 * vt + 8 * g + 4 * hh;
                    const u32x2 cw = *(const u32x2*)(H + tok * NH + HCO + hc + v); const f32x4 ng = *(const f32x4*)(ml_norm_g + l * 256 + hc + v);
                    const float o0 = __uint_as_float(cw.x << 16), o1 = __uint_as_float(cw.x & 0xffff0000u), o2 = __uint_as_float(cw.y << 16), o3 = __uint_as_float(cw.y & 0xffff0000u);
                    u32x2 wv; wv.x = pk2((Hh[tt][vt][4 * g] - mu) * rstd * ng[0] * sigmoidf_(o0), (Hh[tt][vt][4 * g + 1] - mu) * rstd * ng[1] * sigmoidf_(o1));
                    wv.y = pk2((Hh[tt][vt][4 * g + 2] - mu) * rstd * ng[2] * sigmoidf_(o2), (Hh[tt][vt][4 * g + 3] - mu) * rstd * ng[3] * sigmoidf_(o3));
                    *(u32x2*)(YS + tok * D + 512 + hc + v) = wv; } }
    }
    __syncthreads();
}
__device__ __forceinline__ void pool_m(int l, int witem) {
    FRAME_SETUP; WS_PTRS; const float* pool_scale = inp(I_POOLS); const bf16* PWT = (const bf16*)(ws + WS_PWT);
    const int lane = F.lane, tl = lane & 31, hh = lane >> 5;
    const int g = witem & 3, tb = witem >> 2, tok0 = tb * 32, b = tok0 >> 13, s = (tok0 & (SEQ - 1)) + tl, half = 1 << g, W = 2 * half;
    const int lo = max(s - half, 0), hi = min(s + half, SEQ); const float inv = 1.0f / (float)(hi - lo);
    const bf16* hb = H + (size_t)b * SEQ * NH + HDX + g * 64 + 8 * hh;
    const size_t tok = (size_t)tok0 + tl;
    f32x16 acc[2];
#pragma unroll
    for (int ot = 0; ot < 2; ++ot)
#pragma unroll
        for (int i = 0; i < 16; ++i) acc[ot][i] = F.zf;
#pragma unroll 1
    for (int ks = 0; ks < 4; ++ks) { float a8[8];
#pragma unroll
        for (int q = 0; q < 8; ++q) a8[q] = 0.f;
#pragma unroll 1
        for (int j0 = 0; j0 < W; j0 += 4) { u32x4 raw[4];
#pragma unroll
            for (int j = 0; j < 4; ++j) { const int sp = min(max(s - half + j0 + j, 0), SEQ - 1); raw[j] = *(const u32x4*)(hb + (size_t)sp * NH + 16 * ks); }
#pragma unroll
            for (int j = 0; j < 4; ++j) { const int sp = s - half + j0 + j; const float m = (j0 + j < W && sp >= 0 && sp < SEQ) ? 1.f : 0.f; float v8[8]; unpack8(raw[j], v8);
#pragma unroll
                for (int q = 0; q < 8; ++q) a8[q] += m * v8[q]; } }
        float x8[8]; unpack8(*(const u32x4*)(hb + (size_t)s * NH + 16 * ks), x8);
        const bf16x8 pf = pack8(a8[0] * inv - x8[0], a8[1] * inv - x8[1], a8[2] * inv - x8[2], a8[3] * inv - x8[3], a8[4] * inv - x8[4], a8[5] * inv - x8[5], a8[6] * inv - x8[6], a8[7] * inv - x8[7]);
#pragma unroll
        for (int ot = 0; ot < 2; ++ot) { const bf16x8 wf = *(const bf16x8*)(PWT + ((size_t)(l * 4 + g) * 64 + 32 * ot + tl) * 64 + 16 * ks + 8 * hh); acc[ot] = MFMA32(wf, pf, acc[ot]); } }
#pragma unroll
    for (int ot = 0; ot < 2; ++ot)
#pragma unroll
        for (int gg = 0; gg < 4; ++gg) { const int o = g * 64 + 32 * ot + 8 * gg + 4 * hh; const f32x4 sc = *(const f32x4*)(pool_scale + l * 256 + o);
            u32x2 w; w.x = pk2(acc[ot][4 * gg] * sc[0], acc[ot][4 * gg + 1] * sc[1]); w.y = pk2(acc[ot][4 * gg + 2] * sc[2], acc[ot][4 * gg + 3] * sc[3]);
            *(u32x2*)(YS + tok * D + 768 + o) = w; }
}
constexpr int ATT_PITCH = 144;
__device__ __forceinline__ void att2_item(int item) {
    FRAME_SETUP;
    WS_PTRS; const float* rel_bias = inp(I_RELB);
    const int tid = F.tid, lane = F.lane, w = F.wave;
    const int pat = item >> 8, idx = item & 255, dil = 1 << (2 * pat), L = SEQ / dil, nqb = L >> 8;
    const int jr = idx & 31, h = (idx >> 5) & 3, b = idx >> 7, r = jr / nqb, Q0 = (jr % nqb) * 256;
    LAS unsigned char* Kt = F.lds; LAS unsigned char* Vt = F.lds + 384 * ATT_PITCH; LAS float* bt = (LAS float*)(F.lds + 2 * 384 * ATT_PITCH);
    { u32x4 k8[6], v8[6];
#pragma unroll
        for (int u = 0; u < 6; ++u) { const int i = tid + u * NTHREADS, kk = i >> 3, cg = (i & 7) * 8, kidx = min(max(Q0 - 64 + kk, 0), L - 1);
            const bf16* row = H + (size_t)(b * SEQ + r + dil * kidx) * NH; k8[u] = *(const u32x4*)(row + HAK + h * 64 + cg); v8[u] = *(const u32x4*)(row + HAV + h * 64 + cg); }
#pragma unroll
        for (int u = 0; u < 6; ++u) { const int i = tid + u * NTHREADS, kk = i >> 3, cg = (i & 7) * 8;
            *(LAS u32x4*)(Kt + kk * ATT_PITCH + cg * 2) = k8[u]; *(LAS u32x4*)(Vt + kk * ATT_PITCH + cg * 2) = v8[u]; } }
    if (tid < 192) { const int u = tid - 32, j = u - 64, rel = dil * j, na = rel < 0 ? -rel : rel;
        int bucket = na < 8 ? na : 8 + (na >= 15) + (na >= 27) + (na >= 50) + (na >= 91) + (na >= 166) + (na >= 305) + (na >= 559);
        if (rel > 0) bucket += 16;
        bt[tid] = (u >= 0 && u <= 128) ? rel_bias[min(bucket, 31) * 4 + h] * 1.4426950408889634f : -1e30f; }
    const int ql = lane & 31, hh = lane >> 5;
    const int qi = Q0 + 32 * w + ql; const size_t tok = (size_t)b * SEQ + r + dil * qi;
    bf16x8 qf[4];
#pragma unroll
    for (int ks = 0; ks < 4; ++ks) qf[ks] = *(const bf16x8*)(H + tok * NH + HAQ + h * 64 + 16 * ks + 8 * hh);
    __syncthreads();
    f32x16 S[5];
#pragma unroll
    for (int tk = 0; tk < 5; ++tk) {
#pragma unroll
        for (int i = 0; i < 16; ++i) S[tk][i] = F.zf;
#pragma unroll
        for (int ks = 0; ks < 4; ++ks) { const bf16x8 kf = *(const LAS bf16x8*)(Kt + (32 * w + 32 * tk + ql) * ATT_PITCH + (16 * ks + 8 * hh) * 2); S[tk] = MFMA32(kf, qf[ks], S[tk]); } }
    const LAS float* btl = bt + 32 + 4 * hh - ql;
    float mx = -3.0e38f;
#pragma unroll
    for (int tk = 0; tk < 5; ++tk) {
#pragma unroll
        for (int i = 0; i < 16; ++i) { const float sc = S[tk][i] * (0.125f * 1.4426950408889634f) + btl[32 * tk + (i & 3) + 8 * (i >> 2)]; S[tk][i] = sc; mx = fmaxf(mx, sc); }
        __builtin_amdgcn_sched_barrier(0); }
    const int e0 = Q0 - 64 + 32 * w;
    if (e0 < 0 || e0 + 160 > L) {
        mx = -3.0e38f;
#pragma unroll
        for (int tk = 0; tk < 5; ++tk)
#pragma unroll
            for (int i = 0; i < 16; ++i) { const int kidx = e0 + 32 * tk + crow(i, hh); const float sc = (kidx >= 0 && kidx < L) ? S[tk][i] : -1e30f; S[tk][i] = sc; mx = fmaxf(mx, sc); }
    }
    mx = fmaxf(mx, shx(mx, 32, lane));
    float lsum = 0.f;
#pragma unroll
    for (int tk = 0; tk < 5; ++tk)
#pragma unroll
        for (int i = 0; i < 16; ++i) { const float p = __builtin_amdgcn_exp2f(S[tk][i] - mx); S[tk][i] = p; lsum += p; }
    lsum += shx(lsum, 32, lane);
    f32x16 O[2];
#pragma unroll
    for (int dt = 0; dt < 2; ++dt)
#pragma unroll
        for (int i = 0; i < 16; ++i) O[dt][i] = F.zf;
#pragma unroll
    for (int tk = 0; tk < 5; ++tk)
#pragma unroll
        for (int s2 = 0; s2 < 2; ++s2) { const bf16x8 pf = pack8(S[tk][8 * s2], S[tk][8 * s2 + 1], S[tk][8 * s2 + 2], S[tk][8 * s2 + 3], S[tk][8 * s2 + 4], S[tk][8 * s2 + 5], S[tk][8 * s2 + 6], S[tk][8 * s2 + 7]);
            const int k0 = 32 * w + 32 * tk + 16 * s2 + 4 * hh;
#pragma unroll
            for (int dt = 0; dt < 2; ++dt) { const bf16x8 vf = tr_frag(Vt, ATT_PITCH, k0, k0 + 8, 32 * dt, lane); O[dt] = MFMA32(vf, pf, O[dt]); } }
    const float inv = 1.0f / lsum;
    bf16* op = ATTO + ((size_t)pat * T + tok) * 256 + h * 64 + 4 * hh;
#pragma unroll
    for (int dt = 0; dt < 2; ++dt)
#pragma unroll
        for (int g = 0; g < 4; ++g) { u32x2 wv; wv.x = pk2(O[dt][4 * g] * inv, O[dt][4 * g + 1] * inv); wv.y = pk2(O[dt][4 * g + 2] * inv, O[dt][4 * g + 3] * inv); *(u32x2*)(op + 32 * dt + 8 * g) = wv; }
    if (hh == 0) ATTL[((size_t)pat * T + tok) * 4 + h] = (mx + __builtin_amdgcn_logf(lsum)) * 0.6931471805599453f;
    __syncthreads();
}
__device__ __forceinline__ void att_merge(int item) {
    FRAME_SETUP;
    WS_PTRS;
    const int tid = F.tid; const size_t tok = (size_t)item * 64 + (tid >> 3); const int sub = tid & 7, h = sub >> 1, c0 = h * 64 + (sub & 1) * 32;
    const float l0 = ATTL[tok * 4 + h], l1 = ATTL[((size_t)T + tok) * 4 + h], l2 = ATTL[((size_t)2 * T + tok) * 4 + h];
    const float M = fmaxf(l0, fmaxf(l1, l2)); float w0 = __expf(l0 - M), w1 = __expf(l1 - M), w2 = __expf(l2 - M); const float inv = 1.0f / (w0 + w1 + w2); w0 *= inv; w1 *= inv; w2 *= inv;
    const bf16* o0 = ATTO + tok * 256 + c0; const bf16* o1 = ATTO + ((size_t)T + tok) * 256 + c0; const bf16* o2 = ATTO + ((size_t)2 * T + tok) * 256 + c0;
    bf16* yp = YS + tok * D + 256 + c0;
#pragma unroll
    for (int q = 0; q < 4; ++q) { float a8[8], b8[8], c8[8]; unpack8(*(const u32x4*)(o0 + q * 8), a8); unpack8(*(const u32x4*)(o1 + q * 8), b8); unpack8(*(const u32x4*)(o2 + q * 8), c8);
        u32x4 w; w.x = pk2(a8[0] * w0 + b8[0] * w1 + c8[0] * w2, a8[1] * w0 + b8[1] * w1 + c8[1] * w2); w.y = pk2(a8[2] * w0 + b8[2] * w1 + c8[2] * w2, a8[3] * w0 + b8[3] * w1 + c8[3] * w2);
        w.z = pk2(a8[4] * w0 + b8[4] * w1 + c8[4] * w2, a8[5] * w0 + b8[5] * w1 + c8[5] * w2); w.w = pk2(a8[6] * w0 + b8[6] * w1 + c8[6] * w2, a8[7] * w0 + b8[7] * w1 + c8[7] * w2);
        *(u32x4*)(yp + q * 8) = w; }
}

template <int CTRL> __device__ __forceinline__ float dpp_max(float v) { return fmaxf(v, dpp_mov<CTRL>(v)); }
__device__ __forceinline__ void ln1_router(int l) {
    FRAME_SETUP;
    WS_PTRS; const float* ln1_g = inp(I_LN1G); const float* ln1_b = inp(I_LN1B); const bf16* WRT = (const bf16*)(ws + WS_WRT) + (size_t)l * NE * D; const float* STAT = (const float*)(ws + WS_STAT);
    LAS float* gl = (LAS float*)F.lds; LAS float* bl = gl + D;
    { const int i = F.tid * 2; *(LAS f32x2*)(gl + i) = *(const f32x2*)(ln1_g + l * D + i); *(LAS f32x2*)(bl + i) = *(const f32x2*)(ln1_b + l * D + i); }
    __syncthreads();
    const int lane = F.lane, r = lane & 15, kg = lane >> 4;
    for (int item = F.bid * 4 + F.wave; item < T / 16 && F.wave < 4; item += F.G * 4) {
        const size_t tok = (size_t)item * 16 + r;
        float s1 = 0.f, s2 = 0.f;
        { const f32x4 a = *(const f32x4*)(STAT + (tok * 16 + 4 * kg) * 2), c = *(const f32x4*)(STAT + (tok * 16 + 4 * kg) * 2 + 4); s1 = (a[0] + a[2]) + (c[0] + c[2]); s2 = (a[1] + a[3]) + (c[1] + c[3]); }
        s1 += shx(s1, 16, lane); s1 += shx(s1, 32, lane); s2 += shx(s2, 16, lane); s2 += shx(s2, 32, lane);
        const float mean = s1 * (1.0f / D), var = fmaxf(s2 * (1.0f / D) - mean * mean, 0.f), rstd = 1.0f / sqrtf(var + LN_EPS);
        const bf16* rp = (const bf16*)MGF + tok * D + 8 * kg; bf16* xp = XB + tok * D + 8 * kg; const bf16* wp = WRT + (size_t)r * D + 8 * kg;
        f32x4 acc = (f32x4){F.zf, F.zf, F.zf, F.zf};
#pragma unroll 4
        for (int ks = 0; ks < 32; ++ks) {
            float x8[8]; unpack8(*(const u32x4*)(rp + 32 * ks), x8); const f32x4 x0 = (f32x4){x8[0], x8[1], x8[2], x8[3]}, x1 = (f32x4){x8[4], x8[5], x8[6], x8[7]};
            const f32x4 g0 = *(const LAS f32x4*)(gl + 32 * ks + 8 * kg), g1 = *(const LAS f32x4*)(gl + 32 * ks + 8 * kg + 4), b0 = *(const LAS f32x4*)(bl + 32 * ks + 8 * kg), b1 = *(const LAS f32x4*)(bl + 32 * ks + 8 * kg + 4);
            const f32x4 y0 = (x0 - mean) * rstd * g0 + b0, y1 = (x1 - mean) * rstd * g1 + b1;
            u32x4 yw; yw.x = pk2(y0[0], y0[1]); yw.y = pk2(y0[2], y0[3]); yw.z = pk2(y1[0], y1[1]); yw.w = pk2(y1[2], y1[3]);
            *(u32x4*)(xp + 32 * ks) = yw;
            const bf16x8 wf = *(const bf16x8*)(wp + 32 * ks);
            acc = __builtin_amdgcn_mfma_f32_16x16x32_bf16(__builtin_bit_cast(bf16x8, yw), wf, acc, 0, 0, 0);
        }
        f32x4 aff;
#pragma unroll
        for (int i = 0; i < 4; ++i) { float m = acc[i]; m = dpp_max<0xB1>(m); m = dpp_max<0x4E>(m); m = dpp_max<0x141>(m); m = dpp_max<0x140>(m);
            const float e = __expf(acc[i] - m); float se = e; se += dpp_mov<0xB1>(se); se += dpp_mov<0x4E>(se); se += dpp_mov<0x141>(se); se += dpp_mov<0x140>(se);
            aff[i] = e * rcpf_(se); }
        { const size_t t0 = (size_t)item * 16 + 4 * kg; const int b = (int)(t0 >> 13), sp = (int)(t0 & (SEQ - 1)); *(f32x4*)(AFF + ((size_t)(b * NE + r)) * SEQ + sp) = aff; }
    }
    __syncthreads();
}
__device__ __forceinline__ unsigned block_excl_scan(LAS unsigned* sc, unsigned val, int tid) {
    sc[tid] = val; __syncthreads();
#pragma unroll 1
    for (int off = 1; off < NTHREADS; off <<= 1) { const unsigned v = tid >= off ? sc[tid - off] : 0u; __syncthreads(); sc[tid] += v; __syncthreads(); }
    const unsigned r = sc[tid] - val; __syncthreads(); return r;
}
__device__ __forceinline__ void topk_item(int be) {
    FRAME_SETUP;
    WS_PTRS;
    const int tid = F.tid, b = be >> 4;
    const float* aff = AFF + (size_t)be * SEQ;
    LAS unsigned* hist = (LAS unsigned*)F.lds; LAS unsigned* sfx = hist + 256; LAS unsigned* sc = sfx + 256; LAS unsigned* misc = sc + 512; LAS int* idxl = (LAS int*)(misc + 4);
    unsigned key[16];
    { const u32x4* ap = (const u32x4*)(aff + tid * 16);
#pragma unroll
        for (int q = 0; q < 4; ++q) { const u32x4 w = ap[q]; key[q * 4] = w.x; key[q * 4 + 1] = w.y; key[q * 4 + 2] = w.z; key[q * 4 + 3] = w.w; } }
    unsigned prefix = 0u, kth = CAP, hmask = 0u;
#pragma unroll 1
    for (int shift = 24; shift >= 0; shift -= 8) {
        if (tid < 256) hist[tid] = 0u;
        __syncthreads();
#pragma unroll
        for (int i = 0; i < 16; ++i) { if (((key[i] ^ prefix) & hmask) == 0u) __hip_atomic_fetch_add(&hist[(key[i] >> shift) & 255u], 1u, __ATOMIC_RELAXED, __HIP_MEMORY_SCOPE_WORKGROUP); }
        __syncthreads();
        if (tid < 256) sfx[tid] = hist[tid];
        __syncthreads();
#pragma unroll 1
        for (int off = 1; off < 256; off <<= 1) { unsigned v = 0u; if (tid < 256 && tid + off < 256) v = sfx[tid + off]; __syncthreads(); if (tid < 256) sfx[tid] += v; __syncthreads(); }
        if (tid < 256) { const unsigned incl = sfx[tid], excl = incl - hist[tid]; if (excl < kth && kth <= incl) { misc[0] = (unsigned)tid; misc[1] = kth - excl; } }
        __syncthreads();
        prefix |= misc[0] << shift; kth = misc[1]; hmask |= 255u << shift;
        __syncthreads();
    }
    unsigned ceq = 0u;
#pragma unroll
    for (int i = 0; i < 16; ++i) ceq += (key[i] == prefix) ? 1u : 0u;
    unsigned eqrank = block_excl_scan(sc, ceq, tid);
    unsigned selmask = 0u, csel = 0u;
#pragma unroll
    for (int i = 0; i < 16; ++i) { bool sel = key[i] > prefix; if (key[i] == prefix) { sel = eqrank < kth; ++eqrank; } if (sel) { selmask |= 1u << i; ++csel; } }
    unsigned slot = block_excl_scan(sc, csel, tid);
#pragma unroll
    for (int i = 0; i < 16; ++i) { const int s = tid * 16 + i;
        if (selmask & (1u << i)) { if (slot < (unsigned)CAP) { IDX[be * CAP + slot] = s; GATE[be * CAP + slot] = __uint_as_float(key[i]); idxl[slot] = s; } SLOT[(size_t)be * SEQ + s] = (int)slot; ++slot; }
        else SLOT[(size_t)be * SEQ + s] = -1; }
    __syncthreads();
    __syncthreads();
}
__device__ __forceinline__ void combine_ln2(int l) {
    FRAME_SETUP;
    WS_PTRS; const float* ln2_g = inp(I_LN2G); const float* ln2_b = inp(I_LN2B); float* out = outp();
    const int lane = F.lane;
    const float* g2 = ln2_g + l * D; const float* b2 = ln2_b + l * D;
    f32x4 gg4[4], bb4[4];
#pragma unroll
    for (int j = 0; j < 4; ++j) { const int d = 8 * lane + 512 * (j >> 1) + 4 * (j & 1); gg4[j] = *(const f32x4*)(g2 + d); bb4[j] = *(const f32x4*)(b2 + d); }
    for (int tok = (F.bid * NWAVES + F.wave) * 2; tok < T; tok += F.G * NWAVES * 2) {
        const int b = tok >> 13, sp = tok & (SEQ - 1);
        int slotv[2]; unsigned mask[2]; f32x4 v[2][4]; u32x4 xr[2][2];
#pragma unroll
        for (int u = 0; u < 2; ++u) slotv[u] = lane < NE ? SLOT[((size_t)(b * NE + lane)) * SEQ + sp + u] : -1;
#pragma unroll
        for (int u = 0; u < 2; ++u)
#pragma unroll
            for (int jj = 0; jj < 2; ++jj) xr[u][jj] = *(const u32x4*)(XB + (size_t)(tok + u) * D + 8 * lane + 512 * jj);
        __builtin_amdgcn_sched_barrier(0);
#pragma unroll
        for (int u = 0; u < 2; ++u) mask[u] = (unsigned)__ballot(slotv[u] >= 0);
#pragma unroll
        for (int u = 0; u < 2; ++u)
#pragma unroll
            for (int jj = 0; jj < 2; ++jj) { float x8[8]; unpack8(xr[u][jj], x8); v[u][2 * jj] = (f32x4){x8[0], x8[1], x8[2], x8[3]} * ALPHA; v[u][2 * jj + 1] = (f32x4){x8[4], x8[5], x8[6], x8[7]} * ALPHA; }
        while (mask[0] | mask[1]) {
            u32x4 r[2][3][2]; bool on[2][3];
#pragma unroll
            for (int u = 0; u < 2; ++u)
#pragma unroll
                for (int k = 0; k < 3; ++k) { on[u][k] = mask[u] != 0u; const int e = on[u][k] ? __builtin_ctz(mask[u]) : 0; mask[u] &= mask[u] - 1u;
                    const int sl = __builtin_amdgcn_readlane(slotv[u], e);
                    if (on[u][k]) { const bf16* yr = YE + ((size_t)(b * NE + e) * CAP + sl) * D;
#pragma unroll
                        for (int jj = 0; jj < 2; ++jj) r[u][k][jj] = *(const u32x4*)(yr + 8 * lane + 512 * jj); } }
#pragma unroll
            for (int u = 0; u < 2; ++u)
#pragma unroll
                for (int k = 0; k < 3; ++k) if (on[u][k]) {
#pragma unroll
                    for (int jj = 0; jj < 2; ++jj) { float y8[8]; unpack8(r[u][k][jj], y8); v[u][2 * jj] += (f32x4){y8[0], y8[1], y8[2], y8[3]}; v[u][2 * jj + 1] += (f32x4){y8[4], y8[5], y8[6], y8[7]}; } }
        }
        float s[2], s2[2];
#pragma unroll
        for (int u = 0; u < 2; ++u) { s[u] = 0.f;
#pragma unroll
            for (int j = 0; j < 4; ++j) s[u] += (v[u][j].x + v[u][j].y) + (v[u][j].z + v[u][j].w); }
        s[0] = wave_sum(s[0], lane); s[1] = wave_sum(s[1], lane);
#pragma unroll
        for (int u = 0; u < 2; ++u) { const float mean = s[u] * (1.f / D); s2[u] = 0.f;
#pragma unroll
            for (int j = 0; j < 4; ++j) { v[u][j] = v[u][j] - mean; s2[u] += (v[u][j].x * v[u][j].x + v[u][j].y * v[u][j].y) + (v[u][j].z * v[u][j].z + v[u][j].w * v[u][j].w); } }
        s2[0] = wave_sum(s2[0], lane); s2[1] = wave_sum(s2[1], lane);
#pragma unroll
        for (int u = 0; u < 2; ++u) { const float rstd = 1.f / sqrtf(s2[u] * (1.f / D) + LN_EPS);
#pragma unroll
            for (int jj = 0; jj < 2; ++jj) { const int d = 8 * lane + 512 * jj;
                const f32x4 x0 = v[u][2 * jj] * rstd * gg4[2 * jj] + bb4[2 * jj], x1 = v[u][2 * jj + 1] * rstd * gg4[2 * jj + 1] + bb4[2 * jj + 1];
                u32x4 w; w.x = pk2(x0.x, x0.y); w.y = pk2(x0.z, x0.w); w.z = pk2(x1.x, x1.y); w.w = pk2(x1.z, x1.w); *((u32x4*)(XB + (size_t)(tok + u) * D + d)) = w;
                if (l == DEPTH - 1) { *((f32x4*)(out + (size_t)(tok + u) * D + d)) = x0; *((f32x4*)(out + (size_t)(tok + u) * D + d + 4)) = x1; } } }
    }
}

constexpr int PH_PER_LAYER = 11, N_PHASES = 1 + DEPTH * PH_PER_LAYER;
struct Args { const float* in[22]; float* out; unsigned char* ws; int ph_lo, ph_hi; };
__device__ __forceinline__ void phase_mix1(int l) { FRAME_SETUP;
    for (int it = F.bid; it < 256 + 128; it += F.G) { if (it < 256) mlstm_c1m(l, it); else gmlp_m(l, it - 256); }
    { const int nw = F.G * NWAVES; int first = (F.bid >= 128 ? F.bid - 128 : F.bid + F.G - 128) * NWAVES + F.wave;
      for (int wi = first; wi < 2048; wi += nw) pool_m(l, wi); } }
__device__ __forceinline__ void phase_mix2(int l) { FRAME_SETUP;
    for (int wi = F.bid * 2 + F.wave; wi < 272 && F.wave < 2; wi += F.G * 2) mlstm_scan(wi);
    const bool g256 = F.G == 256, sc = F.bid < 130;
    const int n = g256 ? (sc ? (F.bid < 4 ? 3 : 2) : 4) : (768 - F.bid + F.G - 1) / F.G, first = g256 ? (sc ? 2 * F.bid : 260 + 4 * (F.bid - 130)) : F.bid, stride = g256 ? 1 : F.G;
    for (int k = 0; k < n; ++k) att2_item((g256 && sc && k == 2) ? 764 + F.bid : first + k * stride); }
__device__ __forceinline__ void phase_mix3(int l) { FRAME_SETUP;
    for (int it = F.bid; it < 256 + 256; it += F.G) { if (it < 256) mlstm_c3m(l, it); else att_merge(it - 256); } }
__device__ __forceinline__ void phase_topk(int l) { FRAME_SETUP;
    const bool wide = F.G > 2 * BATCH * NE;
    for (int it = F.bid; it < BATCH * NE; it += F.G) topk_item(it);
    if (l + 1 < DEPTH && (!wide || F.bid >= BATCH * NE)) convert_layer(l + 1, ((wide ? F.bid - BATCH * NE : F.bid)) * NWAVES + F.wave, (wide ? F.G - BATCH * NE : F.G) * NWAVES); }
__device__ __forceinline__ void phase_g1(int l) { FRAME_SETUP; WS_PTRS;
    pg8::GemmP g{D, D, D}; SchedG1 S{F.G, F.bid, (const char*)XB, (const char*)wl(ws, l, OW_IN)}; EpiG1 E{H, GI, BIN + (size_t)l * NINP};
    pg8::gemm_phase<EpiG1, SchedG1, true>(F.lds, F.tid, g, S, E); }
__device__ __forceinline__ void phase_g2(int l) { FRAME_SETUP; WS_PTRS;
    pg8::GemmP g{D, D, D}; SchedG2 S{F.G, F.bid, (const char*)YS, (const char*)wl(ws, l, OW_B)}; EpiG2 E{H, MGB};
    pg8::gemm_phase<EpiG2, SchedG2, true>(F.lds, F.tid, g, S, E); }
__device__ __forceinline__ void phase_g3(int l) { FRAME_SETUP; WS_PTRS;
    pg8::GemmP g{D, D, D}; SchedG3 S{F.G, F.bid, (const char*)MGB, (const char*)wl(ws, l, OW_O)}; EpiG3 E{XB, (bf16*)MGF, (float*)(ws + WS_STAT)};
    pg8::gemm_phase<EpiG3, SchedG3, true>(F.lds, F.tid, g, S, E); }
__device__ __forceinline__ void phase_g4(int l) { FRAME_SETUP; WS_PTRS;
    pg8::GemmP g{D, D, D}; SchedG4 S{F.G, F.bid, (const char*)XB, (const char*)wl(ws, l, OW_13), IDX}; EpiG4 E{HID};
    pg8::gemm_phase<EpiG4, SchedG4, true>(F.lds, F.tid, g, S, E); }
__device__ __forceinline__ void phase_g5(int l) { FRAME_SETUP; WS_PTRS;
    pg8::GemmP g{FF, FF, FF}; SchedG5 S{F.G, F.bid, (const char*)HID, (const char*)wl(ws, l, OW_2)}; EpiG5 E{GATE, YE};
    pg8::gemm_phase<EpiG5, SchedG5, true>(F.lds, F.tid, g, S, E); }

__global__ void __launch_bounds__(NTHREADS, 2) fwd_kernel(Args args) {
    { LAS unsigned char* l0 = lds_base(); for (int u = threadIdx.x; u < (LDS_BYTES - LDSCTL_OFF) / 4; u += NTHREADS) ((LAS unsigned*)(l0 + LDSCTL_OFF))[u] = 0u; }
    __syncthreads();
#if !MK_PER_PHASE
    (void)xcd_barrier_post((unsigned*)(args.ws + WS_CTL) + CW_BAR, (volatile LAS unsigned*)(lds_base() + MISC_OFF) + 8);
#endif
    const int lo = args.ph_lo, hi = args.ph_hi;
#if PROBE_MASK
    volatile LAS unsigned long long* pacc = (volatile LAS unsigned long long*)(lds_base() + MISC_OFF + 64);
#endif
    for (int ph = lo; ph < hi; ++ph) {
#if PROBE_MASK
        const unsigned long long pt0 = __builtin_amdgcn_s_memrealtime();
#endif
        if (ph == 0) { if (PHEN(15)) p0_prologue(); }
        else {
            const int l = (ph - 1) / PH_PER_LAYER, sp = (ph - 1) % PH_PER_LAYER;
            if (sp == 0) { if (PHEN(0)) phase_g1(l); }
            else if (sp == 1) { if (PHEN(1)) phase_mix1(l); }
            else if (sp == 2) { if (PHEN(2)) phase_mix2(l); }
            else if (sp == 3) { if (PHEN(3)) phase_mix3(l); }
            else if (sp == 4) { if (PHEN(4)) phase_g2(l); }
            else if (sp == 5) { if (PHEN(5)) phase_g3(l); }
            else if (sp == 6) { if (PHEN(6)) ln1_router(l); }
            else if (sp == 7) { if (PHEN(7)) phase_topk(l); }
            else if (sp == 8) { if (PHEN(8)) phase_g4(l); }
            else if (sp == 9) { if (PHEN(9)) phase_g5(l); }
            else { if (PHEN(10)) combine_ln2(l); }
        }
#if PROBE_MASK && defined(PROBE_MODE) && PROBE_MODE == 1
        { const int sp_ = ph == 0 ? 15 : (ph - 1) % PH_PER_LAYER; asm volatile("s_waitcnt vmcnt(0)" ::: "memory"); __syncthreads(); const unsigned long long pt1 = __builtin_amdgcn_s_memrealtime();
          if (threadIdx.x == 0 && ((PROBE_MASK >> sp_) & 1)) pacc[0] = pacc[0] + (pt1 - pt0); }
#endif
        if (ph + 1 < hi) {
#if !MK_PER_PHASE
            { XcdBarrier bar; bar.bar = (unsigned*)(wsp() + WS_CTL) + CW_BAR; bar.x = xb_xcc_id(); bar.st = (volatile LAS unsigned*)(lds_base() + MISC_OFF) + 8; xcd_barrier(bar); }
#endif
        }
#if PROBE_MASK && !(defined(PROBE_MODE) && PROBE_MODE == 1)
        { const int sp_ = ph == 0 ? 15 : (ph - 1) % PH_PER_LAYER; const unsigned long long pt1 = __builtin_amdgcn_s_memrealtime();
          if (threadIdx.x == 0 && ((PROBE_MASK >> sp_) & 1)) pacc[0] = pacc[0] + (pt1 - pt0); }
#endif
    }
#if PROBE_MASK
    if (threadIdx.x == 0 && blockIdx.x == 0) { const unsigned long long t0 = __builtin_amdgcn_s_memrealtime(), need = pacc[0]; while (__builtin_amdgcn_s_memrealtime() - t0 < need) __builtin_amdgcn_s_sleep(8); }
#endif
}

extern "C" void kernel_launch(void* const* d_in, const int* in_sizes, int n_in, void* d_out, int out_size, void* d_ws, size_t ws_size, hipStream_t stream) {
    static int grid = 0;
    if (grid == 0) {
        if (n_in != 22 || in_sizes[0] != T * D || out_size != T * D || ws_size < WS_END) {
            fprintf(stderr, "kernel_launch: unexpected shapes: n_in %d in0 %d out %d ws %zu (need %zu); nothing launched\n", n_in, n_in > 0 ? in_sizes[0] : -1, out_size, ws_size, (size_t)WS_END); grid = -1; return; }
        int dev = 0, cus = 0;
        if (hipGetDevice(&dev) != hipSuccess || hipDeviceGetAttribute(&cus, hipDeviceAttributeMultiprocessorCount, dev) != hipSuccess) { grid = -1; return; }
        if (hipFuncSetAttribute((const void*)fwd_kernel, hipFuncAttributeMaxDynamicSharedMemorySize, LDS_BYTES) != hipSuccess) { fprintf(stderr, "kernel_launch: hipFuncSetAttribute failed\n"); grid = -1; return; }
        int per_cu = 0;
        if (hipOccupancyMaxActiveBlocksPerMultiprocessor(&per_cu, (const void*)fwd_kernel, NTHREADS, LDS_BYTES) != hipSuccess || per_cu < 1)
            fprintf(stderr, "kernel_launch: note: occupancy query reports %d workgroups per CU\n", per_cu);
        (void)hipGetLastError();
        grid = cus;
    }
    if (grid < 0) return;
    (void)hipMemsetAsync((char*)d_ws + WS_CTL, 0, CTL_ZERO_BYTES, stream);
    Args a{};
    for (int i = 0; i < 22; ++i) a.in[i] = (const float*)d_in[i];
    a.out = (float*)d_out; a.ws = (unsigned char*)d_ws;
#if MK_PER_PHASE
    for (int ph = 0; ph < N_PHASES; ++ph) { a.ph_lo = ph; a.ph_hi = ph + 1; hipLaunchKernelGGL(fwd_kernel, dim3(grid), dim3(NTHREADS), LDS_BYTES, stream, a); }
#else
    a.ph_lo = 0; a.ph_hi = N_PHASES; hipLaunchKernelGGL(fwd_kernel, dim3(grid), dim3(NTHREADS), LDS_BYTES, stream, a);
#endif
}
```

```cpp
#include <hip/hip_runtime.h>
#include <cstdio>
#include <cstdint>

#ifndef PH_MASK
#define PH_MASK 0xFFFF
#endif
#define PHEN(k) ((PH_MASK >> (k)) & 1)
#ifndef PROBE_MASK
#define PROBE_MASK 0
#endif
#ifndef MK_PER_PHASE
#define MK_PER_PHASE 0
#endif

#define GAS __attribute__((address_space(1)))
#define LAS __attribute__((address_space(3)))
typedef unsigned short bf16;
typedef short bf16x8 __attribute__((ext_vector_type(8)));
typedef float f32x4 __attribute__((ext_vector_type(4)));
typedef float f32x2 __attribute__((ext_vector_type(2)));
typedef unsigned u32x4 __attribute__((ext_vector_type(4)));
typedef unsigned u32x2 __attribute__((ext_vector_type(2)));
typedef GAS unsigned gu32;
#define RLX_AGENT __ATOMIC_RELAXED, __HIP_MEMORY_SCOPE_AGENT
#define LDS_WAIT() asm volatile("s_waitcnt lgkmcnt(0)" ::: "memory")
#define VM_WAIT() asm volatile("s_waitcnt vmcnt(0)" ::: "memory")

constexpr int BATCH = 2, SEQ = 8192, D = 1024, T = BATCH * SEQ, DEPTH = 4;
constexpr int NIN = 6672;
constexpr int NH = 6656;
constexpr int NINP = 6912;
constexpr int NE = 16, CAP = 1024, FF = 1024, NSLOT = BATCH * NE * CAP;
constexpr float ALPHA = 1.6817928305074292f;
constexpr float LN_EPS = 1e-5f;
constexpr int HU = 0, HV = 256, HAQ = 512, HAK = 768, HAV = 1024, HCQ = 1280, HCK = 1536, HCV = 1792, HCO = 2048, HDX = 2304, HG = 2560;

constexpr size_t MiB = 1u << 20;
constexpr size_t WS_CTL = 0, CTL_ZERO_BYTES = 64 * 1024;
constexpr size_t WS_BIN = 1 * MiB;
constexpr size_t WS_WSB = 1 * MiB + 512 * 1024;
constexpr size_t WS_PWT = 1 * MiB + 256 * 1024;
constexpr size_t WS_W = 2 * MiB, LW = 114 * MiB;
constexpr size_t OW_IN = 0, OW_B = 14 * MiB, OW_O = 16 * MiB, OW_13 = 18 * MiB, OW_2 = 82 * MiB;
constexpr size_t WS_XF = 458 * MiB;
constexpr size_t WS_STAT = WS_XF;
constexpr size_t WS_WRT = 1 * MiB + 128 * 1024;
constexpr size_t WS_XB = 522 * MiB;
constexpr size_t WS_BIG = 554 * MiB;
constexpr size_t WS_XS = WS_BIG, WS_HID = WS_BIG + 64 * MiB, WS_YE = WS_BIG + 128 * MiB;
constexpr size_t WS_GI = 762 * MiB;
constexpr size_t WS_ATTO = 763 * MiB;
constexpr size_t WS_ATTL = 811 * MiB;
constexpr size_t WS_YS = 812 * MiB;
constexpr size_t WS_MGF = 844 * MiB;
constexpr size_t WS_MGB = 908 * MiB;
constexpr size_t WS_QC = 940 * MiB, WS_KC = 956 * MiB;
constexpr size_t WS_DC = 972 * MiB;
constexpr size_t WS_DG = 1005 * MiB;
constexpr size_t WS_AFF = 1006 * MiB;
constexpr size_t WS_IDX = 1007 * MiB;
constexpr size_t WS_GATE = 1007 * MiB + 512 * 1024;
constexpr size_t WS_SLOT = 1008 * MiB;
constexpr size_t WS_END = 1009 * MiB;

constexpr int CW_BAR = 4096;

constexpr int RING_BYTES = 131072;
constexpr int LDSCTL_OFF = RING_BYTES, MISC_OFF = LDSCTL_OFF + 320;
constexpr int LDS_BYTES = 147456;
constexpr int NWAVES = 8, NTHREADS = 512;

__device__ __forceinline__ float bf2f(unsigned v) { return __uint_as_float(v << 16); }
__device__ __forceinline__ unsigned f2bf(float f) { unsigned u = __float_as_uint(f); return (u + 0x7fffu + ((u >> 16) & 1u)) >> 16; }
typedef __bf16 bf16x2_t_ __attribute__((ext_vector_type(2)));
__device__ __forceinline__ unsigned pk2(float lo, float hi) { f32x2 v = {lo, hi}; bf16x2_t_ b = __builtin_convertvector(v, bf16x2_t_); return __builtin_bit_cast(unsigned, b); }
__device__ __forceinline__ float rcpf_(float x) { return __builtin_amdgcn_rcpf(x); }
__device__ __forceinline__ void unpack8(const u32x4 w, float (&o)[8]) {
    o[0] = __uint_as_float(w.x << 16); o[1] = __uint_as_float(w.x & 0xffff0000u);
    o[2] = __uint_as_float(w.y << 16); o[3] = __uint_as_float(w.y & 0xffff0000u);
    o[4] = __uint_as_float(w.z << 16); o[5] = __uint_as_float(w.z & 0xffff0000u);
    o[6] = __uint_as_float(w.w << 16); o[7] = __uint_as_float(w.w & 0xffff0000u);
}
__device__ __forceinline__ float sigmoidf_(float x) { return rcpf_(1.0f + __expf(-x)); }
__device__ __forceinline__ float siluf_(float x) { return x * rcpf_(1.0f + __expf(-x)); }
__device__ __forceinline__ float gelu_tanh(float x) { const float u = 1.5957691216057308f * (x + 0.044715f * x * x * x); return x * rcpf_(1.0f + __expf(-u)); }
__device__ __forceinline__ float logsigmoidf_(float z) { return fminf(z, 0.f) - log1pf(__expf(-fabsf(z))); }
__device__ __forceinline__ float shx(float v, int o, int lane) { return __int_as_float(__builtin_amdgcn_ds_bpermute((lane ^ o) << 2, __float_as_int(v))); }
template <int CTRL> __device__ __forceinline__ float dpp_mov(float v) { return __int_as_float(__builtin_amdgcn_update_dpp(0, __float_as_int(v), CTRL, 0xF, 0xF, false)); }
__device__ __forceinline__ float wave_sum(float v, int lane) { (void)lane;
    v += dpp_mov<0xB1>(v); v += dpp_mov<0x4E>(v); v += dpp_mov<0x141>(v); v += dpp_mov<0x140>(v);
    const int iv = __float_as_int(v);
    return (__int_as_float(__builtin_amdgcn_readlane(iv, 0)) + __int_as_float(__builtin_amdgcn_readlane(iv, 16))) + (__int_as_float(__builtin_amdgcn_readlane(iv, 32)) + __int_as_float(__builtin_amdgcn_readlane(iv, 48)));
}

#define XB_TMO      128
#define XB_XCNT(j)  (256  + 64 * (j))
#define XB_XSUB(j)  (1280 + 64 * (j))
#define XB_XGEN(j)  (2304 + 64 * (j))
#define XB_TOP      3328
#define XB_TOPGEN   3392
#define XCD_BAR_WORDS 3456
#define XB_SPIN_CAP (1u << 18)
__device__ __forceinline__ unsigned xb_ld(unsigned* p)              { return __hip_atomic_load(p, __ATOMIC_RELAXED, __HIP_MEMORY_SCOPE_AGENT); }
__device__ __forceinline__ unsigned xb_add(unsigned* p, unsigned v) { return __hip_atomic_fetch_add(p, v, __ATOMIC_RELAXED, __HIP_MEMORY_SCOPE_AGENT); }
__device__ __forceinline__ unsigned xb_xcc_id() { return (unsigned)__builtin_amdgcn_s_getreg((3 << 11) | 20) & 0xFu; }
#define XB_SPIN(cond, bar) do { unsigned _sp = 0; while (cond) { __builtin_amdgcn_s_sleep(1); \
    if ((++_sp & 255u) == 0u) { if (xb_ld(&(bar)[XB_TMO])) break; if (_sp > XB_SPIN_CAP) { atomicAdd(&(bar)[XB_TMO], 1u); break; } } } } while (0)
struct XcdBarrier { unsigned* bar; unsigned x; volatile LAS unsigned* st; };
__device__ __forceinline__ XcdBarrier xcd_barrier_post(unsigned* bar, volatile LAS unsigned* st) {
    XcdBarrier b; b.bar = bar; b.x = xb_xcc_id(); b.st = st;
    if (threadIdx.x == 0) (void)xb_add(&bar[XB_XCNT(b.x)], 1u);
    return b;
}
__device__ __forceinline__ void xcd_barrier_complete(unsigned* bar, unsigned x, unsigned& nloc, unsigned& nx) {
    const unsigned G = gridDim.x * gridDim.y * gridDim.z;
    unsigned sum, cnt, mine, sp = 0u;
    for (;;) {
        sum = 0u; cnt = 0u; mine = 0u;
#pragma unroll
        for (unsigned j = 0; j < 16; ++j) { const unsigned c = xb_ld(&bar[XB_XCNT(j)]); sum += c; cnt += (c > 0u) ? 1u : 0u; mine = (j == x) ? c : mine; }
        if (sum == G) break;
        __builtin_amdgcn_s_sleep(1);
        if ((++sp & 255u) == 0u) { if (xb_ld(&bar[XB_TMO])) break; if (sp > XB_SPIN_CAP) { atomicAdd(&bar[XB_TMO], 1u); break; } }
    }
    nloc = mine > 0u ? mine : 1u; nx = cnt > 0u ? cnt : 1u;
}
__device__ __forceinline__ void xcd_barrier(const XcdBarrier& b) {
    asm volatile("s_waitcnt vmcnt(0)" ::: "memory");
    __syncthreads();
    if (threadIdx.x == 0) {
        unsigned* bar = b.bar;
        __builtin_amdgcn_s_waitcnt(0);
        unsigned nloc = b.st[0], nx = b.st[1];
        if (nloc == 0u) { xcd_barrier_complete(bar, b.x, nloc, nx); b.st[0] = nloc; b.st[1] = nx; }
        const unsigned old = xb_add(&bar[XB_XSUB(b.x)], 1u);
        const unsigned gen = old / nloc;
        if (old + 1u == (gen + 1u) * nloc) {
            __builtin_amdgcn_fence(__ATOMIC_RELEASE, "agent");
            asm volatile("s_waitcnt vmcnt(0)" ::: "memory");
            const unsigned og = xb_add(&bar[XB_TOP], 1u);
            const unsigned tg = og / nx;
            if (og + 1u == (tg + 1u) * nx) xb_add(&bar[XB_TOPGEN], 1u);
            else XB_SPIN(xb_ld(&bar[XB_TOPGEN]) == tg, bar);
            __builtin_amdgcn_fence(__ATOMIC_ACQUIRE, "agent");
            xb_add(&bar[XB_XGEN(b.x)], 1u);
            asm volatile("s_waitcnt vmcnt(0)" ::: "memory");
        } else {
            XB_SPIN(xb_ld(&bar[XB_XGEN(b.x)]) == gen, bar);
            __builtin_amdgcn_fence(__ATOMIC_ACQUIRE, "agent");
            asm volatile("s_waitcnt vmcnt(0)" ::: "memory");
        }
    }
    __syncthreads();
}

namespace pg8 {
constexpr int BM = 256, BK = 64, HALF = 128, HTB = HALF * BK * 2, STAGE_BYTES = 8 * HTB, NXCD = 8, WGM = 8;
__host__ __device__ __forceinline__ int lds_byte(int r, int c) { const int st = (r >> 4) * 2 + (c >> 5), rr = r & 15, cc = c & 31, ob = rr * 64 + cc * 2; return st * 1024 + (ob ^ (((ob >> 9) & 1) << 5)); }
__host__ __device__ __forceinline__ void stage_rc(int b, int& R, int& C) { const int st = b / 1024, sb = b % 1024, swz = sb ^ (((sb >> 9) & 1) << 5); R = (st >> 1) * 16 + swz / 64; C = (st & 1) * 32 + (swz % 64) / 2; }
__host__ __device__ __forceinline__ int perm32(int rho) { const int n = rho >> 4, i = rho & 15; return 8 * (i >> 2) + 4 * n + (i & 3); }

struct Unit { int pm, pn, aux; const char* A; const char* B; };
struct GemmP { int K, lda, ldb; };

__device__ __forceinline__ bool tile_of(int i, int G, int c, int nM, int nN, int& pm, int& pn) {
    const int nwg = nM * nN; const int L = i * G + c; if (L >= nwg) return false;
    int wgid = L; { const int q = nwg / NXCD, r = nwg % NXCD, xcd = wgid % NXCD, off = wgid / NXCD; wgid = (xcd < r ? xcd * (q + 1) : r * (q + 1) + (xcd - r) * q) + off; }
    const int nig = WGM * nN, gid = wgid / nig, fm = gid * WGM, gsz = (nM - fm) < WGM ? (nM - fm) : WGM;
    pm = fm + ((wgid % nig) % gsz); pn = (wgid % nig) / gsz; return true;
}

__device__ __forceinline__ unsigned cvt_pk_bf16(float lo, float hi) { unsigned r; asm volatile("v_cvt_pk_bf16_f32 %0, %1, %2" : "=v"(r) : "v"(lo), "v"(hi)); return r; }

template <class Epi, class Sched, bool ALIGN_EPI>
__device__ __forceinline__ void gemm_phase(LAS unsigned char* lds, const int tid, const GemmP g, const Sched& S, const Epi& E) {
    const int wid = __builtin_amdgcn_readfirstlane(tid >> 6), lane = tid & 63, wr = wid >> 2, wc = wid & 3, fr = lane & 15, fq = lane >> 4;
    const int K = g.K, nt = K / BK;
    unsigned voffB[2]; int Ri[2], Ci[2];
#pragma unroll
    for (int i = 0; i < 2; ++i) { int R, C; stage_rc(tid * 16 + i * 8192, R, C); const int Rb = Epi::PERM ? ((R & ~31) + perm32(R & 31)) : R;
        Ri[i] = R; Ci[i] = C; voffB[i] = (unsigned)(Rb * g.ldb + C) * 2u; }
    const size_t kstep = (size_t)(BK * 2);
    const size_t hstepB = (size_t)HALF * g.ldb * 2;
    unsigned vA0[2], vA1[2], nvA0[2], nvA1[2];
    const unsigned ldsw = (unsigned)wid * 1024u;
    const int aoff = lds_byte(wr * 64 + fr, fq * 8), boff = lds_byte(wc * 32 + fr, fq * 8);
#define PG8_SA(b, h) (((b) * 2 + (h)) * HTB)
#define PG8_SB(b, h) ((4 + (b) * 2 + (h)) * HTB)
#define PG8_STAGE(bufoff, gbase, voff) do { _Pragma("unroll") for (int _i = 0; _i < 2; ++_i) \
        __builtin_amdgcn_global_load_lds((const unsigned*)((const char*)(gbase) + (voff)[_i]), (LAS unsigned*)(lds + (bufoff) + ldsw + _i * 8192), 16, 0, 0); } while (0)
#define PG8_LDA(dst, b, h) do { _Pragma("unroll") for (int m = 0; m < 4; ++m) _Pragma("unroll") for (int k = 0; k < 2; ++k) dst[m][k] = *(const LAS bf16x8*)(lds + PG8_SA(b, h) + aoff + m * 2048 + k * 1024); } while (0)
#define PG8_LDB(dst, b, h) do { _Pragma("unroll") for (int n = 0; n < 2; ++n) _Pragma("unroll") for (int k = 0; k < 2; ++k) dst[n][k] = *(const LAS bf16x8*)(lds + PG8_SB(b, h) + boff + n * 2048 + k * 1024); } while (0)
#define PG8_MMA(ai, bj, At, Bt) do { __builtin_amdgcn_s_setprio(1); _Pragma("unroll") for (int m = 0; m < 4; ++m) _Pragma("unroll") for (int n = 0; n < 2; ++n) _Pragma("unroll") for (int k = 0; k < 2; ++k) \
        acc[ai][bj][m][n] = __builtin_amdgcn_mfma_f32_16x16x32_bf16(Bt[n][k], At[m][k], acc[ai][bj][m][n], 0, 0, 0); __builtin_amdgcn_s_setprio(0); } while (0)
#define PG8_WAIT_V(n) asm volatile("s_waitcnt vmcnt(" #n ")" ::: "memory")
#define PG8_WAIT_L(n) asm volatile("s_waitcnt lgkmcnt(" #n ")" ::: "memory")
#define PG8_BAR __builtin_amdgcn_s_barrier()
#define PG8_SCHED __builtin_amdgcn_sched_barrier(0)
    Unit cur, nxt; int ui = 0;
    if (!S.next(0, cur)) return;
    float zf = 0.f; asm volatile("" : "+v"(zf));
    f32x4 acc[2][2][4][2];
#pragma unroll
    for (int a = 0; a < 2; ++a)
#pragma unroll
        for (int b = 0; b < 2; ++b)
#pragma unroll
            for (int m = 0; m < 4; ++m)
#pragma unroll
                for (int n = 0; n < 2; ++n) acc[a][b][m][n] = (f32x4){zf, zf, zf, zf};
    bf16x8 At[4][2], B0[2][2], B1[2][2];
    typename Epi::Pre pre;
    const char* cA = cur.A; const char* cB = cur.B;
    S.a_off(cur, g.lda, Ri, Ci, vA0, vA1);
    PG8_STAGE(PG8_SB(0, 0), cB, voffB); PG8_STAGE(PG8_SB(0, 1), cB + hstepB, voffB); PG8_STAGE(PG8_SA(0, 0), cA, vA0); PG8_STAGE(PG8_SA(0, 1), cA, vA1);
    if (wr == 1) PG8_BAR;
    PG8_WAIT_V(2); PG8_BAR;
    PG8_STAGE(PG8_SB(1, 0), cB + kstep, voffB); PG8_STAGE(PG8_SA(1, 0), cA + kstep, vA0); PG8_STAGE(PG8_SB(1, 1), cB + hstepB + kstep, voffB);
    PG8_WAIT_V(6); PG8_BAR;
    for (;;) {
        const bool has_next = S.next(ui + 1, nxt);
        const char* nA = has_next ? nxt.A : cA; const char* nB = has_next ? nxt.B : cB;
        if (has_next) S.a_off(nxt, g.lda, Ri, Ci, nvA0, nvA1); else { nvA0[0] = vA0[0]; nvA0[1] = vA0[1]; nvA1[0] = vA1[0]; nvA1[1] = vA1[1]; }
        for (int t = 0; t < nt; t += 2) {
            if constexpr (Epi::HOOK) { if (t != 0 && (t & 3) == 0) E.hook(acc, cur, t >> 2, wr, wc, fr, fq); }
            const bool last = (t == nt - 2);
            if (last) E.prefetch(cur, wr, wc, fr, fq, pre);
            const char* a1 = cA + (size_t)(t + 1) * kstep;
            const char* a2 = last ? nA : cA + (size_t)(t + 2) * kstep; const char* b2 = last ? nB : cB + (size_t)(t + 2) * kstep;
            const char* a3 = a2 + kstep; const char* b3 = b2 + kstep;
            unsigned w0[2], w1[2];
            w0[0] = last ? nvA0[0] : vA0[0]; w0[1] = last ? nvA0[1] : vA0[1]; w1[0] = last ? nvA1[0] : vA1[0]; w1[1] = last ? nvA1[1] : vA1[1];
            PG8_LDB(B0, 0, 0); PG8_LDB(B1, 0, 1); PG8_SCHED; PG8_LDA(At, 0, 0); PG8_STAGE(PG8_SA(1, 1), a1, vA1);
            PG8_WAIT_V(8); PG8_WAIT_L(0); PG8_BAR; PG8_MMA(0, 0, At, B0); PG8_MMA(0, 1, At, B1); PG8_BAR; PG8_SCHED;
            PG8_LDA(At, 0, 1); PG8_STAGE(PG8_SB(0, 0), b2, voffB); PG8_STAGE(PG8_SB(0, 1), b2 + hstepB, voffB); PG8_STAGE(PG8_SA(0, 0), a2, w0);
            PG8_WAIT_V(8); PG8_WAIT_L(0); PG8_BAR; PG8_MMA(1, 0, At, B0); PG8_MMA(1, 1, At, B1); PG8_BAR; PG8_SCHED;
            PG8_LDB(B0, 1, 0); PG8_LDB(B1, 1, 1); PG8_SCHED; PG8_LDA(At, 1, 0); PG8_STAGE(PG8_SA(0, 1), a2, w1);
            PG8_WAIT_V(8); PG8_WAIT_L(0); PG8_BAR; PG8_MMA(0, 0, At, B0); PG8_MMA(0, 1, At, B1); PG8_BAR; PG8_SCHED;
            PG8_LDA(At, 1, 1); PG8_STAGE(PG8_SB(1, 0), b3, voffB); PG8_STAGE(PG8_SB(1, 1), b3 + hstepB, voffB); PG8_STAGE(PG8_SA(1, 0), a3, w0);
            PG8_WAIT_V(8); PG8_WAIT_L(0); PG8_BAR; PG8_MMA(1, 0, At, B0); PG8_MMA(1, 1, At, B1); PG8_BAR; PG8_SCHED;
        }
        if constexpr (ALIGN_EPI) { if (wr == 0) PG8_BAR; }
        E(acc, cur, wr, wc, fr, fq, pre);
        if (!has_next) break;
#pragma unroll
        for (int a = 0; a < 2; ++a)
#pragma unroll
            for (int b = 0; b < 2; ++b)
#pragma unroll
                for (int m = 0; m < 4; ++m)
#pragma unroll
                    for (int n = 0; n < 2; ++n) acc[a][b][m][n] = (f32x4){zf, zf, zf, zf};
        cur = nxt; cA = nA; cB = nB; ++ui; vA0[0] = nvA0[0]; vA0[1] = nvA0[1]; vA1[0] = nvA1[0]; vA1[1] = nvA1[1];
        if constexpr (ALIGN_EPI) { if (wr == 1) PG8_BAR; }
    }
    PG8_WAIT_V(0);
    if constexpr (!ALIGN_EPI) { if (wr == 0) PG8_BAR; }
    PG8_BAR;
#undef PG8_SA
#undef PG8_SB
#undef PG8_STAGE
#undef PG8_LDA
#undef PG8_LDB
#undef PG8_MMA
#undef PG8_WAIT_V
#undef PG8_WAIT_L
#undef PG8_BAR
#undef PG8_SCHED
}
}

struct Frame { LAS unsigned char* lds; int tid, lane, wave, G, bid; float zf; unsigned zu; };
#define FRAME_SETUP Frame F; { int t_ = threadIdx.x, b_ = blockIdx.x, g_ = gridDim.x; float z_ = 0.f; unsigned zu_ = 0u; asm volatile("" : "+v"(t_), "+s"(b_), "+s"(g_), "+v"(z_), "+v"(zu_)); \
    F.lds = lds_base(); F.tid = t_; F.lane = t_ & 63; F.wave = __builtin_amdgcn_readfirstlane(t_ >> 6); F.G = g_; F.bid = b_; F.zf = z_; F.zu = zu_; }
extern __shared__ __attribute__((aligned(16))) unsigned char lds_dyn[];
__device__ __forceinline__ LAS unsigned char* lds_base() { return (LAS unsigned char*)lds_dyn; }
typedef const __attribute__((address_space(4))) unsigned long long karg_t;
__device__ __forceinline__ unsigned long long karg(int k) { asm volatile("" : "+s"(k)); return ((karg_t*)__builtin_amdgcn_kernarg_segment_ptr())[k]; }
__device__ __forceinline__ const float* inp(int k) { return (const float*)(const GAS float*)karg(k); }
__device__ __forceinline__ float* outp() { return (float*)(GAS float*)karg(22); }
__device__ __forceinline__ unsigned char* wsp() { return (unsigned char*)(GAS unsigned char*)karg(23); }
enum { I_X = 0, I_WIN, I_BIN, I_GMLNG, I_GMWS, I_GMBS, I_RELB, I_MLCONV, I_MLFB, I_MLNG, I_POOLW, I_POOLS, I_WBR, I_WOUT, I_LN1G, I_LN1B, I_WR, I_WE1, I_WE3, I_WE2, I_LN2G, I_LN2B };
__device__ __forceinline__ bf16* wl(unsigned char* ws, int l, size_t off) { return (bf16*)(ws + WS_W + (size_t)l * LW + off); }

#define WS_PTRS unsigned char* ws = wsp(); float* BIN = (float*)(ws + WS_BIN); float* XF = (float*)(ws + WS_XF); bf16* XB = (bf16*)(ws + WS_XB); bf16* H = (bf16*)(ws + WS_BIG); bf16* XS = (bf16*)(ws + WS_XS); \
    bf16* HID = (bf16*)(ws + WS_HID); bf16* YE = (bf16*)(ws + WS_YE); float* GI = (float*)(ws + WS_GI); bf16* ATTO = (bf16*)(ws + WS_ATTO); float* ATTL = (float*)(ws + WS_ATTL); bf16* YS = (bf16*)(ws + WS_YS); \
    float* MGF = (float*)(ws + WS_MGF); bf16* MGB = (bf16*)(ws + WS_MGB); bf16* QC = (bf16*)(ws + WS_QC); bf16* KC = (bf16*)(ws + WS_KC); bf16* DC = (bf16*)(ws + WS_DC); float* DG = (float*)(ws + WS_DG); \
    float* AFF = (float*)(ws + WS_AFF); float* GATE = (float*)(ws + WS_GATE); int* IDX = (int*)(ws + WS_IDX); int* SLOT = (int*)(ws + WS_SLOT); \
    (void)BIN; (void)XF; (void)XB; (void)H; (void)XS; (void)HID; (void)YE; (void)GI; (void)ATTO; (void)ATTL; (void)YS; (void)MGF; (void)MGB; (void)QC; (void)KC; (void)DC; (void)DG; (void)AFF; (void)GATE; (void)IDX; (void)SLOT
__device__ __forceinline__ void tr_item(const float* W, int ldw, int k0, int n0, int ncols, bf16* WT, int ldt, int trow0, LAS float* scr, int lane) {
    const int c4 = lane & 7, r = lane >> 3; const bool cv = 4 * c4 < ncols;
    f32x4 tv[8];
#pragma unroll
    for (int i = 0; i < 8; ++i) tv[i] = cv ? __builtin_nontemporal_load((const f32x4*)(W + (size_t)(k0 + r + 8 * i) * ldw + n0 + 4 * c4)) : (f32x4){0.f, 0.f, 0.f, 0.f};
#pragma unroll
    for (int i = 0; i < 8; ++i) { LAS float* d = scr + (r + 8 * i) * 33 + 4 * c4; d[0] = tv[i][0]; d[1] = tv[i][1]; d[2] = tv[i][2]; d[3] = tv[i][3]; }
    LDS_WAIT(); asm volatile("" ::: "memory");
    const int ch = lane & 7;
#pragma unroll
    for (int j = 0; j < 4; ++j) { const int n = (lane >> 3) + 8 * j; const LAS float* s = scr + (8 * ch) * 33 + n;
        u32x4 o; o.x = pk2(s[0 * 33], s[1 * 33]); o.y = pk2(s[2 * 33], s[3 * 33]); o.z = pk2(s[4 * 33], s[5 * 33]); o.w = pk2(s[6 * 33], s[7 * 33]);
        if (n < ncols) *(GAS u32x4*)(WT + (size_t)(trow0 + n) * ldt + k0 + 8 * ch) = o; }
    LDS_WAIT(); asm volatile("" ::: "memory");
}
constexpr int IT_IN = 16 * 209, IT_B = 512, IT_O = 512, IT_13 = 16384, IT_2 = 8192, IT_LAYER = IT_IN + IT_B + IT_O + IT_13 + IT_2;
__device__ __forceinline__ void convert_layer(int l, int gw, int NGW) {
    FRAME_SETUP;
    WS_PTRS; const float* w_in = inp(I_WIN); const float* w_branch = inp(I_WBR); const float* w_out = inp(I_WOUT); const float* w_e1 = inp(I_WE1); const float* w_e3 = inp(I_WE3); const float* w_e2 = inp(I_WE2);
    LAS float* scr = (LAS float*)(F.lds + F.wave * 16384);
    const int lane = F.lane;
    for (int it = gw; it < IT_LAYER; it += NGW) {
        int r = it; const float* W; int ldw, k0, n0, nc = 32, ldt, trow; bf16* WT;
        if (r < IT_IN) { const int kb = r / 209, cb = r % 209; k0 = 64 * kb;
            if (cb < 72) { n0 = 32 * cb; trow = n0; } else if (cb < 208) { n0 = 2320 + 32 * (cb - 72); trow = 2304 + 32 * (cb - 72); } else { n0 = 2304; trow = 6656; nc = 16; }
            W = w_in + (size_t)l * D * NIN; ldw = NIN; WT = wl(ws, l, OW_IN); ldt = D; }
        else if ((r -= IT_IN) < IT_B) { const int n = r / 128, q = r % 128, kb = q / 32, nb = q % 32;
            W = w_branch + ((size_t)(l * 4 + n) * 256) * D; ldw = D; k0 = 64 * kb; n0 = 32 * nb; WT = wl(ws, l, OW_B) + (size_t)n * 256; ldt = D; trow = 32 * nb; }
        else if ((r -= IT_B) < IT_O) { const int kb = r / 32, nb = r % 32;
            W = w_out + (size_t)l * D * D; ldw = D; k0 = 64 * kb; n0 = 32 * nb; WT = wl(ws, l, OW_O); ldt = D; trow = 32 * nb; }
        else if ((r -= IT_O) < IT_13) { const int e = r / 1024, q = r % 1024, which = q / 512, q2 = q % 512, kb = q2 / 32, nb = q2 % 32, f0 = 32 * nb;
            W = (which ? w_e3 : w_e1) + ((size_t)(l * NE + e) * D) * FF; ldw = FF; k0 = 64 * kb; n0 = f0; WT = wl(ws, l, OW_13) + (size_t)e * 2048 * D; ldt = D; trow = (f0 / 128) * 256 + (f0 % 128) + which * 128; }
        else { r -= IT_13; const int e = r / 512, q = r % 512, kb = q / 32, nb = q % 32;
            W = w_e2 + ((size_t)(l * NE + e) * FF) * D; ldw = D; k0 = 64 * kb; n0 = 32 * nb; WT = wl(ws, l, OW_2) + (size_t)e * D * FF; ldt = FF; trow = 32 * nb; }
        tr_item(W, ldw, k0, n0, nc, WT, ldt, trow, scr, lane);
    }
}
__device__ __forceinline__ void p0_prologue() {
    FRAME_SETUP;
    WS_PTRS; const float* x = inp(I_X); const float* b_in = inp(I_BIN);
    convert_layer(0, F.bid * NWAVES + F.wave, F.G * NWAVES);
    const int gt = F.bid * NTHREADS + F.tid, NGT = F.G * NTHREADS;
    for (int i = gt; i < DEPTH * 240 * (D / 8); i += NGT) { const int l = i / (240 * (D / 8)), r = i % (240 * (D / 8));
        *(GAS u32x4*)(wl(ws, l, OW_IN) + (size_t)NIN * D + (size_t)r * 8) = (u32x4){F.zu, F.zu, F.zu, F.zu}; }
    for (int i = gt; i < DEPTH * NINP; i += NGT) { const int l = i / NINP, c = i % NINP;
        float v = 0.f; if (c < 2304) v = b_in[l * NIN + c]; else if (c < NH) v = b_in[l * NIN + c + 16]; else if (c < NH + 16) v = b_in[l * NIN + c - NH + 2304];
        BIN[i] = v; }
    { const float* gm_ws = inp(I_GMWS); bf16* WSB = (bf16*)(ws + WS_WSB);
      for (int i = gt; i < DEPTH * 4 * 128 * 128 / 4; i += NGT) { const f32x4 v = ((const GAS f32x4*)gm_ws)[i]; u32x2 w; w.x = pk2(v.x, v.y); w.y = pk2(v.z, v.w); ((GAS u32x2*)WSB)[i] = w; } }
    { const float* pool_w = inp(I_POOLW); bf16* PWT = (bf16*)(ws + WS_PWT);
      for (int i = gt; i < DEPTH * 4 * 64 * 64; i += NGT) { const int lg = i >> 12, o = (i >> 6) & 63, ii = i & 63; PWT[i] = (bf16)f2bf(pool_w[(size_t)lg * 4096 + ii * 64 + o]); } }
    { const float* w_router = inp(I_WR); bf16* WRT = (bf16*)(ws + WS_WRT);
      for (int i = gt; i < DEPTH * NE * D; i += NGT) { const int ll = i / (NE * D), e = (i / D) % NE, d = i % D; WRT[i] = (bf16)f2bf(w_router[((size_t)ll * D + d) * NE + e]); } }
    for (int i = gt; i < T * D / 4; i += NGT) { const f32x4 v = ((const GAS f32x4*)x)[i];
        u32x2 w; w.x = pk2(v.x, v.y); w.y = pk2(v.z, v.w); ((GAS u32x2*)XB)[i] = w; }
}

typedef f32x4 Acc[2][2][4][2];
struct SchedG1 { int G, c; const char* A; const char* B;
    __device__ __forceinline__ void a_off(const pg8::Unit&, int lda, const int (&Ri)[2], const int (&Ci)[2], unsigned (&v0)[2], unsigned (&v1)[2]) const {
#pragma unroll
        for (int i = 0; i < 2; ++i) { v0[i] = (unsigned)(Ri[i] * lda + Ci[i]) * 2u; v1[i] = v0[i] + (unsigned)(128 * lda * 2); } }
    __device__ __forceinline__ bool next(int i, pg8::Unit& u) const { int pm, pn; if (!pg8::tile_of(i, G, c, T / 256, NINP / 256, pm, pn)) return false;
        u.pm = pm; u.pn = pn; u.aux = 0; u.A = A + (size_t)pm * 256 * D * 2; u.B = B + (size_t)pn * 256 * D * 2; return true; } };
struct EpiG1 { static constexpr bool PERM = true, HOOK = false; bf16* H; float* GI; const float* bias;
    struct Pre { f32x4 bv[2][2]; };
    __device__ __forceinline__ void prefetch(const pg8::Unit& u, int wr, int wc, int fr, int fq, Pre& p) const { const int col0 = u.pn * 256 + wc * 32 + 8 * fq;
#pragma unroll
        for (int bj = 0; bj < 2; ++bj)
#pragma unroll
            for (int n = 0; n < 2; ++n) p.bv[bj][n] = *(const f32x4*)(bias + col0 + bj * 128 + 4 * n); }
    __device__ __forceinline__ void operator()(const Acc& acc, const pg8::Unit& u, int wr, int wc, int fr, int fq, const Pre& pre) const {
        const int row0 = u.pm * 256 + wr * 64 + fr;
        if (u.pn < 26) {
            const int col0 = u.pn * 256 + wc * 32 + 8 * fq; const bool act = u.pn < 2, sg = u.pn >= 10;
#pragma unroll
            for (int ai = 0; ai < 2; ++ai)
#pragma unroll
                for (int m = 0; m < 4; ++m) { bf16* rowp = H + (size_t)(row0 + ai * 128 + m * 16) * NH + col0;
#pragma unroll
                    for (int bj = 0; bj < 2; ++bj) { f32x4 v0 = acc[ai][bj][m][0] + pre.bv[bj][0], v1 = acc[ai][bj][m][1] + pre.bv[bj][1];
                        if (act) { v0 = (f32x4){gelu_tanh(v0[0]), gelu_tanh(v0[1]), gelu_tanh(v0[2]), gelu_tanh(v0[3])}; v1 = (f32x4){gelu_tanh(v1[0]), gelu_tanh(v1[1]), gelu_tanh(v1[2]), gelu_tanh(v1[3])}; }
                        if (sg) {
                            u32x2 qb; qb.x = 0u; qb.y = 0u;
#pragma unroll
                            for (int j = 0; j < 4; ++j) { qb.x = __builtin_amdgcn_cvt_pk_u8_f32(sigmoidf_(v0[j]) * 256.0f - 0.5f, j, qb.x); qb.y = __builtin_amdgcn_cvt_pk_u8_f32(sigmoidf_(v1[j]) * 256.0f - 0.5f, j, qb.y); }
                            *(u32x2*)((unsigned char*)(H + (size_t)(row0 + ai * 128 + m * 16) * NH + HG) + (col0 + bj * 128 - HG)) = qb;
                        } else {
                        u32x4 w; w.x = pk2(v0[0], v0[1]); w.y = pk2(v0[2], v0[3]); w.z = pk2(v1[0], v1[1]); w.w = pk2(v1[2], v1[3]);
                        *(u32x4*)(rowp + bj * 128) = w; } } }
        } else if (wc == 0 && fq < 2) {
#pragma unroll
            for (int ai = 0; ai < 2; ++ai)
#pragma unroll
                for (int m = 0; m < 4; ++m) { float* rowp = GI + (size_t)(row0 + ai * 128 + m * 16) * 16 + 8 * fq;
#pragma unroll
                    for (int n = 0; n < 2; ++n) *(f32x4*)(rowp + 4 * n) = acc[ai][0][m][n] + pre.bv[0][n]; }
        }
    } };
struct SchedG2 { int G, c; const char* A; const char* B;
    __device__ __forceinline__ void a_off(const pg8::Unit&, int lda, const int (&Ri)[2], const int (&Ci)[2], unsigned (&v0)[2], unsigned (&v1)[2]) const {
#pragma unroll
        for (int i = 0; i < 2; ++i) { v0[i] = (unsigned)(Ri[i] * lda + Ci[i]) * 2u; v1[i] = v0[i] + (unsigned)(128 * lda * 2); } }
    __device__ __forceinline__ bool next(int i, pg8::Unit& u) const { int pm, pn; if (!pg8::tile_of(i, G, c, T / 256, D / 256, pm, pn)) return false;
        u.pm = pm; u.pn = pn; u.aux = 0; u.A = A + (size_t)pm * 256 * D * 2; u.B = B + (size_t)pn * 256 * D * 2; return true; } };
__device__ __forceinline__ void unq8(const u32x2 w, float (&o)[8]) {
    o[0] = ((float)(w.x & 255u) + 0.5f) * (1.0f / 256.0f); o[1] = ((float)((w.x >> 8) & 255u) + 0.5f) * (1.0f / 256.0f); o[2] = ((float)((w.x >> 16) & 255u) + 0.5f) * (1.0f / 256.0f); o[3] = ((float)(w.x >> 24) + 0.5f) * (1.0f / 256.0f);
    o[4] = ((float)(w.y & 255u) + 0.5f) * (1.0f / 256.0f); o[5] = ((float)((w.y >> 8) & 255u) + 0.5f) * (1.0f / 256.0f); o[6] = ((float)((w.y >> 16) & 255u) + 0.5f) * (1.0f / 256.0f); o[7] = ((float)(w.y >> 24) + 0.5f) * (1.0f / 256.0f); }
struct EpiG2 { static constexpr bool PERM = true, HOOK = true; struct Pre {}; __device__ __forceinline__ void prefetch(const pg8::Unit&, int, int, int, int, Pre&) const {} const bf16* H; bf16* MGB;
    __device__ __forceinline__ void hook(Acc& acc, const pg8::Unit& u, int n, int wr, int wc, int fr, int fq) const {
        const size_t rowb = (size_t)(u.pm * 256 + wr * 64 + fr); const int col0 = u.pn * 256 + wc * 32 + 8 * fq;
        const unsigned char* hp = (const unsigned char*)(H + rowb * NH + HG) + (n - 1) * D + col0;
        u32x2 ga[2][4][2], gb[2][4][2];
#pragma unroll
        for (int ai = 0; ai < 2; ++ai)
#pragma unroll
            for (int m = 0; m < 4; ++m)
#pragma unroll
                for (int bj = 0; bj < 2; ++bj) { const unsigned char* p = hp + (size_t)(ai * 128 + m * 16) * NH * 2 + bj * 128; ga[ai][m][bj] = *(const u32x2*)p; gb[ai][m][bj] = *(const u32x2*)(p + D); }
#pragma unroll
        for (int ai = 0; ai < 2; ++ai)
#pragma unroll
            for (int m = 0; m < 4; ++m)
#pragma unroll
                for (int bj = 0; bj < 2; ++bj) { float sa[8], sb[8]; unq8(ga[ai][m][bj], sa); unq8(gb[ai][m][bj], sb);
                    float r[8];
#pragma unroll
                    for (int j = 0; j < 8; ++j) r[j] = sa[j] * __builtin_amdgcn_rcpf(sb[j]);
                    acc[ai][bj][m][0] *= (f32x4){r[0], r[1], r[2], r[3]}; acc[ai][bj][m][1] *= (f32x4){r[4], r[5], r[6], r[7]}; }
        asm volatile("" ::: "memory");
    }
    __device__ __forceinline__ void operator()(const Acc& acc, const pg8::Unit& u, int wr, int wc, int fr, int fq, const Pre& pre) const {
        const size_t rowb = (size_t)(u.pm * 256 + wr * 64 + fr); const int col0 = u.pn * 256 + wc * 32 + 8 * fq;
        const unsigned char* hp = (const unsigned char*)(H + rowb * NH + HG) + 3 * D + col0; bf16* bp = MGB + rowb * D + col0;
        u32x2 gv[2][4][2];
#pragma unroll
        for (int ai = 0; ai < 2; ++ai)
#pragma unroll
            for (int m = 0; m < 4; ++m)
#pragma unroll
                for (int bj = 0; bj < 2; ++bj) gv[ai][m][bj] = *(const u32x2*)(hp + (size_t)(ai * 128 + m * 16) * NH * 2 + bj * 128);
#pragma unroll
        for (int ai = 0; ai < 2; ++ai)
#pragma unroll
            for (int m = 0; m < 4; ++m)
#pragma unroll
                for (int bj = 0; bj < 2; ++bj) { const int ro = ai * 128 + m * 16; float sv[8]; unq8(gv[ai][m][bj], sv);
                    const f32x4 a0 = acc[ai][bj][m][0], a1 = acc[ai][bj][m][1];
                    u32x4 w; w.x = pk2(a0[0] * sv[0], a0[1] * sv[1]); w.y = pk2(a0[2] * sv[2], a0[3] * sv[3]); w.z = pk2(a1[0] * sv[4], a1[1] * sv[5]); w.w = pk2(a1[2] * sv[6], a1[3] * sv[7]);
                    *(u32x4*)(bp + (size_t)ro * D + bj * 128) = w; }
    } };
struct SchedG3 { int G, c; const char* A; const char* B;
    __device__ __forceinline__ void a_off(const pg8::Unit&, int lda, const int (&Ri)[2], const int (&Ci)[2], unsigned (&v0)[2], unsigned (&v1)[2]) const {
#pragma unroll
        for (int i = 0; i < 2; ++i) { v0[i] = (unsigned)(Ri[i] * lda + Ci[i]) * 2u; v1[i] = v0[i] + (unsigned)(128 * lda * 2); } }
    __device__ __forceinline__ bool next(int i, pg8::Unit& u) const { int pm, pn; if (!pg8::tile_of(i, G, c, T / 256, D / 256, pm, pn)) return false;
        u.pm = pm; u.pn = pn; u.aux = 0; u.A = A + (size_t)pm * 256 * D * 2; u.B = B + (size_t)pn * 256 * D * 2; return true; } };
struct EpiG3 { static constexpr bool PERM = true, HOOK = false; struct Pre {}; __device__ __forceinline__ void prefetch(const pg8::Unit&, int, int, int, int, Pre&) const {} const bf16* XB; bf16* R; float* STAT;
    __device__ __forceinline__ void operator()(const Acc& acc, const pg8::Unit& u, int wr, int wc, int fr, int fq, const Pre& pre) const {
        const int row0 = u.pm * 256 + wr * 64 + fr, col0 = u.pn * 256 + wc * 32 + 8 * fq, lane = fq * 16 + fr;
#pragma unroll
        for (int ai = 0; ai < 2; ++ai) { u32x4 xr[4][2];
#pragma unroll
            for (int m = 0; m < 4; ++m)
#pragma unroll
                for (int bj = 0; bj < 2; ++bj) xr[m][bj] = *(const u32x4*)(XB + (size_t)(row0 + ai * 128 + m * 16) * D + col0 + bj * 128);
#pragma unroll
            for (int m = 0; m < 4; ++m) { const size_t row = (size_t)(row0 + ai * 128 + m * 16); float s1 = 0.f, s2 = 0.f;
#pragma unroll
                for (int bj = 0; bj < 2; ++bj) { const size_t o = row * D + col0 + bj * 128; float x8[8]; unpack8(xr[m][bj], x8);
                    const f32x4 r0 = (f32x4){x8[0], x8[1], x8[2], x8[3]} * ALPHA + acc[ai][bj][m][0], r1 = (f32x4){x8[4], x8[5], x8[6], x8[7]} * ALPHA + acc[ai][bj][m][1];
                    { u32x4 w; w.x = pk2(r0[0], r0[1]); w.y = pk2(r0[2], r0[3]); w.z = pk2(r1[0], r1[1]); w.w = pk2(r1[2], r1[3]); *(u32x4*)(R + o) = w; }
                    s1 += ((r0[0] + r0[1]) + (r0[2] + r0[3])) + ((r1[0] + r1[1]) + (r1[2] + r1[3]));
                    s2 += ((r0[0] * r0[0] + r0[1] * r0[1]) + (r0[2] * r0[2] + r0[3] * r0[3])) + ((r1[0] * r1[0] + r1[1] * r1[1]) + (r1[2] * r1[2] + r1[3] * r1[3])); }
                s1 += shx(s1, 16, lane); s1 += shx(s1, 32, lane); s2 += shx(s2, 16, lane); s2 += shx(s2, 32, lane);
                if (fq == 0) *(f32x2*)(STAT + (row * 16 + u.pn * 4 + wc) * 2) = (f32x2){s1, s2}; } }
    } };
struct SchedG4 { int G, c; const char* A; const char* B; const int* IDX;
    __device__ __forceinline__ bool next(int i, pg8::Unit& u) const { int pm, pn; if (!pg8::tile_of(i, G, c, NSLOT / 256, 2048 / 256, pm, pn)) return false; const int e = (pm >> 2) & 15;
        u.pm = pm; u.pn = pn; u.aux = e; u.A = A + (size_t)(pm >> 6) * SEQ * D * 2; u.B = B + (size_t)e * 2048 * D * 2 + (size_t)pn * 256 * D * 2; return true; }
    __device__ __forceinline__ void a_off(const pg8::Unit& u, int lda, const int (&Ri)[2], const int (&Ci)[2], unsigned (&v0)[2], unsigned (&v1)[2]) const {
#pragma unroll
        for (int i = 0; i < 2; ++i) { const int r0 = IDX[u.pm * 256 + Ri[i]], r1 = IDX[u.pm * 256 + 128 + Ri[i]]; v0[i] = (unsigned)(r0 * lda + Ci[i]) * 2u; v1[i] = (unsigned)(r1 * lda + Ci[i]) * 2u; } } };
struct EpiG4 { static constexpr bool PERM = true, HOOK = false; struct Pre {}; __device__ __forceinline__ void prefetch(const pg8::Unit&, int, int, int, int, Pre&) const {} bf16* HID;
    __device__ __forceinline__ void operator()(const Acc& acc, const pg8::Unit& u, int wr, int wc, int fr, int fq, const Pre& pre) const {
        const int row0 = u.pm * 256 + wr * 64 + fr, col0 = u.pn * 128 + wc * 32 + 8 * fq;
#pragma unroll
        for (int ai = 0; ai < 2; ++ai)
#pragma unroll
            for (int m = 0; m < 4; ++m) { const size_t row = (size_t)(row0 + ai * 128 + m * 16);
                const f32x4 a0 = acc[ai][0][m][0], a1 = acc[ai][0][m][1], g0 = acc[ai][1][m][0], g1 = acc[ai][1][m][1];
                u32x4 w; w.x = pk2(siluf_(a0[0]) * g0[0], siluf_(a0[1]) * g0[1]); w.y = pk2(siluf_(a0[2]) * g0[2], siluf_(a0[3]) * g0[3]);
                w.z = pk2(siluf_(a1[0]) * g1[0], siluf_(a1[1]) * g1[1]); w.w = pk2(siluf_(a1[2]) * g1[2], siluf_(a1[3]) * g1[3]);
                *(u32x4*)(HID + row * FF + col0) = w; }
    } };
struct SchedG5 { int G, c; const char* A; const char* B;
    __device__ __forceinline__ void a_off(const pg8::Unit&, int lda, const int (&Ri)[2], const int (&Ci)[2], unsigned (&v0)[2], unsigned (&v1)[2]) const {
#pragma unroll
        for (int i = 0; i < 2; ++i) { v0[i] = (unsigned)(Ri[i] * lda + Ci[i]) * 2u; v1[i] = v0[i] + (unsigned)(128 * lda * 2); } }
    __device__ __forceinline__ bool next(int i, pg8::Unit& u) const { int pm, pn; if (!pg8::tile_of(i, G, c, NSLOT / 256, D / 256, pm, pn)) return false; const int e = (pm >> 2) & 15;
        u.pm = pm; u.pn = pn; u.aux = e; u.A = A + (size_t)pm * 256 * FF * 2; u.B = B + (size_t)e * D * FF * 2 + (size_t)pn * 256 * FF * 2; return true; } };
struct EpiG5 { static constexpr bool PERM = true, HOOK = false; const float* GATE; bf16* YE;
    struct Pre { float g[2][4]; };
    __device__ __forceinline__ void prefetch(const pg8::Unit& u, int wr, int wc, int fr, int fq, Pre& p) const { const int row0 = u.pm * 256 + wr * 64 + fr;
#pragma unroll
        for (int ai = 0; ai < 2; ++ai)
#pragma unroll
            for (int m = 0; m < 4; ++m) p.g[ai][m] = GATE[row0 + ai * 128 + m * 16]; }
    __device__ __forceinline__ void operator()(const Acc& acc, const pg8::Unit& u, int wr, int wc, int fr, int fq, const Pre& pre) const {
        const int row0 = u.pm * 256 + wr * 64 + fr, col0 = u.pn * 256 + wc * 32 + 8 * fq;
#pragma unroll
        for (int ai = 0; ai < 2; ++ai)
#pragma unroll
            for (int m = 0; m < 4; ++m) { const size_t row = (size_t)(row0 + ai * 128 + m * 16); const float gt = pre.g[ai][m];
#pragma unroll
                for (int bj = 0; bj < 2; ++bj) { const f32x4 v0 = acc[ai][bj][m][0] * gt, v1 = acc[ai][bj][m][1] * gt;
                    u32x4 w; w.x = pk2(v0[0], v0[1]); w.y = pk2(v0[2], v0[3]); w.z = pk2(v1[0], v1[1]); w.w = pk2(v1[2], v1[3]);
                    *(u32x4*)(YE + row * D + col0 + bj * 128) = w; } }
    } };

typedef float f32x16 __attribute__((ext_vector_type(16)));
typedef short s16x4 __attribute__((ext_vector_type(4)));
typedef __bf16 bf16x2_t __attribute__((ext_vector_type(2)));
#define MFMA32(a, b, c) __builtin_amdgcn_mfma_f32_32x32x16_bf16((a), (b), (c), 0, 0, 0)
__device__ __forceinline__ int crow(int reg, int h) { return (reg & 3) + 8 * (reg >> 2) + 4 * h; }
__device__ __forceinline__ unsigned cvtpk(float lo, float hi) { f32x2 v = {lo, hi}; bf16x2_t b = __builtin_convertvector(v, bf16x2_t); return __builtin_bit_cast(unsigned, b); }
__device__ __forceinline__ bf16x8 pack8(float a0, float a1, float a2, float a3, float a4, float a5, float a6, float a7) {
    u32x4 p; p.x = cvtpk(a0, a1); p.y = cvtpk(a2, a3); p.z = cvtpk(a4, a5); p.w = cvtpk(a6, a7); return __builtin_bit_cast(bf16x8, p); }
typedef short v4i16_t __attribute__((ext_vector_type(4)));
__device__ __forceinline__ s16x4 tr_rd(const LAS unsigned char* p) { return __builtin_bit_cast(s16x4, __builtin_amdgcn_ds_read_tr16_b64_v4i16((LAS v4i16_t*)p)); }
__device__ __forceinline__ bf16x8 tr_frag(const LAS unsigned char* img, int pitch, int k0, int k1, int col0, int lane) {
    const int i16 = lane & 15, qd = i16 >> 2, p = i16 & 3, blk = (lane >> 4) & 1;
    const s16x4 lo = tr_rd(img + (k0 + qd) * pitch + (col0 + 16 * blk + 4 * p) * 2), hi = tr_rd(img + (k1 + qd) * pitch + (col0 + 16 * blk + 4 * p) * 2);
    return __builtin_shufflevector(lo, hi, 0, 1, 2, 3, 4, 5, 6, 7); }
constexpr int C1_ITEM_LDS = 3 * 64 * 144 + 2048;
__device__ __forceinline__ void mlstm_c1m(int l, int bi) {
    FRAME_SETUP; WS_PTRS; const float* ml_conv = inp(I_MLCONV); const float* ml_fbias = inp(I_MLFB);
    const int tid = F.tid, lane = F.lane, w = F.wave, dir = w & 1, jj = w >> 1, tp = tid & 127;
    const int item = bi * 4 + jj, c = item & 127, h = (item >> 7) & 3, b = item >> 9;
    const int p0 = b * SEQ + c * 64, hc = h * 64;
    LAS unsigned char* base = F.lds + jj * C1_ITEM_LDS;
    LAS unsigned char* Vt = base; LAS unsigned char* K0 = base + 64 * 144; LAS unsigned char* K1 = base + 2 * 64 * 144; LAS float* wT = (LAS float*)(base + 3 * 64 * 144);
    const int chain = ((dir * 2 + b) * 4 + h) * 128 + c; bf16* dc = DC + (size_t)chain * 4160;
    u32x4 cq[4][3], ck[4][3], cv[4]; bool rok[4][3];
    const int cg = (tp & 7) * 8, r0 = tp >> 3;
#pragma unroll
    for (int i = 0; i < 4; ++i) { const int row = r0 + 16 * i, sq = c * 64 + row;
#pragma unroll
        for (int dr = 0; dr < 3; ++dr) { rok[i][dr] = (sq + dr - 1 >= 0) && (sq + dr - 1 < SEQ); const int sc = min(max(sq + dr - 1, 0), SEQ - 1); const bf16* r2 = H + (size_t)(b * SEQ + sc) * NH;
            cq[i][dr] = *(const u32x4*)(r2 + HCQ + hc + cg); ck[i][dr] = *(const u32x4*)(r2 + HCK + hc + cg); }
        cv[i] = *(const u32x4*)(H + (size_t)(p0 + row) * NH + HCV + hc + cg); }
    f32x4 cwq[3][2], cwk[3][2];
    { const float* cw = ml_conv + (size_t)l * 3 * 512;
#pragma unroll
      for (int dr = 0; dr < 3; ++dr) { cwq[dr][0] = *(const f32x4*)(cw + dr * 512 + hc + cg); cwq[dr][1] = *(const f32x4*)(cw + dr * 512 + hc + cg + 4); cwk[dr][0] = *(const f32x4*)(cw + dr * 512 + 256 + hc + cg); cwk[dr][1] = *(const f32x4*)(cw + dr * 512 + 256 + hc + cg + 4); } }
    { const float* gi = GI + (size_t)(p0 + lane) * 16; const float li = gi[dir * 4 + h]; float cum = logsigmoidf_(gi[8 + dir * 4 + h] + ml_fbias[l * 8 + dir * 4 + h]);
#pragma unroll
        for (int off = 1; off < 64; off <<= 1) { const int src = dir ? lane + off : lane - off; const float v = __int_as_float(__builtin_amdgcn_ds_bpermute((src & 63) << 2, __float_as_int(cum))); if (src >= 0 && src < 64) cum += v; }
        const float g = __int_as_float(__builtin_amdgcn_ds_bpermute((dir ? 0 : 63) << 2, __float_as_int(cum)));
        wT[dir * 64 + lane] = __expf(g - cum + li); if (lane == 0) DG[chain] = g; }
    __syncthreads();
    {
#pragma unroll
        for (int i = 0; i < 4; ++i) { const int row = r0 + 16 * i; const float w0 = wT[row], w1 = wT[64 + row];
            float qv[8], kv[8];
#pragma unroll
            for (int j = 0; j < 8; ++j) { qv[j] = 0.f; kv[j] = 0.f; }
#pragma unroll
            for (int dr = 0; dr < 3; ++dr) { const float m = rok[i][dr] ? 1.f : 0.f; float q8[8], k8[8]; unpack8(cq[i][dr], q8); unpack8(ck[i][dr], k8);
#pragma unroll
                for (int j = 0; j < 8; ++j) { qv[j] += m * cwq[dr][j >> 2][j & 3] * q8[j]; kv[j] += m * cwk[dr][j >> 2][j & 3] * k8[j]; } }
#pragma unroll
            for (int j = 0; j < 8; ++j) { qv[j] = siluf_(qv[j]); kv[j] = siluf_(kv[j]) * 0.125f; }
            u32x4 wq, wk, wk0, wk1; wq.x = pk2(qv[0], qv[1]); wq.y = pk2(qv[2], qv[3]); wq.z = pk2(qv[4], qv[5]); wq.w = pk2(qv[6], qv[7]); wk.x = pk2(kv[0], kv[1]); wk.y = pk2(kv[2], kv[3]); wk.z = pk2(kv[4], kv[5]); wk.w = pk2(kv[6], kv[7]);
            wk0.x = pk2(kv[0] * w0, kv[1] * w0); wk0.y = pk2(kv[2] * w0, kv[3] * w0); wk0.z = pk2(kv[4] * w0, kv[5] * w0); wk0.w = pk2(kv[6] * w0, kv[7] * w0);
            wk1.x = pk2(kv[0] * w1, kv[1] * w1); wk1.y = pk2(kv[2] * w1, kv[3] * w1); wk1.z = pk2(kv[4] * w1, kv[5] * w1); wk1.w = pk2(kv[6] * w1, kv[7] * w1);
            *(u32x4*)(QC + (size_t)(p0 + row) * 256 + hc + cg) = wq; *(u32x4*)(KC + (size_t)(p0 + row) * 256 + hc + cg) = wk;
            *(LAS u32x4*)(K0 + row * 144 + cg * 2) = wk0; *(LAS u32x4*)(K1 + row * 144 + cg * 2) = wk1; *(LAS u32x4*)(Vt + row * 144 + cg * 2) = cv[i]; }
    }
    __syncthreads();
    {
        const int tl = lane & 31, hh = lane >> 5; const LAS unsigned char* Kimg = dir ? K1 : K0;
#pragma unroll
        for (int kt = 0; kt < 2; ++kt) { bf16x8 kf[4]; float dn = 0.f;
#pragma unroll
            for (int ks = 0; ks < 4; ++ks) { kf[ks] = tr_frag(Kimg, 144, 16 * ks + 8 * hh, 16 * ks + 8 * hh + 4, 32 * kt, lane); float k8[8]; unpack8(__builtin_bit_cast(u32x4, kf[ks]), k8);
#pragma unroll
                for (int j = 0; j < 8; ++j) dn += k8[j]; }
            dn += shx(dn, 32, lane); if (hh == 0) dc[4096 + 32 * kt + tl] = (bf16)f2bf(dn);
#pragma unroll
            for (int vt = 0; vt < 2; ++vt) { f32x16 acc;
#pragma unroll
                for (int i = 0; i < 16; ++i) acc[i] = F.zf;
#pragma unroll
                for (int ks = 0; ks < 4; ++ks) { const bf16x8 vf = tr_frag(Vt, 144, 16 * ks + 8 * hh, 16 * ks + 8 * hh + 4, 32 * vt, lane); acc = MFMA32(kf[ks], vf, acc); }
#pragma unroll
                for (int g4 = 0; g4 < 4; ++g4) { u32x2 wv; wv.x = pk2(acc[4 * g4], acc[4 * g4 + 1]); wv.y = pk2(acc[4 * g4 + 2], acc[4 * g4 + 3]); *(u32x2*)(dc + (32 * vt + tl) * 64 + 32 * kt + 8 * g4 + 4 * hh) = wv; } } }
    }
    __syncthreads();
}
constexpr int GM_PITCH = 576;
__device__ __forceinline__ void gmlp_m(int l, int item) {
    FRAME_SETUP; WS_PTRS; const float* gm_ln_g = inp(I_GMLNG); const float* gm_bs = inp(I_GMBS); const bf16* WSB = (const bf16*)(ws + WS_WSB);
    const int tid = F.tid, lane = F.lane, w = F.wave;
    const int b = item >> 6, ch = item & 63, p0 = b * SEQ + ch * 128;
    LAS unsigned char* vn = F.lds;
    {
        const int part = tid & 7; const float* lgp = gm_ln_g + l * 256;
        u32x4 raw[2][4];
#pragma unroll
        for (int rr = 0; rr < 2; ++rr)
#pragma unroll
            for (int q = 0; q < 4; ++q) raw[rr][q] = *(const u32x4*)(H + (size_t)(p0 + (tid >> 3) + 64 * rr) * NH + HV + (part + 8 * q) * 8);
#pragma unroll
        for (int rr = 0; rr < 2; ++rr) { const int row = (tid >> 3) + 64 * rr; float s = 0.f, s2 = 0.f;
#pragma unroll
            for (int q = 0; q < 4; ++q) { float v8[8]; unpack8(raw[rr][q], v8);
#pragma unroll
                for (int j = 0; j < 8; ++j) { s += v8[j]; s2 += v8[j] * v8[j]; } }
            s += shx(s, 1, lane); s += shx(s, 2, lane); s += shx(s, 4, lane); s2 += shx(s2, 1, lane); s2 += shx(s2, 2, lane); s2 += shx(s2, 4, lane);
            const float mean = s * (1.0f / 256.0f), var = fmaxf(s2 * (1.0f / 256.0f) - mean * mean, 0.f), rstd = 1.0f / sqrtf(var + LN_EPS);
#pragma unroll
            for (int q = 0; q < 4; ++q) { const int c0 = (part + 8 * q) * 8; float v8[8]; unpack8(raw[rr][q], v8); const f32x4 g0 = *(const f32x4*)(lgp + c0), g1 = *(const f32x4*)(lgp + c0 + 4);
                u32x4 o; o.x = pk2((v8[0] - mean) * rstd * g0[0], (v8[1] - mean) * rstd * g0[1]); o.y = pk2((v8[2] - mean) * rstd * g0[2], (v8[3] - mean) * rstd * g0[3]);
                o.z = pk2((v8[4] - mean) * rstd * g1[0], (v8[5] - mean) * rstd * g1[1]); o.w = pk2((v8[6] - mean) * rstd * g1[2], (v8[7] - mean) * rstd * g1[3]);
                *(LAS u32x4*)(vn + row * GM_PITCH + c0 * 2) = o; } }
    }
    __syncthreads();
    {
        const int g = w >> 1, ph = w & 1, tl = lane & 31, hh = lane >> 5;
#pragma unroll 1
        for (int pt = 0; pt < 2; ++pt) { const int p = 64 * ph + 32 * pt + tl; const size_t tok = (size_t)p0 + p;
            f32x16 M[2];
#pragma unroll
            for (int dt = 0; dt < 2; ++dt)
#pragma unroll
                for (int i = 0; i < 16; ++i) M[dt][i] = F.zf;
            const bf16* wrow = WSB + ((size_t)(l * 4 + g) * 128 + p) * 128 + 8 * hh;
#pragma unroll
            for (int ks = 0; ks < 8; ++ks) { const bf16x8 wf = *(const bf16x8*)(wrow + 16 * ks);
#pragma unroll
                for (int dt = 0; dt < 2; ++dt) { const bf16x8 vf = tr_frag(vn, GM_PITCH, 16 * ks + 8 * hh, 16 * ks + 8 * hh + 4, g * 64 + 32 * dt, lane); M[dt] = MFMA32(vf, wf, M[dt]); } }
            const float bsv = gm_bs[(size_t)(l * 4 + g) * 128 + p];
#pragma unroll
            for (int dt = 0; dt < 2; ++dt)
#pragma unroll
                for (int gg = 0; gg < 4; ++gg) { const int d = g * 64 + 32 * dt + 8 * gg + 4 * hh; const u32x2 uw = *(const u32x2*)(H + tok * NH + HU + d);
                    const float u0 = __uint_as_float(uw.x << 16), u1 = __uint_as_float(uw.x & 0xffff0000u), u2 = __uint_as_float(uw.y << 16), u3 = __uint_as_float(uw.y & 0xffff0000u);
                    u32x2 o; o.x = pk2(u0 * (M[dt][4 * gg] + bsv), u1 * (M[dt][4 * gg + 1] + bsv)); o.y = pk2(u2 * (M[dt][4 * gg + 2] + bsv), u3 * (M[dt][4 * gg + 3] + bsv));
                    *(u32x2*)(YS + tok * D + d) = o; } }
    }
    __syncthreads();
}
__device__ __forceinline__ void mlstm_scan(int wi) {
    FRAME_SETUP;
    WS_PTRS;
    const int lane = F.lane, chain = wi / 17, quad = (wi % 17) * 64 + lane, dir = chain >> 3, base = chain * 128;
    const bool on = quad < 1040;
    const int e = on ? 4 * quad : 0;
    const float d0 = __expf(DG[base + (dir ? 127 - lane : lane)]), d1 = __expf(DG[base + (dir ? 63 - lane : 64 + lane)]);
    f32x4 S = {0.f, 0.f, 0.f, 0.f};
#pragma unroll 1
    for (int i0 = 0; i0 < 128; i0 += 32) {
        u32x2 tmp[32];
#pragma unroll
        for (int j = 0; j < 32; ++j) { const int c = dir ? 127 - (i0 + j) : (i0 + j); tmp[j] = *(const u32x2*)(DC + (size_t)(base + c) * 4160 + e); }
#pragma unroll
        for (int j = 0; j < 32; ++j) { const int c = dir ? 127 - (i0 + j) : (i0 + j);
            const float dec = (i0 < 64) ? __int_as_float(__builtin_amdgcn_readlane(__float_as_int(d0), (i0 & 63) + j)) : __int_as_float(__builtin_amdgcn_readlane(__float_as_int(d1), (i0 & 63) + j));
            if (on) { u32x2 wv; wv.x = pk2(S[0], S[1]); wv.y = pk2(S[2], S[3]); *(u32x2*)(DC + (size_t)(base + c) * 4160 + e) = wv; }
            const f32x4 t = (f32x4){__uint_as_float(tmp[j].x << 16), __uint_as_float(tmp[j].x & 0xffff0000u), __uint_as_float(tmp[j].y << 16), __uint_as_float(tmp[j].y & 0xffff0000u)};
            S = S * dec + t; }
    }
}
constexpr int C3_ITEM_LDS = 20480, C3_PITCH = 144;
__device__ __forceinline__ void mlstm_c3m(int l, int bi) {
    FRAME_SETUP; WS_PTRS; const float* ml_fbias = inp(I_MLFB); const float* ml_norm_g = inp(I_MLNG);
    const int tid = F.tid, lane = F.lane, w = F.wave, dir = w & 1, jj = w >> 1, tp = tid & 127;
    const int item = bi * 4 + jj, c = item & 127, h = (item >> 7) & 3, b = item >> 9;
    const int p0 = b * SEQ + c * 64, hc = h * 64;
    LAS unsigned char* base = F.lds + jj * C3_ITEM_LDS;
    LAS unsigned char* Kt = base; LAS unsigned char* Vt = base + 64 * C3_PITCH;
    LAS float* tab = (LAS float*)(base + 2 * 64 * C3_PITCH);
    LAS float* cumT = tab + dir * 64; LAS float* liT = tab + 128 + dir * 64; LAS float* nsT = tab + 256 + dir * 64;
    LAS float* hbuf = (LAS float*)base;
    const int chain = ((dir * 2 + b) * 4 + h) * 128 + c; const bf16* dc = DC + (size_t)chain * 4160;
    { u32x4 k8[4], v8[4];
#pragma unroll
        for (int u = 0; u < 4; ++u) { const int i = tp + 128 * u, row = i >> 3, cg = (i & 7) * 8; k8[u] = *(const u32x4*)(KC + (size_t)(p0 + row) * 256 + hc + cg); v8[u] = *(const u32x4*)(H + (size_t)(p0 + row) * NH + HCV + hc + cg); }
#pragma unroll
        for (int u = 0; u < 4; ++u) { const int i = tp + 128 * u, row = i >> 3, cg = (i & 7) * 8; *(LAS u32x4*)(Kt + row * C3_PITCH + cg * 2) = k8[u]; *(LAS u32x4*)(Vt + row * C3_PITCH + cg * 2) = v8[u]; } }
    { const float* gi = GI + (size_t)(p0 + lane) * 16; const float li = gi[dir * 4 + h]; float cum = logsigmoidf_(gi[8 + dir * 4 + h] + ml_fbias[l * 8 + dir * 4 + h]);
#pragma unroll
        for (int off = 1; off < 64; off <<= 1) { const int src = dir ? lane + off : lane - off; const float v = __int_as_float(__builtin_amdgcn_ds_bpermute((src & 63) << 2, __float_as_int(cum))); if (src >= 0 && src < 64) cum += v; }
        cumT[lane] = cum; liT[lane] = li - cum; nsT[lane] = bf2f(dc[4096 + lane]); }
    __syncthreads();
    const int tl = lane & 31, hh = lane >> 5;
    f32x16 Hh[2][2];
#pragma unroll
    for (int tt = 0; tt < 2; ++tt) {
        const int t = 32 * tt + tl; const size_t tok = (size_t)p0 + t;
        const float ct = cumT[t], ewt = __expf(ct);
        bf16x8 qf[4], qf2[4]; float nqp = 0.f;
#pragma unroll
        for (int ks = 0; ks < 4; ++ks) { const u32x4 raw = *(const u32x4*)(QC + tok * 256 + hc + 16 * ks + 8 * hh); qf[ks] = __builtin_bit_cast(bf16x8, raw);
            float q8[8]; unpack8(raw, q8);
#pragma unroll
            for (int j = 0; j < 8; ++j) { q8[j] *= ewt; nqp += nsT[16 * ks + 8 * hh + j] * q8[j]; }
            qf2[ks] = pack8(q8[0], q8[1], q8[2], q8[3], q8[4], q8[5], q8[6], q8[7]); }
        f32x16 S[2]; float denp = 0.f;
#pragma unroll
        for (int st = 0; st < 2; ++st) {
#pragma unroll
            for (int i = 0; i < 16; ++i) S[st][i] = F.zf;
#pragma unroll
            for (int ks = 0; ks < 4; ++ks) { const bf16x8 kf = *(const LAS bf16x8*)(Kt + (32 * st + tl) * C3_PITCH + (16 * ks + 8 * hh) * 2); S[st] = MFMA32(kf, qf[ks], S[st]); }
#pragma unroll
            for (int i = 0; i < 16; ++i) { const int sidx = 32 * st + crow(i, hh); const bool valid = dir ? (sidx >= t) : (sidx <= t);
                const float arg = ct + liT[sidx]; const float wgt = __expf(valid ? arg : -1e30f); const float pv = S[st][i] * wgt; S[st][i] = pv; denp += pv; }
            __builtin_amdgcn_sched_barrier(0); }
        const float dn = (denp + shx(denp, 32, lane)) + (nqp + shx(nqp, 32, lane));
        const float inv = 1.0f / fmaxf(fabsf(dn), 1.0f);
#pragma unroll
        for (int vt = 0; vt < 2; ++vt) { f32x16 N;
#pragma unroll
            for (int i = 0; i < 16; ++i) N[i] = F.zf;
#pragma unroll
            for (int st = 0; st < 2; ++st)
#pragma unroll
                for (int s2 = 0; s2 < 2; ++s2) { const bf16x8 pf = pack8(S[st][8 * s2], S[st][8 * s2 + 1], S[st][8 * s2 + 2], S[st][8 * s2 + 3], S[st][8 * s2 + 4], S[st][8 * s2 + 5], S[st][8 * s2 + 6], S[st][8 * s2 + 7]);
                    const int k0 = 32 * st + 16 * s2 + 4 * hh; const bf16x8 vf = tr_frag(Vt, C3_PITCH, k0, k0 + 8, 32 * vt, lane); N = MFMA32(vf, pf, N); }
#pragma unroll
            for (int ks = 0; ks < 4; ++ks) { const bf16x8 cf = *(const bf16x8*)(dc + (32 * vt + tl) * 64 + 16 * ks + 8 * hh); N = MFMA32(cf, qf2[ks], N); }
#pragma unroll
            for (int i = 0; i < 16; ++i) Hh[tt][vt][i] = N[i] * inv; }
    }
    __syncthreads();
    if (dir == 1) {
#pragma unroll
        for (int tt = 0; tt < 2; ++tt)
#pragma unroll
            for (int vt = 0; vt < 2; ++vt)
#pragma unroll
                for (int i = 0; i < 16; ++i) hbuf[(32 * tt + tl) * 65 + 32 * vt + crow(i, hh)] = Hh[tt][vt][i]; }
    __syncthreads();
    if (dir == 0) {
#pragma unroll
        for (int tt = 0; tt < 2; ++tt) { const int t = 32 * tt + tl; const size_t tok = (size_t)p0 + t; float s1 = 0.f;
#pragma unroll
            for (int vt = 0; vt < 2; ++vt)
#pragma unroll
                for (int i = 0; i < 16; ++i) { const float x = Hh[tt][vt][i] + hbuf[t * 65 + 32 * vt + crow(i, hh)]; Hh[tt][vt][i] = x; s1 += x; }
            const float mu = (s1 + shx(s1, 32, lane)) * (1.0f / 64.0f); float s2 = 0.f;
#pragma unroll
            for (int vt = 0; vt < 2; ++vt)
#pragma unroll
                for (int i = 0; i < 16; ++i) { const float dv = Hh[tt][vt][i] - mu; s2 += dv * dv; }
            const float rstd = 1.0f / sqrtf((s2 + shx(s2, 32, lane)) * (1.0f / 64.0f) + LN_EPS);
#pragma unroll
            for (int vt = 0; vt < 2; ++vt)
#pragma unroll
                for (int g = 0; g < 4; ++g) { const int v = 32 * vt + 8 * g + 4 * hh;
                    const u32x2 cw = *(const u32x2*)(H + tok * NH + HCO + hc + v); const f32x4 ng = *(const f32x4*)(ml_norm_g + l * 256 + hc + v);
                    const float o0 = __uint_as_float(cw.x << 16), o1 = __uint_as_float(cw.x & 0xffff0000u), o2 = __uint_as_float(cw.y << 16), o3 = __uint_as_float(cw.y & 0xffff0000u);
                    u32x2 wv; wv.x = pk2((Hh[tt][vt][4 * g] - mu) * rstd * ng[0] * sigmoidf_(o0), (Hh[tt][vt][4 * g + 1] - mu) * rstd * ng[1] * sigmoidf_(o1));
                    wv.y = pk2((Hh[tt][vt][4 * g + 2] - mu) * rstd * ng[2] * sigmoidf_(o2), (Hh[tt][vt][4 * g + 3] - mu) * rstd * ng[3] * sigmoidf_(o3));
                    *(u32x2*)(YS + tok * D + 512 + hc + v) = wv; } }
    }
    __syncthreads();
}
__device__ __forceinline__ void pool_m(int l, int witem) {
    FRAME_SETUP; WS_PTRS; const float* pool_scale = inp(I_POOLS); const bf16* PWT = (const bf16*)(ws + WS_PWT);
    const int lane = F.lane, tl = lane & 31, hh = lane >> 5;
    const int g = witem & 3, tb = witem >> 2, tok0 = tb * 32, b = tok0 >> 13, s = (tok0 & (SEQ - 1)) + tl, half = 1 << g, W = 2 * half;
    const int lo = max(s - half, 0), hi = min(s + half, SEQ); const float inv = 1.0f / (float)(hi - lo);
    const bf16* hb = H + (size_t)b * SEQ * NH + HDX + g * 64 + 8 * hh;
    const size_t tok = (size_t)tok0 + tl;
    f32x16 acc[2];
#pragma unroll
    for (int ot = 0; ot < 2; ++ot)
#pragma unroll
        for (int i = 0; i < 16; ++i) acc[ot][i] = F.zf;
#pragma unroll 1
    for (int ks = 0; ks < 4; ++ks) { float a8[8];
#pragma unroll
        for (int q = 0; q < 8; ++q) a8[q] = 0.f;
#pragma unroll 1
        for (int j0 = 0; j0 < W; j0 += 4) { u32x4 raw[4];
#pragma unroll
            for (int j = 0; j < 4; ++j) { const int sp = min(max(s - half + j0 + j, 0), SEQ - 1); raw[j] = *(const u32x4*)(hb + (size_t)sp * NH + 16 * ks); }
#pragma unroll
            for (int j = 0; j < 4; ++j) { const int sp = s - half + j0 + j; const float m = (j0 + j < W && sp >= 0 && sp < SEQ) ? 1.f : 0.f; float v8[8]; unpack8(raw[j], v8);
#pragma unroll
                for (int q = 0; q < 8; ++q) a8[q] += m * v8[q]; } }
        float x8[8]; unpack8(*(const u32x4*)(hb + (size_t)s * NH + 16 * ks), x8);
        const bf16x8 pf = pack8(a8[0] * inv - x8[0], a8[1] * inv - x8[1], a8[2] * inv - x8[2], a8[3] * inv - x8[3], a8[4] * inv - x8[4], a8[5] * inv - x8[5], a8[6] * inv - x8[6], a8[7] * inv - x8[7]);
#pragma unroll
        for (int ot = 0; ot < 2; ++ot) { const bf16x8 wf = *(const bf16x8*)(PWT + ((size_t)(l * 4 + g) * 64 + 32 * ot + tl) * 64 + 16 * ks + 8 * hh); acc[ot] = MFMA32(wf, pf, acc[ot]); } }
#pragma unroll
    for (int ot = 0; ot < 2; ++ot)
#pragma unroll
        for (int gg = 0; gg < 4; ++gg) { const int o = g * 64 + 32 * ot + 8 * gg + 4 * hh; const f32x4 sc = *(const f32x4*)(pool_scale + l * 256 + o);
            u32x2 w; w.x = pk2(acc[ot][4 * gg] * sc[0], acc[ot][4 * gg + 1] * sc[1]); w.y = pk2(acc[ot][4 * gg + 2] * sc[2], acc[ot][4 * gg + 3] * sc[3]);
            *(u32x2*)(YS + tok * D + 768 + o) = w; }
}
constexpr int ATT_PITCH = 144;
__device__ __forceinline__ void att2_item(int item) {
    FRAME_SETUP;
    WS_PTRS; const float* rel_bias = inp(I_RELB);
    const int tid = F.tid, lane = F.lane, w = F.wave;
    const int pat = item >> 8, idx = item & 255, dil = 1 << (2 * pat), L = SEQ / dil, nqb = L >> 8;
    const int jr = idx & 31, h = (idx >> 5) & 3, b = idx >> 7, r = jr / nqb, Q0 = (jr % nqb) * 256;
    LAS unsigned char* Kt = F.lds; LAS unsigned char* Vt = F.lds + 384 * ATT_PITCH; LAS float* bt = (LAS float*)(F.lds + 2 * 384 * ATT_PITCH);
    { u32x4 k8[6], v8[6];
#pragma unroll
        for (int u = 0; u < 6; ++u) { const int i = tid + u * NTHREADS, kk = i >> 3, cg = (i & 7) * 8, kidx = min(max(Q0 - 64 + kk, 0), L - 1);
            const bf16* row = H + (size_t)(b * SEQ + r + dil * kidx) * NH; k8[u] = *(const u32x4*)(row + HAK + h * 64 + cg); v8[u] = *(const u32x4*)(row + HAV + h * 64 + cg); }
#pragma unroll
        for (int u = 0; u < 6; ++u) { const int i = tid + u * NTHREADS, kk = i >> 3, cg = (i & 7) * 8;
            *(LAS u32x4*)(Kt + kk * ATT_PITCH + cg * 2) = k8[u]; *(LAS u32x4*)(Vt + kk * ATT_PITCH + cg * 2) = v8[u]; } }
    if (tid < 192) { const int u = tid - 32, j = u - 64, rel = dil * j, na = rel < 0 ? -rel : rel;
        int bucket = na < 8 ? na : 8 + (na >= 15) + (na >= 27) + (na >= 50) + (na >= 91) + (na >= 166) + (na >= 305) + (na >= 559);
        if (rel > 0) bucket += 16;
        bt[tid] = (u >= 0 && u <= 128) ? rel_bias[min(bucket, 31) * 4 + h] * 1.4426950408889634f : -1e30f; }
    const int ql = lane & 31, hh = lane >> 5;
    const int qi = Q0 + 32 * w + ql; const size_t tok = (size_t)b * SEQ + r + dil * qi;
    bf16x8 qf[4];
#pragma unroll
    for (int ks = 0; ks < 4; ++ks) qf[ks] = *(const bf16x8*)(H + tok * NH + HAQ + h * 64 + 16 * ks + 8 * hh);
    __syncthreads();
    f32x16 S[5];
#pragma unroll
    for (int tk = 0; tk < 5; ++tk) {
#pragma unroll
        for (int i = 0; i < 16; ++i) S[tk][i] = F.zf;
#pragma unroll
        for (int ks = 0; ks < 4; ++ks) { const bf16x8 kf = *(const LAS bf16x8*)(Kt + (32 * w + 32 * tk + ql) * ATT_PITCH + (16 * ks + 8 * hh) * 2); S[tk] = MFMA32(kf, qf[ks], S[tk]); } }
    const LAS float* btl = bt + 32 + 4 * hh - ql;
    float mx = -3.0e38f;
#pragma unroll
    for (int tk = 0; tk < 5; ++tk) {
#pragma unroll
        for (int i = 0; i < 16; ++i) { const float sc = S[tk][i] * (0.125f * 1.4426950408889634f) + btl[32 * tk + (i & 3) + 8 * (i >> 2)]; S[tk][i] = sc; mx = fmaxf(mx, sc); }
        __builtin_amdgcn_sched_barrier(0); }
    const int e0 = Q0 - 64 + 32 * w;
    if (e0 < 0 || e0 + 160 > L) {
        mx = -3.0e38f;
#pragma unroll
        for (int tk = 0; tk < 5; ++tk)
#pragma unroll
            for (int i = 0; i < 16; ++i) { const int kidx = e0 + 32 * tk + crow(i, hh); const float sc = (kidx >= 0 && kidx < L) ? S[tk][i] : -1e30f; S[tk][i] = sc; mx = fmaxf(mx, sc); }
    }
    mx = fmaxf(mx, shx(mx, 32, lane));
    float lsum = 0.f;
#pragma unroll
    for (int tk = 0; tk < 5; ++tk)
#pragma unroll
        for (int i = 0; i < 16; ++i) { const float p = __builtin_amdgcn_exp2f(S[tk][i] - mx); S[tk][i] = p; lsum += p; }
    lsum += shx(lsum, 32, lane);
    f32x16 O[2];
#pragma unroll
    for (int dt = 0; dt < 2; ++dt)
#pragma unroll
        for (int i = 0; i < 16; ++i) O[dt][i] = F.zf;
#pragma unroll
    for (int tk = 0; tk < 5; ++tk)
#pragma unroll
        for (int s2 = 0; s2 < 2; ++s2) { const bf16x8 pf = pack8(S[tk][8 * s2], S[tk][8 * s2 + 1], S[tk][8 * s2 + 2], S[tk][8 * s2 + 3], S[tk][8 * s2 + 4], S[tk][8 * s2 + 5], S[tk][8 * s2 + 6], S[tk][8 * s2 + 7]);
            const int k0 = 32 * w + 32 * tk + 16 * s2 + 4 * hh;
#pragma unroll
            for (int dt = 0; dt < 2; ++dt) { const bf16x8 vf = tr_frag(Vt, ATT_PITCH, k0, k0 + 8, 32 * dt, lane); O[dt] = MFMA32(vf, pf, O[dt]); } }
    const float inv = 1.0f / lsum;
    bf16* op = ATTO + ((size_t)pat * T + tok) * 256 + h * 64 + 4 * hh;
#pragma unroll
    for (int dt = 0; dt < 2; ++dt)
#pragma unroll
        for (int g = 0; g < 4; ++g) { u32x2 wv; wv.x = pk2(O[dt][4 * g] * inv, O[dt][4 * g + 1] * inv); wv.y = pk2(O[dt][4 * g + 2] * inv, O[dt][4 * g + 3] * inv); *(u32x2*)(op + 32 * dt + 8 * g) = wv; }
    if (hh == 0) ATTL[((size_t)pat * T + tok) * 4 + h] = (mx + __builtin_amdgcn_logf(lsum)) * 0.6931471805599453f;
    __syncthreads();
}
__device__ __forceinline__ void att_merge(int item) {
    FRAME_SETUP;
    WS_PTRS;
    const int tid = F.tid; const size_t tok = (size_t)item * 64 + (tid >> 3); const int sub = tid & 7, h = sub >> 1, c0 = h * 64 + (sub & 1) * 32;
    const float l0 = ATTL[tok * 4 + h], l1 = ATTL[((size_t)T + tok) * 4 + h], l2 = ATTL[((size_t)2 * T + tok) * 4 + h];
    const float M = fmaxf(l0, fmaxf(l1, l2)); float w0 = __expf(l0 - M), w1 = __expf(l1 - M), w2 = __expf(l2 - M); const float inv = 1.0f / (w0 + w1 + w2); w0 *= inv; w1 *= inv; w2 *= inv;
    const bf16* o0 = ATTO + tok * 256 + c0; const bf16* o1 = ATTO + ((size_t)T + tok) * 256 + c0; const bf16* o2 = ATTO + ((size_t)2 * T + tok) * 256 + c0;
    bf16* yp = YS + tok * D + 256 + c0;
#pragma unroll
    for (int q = 0; q < 4; ++q) { float a8[8], b8[8], c8[8]; unpack8(*(const u32x4*)(o0 + q * 8), a8); unpack8(*(const u32x4*)(o1 + q * 8), b8); unpack8(*(const u32x4*)(o2 + q * 8), c8);
        u32x4 w; w.x = pk2(a8[0] * w0 + b8[0] * w1 + c8[0] * w2, a8[1] * w0 + b8[1] * w1 + c8[1] * w2); w.y = pk2(a8[2] * w0 + b8[2] * w1 + c8[2] * w2, a8[3] * w0 + b8[3] * w1 + c8[3] * w2);
        w.z = pk2(a8[4] * w0 + b8[4] * w1 + c8[4] * w2, a8[5] * w0 + b8[5] * w1 + c8[5] * w2); w.w = pk2(a8[6] * w0 + b8[6] * w1 + c8[6] * w2, a8[7] * w0 + b8[7] * w1 + c8[7] * w2);
        *(u32x4*)(yp + q * 8) = w; }
}

template <int CTRL> __device__ __forceinline__ float dpp_max(float v) { return fmaxf(v, dpp_mov<CTRL>(v)); }
__device__ __forceinline__ void ln1_router(int l) {
    FRAME_SETUP;
    WS_PTRS; const float* ln1_g = inp(I_LN1G); const float* ln1_b = inp(I_LN1B); const bf16* WRT = (const bf16*)(ws + WS_WRT) + (size_t)l * NE * D; const float* STAT = (const float*)(ws + WS_STAT);
    LAS float* gl = (LAS float*)F.lds; LAS float* bl = gl + D;
    { const int i = F.tid * 2; *(LAS f32x2*)(gl + i) = *(const f32x2*)(ln1_g + l * D + i); *(LAS f32x2*)(bl + i) = *(const f32x2*)(ln1_b + l * D + i); }
    __syncthreads();
    const int lane = F.lane, r = lane & 15, kg = lane >> 4;
    LAS f32x4* red = (LAS f32x4*)(bl + D);
    const int half = F.wave >> 2;
    for (int it0 = F.bid * 4; it0 < T / 16; it0 += F.G * 4) {
        const int item = it0 + (F.wave & 3);
        const size_t tok = (size_t)item * 16 + r;
        float s1 = 0.f, s2 = 0.f;
        { const f32x4 a = *(const f32x4*)(STAT + (tok * 16 + 4 * kg) * 2), c = *(const f32x4*)(STAT + (tok * 16 + 4 * kg) * 2 + 4); s1 = (a[0] + a[2]) + (c[0] + c[2]); s2 = (a[1] + a[3]) + (c[1] + c[3]); }
        s1 += shx(s1, 16, lane); s1 += shx(s1, 32, lane); s2 += shx(s2, 16, lane); s2 += shx(s2, 32, lane);
        const float mean = s1 * (1.0f / D), var = fmaxf(s2 * (1.0f / D) - mean * mean, 0.f), rstd = 1.0f / sqrtf(var + LN_EPS);
        const bf16* rp = (const bf16*)MGF + tok * D + 8 * kg; bf16* xp = XB + tok * D + 8 * kg; const bf16* wp = WRT + (size_t)r * D + 8 * kg;
        f32x4 acc = (f32x4){F.zf, F.zf, F.zf, F.zf};
#pragma unroll 8
        for (int ks = half * 16; ks < half * 16 + 16; ++ks) {
            float x8[8]; unpack8(*(const u32x4*)(rp + 32 * ks), x8); const f32x4 x0 = (f32x4){x8[0], x8[1], x8[2], x8[3]}, x1 = (f32x4){x8[4], x8[5], x8[6], x8[7]};
            const f32x4 g0 = *(const LAS f32x4*)(gl + 32 * ks + 8 * kg), g1 = *(const LAS f32x4*)(gl + 32 * ks + 8 * kg + 4), b0 = *(const LAS f32x4*)(bl + 32 * ks + 8 * kg), b1 = *(const LAS f32x4*)(bl + 32 * ks + 8 * kg + 4);
            const f32x4 y0 = (x0 - mean) * rstd * g0 + b0, y1 = (x1 - mean) * rstd * g1 + b1;
            u32x4 yw; yw.x = pk2(y0[0], y0[1]); yw.y = pk2(y0[2], y0[3]); yw.z = pk2(y1[0], y1[1]); yw.w = pk2(y1[2], y1[3]);
            *(u32x4*)(xp + 32 * ks) = yw;
            const bf16x8 wf = *(const bf16x8*)(wp + 32 * ks);
            acc = __builtin_amdgcn_mfma_f32_16x16x32_bf16(__builtin_bit_cast(bf16x8, yw), wf, acc, 0, 0, 0);
        }
        if (half) red[(F.wave & 3) * 64 + lane] = acc;
        __syncthreads();
        if (!half) {
        acc += red[(F.wave & 3) * 64 + lane];
        f32x4 aff;
#pragma unroll
        for (int i = 0; i < 4; ++i) { float m = acc[i]; m = dpp_max<0xB1>(m); m = dpp_max<0x4E>(m); m = dpp_max<0x141>(m); m = dpp_max<0x140>(m);
            const float e = __expf(acc[i] - m); float se = e; se += dpp_mov<0xB1>(se); se += dpp_mov<0x4E>(se); se += dpp_mov<0x141>(se); se += dpp_mov<0x140>(se);
            aff[i] = e * rcpf_(se); }
        { const size_t t0 = (size_t)item * 16 + 4 * kg; const int b = (int)(t0 >> 13), sp = (int)(t0 & (SEQ - 1)); *(f32x4*)(AFF + ((size_t)(b * NE + r)) * SEQ + sp) = aff; }
        }
        __syncthreads();
    }
    __syncthreads();
}
__device__ __forceinline__ unsigned block_excl_scan(LAS unsigned* sc, unsigned val, int tid) {
    sc[tid] = val; __syncthreads();
#pragma unroll 1
    for (int off = 1; off < NTHREADS; off <<= 1) { const unsigned v = tid >= off ? sc[tid - off] : 0u; __syncthreads(); sc[tid] += v; __syncthreads(); }
    const unsigned r = sc[tid] - val; __syncthreads(); return r;
}
__device__ __forceinline__ void topk_item(int be) {
    FRAME_SETUP;
    WS_PTRS;
    const int tid = F.tid, b = be >> 4;
    const float* aff = AFF + (size_t)be * SEQ;
    LAS unsigned* hist = (LAS unsigned*)F.lds; LAS unsigned* sfx = hist + 256; LAS unsigned* sc = sfx + 256; LAS unsigned* misc = sc + 512; LAS int* idxl = (LAS int*)(misc + 4);
    unsigned key[16];
    { const u32x4* ap = (const u32x4*)(aff + tid * 16);
#pragma unroll
        for (int q = 0; q < 4; ++q) { const u32x4 w = ap[q]; key[q * 4] = w.x; key[q * 4 + 1] = w.y; key[q * 4 + 2] = w.z; key[q * 4 + 3] = w.w; } }
    unsigned prefix = 0u, kth = CAP, hmask = 0u;
#pragma unroll 1
    for (int shift = 24; shift >= 0; shift -= 8) {
        if (tid < 256) hist[tid] = 0u;
        __syncthreads();
#pragma unroll
        for (int i = 0; i < 16; ++i) { if (((key[i] ^ prefix) & hmask) == 0u) __hip_atomic_fetch_add(&hist[(key[i] >> shift) & 255u], 1u, __ATOMIC_RELAXED, __HIP_MEMORY_SCOPE_WORKGROUP); }
        __syncthreads();
        if (tid < 256) sfx[tid] = hist[tid];
        __syncthreads();
#pragma unroll 1
        for (int off = 1; off < 256; off <<= 1) { unsigned v = 0u; if (tid < 256 && tid + off < 256) v = sfx[tid + off]; __syncthreads(); if (tid < 256) sfx[tid] += v; __syncthreads(); }
        if (tid < 256) { const unsigned incl = sfx[tid], excl = incl - hist[tid]; if (excl < kth && kth <= incl) { misc[0] = (unsigned)tid; misc[1] = kth - excl; } }
        __syncthreads();
        prefix |= misc[0] << shift; kth = misc[1]; hmask |= 255u << shift;
        __syncthreads();
    }
    unsigned ceq = 0u;
#pragma unroll
    for (int i = 0; i < 16; ++i) ceq += (key[i] == prefix) ? 1u : 0u;
    unsigned eqrank = block_excl_scan(sc, ceq, tid);
    unsigned selmask = 0u, csel = 0u;
#pragma unroll
    for (int i = 0; i < 16; ++i) { bool sel = key[i] > prefix; if (key[i] == prefix) { sel = eqrank < kth; ++eqrank; } if (sel) { selmask |= 1u << i; ++csel; } }
    unsigned slot = block_excl_scan(sc, csel, tid);
#pragma unroll
    for (int i = 0; i < 16; ++i) { const int s = tid * 16 + i;
        if (selmask & (1u << i)) { if (slot < (unsigned)CAP) { IDX[be * CAP + slot] = s; GATE[be * CAP + slot] = __uint_as_float(key[i]); idxl[slot] = s; } SLOT[(size_t)be * SEQ + s] = (int)slot; ++slot; }
        else SLOT[(size_t)be * SEQ + s] = -1; }
    __syncthreads();
    __syncthreads();
}
__device__ __forceinline__ void combine_ln2(int l) {
    FRAME_SETUP;
    WS_PTRS; const float* ln2_g = inp(I_LN2G); const float* ln2_b = inp(I_LN2B); float* out = outp();
    const int lane = F.lane;
    const float* g2 = ln2_g + l * D; const float* b2 = ln2_b + l * D;
    f32x4 gg4[4], bb4[4];
#pragma unroll
    for (int j = 0; j < 4; ++j) { const int d = 8 * lane + 512 * (j >> 1) + 4 * (j & 1); gg4[j] = *(const f32x4*)(g2 + d); bb4[j] = *(const f32x4*)(b2 + d); }
    for (int tok = (F.bid * NWAVES + F.wave) * 2; tok < T; tok += F.G * NWAVES * 2) {
        const int b = tok >> 13, sp = tok & (SEQ - 1);
        int slotv[2]; unsigned mask[2]; f32x4 v[2][4]; u32x4 xr[2][2];
#pragma unroll
        for (int u = 0; u < 2; ++u) slotv[u] = lane < NE ? SLOT[((size_t)(b * NE + lane)) * SEQ + sp + u] : -1;
#pragma unroll
        for (int u = 0; u < 2; ++u)
#pragma unroll
            for (int jj = 0; jj < 2; ++jj) xr[u][jj] = *(const u32x4*)(XB + (size_t)(tok + u) * D + 8 * lane + 512 * jj);
        __builtin_amdgcn_sched_barrier(0);
#pragma unroll
        for (int u = 0; u < 2; ++u) mask[u] = (unsigned)__ballot(slotv[u] >= 0);
#pragma unroll
        for (int u = 0; u < 2; ++u)
#pragma unroll
            for (int jj = 0; jj < 2; ++jj) { float x8[8]; unpack8(xr[u][jj], x8); v[u][2 * jj] = (f32x4){x8[0], x8[1], x8[2], x8[3]} * ALPHA; v[u][2 * jj + 1] = (f32x4){x8[4], x8[5], x8[6], x8[7]} * ALPHA; }
        while (mask[0] | mask[1]) {
            u32x4 r[2][3][2]; bool on[2][3];
#pragma unroll
            for (int u = 0; u < 2; ++u)
#pragma unroll
                for (int k = 0; k < 3; ++k) { on[u][k] = mask[u] != 0u; const int e = on[u][k] ? __builtin_ctz(mask[u]) : 0; mask[u] &= mask[u] - 1u;
                    const int sl = __builtin_amdgcn_readlane(slotv[u], e);
                    if (on[u][k]) { const bf16* yr = YE + ((size_t)(b * NE + e) * CAP + sl) * D;
#pragma unroll
                        for (int jj = 0; jj < 2; ++jj) r[u][k][jj] = *(const u32x4*)(yr + 8 * lane + 512 * jj); } }
#pragma unroll
            for (int u = 0; u < 2; ++u)
#pragma unroll
                for (int k = 0; k < 3; ++k) if (on[u][k]) {
#pragma unroll
                    for (int jj = 0; jj < 2; ++jj) { float y8[8]; unpack8(r[u][k][jj], y8); v[u][2 * jj] += (f32x4){y8[0], y8[1], y8[2], y8[3]}; v[u][2 * jj + 1] += (f32x4){y8[4], y8[5], y8[6], y8[7]}; } }
        }
        float s[2], s2[2];
#pragma unroll
        for (int u = 0; u < 2; ++u) { s[u] = 0.f;
#pragma unroll
            for (int j = 0; j < 4; ++j) s[u] += (v[u][j].x + v[u][j].y) + (v[u][j].z + v[u][j].w); }
        s[0] = wave_sum(s[0], lane); s[1] = wave_sum(s[1], lane);
#pragma unroll
        for (int u = 0; u < 2; ++u) { const float mean = s[u] * (1.f / D); s2[u] = 0.f;
#pragma unroll
            for (int j = 0; j < 4; ++j) { v[u][j] = v[u][j] - mean; s2[u] += (v[u][j].x * v[u][j].x + v[u][j].y * v[u][j].y) + (v[u][j].z * v[u][j].z + v[u][j].w * v[u][j].w); } }
        s2[0] = wave_sum(s2[0], lane); s2[1] = wave_sum(s2[1], lane);
#pragma unroll
        for (int u = 0; u < 2; ++u) { const float rstd = 1.f / sqrtf(s2[u] * (1.f / D) + LN_EPS);
#pragma unroll
            for (int jj = 0; jj < 2; ++jj) { const int d = 8 * lane + 512 * jj;
                const f32x4 x0 = v[u][2 * jj] * rstd * gg4[2 * jj] + bb4[2 * jj], x1 = v[u][2 * jj + 1] * rstd * gg4[2 * jj + 1] + bb4[2 * jj + 1];
                u32x4 w; w.x = pk2(x0.x, x0.y); w.y = pk2(x0.z, x0.w); w.z = pk2(x1.x, x1.y); w.w = pk2(x1.z, x1.w); *((u32x4*)(XB + (size_t)(tok + u) * D + d)) = w;
                if (l == DEPTH - 1) { *((f32x4*)(out + (size_t)(tok + u) * D + d)) = x0; *((f32x4*)(out + (size_t)(tok + u) * D + d + 4)) = x1; } } }
    }
}

constexpr int PH_PER_LAYER = 11, N_PHASES = 1 + DEPTH * PH_PER_LAYER;
struct Args { const float* in[22]; float* out; unsigned char* ws; int ph_lo, ph_hi; };
__device__ __forceinline__ void phase_mix1(int l) { FRAME_SETUP;
    for (int it = F.bid; it < 256 + 128; it += F.G) { if (it < 256) mlstm_c1m(l, it); else gmlp_m(l, it - 256); }
    { const int nw = F.G * NWAVES; int first = (F.bid >= 128 ? F.bid - 128 : F.bid + F.G - 128) * NWAVES + F.wave;
      for (int wi = first; wi < 2048; wi += nw) pool_m(l, wi); } }
__device__ __forceinline__ void phase_mix2(int l) { FRAME_SETUP;
    for (int wi = F.bid * 2 + F.wave; wi < 272 && F.wave < 2; wi += F.G * 2) mlstm_scan(wi);
    const bool g256 = F.G == 256, sc = F.bid < 130;
    const int n = g256 ? (sc ? (F.bid < 4 ? 3 : 2) : 4) : (768 - F.bid + F.G - 1) / F.G, first = g256 ? (sc ? 2 * F.bid : 260 + 4 * (F.bid - 130)) : F.bid, stride = g256 ? 1 : F.G;
    for (int k = 0; k < n; ++k) att2_item((g256 && sc && k == 2) ? 764 + F.bid : first + k * stride); }
__device__ __forceinline__ void phase_mix3(int l) { FRAME_SETUP;
    for (int it = F.bid; it < 256 + 256; it += F.G) { if (it < 256) mlstm_c3m(l, it); else att_merge(it - 256); } }
__device__ __forceinline__ void phase_topk(int l) { FRAME_SETUP;
    const bool wide = F.G > 2 * BATCH * NE;
    for (int it = F.bid; it < BATCH * NE; it += F.G) topk_item(it);
    if (l + 1 < DEPTH && (!wide || F.bid >= BATCH * NE)) convert_layer(l + 1, ((wide ? F.bid - BATCH * NE : F.bid)) * NWAVES + F.wave, (wide ? F.G - BATCH * NE : F.G) * NWAVES); }
__device__ __forceinline__ void phase_g1(int l) { FRAME_SETUP; WS_PTRS;
    pg8::GemmP g{D, D, D}; SchedG1 S{F.G, F.bid, (const char*)XB, (const char*)wl(ws, l, OW_IN)}; EpiG1 E{H, GI, BIN + (size_t)l * NINP};
    pg8::gemm_phase<EpiG1, SchedG1, true>(F.lds, F.tid, g, S, E); }
__device__ __forceinline__ void phase_g2(int l) { FRAME_SETUP; WS_PTRS;
    pg8::GemmP g{D, D, D}; SchedG2 S{F.G, F.bid, (const char*)YS, (const char*)wl(ws, l, OW_B)}; EpiG2 E{H, MGB};
    pg8::gemm_phase<EpiG2, SchedG2, true>(F.lds, F.tid, g, S, E); }
__device__ __forceinline__ void phase_g3(int l) { FRAME_SETUP; WS_PTRS;
    pg8::GemmP g{D, D, D}; SchedG3 S{F.G, F.bid, (const char*)MGB, (const char*)wl(ws, l, OW_O)}; EpiG3 E{XB, (bf16*)MGF, (float*)(ws + WS_STAT)};
    pg8::gemm_phase<EpiG3, SchedG3, true>(F.lds, F.tid, g, S, E); }
__device__ __forceinline__ void phase_g4(int l) { FRAME_SETUP; WS_PTRS;
    pg8::GemmP g{D, D, D}; SchedG4 S{F.G, F.bid, (const char*)XB, (const char*)wl(ws, l, OW_13), IDX}; EpiG4 E{HID};
    pg8::gemm_phase<EpiG4, SchedG4, true>(F.lds, F.tid, g, S, E); }
__device__ __forceinline__ void phase_g5(int l) { FRAME_SETUP; WS_PTRS;
    pg8::GemmP g{FF, FF, FF}; SchedG5 S{F.G, F.bid, (const char*)HID, (const char*)wl(ws, l, OW_2)}; EpiG5 E{GATE, YE};
    pg8::gemm_phase<EpiG5, SchedG5, true>(F.lds, F.tid, g, S, E); }

__global__ void __launch_bounds__(NTHREADS, 2) fwd_kernel(Args args) {
    { LAS unsigned char* l0 = lds_base(); for (int u = threadIdx.x; u < (LDS_BYTES - LDSCTL_OFF) / 4; u += NTHREADS) ((LAS unsigned*)(l0 + LDSCTL_OFF))[u] = 0u; }
    __syncthreads();
#if !MK_PER_PHASE
    (void)xcd_barrier_post((unsigned*)(args.ws + WS_CTL) + CW_BAR, (volatile LAS unsigned*)(lds_base() + MISC_OFF) + 8);
#endif
    const int lo = args.ph_lo, hi = args.ph_hi;
#if PROBE_MASK
    volatile LAS unsigned long long* pacc = (volatile LAS unsigned long long*)(lds_base() + MISC_OFF + 64);
#endif
    for (int ph = lo; ph < hi; ++ph) {
#if PROBE_MASK
        const unsigned long long pt0 = __builtin_amdgcn_s_memrealtime();
#endif
        if (ph == 0) { if (PHEN(15)) p0_prologue(); }
        else {
            const int l = (ph - 1) / PH_PER_LAYER, sp = (ph - 1) % PH_PER_LAYER;
            if (sp == 0) { if (PHEN(0)) phase_g1(l); }
            else if (sp == 1) { if (PHEN(1)) phase_mix1(l); }
            else if (sp == 2) { if (PHEN(2)) phase_mix2(l); }
            else if (sp == 3) { if (PHEN(3)) phase_mix3(l); }
            else if (sp == 4) { if (PHEN(4)) phase_g2(l); }
            else if (sp == 5) { if (PHEN(5)) phase_g3(l); }
            else if (sp == 6) { if (PHEN(6)) ln1_router(l); }
            else if (sp == 7) { if (PHEN(7)) phase_topk(l); }
            else if (sp == 8) { if (PHEN(8)) phase_g4(l); }
            else if (sp == 9) { if (PHEN(9)) phase_g5(l); }
            else { if (PHEN(10)) combine_ln2(l); }
        }
#if PROBE_MASK && defined(PROBE_MODE) && PROBE_MODE == 1
        { const int sp_ = ph == 0 ? 15 : (ph - 1) % PH_PER_LAYER; asm volatile("s_waitcnt vmcnt(0)" ::: "memory"); __syncthreads(); const unsigned long long pt1 = __builtin_amdgcn_s_memrealtime();
          if (threadIdx.x == 0 && ((PROBE_MASK >> sp_) & 1)) pacc[0] = pacc[0] + (pt1 - pt0); }
#endif
        if (ph + 1 < hi) {
#if !MK_PER_PHASE
            { XcdBarrier bar; bar.bar = (unsigned*)(wsp() + WS_CTL) + CW_BAR; bar.x = xb_xcc_id(); bar.st = (volatile LAS unsigned*)(lds_base() + MISC_OFF) + 8; xcd_barrier(bar); }
#endif
        }
#if PROBE_MASK && !(defined(PROBE_MODE) && PROBE_MODE == 1)
        { const int sp_ = ph == 0 ? 15 : (ph - 1) % PH_PER_LAYER; const unsigned long long pt1 = __builtin_amdgcn_s_memrealtime();
          if (threadIdx.x == 0 && ((PROBE_MASK >> sp_) & 1)) pacc[0] = pacc[0] + (pt1 - pt0); }
#endif
    }
#if PROBE_MASK
    if (threadIdx.x == 0 && blockIdx.x == 0) { const unsigned long long t0 = __builtin_amdgcn_s_memrealtime(), need = pacc[0]; while (__builtin_amdgcn_s_memrealtime() - t0 < need) __builtin_amdgcn_s_sleep(8); }
#endif
}

extern "C" void kernel_launch(void* const* d_in, const int* in_sizes, int n_in, void* d_out, int out_size, void* d_ws, size_t ws_size, hipStream_t stream) {
    static int grid = 0;
    if (grid == 0) {
        if (n_in != 22 || in_sizes[0] != T * D || out_size != T * D || ws_size < WS_END) {
            fprintf(stderr, "kernel_launch: unexpected shapes: n_in %d in0 %d out %d ws %zu (need %zu); nothing launched\n", n_in, n_in > 0 ? in_sizes[0] : -1, out_size, ws_size, (size_t)WS_END); grid = -1; return; }
        int dev = 0, cus = 0;
        if (hipGetDevice(&dev) != hipSuccess || hipDeviceGetAttribute(&cus, hipDeviceAttributeMultiprocessorCount, dev) != hipSuccess) { grid = -1; return; }
        if (hipFuncSetAttribute((const void*)fwd_kernel, hipFuncAttributeMaxDynamicSharedMemorySize, LDS_BYTES) != hipSuccess) { fprintf(stderr, "kernel_launch: hipFuncSetAttribute failed\n"); grid = -1; return; }
        int per_cu = 0;
        if (hipOccupancyMaxActiveBlocksPerMultiprocessor(&per_cu, (const void*)fwd_kernel, NTHREADS, LDS_BYTES) != hipSuccess || per_cu < 1)
            fprintf(stderr, "kernel_launch: note: occupancy query reports %d workgroups per CU\n", per_cu);
        (void)hipGetLastError();
        grid = cus;
    }
    if (grid < 0) return;
    (void)hipMemsetAsync((char*)d_ws + WS_CTL, 0, CTL_ZERO_BYTES, stream);
    Args a{};
    for (int i = 0; i < 22; ++i) a.in[i] = (const float*)d_in[i];
    a.out = (float*)d_out; a.ws = (unsigned char*)d_ws;
#if MK_PER_PHASE
    for (int ph = 0; ph < N_PHASES; ++ph) { a.ph_lo = ph; a.ph_hi = ph + 1; hipLaunchKernelGGL(fwd_kernel, dim3(grid), dim3(NTHREADS), LDS_BYTES, stream, a); }
#else
    a.ph_lo = 0; a.ph_hi = N_PHASES; hipLaunchKernelGGL(fwd_kernel, dim3(grid), dim3(NTHREADS), LDS_BYTES, stream, a);
#endif
}
```

```cpp
#include <hip/hip_runtime.h>
#include <cstdio>
#include <cstdint>

#ifndef PH_MASK
#define PH_MASK 0xFFFF
#endif
#define PHEN(k) ((PH_MASK >> (k)) & 1)
#ifndef PROBE_MASK
#define PROBE_MASK 0
#endif
#ifndef MK_PER_PHASE
#define MK_PER_PHASE 0
#endif

#define GAS __attribute__((address_space(1)))
#define LAS __attribute__((address_space(3)))
typedef unsigned short bf16;
typedef short bf16x8 __attribute__((ext_vector_type(8)));
typedef float f32x4 __attribute__((ext_vector_type(4)));
typedef float f32x2 __attribute__((ext_vector_type(2)));
typedef unsigned u32x4 __attribute__((ext_vector_type(4)));
typedef unsigned u32x2 __attribute__((ext_vector_type(2)));
typedef GAS unsigned gu32;
#define RLX_AGENT __ATOMIC_RELAXED, __HIP_MEMORY_SCOPE_AGENT
#define LDS_WAIT() asm volatile("s_waitcnt lgkmcnt(0)" ::: "memory")
#define VM_WAIT() asm volatile("s_waitcnt vmcnt(0)" ::: "memory")

constexpr int BATCH = 2, SEQ = 8192, D = 1024, T = BATCH * SEQ, DEPTH = 4;
constexpr int NIN = 6672;
constexpr int NH = 6656;
constexpr int NINP = 6912;
constexpr int NE = 16, CAP = 1024, FF = 1024, NSLOT = BATCH * NE * CAP;
constexpr float ALPHA = 1.6817928305074292f;
constexpr float LN_EPS = 1e-5f;
constexpr int HU = 0, HV = 256, HAQ = 512, HAK = 768, HAV = 1024, HCQ = 1280, HCK = 1536, HCV = 1792, HCO = 2048, HDX = 2304, HG = 2560;

constexpr size_t MiB = 1u << 20;
constexpr size_t WS_CTL = 0, CTL_ZERO_BYTES = 64 * 1024;
constexpr size_t WS_BIN = 1 * MiB;
constexpr size_t WS_WSB = 1 * MiB + 512 * 1024;
constexpr size_t WS_PWT = 1 * MiB + 256 * 1024;
constexpr size_t WS_W = 2 * MiB, LW = 114 * MiB;
constexpr size_t OW_IN = 0, OW_B = 14 * MiB, OW_O = 16 * MiB, OW_13 = 18 * MiB, OW_2 = 82 * MiB;
constexpr size_t WS_XF = 458 * MiB;
constexpr size_t WS_GQ = WS_XF;
constexpr size_t WS_STAT = 876 * MiB;
constexpr size_t WS_WRT = 1 * MiB + 128 * 1024;
constexpr size_t WS_XB = 522 * MiB;
constexpr size_t WS_BIG = 554 * MiB;
constexpr size_t WS_XS = WS_BIG, WS_HID = WS_BIG + 64 * MiB, WS_YE = WS_BIG + 128 * MiB;
constexpr size_t WS_GI = 762 * MiB;
constexpr size_t WS_ATTO = 763 * MiB;
constexpr size_t WS_ATTL = 811 * MiB;
constexpr size_t WS_YS = 812 * MiB;
constexpr size_t WS_MGF = 844 * MiB;
constexpr size_t WS_MGB = 908 * MiB;
constexpr size_t WS_QC = 940 * MiB, WS_KC = 956 * MiB;
constexpr size_t WS_DC = 972 * MiB;
constexpr size_t WS_DG = 1005 * MiB;
constexpr size_t WS_AFF = 1006 * MiB;
constexpr size_t WS_IDX = 1007 * MiB;
constexpr size_t WS_GATE = 1007 * MiB + 512 * 1024;
constexpr size_t WS_SLOT = 1008 * MiB;
constexpr size_t WS_END = 1009 * MiB;

constexpr int CW_BAR = 4096;

constexpr int RING_BYTES = 131072;
constexpr int LDSCTL_OFF = RING_BYTES, MISC_OFF = LDSCTL_OFF + 320;
constexpr int LDS_BYTES = 147456;
constexpr int NWAVES = 8, NTHREADS = 512;

__device__ __forceinline__ float bf2f(unsigned v) { return __uint_as_float(v << 16); }
__device__ __forceinline__ unsigned f2bf(float f) { unsigned u = __float_as_uint(f); return (u + 0x7fffu + ((u >> 16) & 1u)) >> 16; }
typedef __bf16 bf16x2_t_ __attribute__((ext_vector_type(2)));
__device__ __forceinline__ unsigned pk2(float lo, float hi) { f32x2 v = {lo, hi}; bf16x2_t_ b = __builtin_convertvector(v, bf16x2_t_); return __builtin_bit_cast(unsigned, b); }
__device__ __forceinline__ float rcpf_(float x) { return __builtin_amdgcn_rcpf(x); }
__device__ __forceinline__ void unpack8(const u32x4 w, float (&o)[8]) {
    o[0] = __uint_as_float(w.x << 16); o[1] = __uint_as_float(w.x & 0xffff0000u);
    o[2] = __uint_as_float(w.y << 16); o[3] = __uint_as_float(w.y & 0xffff0000u);
    o[4] = __uint_as_float(w.z << 16); o[5] = __uint_as_float(w.z & 0xffff0000u);
    o[6] = __uint_as_float(w.w << 16); o[7] = __uint_as_float(w.w & 0xffff0000u);
}
__device__ __forceinline__ float sigmoidf_(float x) { return rcpf_(1.0f + __expf(-x)); }
__device__ __forceinline__ float siluf_(float x) { return x * rcpf_(1.0f + __expf(-x)); }
__device__ __forceinline__ float gelu_tanh(float x) { const float u = 1.5957691216057308f * (x + 0.044715f * x * x * x); return x * rcpf_(1.0f + __expf(-u)); }
__device__ __forceinline__ float logsigmoidf_(float z) { return fminf(z, 0.f) - log1pf(__expf(-fabsf(z))); }
__device__ __forceinline__ float shx(float v, int o, int lane) { return __int_as_float(__builtin_amdgcn_ds_bpermute((lane ^ o) << 2, __float_as_int(v))); }
template <int CTRL> __device__ __forceinline__ float dpp_mov(float v) { return __int_as_float(__builtin_amdgcn_update_dpp(0, __float_as_int(v), CTRL, 0xF, 0xF, false)); }
__device__ __forceinline__ float wave_sum(float v, int lane) { (void)lane;
    v += dpp_mov<0xB1>(v); v += dpp_mov<0x4E>(v); v += dpp_mov<0x141>(v); v += dpp_mov<0x140>(v);
    const int iv = __float_as_int(v);
    return (__int_as_float(__builtin_amdgcn_readlane(iv, 0)) + __int_as_float(__builtin_amdgcn_readlane(iv, 16))) + (__int_as_float(__builtin_amdgcn_readlane(iv, 32)) + __int_as_float(__builtin_amdgcn_readlane(iv, 48)));
}

#define XB_TMO      128
#define XB_XCNT(j)  (256  + 64 * (j))
#define XB_XSUB(j)  (1280 + 64 * (j))
#define XB_XGEN(j)  (2304 + 64 * (j))
#define XB_TOP      3328
#define XB_TOPGEN   3392
#define XCD_BAR_WORDS 3456
#define XB_SPIN_CAP (1u << 18)
__device__ __forceinline__ unsigned xb_ld(unsigned* p)              { return __hip_atomic_load(p, __ATOMIC_RELAXED, __HIP_MEMORY_SCOPE_AGENT); }
__device__ __forceinline__ unsigned xb_add(unsigned* p, unsigned v) { return __hip_atomic_fetch_add(p, v, __ATOMIC_RELAXED, __HIP_MEMORY_SCOPE_AGENT); }
__device__ __forceinline__ unsigned xb_xcc_id() { return (unsigned)__builtin_amdgcn_s_getreg((3 << 11) | 20) & 0xFu; }
#define XB_SPIN(cond, bar) do { unsigned _sp = 0; while (cond) { __builtin_amdgcn_s_sleep(1); \
    if ((++_sp & 255u) == 0u) { if (xb_ld(&(bar)[XB_TMO])) break; if (_sp > XB_SPIN_CAP) { atomicAdd(&(bar)[XB_TMO], 1u); break; } } } } while (0)
struct XcdBarrier { unsigned* bar; unsigned x; volatile LAS unsigned* st; };
__device__ __forceinline__ XcdBarrier xcd_barrier_post(unsigned* bar, volatile LAS unsigned* st) {
    XcdBarrier b; b.bar = bar; b.x = xb_xcc_id(); b.st = st;
    if (threadIdx.x == 0) (void)xb_add(&bar[XB_XCNT(b.x)], 1u);
    return b;
}
__device__ __forceinline__ void xcd_barrier_complete(unsigned* bar, unsigned x, unsigned& nloc, unsigned& nx) {
    const unsigned G = gridDim.x * gridDim.y * gridDim.z;
    unsigned sum, cnt, mine, sp = 0u;
    for (;;) {
        sum = 0u; cnt = 0u; mine = 0u;
#pragma unroll
        for (unsigned j = 0; j < 16; ++j) { const unsigned c = xb_ld(&bar[XB_XCNT(j)]); sum += c; cnt += (c > 0u) ? 1u : 0u; mine = (j == x) ? c : mine; }
        if (sum == G) break;
        __builtin_amdgcn_s_sleep(1);
        if ((++sp & 255u) == 0u) { if (xb_ld(&bar[XB_TMO])) break; if (sp > XB_SPIN_CAP) { atomicAdd(&bar[XB_TMO], 1u); break; } }
    }
    nloc = mine > 0u ? mine : 1u; nx = cnt > 0u ? cnt : 1u;
}
__device__ __forceinline__ void xcd_barrier(const XcdBarrier& b) {
    asm volatile("s_waitcnt vmcnt(0)" ::: "memory");
    __syncthreads();
    if (threadIdx.x == 0) {
        unsigned* bar = b.bar;
        __builtin_amdgcn_s_waitcnt(0);
        unsigned nloc = b.st[0], nx = b.st[1];
        if (nloc == 0u) { xcd_barrier_complete(bar, b.x, nloc, nx); b.st[0] = nloc; b.st[1] = nx; }
        const unsigned old = xb_add(&bar[XB_XSUB(b.x)], 1u);
        const unsigned gen = old / nloc;
        if (old + 1u == (gen + 1u) * nloc) {
            __builtin_amdgcn_fence(__ATOMIC_RELEASE, "agent");
            asm volatile("s_waitcnt vmcnt(0)" ::: "memory");
            const unsigned og = xb_add(&bar[XB_TOP], 1u);
            const unsigned tg = og / nx;
            if (og + 1u == (tg + 1u) * nx) xb_add(&bar[XB_TOPGEN], 1u);
            else XB_SPIN(xb_ld(&bar[XB_TOPGEN]) == tg, bar);
            __builtin_amdgcn_fence(__ATOMIC_ACQUIRE, "agent");
            xb_add(&bar[XB_XGEN(b.x)], 1u);
            asm volatile("s_waitcnt vmcnt(0)" ::: "memory");
        } else {
            XB_SPIN(xb_ld(&bar[XB_XGEN(b.x)]) == gen, bar);
            __builtin_amdgcn_fence(__ATOMIC_ACQUIRE, "agent");
            asm volatile("s_waitcnt vmcnt(0)" ::: "memory");
        }
    }
    __syncthreads();
}

namespace pg8 {
constexpr int BM = 256, BK = 64, HALF = 128, HTB = HALF * BK * 2, STAGE_BYTES = 8 * HTB, NXCD = 8, WGM = 8;
__host__ __device__ __forceinline__ int lds_byte(int r, int c) { const int st = (r >> 4) * 2 + (c >> 5), rr = r & 15, cc = c & 31, ob = rr * 64 + cc * 2; return st * 1024 + (ob ^ (((ob >> 9) & 1) << 5)); }
__host__ __device__ __forceinline__ void stage_rc(int b, int& R, int& C) { const int st = b / 1024, sb = b % 1024, swz = sb ^ (((sb >> 9) & 1) << 5); R = (st >> 1) * 16 + swz / 64; C = (st & 1) * 32 + (swz % 64) / 2; }
__host__ __device__ __forceinline__ int perm32(int rho) { const int n = rho >> 4, i = rho & 15; return 8 * (i >> 2) + 4 * n + (i & 3); }

struct Unit { int pm, pn, aux; const char* A; const char* B; };
struct GemmP { int K, lda, ldb; };

__device__ __forceinline__ bool tile_of(int i, int G, int c, int nM, int nN, int& pm, int& pn) {
    const int nwg = nM * nN; const int L = i * G + c; if (L >= nwg) return false;
    int wgid = L; { const int q = nwg / NXCD, r = nwg % NXCD, xcd = wgid % NXCD, off = wgid / NXCD; wgid = (xcd < r ? xcd * (q + 1) : r * (q + 1) + (xcd - r) * q) + off; }
    const int nig = WGM * nN, gid = wgid / nig, fm = gid * WGM, gsz = (nM - fm) < WGM ? (nM - fm) : WGM;
    pm = fm + ((wgid % nig) % gsz); pn = (wgid % nig) / gsz; return true;
}

__device__ __forceinline__ unsigned cvt_pk_bf16(float lo, float hi) { unsigned r; asm volatile("v_cvt_pk_bf16_f32 %0, %1, %2" : "=v"(r) : "v"(lo), "v"(hi)); return r; }

template <class Epi, class Sched, bool ALIGN_EPI>
__device__ __forceinline__ void gemm_phase(LAS unsigned char* lds, const int tid, const GemmP g, const Sched& S, const Epi& E) {
    const int wid = __builtin_amdgcn_readfirstlane(tid >> 6), lane = tid & 63, wr = wid >> 2, wc = wid & 3, fr = lane & 15, fq = lane >> 4;
    const int K = g.K, nt = K / BK;
    unsigned voffB[2]; int Ri[2], Ci[2];
#pragma unroll
    for (int i = 0; i < 2; ++i) { int R, C; stage_rc(tid * 16 + i * 8192, R, C); const int Rb = Epi::PERM ? ((R & ~31) + perm32(R & 31)) : R;
        Ri[i] = R; Ci[i] = C; voffB[i] = (unsigned)(Rb * g.ldb + C) * 2u; }
    const size_t kstep = (size_t)(BK * 2);
    const size_t hstepB = (size_t)HALF * g.ldb * 2;
    unsigned vA0[2], vA1[2], nvA0[2], nvA1[2];
    const unsigned ldsw = (unsigned)wid * 1024u;
    const int aoff = lds_byte(wr * 64 + fr, fq * 8), boff = lds_byte(wc * 32 + fr, fq * 8);
#define PG8_SA(b, h) (((b) * 2 + (h)) * HTB)
#define PG8_SB(b, h) ((4 + (b) * 2 + (h)) * HTB)
#define PG8_STAGE(bufoff, gbase, voff) do { _Pragma("unroll") for (int _i = 0; _i < 2; ++_i) \
        __builtin_amdgcn_global_load_lds((const unsigned*)((const char*)(gbase) + (voff)[_i]), (LAS unsigned*)(lds + (bufoff) + ldsw + _i * 8192), 16, 0, 0); } while (0)
#define PG8_LDA(dst, b, h) do { _Pragma("unroll") for (int m = 0; m < 4; ++m) _Pragma("unroll") for (int k = 0; k < 2; ++k) dst[m][k] = *(const LAS bf16x8*)(lds + PG8_SA(b, h) + aoff + m * 2048 + k * 1024); } while (0)
#define PG8_LDB(dst, b, h) do { _Pragma("unroll") for (int n = 0; n < 2; ++n) _Pragma("unroll") for (int k = 0; k < 2; ++k) dst[n][k] = *(const LAS bf16x8*)(lds + PG8_SB(b, h) + boff + n * 2048 + k * 1024); } while (0)
#define PG8_MMA(ai, bj, At, Bt) do { __builtin_amdgcn_s_setprio(1); _Pragma("unroll") for (int m = 0; m < 4; ++m) _Pragma("unroll") for (int n = 0; n < 2; ++n) _Pragma("unroll") for (int k = 0; k < 2; ++k) \
        acc[ai][bj][m][n] = __builtin_amdgcn_mfma_f32_16x16x32_bf16(Bt[n][k], At[m][k], acc[ai][bj][m][n], 0, 0, 0); __builtin_amdgcn_s_setprio(0); } while (0)
#define PG8_WAIT_V(n) asm volatile("s_waitcnt vmcnt(" #n ")" ::: "memory")
#define PG8_WAIT_L(n) asm volatile("s_waitcnt lgkmcnt(" #n ")" ::: "memory")
#define PG8_BAR __builtin_amdgcn_s_barrier()
#define PG8_SCHED __builtin_amdgcn_sched_barrier(0)
    Unit cur, nxt; int ui = 0;
    if (!S.next(0, cur)) return;
    float zf = 0.f; asm volatile("" : "+v"(zf));
    f32x4 acc[2][2][4][2];
#pragma unroll
    for (int a = 0; a < 2; ++a)
#pragma unroll
        for (int b = 0; b < 2; ++b)
#pragma unroll
            for (int m = 0; m < 4; ++m)
#pragma unroll
                for (int n = 0; n < 2; ++n) acc[a][b][m][n] = (f32x4){zf, zf, zf, zf};
    bf16x8 At[4][2], B0[2][2], B1[2][2];
    typename Epi::Pre pre;
    const char* cA = cur.A; const char* cB = cur.B;
    S.a_off(cur, g.lda, Ri, Ci, vA0, vA1);
    PG8_STAGE(PG8_SB(0, 0), cB, voffB); PG8_STAGE(PG8_SB(0, 1), cB + hstepB, voffB); PG8_STAGE(PG8_SA(0, 0), cA, vA0); PG8_STAGE(PG8_SA(0, 1), cA, vA1);
    if (wr == 1) PG8_BAR;
    PG8_WAIT_V(2); PG8_BAR;
    PG8_STAGE(PG8_SB(1, 0), cB + kstep, voffB); PG8_STAGE(PG8_SA(1, 0), cA + kstep, vA0); PG8_STAGE(PG8_SB(1, 1), cB + hstepB + kstep, voffB);
    PG8_WAIT_V(6); PG8_BAR;
    for (;;) {
        const bool has_next = S.next(ui + 1, nxt);
        const char* nA = has_next ? nxt.A : cA; const char* nB = has_next ? nxt.B : cB;
        if (has_next) S.a_off(nxt, g.lda, Ri, Ci, nvA0, nvA1); else { nvA0[0] = vA0[0]; nvA0[1] = vA0[1]; nvA1[0] = vA1[0]; nvA1[1] = vA1[1]; }
        for (int t = 0; t < nt; t += 2) {
            if constexpr (Epi::HOOK) { if (t != 0 && (t & 3) == 0) E.hook(acc, cur, t >> 2, wr, wc, fr, fq); }
            const bool last = (t == nt - 2);
            if (last) E.prefetch(cur, wr, wc, fr, fq, pre);
            const char* a1 = cA + (size_t)(t + 1) * kstep;
            const char* a2 = last ? nA : cA + (size_t)(t + 2) * kstep; const char* b2 = last ? nB : cB + (size_t)(t + 2) * kstep;
            const char* a3 = a2 + kstep; const char* b3 = b2 + kstep;
            unsigned w0[2], w1[2];
            w0[0] = last ? nvA0[0] : vA0[0]; w0[1] = last ? nvA0[1] : vA0[1]; w1[0] = last ? nvA1[0] : vA1[0]; w1[1] = last ? nvA1[1] : vA1[1];
            PG8_LDB(B0, 0, 0); PG8_LDB(B1, 0, 1); PG8_SCHED; PG8_LDA(At, 0, 0); PG8_STAGE(PG8_SA(1, 1), a1, vA1);
            PG8_WAIT_V(8); PG8_WAIT_L(0); PG8_BAR; PG8_MMA(0, 0, At, B0); PG8_MMA(0, 1, At, B1); PG8_BAR; PG8_SCHED;
            PG8_LDA(At, 0, 1); PG8_STAGE(PG8_SB(0, 0), b2, voffB); PG8_STAGE(PG8_SB(0, 1), b2 + hstepB, voffB); PG8_STAGE(PG8_SA(0, 0), a2, w0);
            PG8_WAIT_V(8); PG8_WAIT_L(0); PG8_BAR; PG8_MMA(1, 0, At, B0); PG8_MMA(1, 1, At, B1); PG8_BAR; PG8_SCHED;
            PG8_LDB(B0, 1, 0); PG8_LDB(B1, 1, 1); PG8_SCHED; PG8_LDA(At, 1, 0); PG8_STAGE(PG8_SA(0, 1), a2, w1);
            PG8_WAIT_V(8); PG8_WAIT_L(0); PG8_BAR; PG8_MMA(0, 0, At, B0); PG8_MMA(0, 1, At, B1); PG8_BAR; PG8_SCHED;
            PG8_LDA(At, 1, 1); PG8_STAGE(PG8_SB(1, 0), b3, voffB); PG8_STAGE(PG8_SB(1, 1), b3 + hstepB, voffB); PG8_STAGE(PG8_SA(1, 0), a3, w0);
            PG8_WAIT_V(8); PG8_WAIT_L(0); PG8_BAR; PG8_MMA(1, 0, At, B0); PG8_MMA(1, 1, At, B1); PG8_BAR; PG8_SCHED;
        }
        if constexpr (ALIGN_EPI) { if (wr == 0) PG8_BAR; }
        E(acc, cur, wr, wc, fr, fq, pre);
        if (!has_next) break;
#pragma unroll
        for (int a = 0; a < 2; ++a)
#pragma unroll
            for (int b = 0; b < 2; ++b)
#pragma unroll
                for (int m = 0; m < 4; ++m)
#pragma unroll
                    for (int n = 0; n < 2; ++n) acc[a][b][m][n] = (f32x4){zf, zf, zf, zf};
        cur = nxt; cA = nA; cB = nB; ++ui; vA0[0] = nvA0[0]; vA0[1] = nvA0[1]; vA1[0] = nvA1[0]; vA1[1] = nvA1[1];
        if constexpr (ALIGN_EPI) { if (wr == 1) PG8_BAR; }
    }
    PG8_WAIT_V(0);
    if constexpr (!ALIGN_EPI) { if (wr == 0) PG8_BAR; }
    PG8_BAR;
#undef PG8_SA
#undef PG8_SB
#undef PG8_STAGE
#undef PG8_LDA
#undef PG8_LDB
#undef PG8_MMA
#undef PG8_WAIT_V
#undef PG8_WAIT_L
#undef PG8_BAR
#undef PG8_SCHED
}
}

struct Frame { LAS unsigned char* lds; int tid, lane, wave, G, bid; float zf; unsigned zu; };
#define FRAME_SETUP Frame F; { int t_ = threadIdx.x, b_ = blockIdx.x, g_ = gridDim.x; float z_ = 0.f; unsigned zu_ = 0u; asm volatile("" : "+v"(t_), "+s"(b_), "+s"(g_), "+v"(z_), "+v"(zu_)); \
    F.lds = lds_base(); F.tid = t_; F.lane = t_ & 63; F.wave = __builtin_amdgcn_readfirstlane(t_ >> 6); F.G = g_; F.bid = b_; F.zf = z_; F.zu = zu_; }
extern __shared__ __attribute__((aligned(16))) unsigned char lds_dyn[];
__device__ __forceinline__ LAS unsigned char* lds_base() { return (LAS unsigned char*)lds_dyn; }
typedef const __attribute__((address_space(4))) unsigned long long karg_t;
__device__ __forceinline__ unsigned long long karg(int k) { asm volatile("" : "+s"(k)); return ((karg_t*)__builtin_amdgcn_kernarg_segment_ptr())[k]; }
__device__ __forceinline__ const float* inp(int k) { return (const float*)(const GAS float*)karg(k); }
__device__ __forceinline__ float* outp() { return (float*)(GAS float*)karg(22); }
__device__ __forceinline__ unsigned char* wsp() { return (unsigned char*)(GAS unsigned char*)karg(23); }
enum { I_X = 0, I_WIN, I_BIN, I_GMLNG, I_GMWS, I_GMBS, I_RELB, I_MLCONV, I_MLFB, I_MLNG, I_POOLW, I_POOLS, I_WBR, I_WOUT, I_LN1G, I_LN1B, I_WR, I_WE1, I_WE3, I_WE2, I_LN2G, I_LN2B };
__device__ __forceinline__ bf16* wl(unsigned char* ws, int l, size_t off) { return (bf16*)(ws + WS_W + (size_t)l * LW + off); }

#define WS_PTRS unsigned char* ws = wsp(); float* BIN = (float*)(ws + WS_BIN); float* XF = (float*)(ws + WS_XF); bf16* XB = (bf16*)(ws + WS_XB); bf16* H = (bf16*)(ws + WS_BIG); bf16* XS = (bf16*)(ws + WS_XS); \
    bf16* HID = (bf16*)(ws + WS_HID); bf16* YE = (bf16*)(ws + WS_YE); float* GI = (float*)(ws + WS_GI); bf16* ATTO = (bf16*)(ws + WS_ATTO); float* ATTL = (float*)(ws + WS_ATTL); bf16* YS = (bf16*)(ws + WS_YS); \
    float* MGF = (float*)(ws + WS_MGF); bf16* MGB = (bf16*)(ws + WS_MGB); bf16* QC = (bf16*)(ws + WS_QC); bf16* KC = (bf16*)(ws + WS_KC); bf16* DC = (bf16*)(ws + WS_DC); float* DG = (float*)(ws + WS_DG); \
    float* AFF = (float*)(ws + WS_AFF); float* GATE = (float*)(ws + WS_GATE); int* IDX = (int*)(ws + WS_IDX); int* SLOT = (int*)(ws + WS_SLOT); \
    (void)BIN; (void)XF; (void)XB; (void)H; (void)XS; (void)HID; (void)YE; (void)GI; (void)ATTO; (void)ATTL; (void)YS; (void)MGF; (void)MGB; (void)QC; (void)KC; (void)DC; (void)DG; (void)AFF; (void)GATE; (void)IDX; (void)SLOT
__device__ __forceinline__ void tr_item(const float* W, int ldw, int k0, int n0, int ncols, bf16* WT, int ldt, int trow0, LAS float* scr, int lane) {
    const int c4 = lane & 7, r = lane >> 3; const bool cv = 4 * c4 < ncols;
    f32x4 tv[8];
#pragma unroll
    for (int i = 0; i < 8; ++i) tv[i] = cv ? __builtin_nontemporal_load((const f32x4*)(W + (size_t)(k0 + r + 8 * i) * ldw + n0 + 4 * c4)) : (f32x4){0.f, 0.f, 0.f, 0.f};
#pragma unroll
    for (int i = 0; i < 8; ++i) { LAS float* d = scr + (r + 8 * i) * 33 + 4 * c4; d[0] = tv[i][0]; d[1] = tv[i][1]; d[2] = tv[i][2]; d[3] = tv[i][3]; }
    LDS_WAIT(); asm volatile("" ::: "memory");
    const int ch = lane & 7;
#pragma unroll
    for (int j = 0; j < 4; ++j) { const int n = (lane >> 3) + 8 * j; const LAS float* s = scr + (8 * ch) * 33 + n;
        u32x4 o; o.x = pk2(s[0 * 33], s[1 * 33]); o.y = pk2(s[2 * 33], s[3 * 33]); o.z = pk2(s[4 * 33], s[5 * 33]); o.w = pk2(s[6 * 33], s[7 * 33]);
        if (n < ncols) *(GAS u32x4*)(WT + (size_t)(trow0 + n) * ldt + k0 + 8 * ch) = o; }
    LDS_WAIT(); asm volatile("" ::: "memory");
}
constexpr int IT_IN = 16 * 209, IT_B = 512, IT_O = 512, IT_13 = 16384, IT_2 = 8192, IT_LAYER = IT_IN + IT_B + IT_O + IT_13 + IT_2;
__device__ __forceinline__ void convert_layer(int l, int gw, int NGW) {
    FRAME_SETUP;
    WS_PTRS; const float* w_in = inp(I_WIN); const float* w_branch = inp(I_WBR); const float* w_out = inp(I_WOUT); const float* w_e1 = inp(I_WE1); const float* w_e3 = inp(I_WE3); const float* w_e2 = inp(I_WE2);
    LAS float* scr = (LAS float*)(F.lds + F.wave * 16384);
    const int lane = F.lane;
    for (int it = gw; it < IT_LAYER; it += NGW) {
        int r = it; const float* W; int ldw, k0, n0, nc = 32, ldt, trow; bf16* WT;
        if (r < IT_IN) { const int kb = r / 209, cb = r % 209; k0 = 64 * kb;
            if (cb < 72) { n0 = 32 * cb; trow = n0; } else if (cb < 208) { n0 = 2320 + 32 * (cb - 72); trow = 2304 + 32 * (cb - 72); } else { n0 = 2304; trow = 6656; nc = 16; }
            W = w_in + (size_t)l * D * NIN; ldw = NIN; WT = wl(ws, l, OW_IN); ldt = D; }
        else if ((r -= IT_IN) < IT_B) { const int n = r / 128, q = r % 128, kb = q / 32, nb = q % 32;
            W = w_branch + ((size_t)(l * 4 + n) * 256) * D; ldw = D; k0 = 64 * kb; n0 = 32 * nb; WT = wl(ws, l, OW_B) + (size_t)n * 256; ldt = D; trow = 32 * nb; }
        else if ((r -= IT_B) < IT_O) { const int kb = r / 32, nb = r % 32;
            W = w_out + (size_t)l * D * D; ldw = D; k0 = 64 * kb; n0 = 32 * nb; WT = wl(ws, l, OW_O); ldt = D; trow = 32 * nb; }
        else if ((r -= IT_O) < IT_13) { const int e = r / 1024, q = r % 1024, which = q / 512, q2 = q % 512, kb = q2 / 32, nb = q2 % 32, f0 = 32 * nb;
            W = (which ? w_e3 : w_e1) + ((size_t)(l * NE + e) * D) * FF; ldw = FF; k0 = 64 * kb; n0 = f0; WT = wl(ws, l, OW_13) + (size_t)e * 2048 * D; ldt = D; trow = (f0 / 128) * 256 + (f0 % 128) + which * 128; }
        else { r -= IT_13; const int e = r / 512, q = r % 512, kb = q / 32, nb = q % 32;
            W = w_e2 + ((size_t)(l * NE + e) * FF) * D; ldw = D; k0 = 64 * kb; n0 = 32 * nb; WT = wl(ws, l, OW_2) + (size_t)e * D * FF; ldt = FF; trow = 32 * nb; }
        tr_item(W, ldw, k0, n0, nc, WT, ldt, trow, scr, lane);
    }
}
__device__ __forceinline__ void p0_prologue() {
    FRAME_SETUP;
    WS_PTRS; const float* x = inp(I_X); const float* b_in = inp(I_BIN);
    convert_layer(0, F.bid * NWAVES + F.wave, F.G * NWAVES);
    const int gt = F.bid * NTHREADS + F.tid, NGT = F.G * NTHREADS;
    for (int i = gt; i < DEPTH * 240 * (D / 8); i += NGT) { const int l = i / (240 * (D / 8)), r = i % (240 * (D / 8));
        *(GAS u32x4*)(wl(ws, l, OW_IN) + (size_t)NIN * D + (size_t)r * 8) = (u32x4){F.zu, F.zu, F.zu, F.zu}; }
    for (int i = gt; i < DEPTH * NINP; i += NGT) { const int l = i / NINP, c = i % NINP;
        float v = 0.f; if (c < 2304) v = b_in[l * NIN + c]; else if (c < NH) v = b_in[l * NIN + c + 16]; else if (c < NH + 16) v = b_in[l * NIN + c - NH + 2304];
        BIN[i] = v; }
    { const float* gm_ws = inp(I_GMWS); bf16* WSB = (bf16*)(ws + WS_WSB);
      for (int i = gt; i < DEPTH * 4 * 128 * 128 / 4; i += NGT) { const f32x4 v = ((const GAS f32x4*)gm_ws)[i]; u32x2 w; w.x = pk2(v.x, v.y); w.y = pk2(v.z, v.w); ((GAS u32x2*)WSB)[i] = w; } }
    { const float* pool_w = inp(I_POOLW); bf16* PWT = (bf16*)(ws + WS_PWT);
      for (int i = gt; i < DEPTH * 4 * 64 * 64; i += NGT) { const int lg = i >> 12, o = (i >> 6) & 63, ii = i & 63; PWT[i] = (bf16)f2bf(pool_w[(size_t)lg * 4096 + ii * 64 + o]); } }
    { const float* w_router = inp(I_WR); bf16* WRT = (bf16*)(ws + WS_WRT);
      for (int i = gt; i < DEPTH * NE * D; i += NGT) { const int ll = i / (NE * D), e = (i / D) % NE, d = i % D; WRT[i] = (bf16)f2bf(w_router[((size_t)ll * D + d) * NE + e]); } }
    for (int i = gt; i < T * D / 4; i += NGT) { const f32x4 v = ((const GAS f32x4*)x)[i];
        u32x2 w; w.x = pk2(v.x, v.y); w.y = pk2(v.z, v.w); ((GAS u32x2*)XB)[i] = w; }
}

typedef f32x4 Acc[2][2][4][2];
struct SchedG1 { int G, c; const char* A; const char* B;
    __device__ __forceinline__ void a_off(const pg8::Unit&, int lda, const int (&Ri)[2], const int (&Ci)[2], unsigned (&v0)[2], unsigned (&v1)[2]) const {
#pragma unroll
        for (int i = 0; i < 2; ++i) { v0[i] = (unsigned)(Ri[i] * lda + Ci[i]) * 2u; v1[i] = v0[i] + (unsigned)(128 * lda * 2); } }
    __device__ __forceinline__ bool next(int i, pg8::Unit& u) const { int pm, pn; if (!pg8::tile_of(i, G, c, T / 256, NINP / 256, pm, pn)) return false;
        u.pm = pm; u.pn = pn; u.aux = 0; u.A = A + (size_t)pm * 256 * D * 2; u.B = B + (size_t)pn * 256 * D * 2; return true; } };
struct EpiG1 { static constexpr bool PERM = true, HOOK = false; bf16* H; float* GI; const float* bias; u32x4* GQ;
    struct Pre { f32x4 bv[2][2]; };
    __device__ __forceinline__ void prefetch(const pg8::Unit& u, int wr, int wc, int fr, int fq, Pre& p) const { const int col0 = u.pn * 256 + wc * 32 + 8 * fq;
#pragma unroll
        for (int bj = 0; bj < 2; ++bj)
#pragma unroll
            for (int n = 0; n < 2; ++n) p.bv[bj][n] = *(const f32x4*)(bias + col0 + bj * 128 + 4 * n); }
    __device__ __forceinline__ void operator()(const Acc& acc, const pg8::Unit& u, int wr, int wc, int fr_, int fq_, const Pre& pre) const {
        unsigned t_ = threadIdx.x; asm volatile("" : "+v"(t_)); const int fr = (int)(t_ & 15u), fq = (int)((t_ >> 4) & 3u);
        const int row0 = u.pm * 256 + wr * 64 + fr;
        if (u.pn < 26) {
            const int col0 = u.pn * 256 + wc * 32 + 8 * fq; const bool act = u.pn < 2, sg = u.pn >= 10;
            const unsigned gq0 = (unsigned)((wr * 4 + wc) * 512 + fq * 16 + fr);
#pragma unroll
            for (int ai = 0; ai < 2; ++ai)
#pragma unroll
                for (int m = 0; m < 4; ++m) { bf16* rowp = H + (size_t)(row0 + ai * 128 + m * 16) * NH + col0;
                    u32x4 qq = (u32x4){0u, 0u, 0u, 0u};
#pragma unroll
                    for (int bj = 0; bj < 2; ++bj) { f32x4 v0 = acc[ai][bj][m][0] + pre.bv[bj][0], v1 = acc[ai][bj][m][1] + pre.bv[bj][1];
                        if (act) { v0 = (f32x4){gelu_tanh(v0[0]), gelu_tanh(v0[1]), gelu_tanh(v0[2]), gelu_tanh(v0[3])}; v1 = (f32x4){gelu_tanh(v1[0]), gelu_tanh(v1[1]), gelu_tanh(v1[2]), gelu_tanh(v1[3])}; }
                        if (sg) {
                            u32x2 qb; qb.x = 0u; qb.y = 0u;
#pragma unroll
                            for (int j = 0; j < 4; ++j) { qb.x = __builtin_amdgcn_cvt_pk_u8_f32(sigmoidf_(v0[j]) * 256.0f - 0.5f, j, qb.x); qb.y = __builtin_amdgcn_cvt_pk_u8_f32(sigmoidf_(v1[j]) * 256.0f - 0.5f, j, qb.y); }
                            if (bj == 0) { qq.x = qb.x; qq.y = qb.y; } else { qq.z = qb.x; qq.w = qb.y; }
                        } else {
                        u32x4 w; w.x = pk2(v0[0], v0[1]); w.y = pk2(v0[2], v0[3]); w.z = pk2(v1[0], v1[1]); w.w = pk2(v1[2], v1[3]);
                        *(u32x4*)(rowp + bj * 128) = w; } }
                    if (sg) GQ[(size_t)((u.pm * 4 + ((u.pn - 10) & 3)) * 4 + ((u.pn - 10) >> 2)) * 4096 + gq0 + (ai * 4 + m) * 64] = qq; }
        } else if (wc == 0 && fq < 2) {
            const unsigned fq8 = 8u * fq;
#pragma unroll
            for (int ai = 0; ai < 2; ++ai)
#pragma unroll
                for (int m = 0; m < 4; ++m) { float* rowp = GI + (size_t)(row0 + ai * 128 + m * 16) * 16 + fq8;
#pragma unroll
                    for (int n = 0; n < 2; ++n) *(f32x4*)(rowp + 4 * n) = acc[ai][0][m][n] + pre.bv[0][n]; }
        }
    } };
struct SchedG2 { int G, c; const char* A; const char* B;
    __device__ __forceinline__ void a_off(const pg8::Unit&, int lda, const int (&Ri)[2], const int (&Ci)[2], unsigned (&v0)[2], unsigned (&v1)[2]) const {
#pragma unroll
        for (int i = 0; i < 2; ++i) { v0[i] = (unsigned)(Ri[i] * lda + Ci[i]) * 2u; v1[i] = v0[i] + (unsigned)(128 * lda * 2); } }
    __device__ __forceinline__ bool next(int i, pg8::Unit& u) const { int pm, pn; if (!pg8::tile_of(i, G, c, T / 256, D / 256, pm, pn)) return false;
        u.pm = pm; u.pn = pn; u.aux = 0; u.A = A + (size_t)pm * 256 * D * 2; u.B = B + (size_t)pn * 256 * D * 2; return true; } };
__device__ __forceinline__ void unq8(const u32x2 w, float (&o)[8]) {
    o[0] = ((float)(w.x & 255u) + 0.5f) * (1.0f / 256.0f); o[1] = ((float)((w.x >> 8) & 255u) + 0.5f) * (1.0f / 256.0f); o[2] = ((float)((w.x >> 16) & 255u) + 0.5f) * (1.0f / 256.0f); o[3] = ((float)(w.x >> 24) + 0.5f) * (1.0f / 256.0f);
    o[4] = ((float)(w.y & 255u) + 0.5f) * (1.0f / 256.0f); o[5] = ((float)((w.y >> 8) & 255u) + 0.5f) * (1.0f / 256.0f); o[6] = ((float)((w.y >> 16) & 255u) + 0.5f) * (1.0f / 256.0f); o[7] = ((float)(w.y >> 24) + 0.5f) * (1.0f / 256.0f); }
struct EpiG2 { static constexpr bool PERM = true, HOOK = true; struct Pre {}; __device__ __forceinline__ void prefetch(const pg8::Unit&, int, int, int, int, Pre&) const {} const u32x4* GQ; bf16* MGB;
    __device__ __forceinline__ void hook(Acc& acc, const pg8::Unit& u, int n, int wr, int wc, int fr, int fq) const {
        const u32x4* ga_p = GQ + ((((size_t)(u.pm * 4 + u.pn) * 4 + (n - 1)) * 8 + (wr * 4 + wc)) * 8) * 64 + fq * 16 + fr; const u32x4* gb_p = ga_p + 8 * 8 * 64;
        u32x4 ga[8], gb[8];
#pragma unroll
        for (int q = 0; q < 8; ++q) { ga[q] = ga_p[q * 64]; gb[q] = gb_p[q * 64]; }
#pragma unroll
        for (int q = 0; q < 8; ++q) { const int ai = q >> 2, m = q & 3;
            { float sa[8], sb[8]; unq8((u32x2){ga[q].x, ga[q].y}, sa); unq8((u32x2){gb[q].x, gb[q].y}, sb);
              acc[ai][0][m][0] *= (f32x4){sa[0] * __builtin_amdgcn_rcpf(sb[0]), sa[1] * __builtin_amdgcn_rcpf(sb[1]), sa[2] * __builtin_amdgcn_rcpf(sb[2]), sa[3] * __builtin_amdgcn_rcpf(sb[3])};
              acc[ai][0][m][1] *= (f32x4){sa[4] * __builtin_amdgcn_rcpf(sb[4]), sa[5] * __builtin_amdgcn_rcpf(sb[5]), sa[6] * __builtin_amdgcn_rcpf(sb[6]), sa[7] * __builtin_amdgcn_rcpf(sb[7])}; }
            { float sa[8], sb[8]; unq8((u32x2){ga[q].z, ga[q].w}, sa); unq8((u32x2){gb[q].z, gb[q].w}, sb);
              acc[ai][1][m][0] *= (f32x4){sa[0] * __builtin_amdgcn_rcpf(sb[0]), sa[1] * __builtin_amdgcn_rcpf(sb[1]), sa[2] * __builtin_amdgcn_rcpf(sb[2]), sa[3] * __builtin_amdgcn_rcpf(sb[3])};
              acc[ai][1][m][1] *= (f32x4){sa[4] * __builtin_amdgcn_rcpf(sb[4]), sa[5] * __builtin_amdgcn_rcpf(sb[5]), sa[6] * __builtin_amdgcn_rcpf(sb[6]), sa[7] * __builtin_amdgcn_rcpf(sb[7])}; }
            __builtin_amdgcn_sched_barrier(0); }
        asm volatile("" ::: "memory");
    }
    __device__ __forceinline__ void operator()(const Acc& acc, const pg8::Unit& u, int wr, int wc, int fr, int fq, const Pre& pre) const {
        const size_t rowb = (size_t)(u.pm * 256 + wr * 64 + fr); const int col0 = u.pn * 256 + wc * 32 + 8 * fq;
        const u32x4* gp = GQ + ((((size_t)(u.pm * 4 + u.pn) * 4 + 3) * 8 + (wr * 4 + wc)) * 8) * 64 + fq * 16 + fr; bf16* bp = MGB + rowb * D + col0;
        u32x4 gv[8];
#pragma unroll
        for (int q = 0; q < 8; ++q) gv[q] = gp[q * 64];
#pragma unroll
        for (int ai = 0; ai < 2; ++ai)
#pragma unroll
            for (int m = 0; m < 4; ++m)
#pragma unroll
                for (int bj = 0; bj < 2; ++bj) { const int ro = ai * 128 + m * 16; const u32x4 G = gv[ai * 4 + m]; float sv[8]; unq8(bj ? (u32x2){G.z, G.w} : (u32x2){G.x, G.y}, sv);
                    const f32x4 a0 = acc[ai][bj][m][0], a1 = acc[ai][bj][m][1];
                    u32x4 w; w.x = pk2(a0[0] * sv[0], a0[1] * sv[1]); w.y = pk2(a0[2] * sv[2], a0[3] * sv[3]); w.z = pk2(a1[0] * sv[4], a1[1] * sv[5]); w.w = pk2(a1[2] * sv[6], a1[3] * sv[7]);
                    *(u32x4*)(bp + (size_t)ro * D + bj * 128) = w; }
    } };
struct SchedG3 { int G, c; const char* A; const char* B;
    __device__ __forceinline__ void a_off(const pg8::Unit&, int lda, const int (&Ri)[2], const int (&Ci)[2], unsigned (&v0)[2], unsigned (&v1)[2]) const {
#pragma unroll
        for (int i = 0; i < 2; ++i) { v0[i] = (unsigned)(Ri[i] * lda + Ci[i]) * 2u; v1[i] = v0[i] + (unsigned)(128 * lda * 2); } }
    __device__ __forceinline__ bool next(int i, pg8::Unit& u) const { int pm, pn; if (!pg8::tile_of(i, G, c, T / 256, D / 256, pm, pn)) return false;
        u.pm = pm; u.pn = pn; u.aux = 0; u.A = A + (size_t)pm * 256 * D * 2; u.B = B + (size_t)pn * 256 * D * 2; return true; } };
struct EpiG3 { static constexpr bool PERM = true, HOOK = false; struct Pre {}; __device__ __forceinline__ void prefetch(const pg8::Unit&, int, int, int, int, Pre&) const {} const bf16* XB; bf16* R; float* STAT;
    __device__ __forceinline__ void operator()(const Acc& acc, const pg8::Unit& u, int wr, int wc, int fr, int fq, const Pre& pre) const {
        const int row0 = u.pm * 256 + wr * 64 + fr, col0 = u.pn * 256 + wc * 32 + 8 * fq, lane = fq * 16 + fr;
#pragma unroll
        for (int ai = 0; ai < 2; ++ai) { u32x4 xr[4][2];
#pragma unroll
            for (int m = 0; m < 4; ++m)
#pragma unroll
                for (int bj = 0; bj < 2; ++bj) xr[m][bj] = *(const u32x4*)(XB + (size_t)(row0 + ai * 128 + m * 16) * D + col0 + bj * 128);
#pragma unroll
            for (int m = 0; m < 4; ++m) { const size_t row = (size_t)(row0 + ai * 128 + m * 16); float s1 = 0.f, s2 = 0.f;
#pragma unroll
                for (int bj = 0; bj < 2; ++bj) { const size_t o = row * D + col0 + bj * 128; float x8[8]; unpack8(xr[m][bj], x8);
                    const f32x4 r0 = (f32x4){x8[0], x8[1], x8[2], x8[3]} * ALPHA + acc[ai][bj][m][0], r1 = (f32x4){x8[4], x8[5], x8[6], x8[7]} * ALPHA + acc[ai][bj][m][1];
                    { u32x4 w; w.x = pk2(r0[0], r0[1]); w.y = pk2(r0[2], r0[3]); w.z = pk2(r1[0], r1[1]); w.w = pk2(r1[2], r1[3]); *(u32x4*)(R + o) = w; }
                    s1 += ((r0[0] + r0[1]) + (r0[2] + r0[3])) + ((r1[0] + r1[1]) + (r1[2] + r1[3]));
                    s2 += ((r0[0] * r0[0] + r0[1] * r0[1]) + (r0[2] * r0[2] + r0[3] * r0[3])) + ((r1[0] * r1[0] + r1[1] * r1[1]) + (r1[2] * r1[2] + r1[3] * r1[3])); }
                s1 += shx(s1, 16, lane); s1 += shx(s1, 32, lane); s2 += shx(s2, 16, lane); s2 += shx(s2, 32, lane);
                if (fq == 0) *(f32x2*)(STAT + (row * 16 + u.pn * 4 + wc) * 2) = (f32x2){s1, s2}; } }
    } };
struct SchedG4 { int G, c; const char* A; const char* B; const int* IDX;
    __device__ __forceinline__ bool next(int i, pg8::Unit& u) const { int pm, pn; if (!pg8::tile_of(i, G, c, NSLOT / 256, 2048 / 256, pm, pn)) return false; const int e = (pm >> 2) & 15;
        u.pm = pm; u.pn = pn; u.aux = e; u.A = A + (size_t)(pm >> 6) * SEQ * D * 2; u.B = B + (size_t)e * 2048 * D * 2 + (size_t)pn * 256 * D * 2; return true; }
    __device__ __forceinline__ void a_off(const pg8::Unit& u, int lda, const int (&Ri)[2], const int (&Ci)[2], unsigned (&v0)[2], unsigned (&v1)[2]) const {
#pragma unroll
        for (int i = 0; i < 2; ++i) { const int r0 = IDX[u.pm * 256 + Ri[i]], r1 = IDX[u.pm * 256 + 128 + Ri[i]]; v0[i] = (unsigned)(r0 * lda + Ci[i]) * 2u; v1[i] = (unsigned)(r1 * lda + Ci[i]) * 2u; } } };
struct EpiG4 { static constexpr bool PERM = true, HOOK = false; struct Pre {}; __device__ __forceinline__ void prefetch(const pg8::Unit&, int, int, int, int, Pre&) const {} bf16* HID;
    __device__ __forceinline__ void operator()(const Acc& acc, const pg8::Unit& u, int wr, int wc, int fr, int fq, const Pre& pre) const {
        const int row0 = u.pm * 256 + wr * 64 + fr, col0 = u.pn * 128 + wc * 32 + 8 * fq;
#pragma unroll
        for (int ai = 0; ai < 2; ++ai)
#pragma unroll
            for (int m = 0; m < 4; ++m) { const size_t row = (size_t)(row0 + ai * 128 + m * 16);
                const f32x4 a0 = acc[ai][0][m][0], a1 = acc[ai][0][m][1], g0 = acc[ai][1][m][0], g1 = acc[ai][1][m][1];
                u32x4 w; w.x = pk2(siluf_(a0[0]) * g0[0], siluf_(a0[1]) * g0[1]); w.y = pk2(siluf_(a0[2]) * g0[2], siluf_(a0[3]) * g0[3]);
                w.z = pk2(siluf_(a1[0]) * g1[0], siluf_(a1[1]) * g1[1]); w.w = pk2(siluf_(a1[2]) * g1[2], siluf_(a1[3]) * g1[3]);
                *(u32x4*)(HID + row * FF + col0) = w; }
    } };
struct SchedG5 { int G, c; const char* A; const char* B;
    __device__ __forceinline__ void a_off(const pg8::Unit&, int lda, const int (&Ri)[2], const int (&Ci)[2], unsigned (&v0)[2], unsigned (&v1)[2]) const {
#pragma unroll
        for (int i = 0; i < 2; ++i) { v0[i] = (unsigned)(Ri[i] * lda + Ci[i]) * 2u; v1[i] = v0[i] + (unsigned)(128 * lda * 2); } }
    __device__ __forceinline__ bool next(int i, pg8::Unit& u) const { int pm, pn; if (!pg8::tile_of(i, G, c, NSLOT / 256, D / 256, pm, pn)) return false; const int e = (pm >> 2) & 15;
        u.pm = pm; u.pn = pn; u.aux = e; u.A = A + (size_t)pm * 256 * FF * 2; u.B = B + (size_t)e * D * FF * 2 + (size_t)pn * 256 * FF * 2; return true; } };
struct EpiG5 { static constexpr bool PERM = true, HOOK = false; const float* GATE; bf16* YE;
    struct Pre { float g[2][4]; };
    __device__ __forceinline__ void prefetch(const pg8::Unit& u, int wr, int wc, int fr, int fq, Pre& p) const { const int row0 = u.pm * 256 + wr * 64 + fr;
#pragma unroll
        for (int ai = 0; ai < 2; ++ai)
#pragma unroll
            for (int m = 0; m < 4; ++m) p.g[ai][m] = GATE[row0 + ai * 128 + m * 16]; }
    __device__ __forceinline__ void operator()(const Acc& acc, const pg8::Unit& u, int wr, int wc, int fr, int fq, const Pre& pre) const {
        const int row0 = u.pm * 256 + wr * 64 + fr, col0 = u.pn * 256 + wc * 32 + 8 * fq;
#pragma unroll
        for (int ai = 0; ai < 2; ++ai)
#pragma unroll
            for (int m = 0; m < 4; ++m) { const size_t row = (size_t)(row0 + ai * 128 + m * 16); const float gt = pre.g[ai][m];
#pragma unroll
                for (int bj = 0; bj < 2; ++bj) { const f32x4 v0 = acc[ai][bj][m][0] * gt, v1 = acc[ai][bj][m][1] * gt;
                    u32x4 w; w.x = pk2(v0[0], v0[1]); w.y = pk2(v0[2], v0[3]); w.z = pk2(v1[0], v1[1]); w.w = pk2(v1[2], v1[3]);
                    *(u32x4*)(YE + row * D + col0 + bj * 128) = w; } }
    } };

typedef float f32x16 __attribute__((ext_vector_type(16)));
typedef short s16x4 __attribute__((ext_vector_type(4)));
typedef __bf16 bf16x2_t __attribute__((ext_vector_type(2)));
#define MFMA32(a, b, c) __builtin_amdgcn_mfma_f32_32x32x16_bf16((a), (b), (c), 0, 0, 0)
__device__ __forceinline__ int crow(int reg, int h) { return (reg & 3) + 8 * (reg >> 2) + 4 * h; }
__device__ __forceinline__ unsigned cvtpk(float lo, float hi) { f32x2 v = {lo, hi}; bf16x2_t b = __builtin_convertvector(v, bf16x2_t); return __builtin_bit_cast(unsigned, b); }
__device__ __forceinline__ bf16x8 pack8(float a0, float a1, float a2, float a3, float a4, float a5, float a6, float a7) {
    u32x4 p; p.x = cvtpk(a0, a1); p.y = cvtpk(a2, a3); p.z = cvtpk(a4, a5); p.w = cvtpk(a6, a7); return __builtin_bit_cast(bf16x8, p); }
typedef short v4i16_t __attribute__((ext_vector_type(4)));
__device__ __forceinline__ s16x4 tr_rd(const LAS unsigned char* p) { return __builtin_bit_cast(s16x4, __builtin_amdgcn_ds_read_tr16_b64_v4i16((LAS v4i16_t*)p)); }
__device__ __forceinline__ bf16x8 tr_frag(const LAS unsigned char* img, int pitch, int k0, int k1, int col0, int lane) {
    const int i16 = lane & 15, qd = i16 >> 2, p = i16 & 3, blk = (lane >> 4) & 1;
    const s16x4 lo = tr_rd(img + (k0 + qd) * pitch + (col0 + 16 * blk + 4 * p) * 2), hi = tr_rd(img + (k1 + qd) * pitch + (col0 + 16 * blk + 4 * p) * 2);
    return __builtin_shufflevector(lo, hi, 0, 1, 2, 3, 4, 5, 6, 7); }
constexpr int C1_ITEM_LDS = 3 * 64 * 144 + 2048;
__device__ __forceinline__ void mlstm_c1m(int l, int bi) {
    FRAME_SETUP; WS_PTRS; const float* ml_conv = inp(I_MLCONV); const float* ml_fbias = inp(I_MLFB);
    const int tid = F.tid, lane = F.lane, w = F.wave, dir = w & 1, jj = w >> 1, tp = tid & 127;
    const int item = bi * 4 + jj, c = item & 127, h = (item >> 7) & 3, b = item >> 9;
    const int p0 = b * SEQ + c * 64, hc = h * 64;
    LAS unsigned char* base = F.lds + jj * C1_ITEM_LDS;
    LAS unsigned char* Vt = base; LAS unsigned char* K0 = base + 64 * 144; LAS unsigned char* K1 = base + 2 * 64 * 144; LAS float* wT = (LAS float*)(base + 3 * 64 * 144);
    const int chain = ((dir * 2 + b) * 4 + h) * 128 + c; bf16* dc = DC + (size_t)chain * 4160;
    u32x4 cq[4][3], ck[4][3], cv[4]; bool rok[4][3];
    const int cg = (tp & 7) * 8, r0 = tp >> 3;
#pragma unroll
    for (int i = 0; i < 4; ++i) { const int row = r0 + 16 * i, sq = c * 64 + row;
#pragma unroll
        for (int dr = 0; dr < 3; ++dr) { rok[i][dr] = (sq + dr - 1 >= 0) && (sq + dr - 1 < SEQ); const int sc = min(max(sq + dr - 1, 0), SEQ - 1); const bf16* r2 = H + (size_t)(b * SEQ + sc) * NH;
            cq[i][dr] = *(const u32x4*)(r2 + HCQ + hc + cg); ck[i][dr] = *(const u32x4*)(r2 + HCK + hc + cg); }
        cv[i] = *(const u32x4*)(H + (size_t)(p0 + row) * NH + HCV + hc + cg); }
    f32x4 cwq[3][2], cwk[3][2];
    { const float* cw = ml_conv + (size_t)l * 3 * 512;
#pragma unroll
      for (int dr = 0; dr < 3; ++dr) { cwq[dr][0] = *(const f32x4*)(cw + dr * 512 + hc + cg); cwq[dr][1] = *(const f32x4*)(cw + dr * 512 + hc + cg + 4); cwk[dr][0] = *(const f32x4*)(cw + dr * 512 + 256 + hc + cg); cwk[dr][1] = *(const f32x4*)(cw + dr * 512 + 256 + hc + cg + 4); } }
    { const float* gi = GI + (size_t)(p0 + lane) * 16; const float li = gi[dir * 4 + h]; float cum = logsigmoidf_(gi[8 + dir * 4 + h] + ml_fbias[l * 8 + dir * 4 + h]);
#pragma unroll
        for (int off = 1; off < 64; off <<= 1) { const int src = dir ? lane + off : lane - off; const float v = __int_as_float(__builtin_amdgcn_ds_bpermute((src & 63) << 2, __float_as_int(cum))); if (src >= 0 && src < 64) cum += v; }
        const float g = __int_as_float(__builtin_amdgcn_ds_bpermute((dir ? 0 : 63) << 2, __float_as_int(cum)));
        wT[dir * 64 + lane] = __expf(g - cum + li); if (lane == 0) DG[chain] = g; }
    __syncthreads();
    {
#pragma unroll
        for (int i = 0; i < 4; ++i) { const int row = r0 + 16 * i; const float w0 = wT[row], w1 = wT[64 + row];
            float qv[8], kv[8];
#pragma unroll
            for (int j = 0; j < 8; ++j) { qv[j] = 0.f; kv[j] = 0.f; }
#pragma unroll
            for (int dr = 0; dr < 3; ++dr) { const float m = rok[i][dr] ? 1.f : 0.f; float q8[8], k8[8]; unpack8(cq[i][dr], q8); unpack8(ck[i][dr], k8);
#pragma unroll
                for (int j = 0; j < 8; ++j) { qv[j] += m * cwq[dr][j >> 2][j & 3] * q8[j]; kv[j] += m * cwk[dr][j >> 2][j & 3] * k8[j]; } }
#pragma unroll
            for (int j = 0; j < 8; ++j) { qv[j] = siluf_(qv[j]); kv[j] = siluf_(kv[j]) * 0.125f; }
            u32x4 wq, wk, wk0, wk1; wq.x = pk2(qv[0], qv[1]); wq.y = pk2(qv[2], qv[3]); wq.z = pk2(qv[4], qv[5]); wq.w = pk2(qv[6], qv[7]); wk.x = pk2(kv[0], kv[1]); wk.y = pk2(kv[2], kv[3]); wk.z = pk2(kv[4], kv[5]); wk.w = pk2(kv[6], kv[7]);
            wk0.x = pk2(kv[0] * w0, kv[1] * w0); wk0.y = pk2(kv[2] * w0, kv[3] * w0); wk0.z = pk2(kv[4] * w0, kv[5] * w0); wk0.w = pk2(kv[6] * w0, kv[7] * w0);
            wk1.x = pk2(kv[0] * w1, kv[1] * w1); wk1.y = pk2(kv[2] * w1, kv[3] * w1); wk1.z = pk2(kv[4] * w1, kv[5] * w1); wk1.w = pk2(kv[6] * w1, kv[7] * w1);
            *(u32x4*)(QC + (size_t)(p0 + row) * 256 + hc + cg) = wq; *(u32x4*)(KC + (size_t)(p0 + row) * 256 + hc + cg) = wk;
            *(LAS u32x4*)(K0 + row * 144 + cg * 2) = wk0; *(LAS u32x4*)(K1 + row * 144 + cg * 2) = wk1; *(LAS u32x4*)(Vt + row * 144 + cg * 2) = cv[i]; }
    }
    __syncthreads();
    {
        const int tl = lane & 31, hh = lane >> 5; const LAS unsigned char* Kimg = dir ? K1 : K0;
#pragma unroll
        for (int kt = 0; kt < 2; ++kt) { bf16x8 kf[4]; float dn = 0.f;
#pragma unroll
            for (int ks = 0; ks < 4; ++ks) { kf[ks] = tr_frag(Kimg, 144, 16 * ks + 8 * hh, 16 * ks + 8 * hh + 4, 32 * kt, lane); float k8[8]; unpack8(__builtin_bit_cast(u32x4, kf[ks]), k8);
#pragma unroll
                for (int j = 0; j < 8; ++j) dn += k8[j]; }
            dn += shx(dn, 32, lane); if (hh == 0) dc[4096 + 32 * kt + tl] = (bf16)f2bf(dn);
#pragma unroll
            for (int vt = 0; vt < 2; ++vt) { f32x16 acc;
#pragma unroll
                for (int i = 0; i < 16; ++i) acc[i] = F.zf;
#pragma unroll
                for (int ks = 0; ks < 4; ++ks) { const bf16x8 vf = tr_frag(Vt, 144, 16 * ks + 8 * hh, 16 * ks + 8 * hh + 4, 32 * vt, lane); acc = MFMA32(kf[ks], vf, acc); }
#pragma unroll
                for (int g4 = 0; g4 < 4; ++g4) { u32x2 wv; wv.x = pk2(acc[4 * g4], acc[4 * g4 + 1]); wv.y = pk2(acc[4 * g4 + 2], acc[4 * g4 + 3]); *(u32x2*)(dc + (32 * vt + tl) * 64 + 32 * kt + 8 * g4 + 4 * hh) = wv; } } }
    }
    __syncthreads();
}
constexpr int GM_PITCH = 576;
__device__ __forceinline__ void gmlp_m(int l, int item) {
    FRAME_SETUP; WS_PTRS; const float* gm_ln_g = inp(I_GMLNG); const float* gm_bs = inp(I_GMBS); const bf16* WSB = (const bf16*)(ws + WS_WSB);
    const int tid = F.tid, lane = F.lane, w = F.wave;
    const int b = item >> 6, ch = item & 63, p0 = b * SEQ + ch * 128;
    LAS unsigned char* vn = F.lds;
    {
        const int part = tid & 7; const float* lgp = gm_ln_g + l * 256;
        u32x4 raw[2][4];
#pragma unroll
        for (int rr = 0; rr < 2; ++rr)
#pragma unroll
            for (int q = 0; q < 4; ++q) raw[rr][q] = *(const u32x4*)(H + (size_t)(p0 + (tid >> 3) + 64 * rr) * NH + HV + (part + 8 * q) * 8);
#pragma unroll
        for (int rr = 0; rr < 2; ++rr) { const int row = (tid >> 3) + 64 * rr; float s = 0.f, s2 = 0.f;
#pragma unroll
            for (int q = 0; q < 4; ++q) { float v8[8]; unpack8(raw[rr][q], v8);
#pragma unroll
                for (int j = 0; j < 8; ++j) { s += v8[j]; s2 += v8[j] * v8[j]; } }
            s += shx(s, 1, lane); s += shx(s, 2, lane); s += shx(s, 4, lane); s2 += shx(s2, 1, lane); s2 += shx(s2, 2, lane); s2 += shx(s2, 4, lane);
            const float mean = s * (1.0f / 256.0f), var = fmaxf(s2 * (1.0f / 256.0f) - mean * mean, 0.f), rstd = 1.0f / sqrtf(var + LN_EPS);
#pragma unroll
            for (int q = 0; q < 4; ++q) { const int c0 = (part + 8 * q) * 8; float v8[8]; unpack8(raw[rr][q], v8); const f32x4 g0 = *(const f32x4*)(lgp + c0), g1 = *(const f32x4*)(lgp + c0 + 4);
                u32x4 o; o.x = pk2((v8[0] - mean) * rstd * g0[0], (v8[1] - mean) * rstd * g0[1]); o.y = pk2((v8[2] - mean) * rstd * g0[2], (v8[3] - mean) * rstd * g0[3]);
                o.z = pk2((v8[4] - mean) * rstd * g1[0], (v8[5] - mean) * rstd * g1[1]); o.w = pk2((v8[6] - mean) * rstd * g1[2], (v8[7] - mean) * rstd * g1[3]);
                *(LAS u32x4*)(vn + row * GM_PITCH + c0 * 2) = o; } }
    }
    __syncthreads();
    {
        const int g = w >> 1, ph = w & 1, tl = lane & 31, hh = lane >> 5;
#pragma unroll 1
        for (int pt = 0; pt < 2; ++pt) { const int p = 64 * ph + 32 * pt + tl; const size_t tok = (size_t)p0 + p;
            f32x16 M[2];
#pragma unroll
            for (int dt = 0; dt < 2; ++dt)
#pragma unroll
                for (int i = 0; i < 16; ++i) M[dt][i] = F.zf;
            const bf16* wrow = WSB + ((size_t)(l * 4 + g) * 128 + p) * 128 + 8 * hh;
#pragma unroll
            for (int ks = 0; ks < 8; ++ks) { const bf16x8 wf = *(const bf16x8*)(wrow + 16 * ks);
#pragma unroll
                for (int dt = 0; dt < 2; ++dt) { const bf16x8 vf = tr_frag(vn, GM_PITCH, 16 * ks + 8 * hh, 16 * ks + 8 * hh + 4, g * 64 + 32 * dt, lane); M[dt] = MFMA32(vf, wf, M[dt]); } }
            const float bsv = gm_bs[(size_t)(l * 4 + g) * 128 + p];
#pragma unroll
            for (int dt = 0; dt < 2; ++dt)
#pragma unroll
                for (int gg = 0; gg < 4; ++gg) { const int d = g * 64 + 32 * dt + 8 * gg + 4 * hh; const u32x2 uw = *(const u32x2*)(H + tok * NH + HU + d);
                    const float u0 = __uint_as_float(uw.x << 16), u1 = __uint_as_float(uw.x & 0xffff0000u), u2 = __uint_as_float(uw.y << 16), u3 = __uint_as_float(uw.y & 0xffff0000u);
                    u32x2 o; o.x = pk2(u0 * (M[dt][4 * gg] + bsv), u1 * (M[dt][4 * gg + 1] + bsv)); o.y = pk2(u2 * (M[dt][4 * gg + 2] + bsv), u3 * (M[dt][4 * gg + 3] + bsv));
                    *(u32x2*)(YS + tok * D + d) = o; } }
    }
    __syncthreads();
}
__device__ __forceinline__ void mlstm_scan(int wi) {
    FRAME_SETUP;
    WS_PTRS;
    const int lane = F.lane, chain = wi / 17, quad = (wi % 17) * 64 + lane, dir = chain >> 3, base = chain * 128;
    const bool on = quad < 1040;
    const int e = on ? 4 * quad : 0;
    const float d0 = __expf(DG[base + (dir ? 127 - lane : lane)]), d1 = __expf(DG[base + (dir ? 63 - lane : 64 + lane)]);
    f32x4 S = {0.f, 0.f, 0.f, 0.f};
#pragma unroll 1
    for (int i0 = 0; i0 < 128; i0 += 32) {
        u32x2 tmp[32];
#pragma unroll
        for (int j = 0; j < 32; ++j) { const int c = dir ? 127 - (i0 + j) : (i0 + j); tmp[j] = *(const u32x2*)(DC + (size_t)(base + c) * 4160 + e); }
#pragma unroll
        for (int j = 0; j < 32; ++j) { const int c = dir ? 127 - (i0 + j) : (i0 + j);
            const float dec = (i0 < 64) ? __int_as_float(__builtin_amdgcn_readlane(__float_as_int(d0), (i0 & 63) + j)) : __int_as_float(__builtin_amdgcn_readlane(__float_as_int(d1), (i0 & 63) + j));
            if (on) { u32x2 wv; wv.x = pk2(S[0], S[1]); wv.y = pk2(S[2], S[3]); *(u32x2*)(DC + (size_t)(base + c) * 4160 + e) = wv; }
            const f32x4 t = (f32x4){__uint_as_float(tmp[j].x << 16), __uint_as_float(tmp[j].x & 0xffff0000u), __uint_as_float(tmp[j].y << 16), __uint_as_float(tmp[j].y & 0xffff0000u)};
            S = S * dec + t; }
    }
}
constexpr int C3_ITEM_LDS = 20480, C3_PITCH = 144;
__device__ __forceinline__ void mlstm_c3m(int l, int bi) {
    FRAME_SETUP; WS_PTRS; const float* ml_fbias = inp(I_MLFB); const float* ml_norm_g = inp(I_MLNG);
    const int tid = F.tid, lane = F.lane, w = F.wave, dir = w & 1, jj = w >> 1, tp = tid & 127;
    const int item = bi * 4 + jj, c = item & 127, h = (item >> 7) & 3, b = item >> 9;
    const int p0 = b * SEQ + c * 64, hc = h * 64;
    LAS unsigned char* base = F.lds + jj * C3_ITEM_LDS;
    LAS unsigned char* Kt = base; LAS unsigned char* Vt = base + 64 * C3_PITCH;
    LAS float* tab = (LAS float*)(base + 2 * 64 * C3_PITCH);
    LAS float* cumT = tab + dir * 64; LAS float* liT = tab + 128 + dir * 64; LAS float* nsT = tab + 256 + dir * 64;
    LAS float* hbuf = (LAS float*)base;
    const int chain = ((dir * 2 + b) * 4 + h) * 128 + c; const bf16* dc = DC + (size_t)chain * 4160;
    { u32x4 k8[4], v8[4];
#pragma unroll
        for (int u = 0; u < 4; ++u) { const int i = tp + 128 * u, row = i >> 3, cg = (i & 7) * 8; k8[u] = *(const u32x4*)(KC + (size_t)(p0 + row) * 256 + hc + cg); v8[u] = *(const u32x4*)(H + (size_t)(p0 + row) * NH + HCV + hc + cg); }
#pragma unroll
        for (int u = 0; u < 4; ++u) { const int i = tp + 128 * u, row = i >> 3, cg = (i & 7) * 8; *(LAS u32x4*)(Kt + row * C3_PITCH + cg * 2) = k8[u]; *(LAS u32x4*)(Vt + row * C3_PITCH + cg * 2) = v8[u]; } }
    { const float* gi = GI + (size_t)(p0 + lane) * 16; const float li = gi[dir * 4 + h]; float cum = logsigmoidf_(gi[8 + dir * 4 + h] + ml_fbias[l * 8 + dir * 4 + h]);
#pragma unroll
        for (int off = 1; off < 64; off <<= 1) { const int src = dir ? lane + off : lane - off; const float v = __int_as_float(__builtin_amdgcn_ds_bpermute((src & 63) << 2, __float_as_int(cum))); if (src >= 0 && src < 64) cum += v; }
        cumT[lane] = cum; liT[lane] = li - cum; nsT[lane] = bf2f(dc[4096 + lane]); }
    __syncthreads();
    const int tl = lane & 31, hh = lane >> 5;
    f32x16 Hh[2][2];
#pragma unroll
    for (int tt = 0; tt < 2; ++tt) {
        const int t = 32 * tt + tl; const size_t tok = (size_t)p0 + t;
        const float ct = cumT[t], ewt = __expf(ct);
        bf16x8 qf[4], qf2[4]; float nqp = 0.f;
#pragma unroll
        for (int ks = 0; ks < 4; ++ks) { const u32x4 raw = *(const u32x4*)(QC + tok * 256 + hc + 16 * ks + 8 * hh); qf[ks] = __builtin_bit_cast(bf16x8, raw);
            float q8[8]; unpack8(raw, q8);
#pragma unroll
            for (int j = 0; j < 8; ++j) { q8[j] *= ewt; nqp += nsT[16 * ks + 8 * hh + j] * q8[j]; }
            qf2[ks] = pack8(q8[0], q8[1], q8[2], q8[3], q8[4], q8[5], q8[6], q8[7]); }
        f32x16 S[2]; float denp = 0.f;
#pragma unroll
        for (int st = 0; st < 2; ++st) {
#pragma unroll
            for (int i = 0; i < 16; ++i) S[st][i] = F.zf;
#pragma unroll
            for (int ks = 0; ks < 4; ++ks) { const bf16x8 kf = *(const LAS bf16x8*)(Kt + (32 * st + tl) * C3_PITCH + (16 * ks + 8 * hh) * 2); S[st] = MFMA32(kf, qf[ks], S[st]); }
#pragma unroll
            for (int i = 0; i < 16; ++i) { const int sidx = 32 * st + crow(i, hh); const bool valid = dir ? (sidx >= t) : (sidx <= t);
                const float arg = ct + liT[sidx]; const float wgt = __expf(valid ? arg : -1e30f); const float pv = S[st][i] * wgt; S[st][i] = pv; denp += pv; }
            __builtin_amdgcn_sched_barrier(0); }
        const float dn = (denp + shx(denp, 32, lane)) + (nqp + shx(nqp, 32, lane));
        const float inv = 1.0f / fmaxf(fabsf(dn), 1.0f);
#pragma unroll
        for (int vt = 0; vt < 2; ++vt) { f32x16 N;
#pragma unroll
            for (int i = 0; i < 16; ++i) N[i] = F.zf;
#pragma unroll
            for (int st = 0; st < 2; ++st)
#pragma unroll
                for (int s2 = 0; s2 < 2; ++s2) { const bf16x8 pf = pack8(S[st][8 * s2], S[st][8 * s2 + 1], S[st][8 * s2 + 2], S[st][8 * s2 + 3], S[st][8 * s2 + 4], S[st][8 * s2 + 5], S[st][8 * s2 + 6], S[st][8 * s2 + 7]);
                    const int k0 = 32 * st + 16 * s2 + 4 * hh; const bf16x8 vf = tr_frag(Vt, C3_PITCH, k0, k0 + 8, 32 * vt, lane); N = MFMA32(vf, pf, N); }
#pragma unroll
            for (int ks = 0; ks < 4; ++ks) { const bf16x8 cf = *(const bf16x8*)(dc + (32 * vt + tl) * 64 + 16 * ks + 8 * hh); N = MFMA32(cf, qf2[ks], N); }
#pragma unroll
            for (int i = 0; i < 16; ++i) Hh[tt][vt][i] = N[i] * inv; }
    }
    __syncthreads();
    if (dir == 1) {
#pragma unroll
        for (int tt = 0; tt < 2; ++tt)
#pragma unroll
            for (int vt = 0; vt < 2; ++vt)
#pragma unroll
                for (int i = 0; i < 16; ++i) hbuf[(32 * tt + tl) * 65 + 32 * vt + crow(i, hh)] = Hh[tt][vt][i]; }
    __syncthreads();
    if (dir == 0) {
#pragma unroll
        for (int tt = 0; tt < 2; ++tt) { const int t = 32 * tt + tl; const size_t tok = (size_t)p0 + t; float s1 = 0.f;
#pragma unroll
            for (int vt = 0; vt < 2; ++vt)
#pragma unroll
                for (int i = 0; i < 16; ++i) { const float x = Hh[tt][vt][i] + hbuf[t * 65 + 32 * vt + crow(i, hh)]; Hh[tt][vt][i] = x; s1 += x; }
            const float mu = (s1 + shx(s1, 32, lane)) * (1.0f / 64.0f); float s2 = 0.f;
#pragma unroll
            for (int vt = 0; vt < 2; ++vt)
#pragma unroll
                for (int i = 0; i < 16; ++i) { const float dv = Hh[tt][vt][i] - mu; s2 += dv * dv; }
            const float rstd = 1.0f / sqrtf((s2 + shx(s2, 32, lane)) * (1.0f / 64.0f) + LN_EPS);
#pragma unroll
            for (int vt = 0; vt < 2; ++vt)
#pragma unroll
                for (int g = 0; g < 4; ++g) { const int v = 32 * vt + 8 * g + 4 * hh;
                    const u32x2 cw = *(const u32x2*)(H + tok * NH + HCO + hc + v); const f32x4 ng = *(const f32x4*)(ml_norm_g + l * 256 + hc + v);
                    const float o0 = __uint_as_float(cw.x << 16), o1 = __uint_as_float(cw.x & 0xffff0000u), o2 = __uint_as_float(cw.y << 16), o3 = __uint_as_float(cw.y & 0xffff0000u);
                    u32x2 wv; wv.x = pk2((Hh[tt][vt][4 * g] - mu) * rstd * ng[0] * sigmoidf_(o0), (Hh[tt][vt][4 * g + 1] - mu) * rstd * ng[1] * sigmoidf_(o1));
                    wv.y = pk2((Hh[tt][vt][4 * g + 2] - mu) * rstd * ng[2] * sigmoidf_(o2), (Hh[tt][vt][4 * g + 3] - mu) * rstd * ng[3] * sigmoidf_(o3));
                    *(u32x2*)(YS + tok * D + 512 + hc + v) = wv; } }
    }
    __syncthreads();
}
__device__ __forceinline__ void pool_m(int l, int witem) {
    FRAME_SETUP; WS_PTRS; const float* pool_scale = inp(I_POOLS); const bf16* PWT = (const bf16*)(ws + WS_PWT);
    const int lane = F.lane, tl = lane & 31, hh = lane >> 5;
    const int g = witem & 3, tb = witem >> 2, tok0 = tb * 32, b = tok0 >> 13, s = (tok0 & (SEQ - 1)) + tl, half = 1 << g, W = 2 * half;
    const int lo = max(s - half, 0), hi = min(s + half, SEQ); const float inv = 1.0f / (float)(hi - lo);
    const bf16* hb = H + (size_t)b * SEQ * NH + HDX + g * 64 + 8 * hh;
    const size_t tok = (size_t)tok0 + tl;
    f32x16 acc[2];
#pragma unroll
    for (int ot = 0; ot < 2; ++ot)
#pragma unroll
        for (int i = 0; i < 16; ++i) acc[ot][i] = F.zf;
#pragma unroll 1
    for (int ks = 0; ks < 4; ++ks) { float a8[8];
#pragma unroll
        for (int q = 0; q < 8; ++q) a8[q] = 0.f;
#pragma unroll 1
        for (int j0 = 0; j0 < W; j0 += 4) { u32x4 raw[4];
#pragma unroll
            for (int j = 0; j < 4; ++j) { const int sp = min(max(s - half + j0 + j, 0), SEQ - 1); raw[j] = *(const u32x4*)(hb + (size_t)sp * NH + 16 * ks); }
#pragma unroll
            for (int j = 0; j < 4; ++j) { const int sp = s - half + j0 + j; const float m = (j0 + j < W && sp >= 0 && sp < SEQ) ? 1.f : 0.f; float v8[8]; unpack8(raw[j], v8);
#pragma unroll
                for (int q = 0; q < 8; ++q) a8[q] += m * v8[q]; } }
        float x8[8]; unpack8(*(const u32x4*)(hb + (size_t)s * NH + 16 * ks), x8);
        const bf16x8 pf = pack8(a8[0] * inv - x8[0], a8[1] * inv - x8[1], a8[2] * inv - x8[2], a8[3] * inv - x8[3], a8[4] * inv - x8[4], a8[5] * inv - x8[5], a8[6] * inv - x8[6], a8[7] * inv - x8[7]);
#pragma unroll
        for (int ot = 0; ot < 2; ++ot) { const bf16x8 wf = *(const bf16x8*)(PWT + ((size_t)(l * 4 + g) * 64 + 32 * ot + tl) * 64 + 16 * ks + 8 * hh); acc[ot] = MFMA32(wf, pf, acc[ot]); } }
#pragma unroll
    for (int ot = 0; ot < 2; ++ot)
#pragma unroll
        for (int gg = 0; gg < 4; ++gg) { const int o = g * 64 + 32 * ot + 8 * gg + 4 * hh; const f32x4 sc = *(const f32x4*)(pool_scale + l * 256 + o);
            u32x2 w; w.x = pk2(acc[ot][4 * gg] * sc[0], acc[ot][4 * gg + 1] * sc[1]); w.y = pk2(acc[ot][4 * gg + 2] * sc[2], acc[ot][4 * gg + 3] * sc[3]);
            *(u32x2*)(YS + tok * D + 768 + o) = w; }
}
constexpr int ATT_PITCH = 144;
__device__ __forceinline__ void att2_item(int item) {
    FRAME_SETUP;
    WS_PTRS; const float* rel_bias = inp(I_RELB);
    const int tid = F.tid, lane = F.lane, w = F.wave;
    const int pat = item >> 8, idx = item & 255, dil = 1 << (2 * pat), L = SEQ / dil, nqb = L >> 8;
    const int jr = idx & 31, h = (idx >> 5) & 3, b = idx >> 7, r = jr / nqb, Q0 = (jr % nqb) * 256;
    LAS unsigned char* Kt = F.lds; LAS unsigned char* Vt = F.lds + 384 * ATT_PITCH; LAS float* bt = (LAS float*)(F.lds + 2 * 384 * ATT_PITCH);
    { u32x4 k8[6], v8[6];
#pragma unroll
        for (int u = 0; u < 6; ++u) { const int i = tid + u * NTHREADS, kk = i >> 3, cg = (i & 7) * 8, kidx = min(max(Q0 - 64 + kk, 0), L - 1);
            const bf16* row = H + (size_t)(b * SEQ + r + dil * kidx) * NH; k8[u] = *(const u32x4*)(row + HAK + h * 64 + cg); v8[u] = *(const u32x4*)(row + HAV + h * 64 + cg); }
#pragma unroll
        for (int u = 0; u < 6; ++u) { const int i = tid + u * NTHREADS, kk = i >> 3, cg = (i & 7) * 8;
            *(LAS u32x4*)(Kt + kk * ATT_PITCH + cg * 2) = k8[u]; *(LAS u32x4*)(Vt + kk * ATT_PITCH + cg * 2) = v8[u]; } }
    if (tid < 192) { const int u = tid - 32, j = u - 64, rel = dil * j, na = rel < 0 ? -rel : rel;
        int bucket = na < 8 ? na : 8 + (na >= 15) + (na >= 27) + (na >= 50) + (na >= 91) + (na >= 166) + (na >= 305) + (na >= 559);
        if (rel > 0) bucket += 16;
        bt[tid] = (u >= 0 && u <= 128) ? rel_bias[min(bucket, 31) * 4 + h] * 1.4426950408889634f : -1e30f; }
    const int ql = lane & 31, hh = lane >> 5;
    const int qi = Q0 + 32 * w + ql; const size_t tok = (size_t)b * SEQ + r + dil * qi;
    bf16x8 qf[4];
#pragma unroll
    for (int ks = 0; ks < 4; ++ks) qf[ks] = *(const bf16x8*)(H + tok * NH + HAQ + h * 64 + 16 * ks + 8 * hh);
    __syncthreads();
    f32x16 S[5];
#pragma unroll
    for (int tk = 0; tk < 5; ++tk) {
#pragma unroll
        for (int i = 0; i < 16; ++i) S[tk][i] = F.zf;
#pragma unroll
        for (int ks = 0; ks < 4; ++ks) { const bf16x8 kf = *(const LAS bf16x8*)(Kt + (32 * w + 32 * tk + ql) * ATT_PITCH + (16 * ks + 8 * hh) * 2); S[tk] = MFMA32(kf, qf[ks], S[tk]); } }
    const LAS float* btl = bt + 32 + 4 * hh - ql;
    float mx = -3.0e38f;
#pragma unroll
    for (int tk = 0; tk < 5; ++tk) {
#pragma unroll
        for (int i = 0; i < 16; ++i) { const float sc = S[tk][i] * (0.125f * 1.4426950408889634f) + btl[32 * tk + (i & 3) + 8 * (i >> 2)]; S[tk][i] = sc; mx = fmaxf(mx, sc); }
        __builtin_amdgcn_sched_barrier(0); }
    const int e0 = Q0 - 64 + 32 * w;
    if (e0 < 0 || e0 + 160 > L) {
        mx = -3.0e38f;
#pragma unroll
        for (int tk = 0; tk < 5; ++tk)
#pragma unroll
            for (int i = 0; i < 16; ++i) { const int kidx = e0 + 32 * tk + crow(i, hh); const float sc = (kidx >= 0 && kidx < L) ? S[tk][i] : -1e30f; S[tk][i] = sc; mx = fmaxf(mx, sc); }
    }
    mx = fmaxf(mx, shx(mx, 32, lane));
    float lsum = 0.f;
#pragma unroll
    for (int tk = 0; tk < 5; ++tk)
#pragma unroll
        for (int i = 0; i < 16; ++i) { const float p = __builtin_amdgcn_exp2f(S[tk][i] - mx); S[tk][i] = p; lsum += p; }
    lsum += shx(lsum, 32, lane);
    f32x16 O[2];
#pragma unroll
    for (int dt = 0; dt < 2; ++dt)
#pragma unroll
        for (int i = 0; i < 16; ++i) O[dt][i] = F.zf;
#pragma unroll
    for (int tk = 0; tk < 5; ++tk)
#pragma unroll
        for (int s2 = 0; s2 < 2; ++s2) { const bf16x8 pf = pack8(S[tk][8 * s2], S[tk][8 * s2 + 1], S[tk][8 * s2 + 2], S[tk][8 * s2 + 3], S[tk][8 * s2 + 4], S[tk][8 * s2 + 5], S[tk][8 * s2 + 6], S[tk][8 * s2 + 7]);
            const int k0 = 32 * w + 32 * tk + 16 * s2 + 4 * hh;
#pragma unroll
            for (int dt = 0; dt < 2; ++dt) { const bf16x8 vf = tr_frag(Vt, ATT_PITCH, k0, k0 + 8, 32 * dt, lane); O[dt] = MFMA32(vf, pf, O[dt]); } }
    const float inv = 1.0f / lsum;
    bf16* op = ATTO + ((size_t)pat * T + tok) * 256 + h * 64 + 4 * hh;
#pragma unroll
    for (int dt = 0; dt < 2; ++dt)
#pragma unroll
        for (int g = 0; g < 4; ++g) { u32x2 wv; wv.x = pk2(O[dt][4 * g] * inv, O[dt][4 * g + 1] * inv); wv.y = pk2(O[dt][4 * g + 2] * inv, O[dt][4 * g + 3] * inv); *(u32x2*)(op + 32 * dt + 8 * g) = wv; }
    if (hh == 0) ATTL[((size_t)pat * T + tok) * 4 + h] = (mx + __builtin_amdgcn_logf(lsum)) * 0.6931471805599453f;
    __syncthreads();
}
__device__ __forceinline__ void att_merge(int item) {
    FRAME_SETUP;
    WS_PTRS;
    const int tid = F.tid; const size_t tok = (size_t)item * 64 + (tid >> 3); const int sub = tid & 7, h = sub >> 1, c0 = h * 64 + (sub & 1) * 32;
    const float l0 = ATTL[tok * 4 + h], l1 = ATTL[((size_t)T + tok) * 4 + h], l2 = ATTL[((size_t)2 * T + tok) * 4 + h];
    const float M = fmaxf(l0, fmaxf(l1, l2)); float w0 = __expf(l0 - M), w1 = __expf(l1 - M), w2 = __expf(l2 - M); const float inv = 1.0f / (w0 + w1 + w2); w0 *= inv; w1 *= inv; w2 *= inv;
    const bf16* o0 = ATTO + tok * 256 + c0; const bf16* o1 = ATTO + ((size_t)T + tok) * 256 + c0; const bf16* o2 = ATTO + ((size_t)2 * T + tok) * 256 + c0;
    bf16* yp = YS + tok * D + 256 + c0;
#pragma unroll
    for (int q = 0; q < 4; ++q) { float a8[8], b8[8], c8[8]; unpack8(*(const u32x4*)(o0 + q * 8), a8); unpack8(*(const u32x4*)(o1 + q * 8), b8); unpack8(*(const u32x4*)(o2 + q * 8), c8);
        u32x4 w; w.x = pk2(a8[0] * w0 + b8[0] * w1 + c8[0] * w2, a8[1] * w0 + b8[1] * w1 + c8[1] * w2); w.y = pk2(a8[2] * w0 + b8[2] * w1 + c8[2] * w2, a8[3] * w0 + b8[3] * w1 + c8[3] * w2);
        w.z = pk2(a8[4] * w0 + b8[4] * w1 + c8[4] * w2, a8[5] * w0 + b8[5] * w1 + c8[5] * w2); w.w = pk2(a8[6] * w0 + b8[6] * w1 + c8[6] * w2, a8[7] * w0 + b8[7] * w1 + c8[7] * w2);
        *(u32x4*)(yp + q * 8) = w; }
}

template <int CTRL> __device__ __forceinline__ float dpp_max(float v) { return fmaxf(v, dpp_mov<CTRL>(v)); }
__device__ __forceinline__ void ln1_router(int l) {
    FRAME_SETUP;
    WS_PTRS; const float* ln1_g = inp(I_LN1G); const float* ln1_b = inp(I_LN1B); const bf16* WRT = (const bf16*)(ws + WS_WRT) + (size_t)l * NE * D; const float* STAT = (const float*)(ws + WS_STAT);
    LAS float* gl = (LAS float*)F.lds; LAS float* bl = gl + D;
    { const int i = F.tid * 2; *(LAS f32x2*)(gl + i) = *(const f32x2*)(ln1_g + l * D + i); *(LAS f32x2*)(bl + i) = *(const f32x2*)(ln1_b + l * D + i); }
    __syncthreads();
    const int lane = F.lane, r = lane & 15, kg = lane >> 4;
    LAS f32x4* red = (LAS f32x4*)(bl + D);
    const int half = F.wave >> 2;
    for (int it0 = F.bid * 4; it0 < T / 16; it0 += F.G * 4) {
        const int item = it0 + (F.wave & 3);
        const size_t tok = (size_t)item * 16 + r;
        float s1 = 0.f, s2 = 0.f;
        { const f32x4 a = *(const f32x4*)(STAT + (tok * 16 + 4 * kg) * 2), c = *(const f32x4*)(STAT + (tok * 16 + 4 * kg) * 2 + 4); s1 = (a[0] + a[2]) + (c[0] + c[2]); s2 = (a[1] + a[3]) + (c[1] + c[3]); }
        s1 += shx(s1, 16, lane); s1 += shx(s1, 32, lane); s2 += shx(s2, 16, lane); s2 += shx(s2, 32, lane);
        const float mean = s1 * (1.0f / D), var = fmaxf(s2 * (1.0f / D) - mean * mean, 0.f), rstd = 1.0f / sqrtf(var + LN_EPS);
        const bf16* rp = (const bf16*)MGF + tok * D + 8 * kg; bf16* xp = XB + tok * D + 8 * kg; const bf16* wp = WRT + (size_t)r * D + 8 * kg;
        f32x4 acc = (f32x4){F.zf, F.zf, F.zf, F.zf};
#pragma unroll 8
        for (int ks = half * 16; ks < half * 16 + 16; ++ks) {
            float x8[8]; unpack8(*(const u32x4*)(rp + 32 * ks), x8); const f32x4 x0 = (f32x4){x8[0], x8[1], x8[2], x8[3]}, x1 = (f32x4){x8[4], x8[5], x8[6], x8[7]};
            const f32x4 g0 = *(const LAS f32x4*)(gl + 32 * ks + 8 * kg), g1 = *(const LAS f32x4*)(gl + 32 * ks + 8 * kg + 4), b0 = *(const LAS f32x4*)(bl + 32 * ks + 8 * kg), b1 = *(const LAS f32x4*)(bl + 32 * ks + 8 * kg + 4);
            const f32x4 y0 = (x0 - mean) * rstd * g0 + b0, y1 = (x1 - mean) * rstd * g1 + b1;
            u32x4 yw; yw.x = pk2(y0[0], y0[1]); yw.y = pk2(y0[2], y0[3]); yw.z = pk2(y1[0], y1[1]); yw.w = pk2(y1[2], y1[3]);
            *(u32x4*)(xp + 32 * ks) = yw;
            const bf16x8 wf = *(const bf16x8*)(wp + 32 * ks);
            acc = __builtin_amdgcn_mfma_f32_16x16x32_bf16(__builtin_bit_cast(bf16x8, yw), wf, acc, 0, 0, 0);
        }
        if (half) red[(F.wave & 3) * 64 + lane] = acc;
        __syncthreads();
        if (!half) {
        acc += red[(F.wave & 3) * 64 + lane];
        f32x4 aff;
#pragma unroll
        for (int i = 0; i < 4; ++i) { float m = acc[i]; m = dpp_max<0xB1>(m); m = dpp_max<0x4E>(m); m = dpp_max<0x141>(m); m = dpp_max<0x140>(m);
            const float e = __expf(acc[i] - m); float se = e; se += dpp_mov<0xB1>(se); se += dpp_mov<0x4E>(se); se += dpp_mov<0x141>(se); se += dpp_mov<0x140>(se);
            aff[i] = e * rcpf_(se); }
        { const size_t t0 = (size_t)item * 16 + 4 * kg; const int b = (int)(t0 >> 13), sp = (int)(t0 & (SEQ - 1)); *(f32x4*)(AFF + ((size_t)(b * NE + r)) * SEQ + sp) = aff; }
        }
        __syncthreads();
    }
    __syncthreads();
}
__device__ __forceinline__ unsigned block_excl_scan(LAS unsigned* sc, unsigned val, int tid) {
    sc[tid] = val; __syncthreads();
#pragma unroll 1
    for (int off = 1; off < NTHREADS; off <<= 1) { const unsigned v = tid >= off ? sc[tid - off] : 0u; __syncthreads(); sc[tid] += v; __syncthreads(); }
    const unsigned r = sc[tid] - val; __syncthreads(); return r;
}
__device__ __forceinline__ void topk_item(int be) {
    FRAME_SETUP;
    WS_PTRS;
    const int tid = F.tid, b = be >> 4;
    const float* aff = AFF + (size_t)be * SEQ;
    LAS unsigned* hist = (LAS unsigned*)F.lds; LAS unsigned* sfx = hist + 256; LAS unsigned* sc = sfx + 256; LAS unsigned* misc = sc + 512; LAS int* idxl = (LAS int*)(misc + 4);
    unsigned key[16];
    { const u32x4* ap = (const u32x4*)(aff + tid * 16);
#pragma unroll
        for (int q = 0; q < 4; ++q) { const u32x4 w = ap[q]; key[q * 4] = w.x; key[q * 4 + 1] = w.y; key[q * 4 + 2] = w.z; key[q * 4 + 3] = w.w; } }
    unsigned prefix = 0u, kth = CAP, hmask = 0u;
#pragma unroll 1
    for (int shift = 24; shift >= 0; shift -= 8) {
        if (tid < 256) hist[tid] = 0u;
        __syncthreads();
#pragma unroll
        for (int i = 0; i < 16; ++i) { if (((key[i] ^ prefix) & hmask) == 0u) __hip_atomic_fetch_add(&hist[(key[i] >> shift) & 255u], 1u, __ATOMIC_RELAXED, __HIP_MEMORY_SCOPE_WORKGROUP); }
        __syncthreads();
        if (tid < 256) sfx[tid] = hist[tid];
        __syncthreads();
#pragma unroll 1
        for (int off = 1; off < 256; off <<= 1) { unsigned v = 0u; if (tid < 256 && tid + off < 256) v = sfx[tid + off]; __syncthreads(); if (tid < 256) sfx[tid] += v; __syncthreads(); }
        if (tid < 256) { const unsigned incl = sfx[tid], excl = incl - hist[tid]; if (excl < kth && kth <= incl) { misc[0] = (unsigned)tid; misc[1] = kth - excl; } }
        __syncthreads();
        prefix |= misc[0] << shift; kth = misc[1]; hmask |= 255u << shift;
        __syncthreads();
    }
    unsigned ceq = 0u;
#pragma unroll
    for (int i = 0; i < 16; ++i) ceq += (key[i] == prefix) ? 1u : 0u;
    unsigned eqrank = block_excl_scan(sc, ceq, tid);
    unsigned selmask = 0u, csel = 0u;
#pragma unroll
    for (int i = 0; i < 16; ++i) { bool sel = key[i] > prefix; if (key[i] == prefix) { sel = eqrank < kth; ++eqrank; } if (sel) { selmask |= 1u << i; ++csel; } }
    unsigned slot = block_excl_scan(sc, csel, tid);
#pragma unroll
    for (int i = 0; i < 16; ++i) { const int s = tid * 16 + i;
        if (selmask & (1u << i)) { if (slot < (unsigned)CAP) { IDX[be * CAP + slot] = s; GATE[be * CAP + slot] = __uint_as_float(key[i]); idxl[slot] = s; } SLOT[(size_t)be * SEQ + s] = (int)slot; ++slot; }
        else SLOT[(size_t)be * SEQ + s] = -1; }
    __syncthreads();
    __syncthreads();
}
__device__ __forceinline__ void combine_ln2(int l) {
    FRAME_SETUP;
    WS_PTRS; const float* ln2_g = inp(I_LN2G); const float* ln2_b = inp(I_LN2B); float* out = outp();
    const int lane = F.lane;
    const float* g2 = ln2_g + l * D; const float* b2 = ln2_b + l * D;
    f32x4 gg4[4], bb4[4];
#pragma unroll
    for (int j = 0; j < 4; ++j) { const int d = 8 * lane + 512 * (j >> 1) + 4 * (j & 1); gg4[j] = *(const f32x4*)(g2 + d); bb4[j] = *(const f32x4*)(b2 + d); }
    for (int tok = (F.bid * NWAVES + F.wave) * 2; tok < T; tok += F.G * NWAVES * 2) {
        const int b = tok >> 13, sp = tok & (SEQ - 1);
        int slotv[2]; unsigned mask[2]; f32x4 v[2][4]; u32x4 xr[2][2];
#pragma unroll
        for (int u = 0; u < 2; ++u) slotv[u] = lane < NE ? SLOT[((size_t)(b * NE + lane)) * SEQ + sp + u] : -1;
#pragma unroll
        for (int u = 0; u < 2; ++u)
#pragma unroll
            for (int jj = 0; jj < 2; ++jj) xr[u][jj] = *(const u32x4*)(XB + (size_t)(tok + u) * D + 8 * lane + 512 * jj);
        __builtin_amdgcn_sched_barrier(0);
#pragma unroll
        for (int u = 0; u < 2; ++u) mask[u] = (unsigned)__ballot(slotv[u] >= 0);
#pragma unroll
        for (int u = 0; u < 2; ++u)
#pragma unroll
            for (int jj = 0; jj < 2; ++jj) { float x8[8]; unpack8(xr[u][jj], x8); v[u][2 * jj] = (f32x4){x8[0], x8[1], x8[2], x8[3]} * ALPHA; v[u][2 * jj + 1] = (f32x4){x8[4], x8[5], x8[6], x8[7]} * ALPHA; }
        while (mask[0] | mask[1]) {
            u32x4 r[2][3][2]; bool on[2][3];
#pragma unroll
            for (int u = 0; u < 2; ++u)
#pragma unroll
                for (int k = 0; k < 3; ++k) { on[u][k] = mask[u] != 0u; const int e = on[u][k] ? __builtin_ctz(mask[u]) : 0; mask[u] &= mask[u] - 1u;
                    const int sl = __builtin_amdgcn_readlane(slotv[u], e);
                    if (on[u][k]) { const bf16* yr = YE + ((size_t)(b * NE + e) * CAP + sl) * D;
#pragma unroll
                        for (int jj = 0; jj < 2; ++jj) r[u][k][jj] = *(const u32x4*)(yr + 8 * lane + 512 * jj); } }
#pragma unroll
            for (int u = 0; u < 2; ++u)
#pragma unroll
                for (int k = 0; k < 3; ++k) if (on[u][k]) {
#pragma unroll
                    for (int jj = 0; jj < 2; ++jj) { float y8[8]; unpack8(r[u][k][jj], y8); v[u][2 * jj] += (f32x4){y8[0], y8[1], y8[2], y8[3]}; v[u][2 * jj + 1] += (f32x4){y8[4], y8[5], y8[6], y8[7]}; } }
        }
        float s[2], s2[2];
#pragma unroll
        for (int u = 0; u < 2; ++u) { s[u] = 0.f;
#pragma unroll
            for (int j = 0; j < 4; ++j) s[u] += (v[u][j].x + v[u][j].y) + (v[u][j].z + v[u][j].w); }
        s[0] = wave_sum(s[0], lane); s[1] = wave_sum(s[1], lane);
#pragma unroll
        for (int u = 0; u < 2; ++u) { const float mean = s[u] * (1.f / D); s2[u] = 0.f;
#pragma unroll
            for (int j = 0; j < 4; ++j) { v[u][j] = v[u][j] - mean; s2[u] += (v[u][j].x * v[u][j].x + v[u][j].y * v[u][j].y) + (v[u][j].z * v[u][j].z + v[u][j].w * v[u][j].w); } }
        s2[0] = wave_sum(s2[0], lane); s2[1] = wave_sum(s2[1], lane);
#pragma unroll
        for (int u = 0; u < 2; ++u) { const float rstd = 1.f / sqrtf(s2[u] * (1.f / D) + LN_EPS);
#pragma unroll
            for (int jj = 0; jj < 2; ++jj) { const int d = 8 * lane + 512 * jj;
                const f32x4 x0 = v[u][2 * jj] * rstd * gg4[2 * jj] + bb4[2 * jj], x1 = v[u][2 * jj + 1] * rstd * gg4[2 * jj + 1] + bb4[2 * jj + 1];
                u32x4 w; w.x = pk2(x0.x, x0.y); w.y = pk2(x0.z, x0.w); w.z = pk2(x1.x, x1.y); w.w = pk2(x1.z, x1.w); *((u32x4*)(XB + (size_t)(tok + u) * D + d)) = w;
                if (l == DEPTH - 1) { *((f32x4*)(out + (size_t)(tok + u) * D + d)) = x0; *((f32x4*)(out + (size_t)(tok + u) * D + d + 4)) = x1; } } }
    }
}

constexpr int PH_PER_LAYER = 11, N_PHASES = 1 + DEPTH * PH_PER_LAYER;
struct Args { const float* in[22]; float* out; unsigned char* ws; int ph_lo, ph_hi; };
__device__ __forceinline__ void phase_mix1(int l) { FRAME_SETUP;
    for (int it = F.bid; it < 256 + 128; it += F.G) { if (it < 256) mlstm_c1m(l, it); else gmlp_m(l, it - 256); }
    { const int nw = F.G * NWAVES; int first = (F.bid >= 128 ? F.bid - 128 : F.bid + F.G - 128) * NWAVES + F.wave;
      for (int wi = first; wi < 2048; wi += nw) pool_m(l, wi); } }
__device__ __forceinline__ void phase_mix2(int l) { FRAME_SETUP;
    for (int wi = F.bid * 2 + F.wave; wi < 272 && F.wave < 2; wi += F.G * 2) mlstm_scan(wi);
    const bool g256 = F.G == 256, sc = F.bid < 130;
    const int n = g256 ? (sc ? (F.bid < 4 ? 3 : 2) : 4) : (768 - F.bid + F.G - 1) / F.G, first = g256 ? (sc ? 2 * F.bid : 260 + 4 * (F.bid - 130)) : F.bid, stride = g256 ? 1 : F.G;
    for (int k = 0; k < n; ++k) att2_item((g256 && sc && k == 2) ? 764 + F.bid : first + k * stride); }
__device__ __forceinline__ void phase_mix3(int l) { FRAME_SETUP;
    for (int it = F.bid; it < 256 + 256; it += F.G) { if (it < 256) mlstm_c3m(l, it); else att_merge(it - 256); } }
__device__ __forceinline__ void phase_topk(int l) { FRAME_SETUP;
    const bool wide = F.G > 2 * BATCH * NE;
    for (int it = F.bid; it < BATCH * NE; it += F.G) topk_item(it);
    if (l + 1 < DEPTH && (!wide || F.bid >= BATCH * NE)) convert_layer(l + 1, ((wide ? F.bid - BATCH * NE : F.bid)) * NWAVES + F.wave, (wide ? F.G - BATCH * NE : F.G) * NWAVES); }
__device__ __forceinline__ void phase_g1(int l) { FRAME_SETUP; WS_PTRS;
    pg8::GemmP g{D, D, D}; SchedG1 S{F.G, F.bid, (const char*)XB, (const char*)wl(ws, l, OW_IN)}; EpiG1 E{H, GI, BIN + (size_t)l * NINP, (u32x4*)(ws + WS_GQ)};
    pg8::gemm_phase<EpiG1, SchedG1, true>(F.lds, F.tid, g, S, E); }
__device__ __forceinline__ void phase_g2(int l) { FRAME_SETUP; WS_PTRS;
    pg8::GemmP g{D, D, D}; SchedG2 S{F.G, F.bid, (const char*)YS, (const char*)wl(ws, l, OW_B)}; EpiG2 E{(const u32x4*)(ws + WS_GQ), MGB};
    pg8::gemm_phase<EpiG2, SchedG2, true>(F.lds, F.tid, g, S, E); }
__device__ __forceinline__ void phase_g3(int l) { FRAME_SETUP; WS_PTRS;
    pg8::GemmP g{D, D, D}; SchedG3 S{F.G, F.bid, (const char*)MGB, (const char*)wl(ws, l, OW_O)}; EpiG3 E{XB, (bf16*)MGF, (float*)(ws + WS_STAT)};
    pg8::gemm_phase<EpiG3, SchedG3, true>(F.lds, F.tid, g, S, E); }
__device__ __forceinline__ void phase_g4(int l) { FRAME_SETUP; WS_PTRS;
    pg8::GemmP g{D, D, D}; SchedG4 S{F.G, F.bid, (const char*)XB, (const char*)wl(ws, l, OW_13), IDX}; EpiG4 E{HID};
    pg8::gemm_phase<EpiG4, SchedG4, true>(F.lds, F.tid, g, S, E); }
__device__ __forceinline__ void phase_g5(int l) { FRAME_SETUP; WS_PTRS;
    pg8::GemmP g{FF, FF, FF}; SchedG5 S{F.G, F.bid, (const char*)HID, (const char*)wl(ws, l, OW_2)}; EpiG5 E{GATE, YE};
    pg8::gemm_phase<EpiG5, SchedG5, true>(F.lds, F.tid, g, S, E); }

__global__ void __launch_bounds__(NTHREADS, 2) fwd_kernel(Args args) {
    { LAS unsigned char* l0 = lds_base(); for (int u = threadIdx.x; u < (LDS_BYTES - LDSCTL_OFF) / 4; u += NTHREADS) ((LAS unsigned*)(l0 + LDSCTL_OFF))[u] = 0u; }
    __syncthreads();
#if !MK_PER_PHASE
    (void)xcd_barrier_post((unsigned*)(args.ws + WS_CTL) + CW_BAR, (volatile LAS unsigned*)(lds_base() + MISC_OFF) + 8);
#endif
    const int lo = args.ph_lo, hi = args.ph_hi;
#if PROBE_MASK
    volatile LAS unsigned long long* pacc = (volatile LAS unsigned long long*)(lds_base() + MISC_OFF + 64);
#endif
    for (int ph = lo; ph < hi; ++ph) {
#if PROBE_MASK
        const unsigned long long pt0 = __builtin_amdgcn_s_memrealtime();
#endif
        if (ph == 0) { if (PHEN(15)) p0_prologue(); }
        else {
            const int l = (ph - 1) / PH_PER_LAYER, sp = (ph - 1) % PH_PER_LAYER;
            if (sp == 0) { if (PHEN(0)) phase_g1(l); }
            else if (sp == 1) { if (PHEN(1)) phase_mix1(l); }
            else if (sp == 2) { if (PHEN(2)) phase_mix2(l); }
            else if (sp == 3) { if (PHEN(3)) phase_mix3(l); }
            else if (sp == 4) { if (PHEN(4)) phase_g2(l); }
            else if (sp == 5) { if (PHEN(5)) phase_g3(l); }
            else if (sp == 6) { if (PHEN(6)) ln1_router(l); }
            else if (sp == 7) { if (PHEN(7)) phase_topk(l); }
            else if (sp == 8) { if (PHEN(8)) phase_g4(l); }
            else if (sp == 9) { if (PHEN(9)) phase_g5(l); }
            else { if (PHEN(10)) combine_ln2(l); }
        }
#if PROBE_MASK && defined(PROBE_MODE) && PROBE_MODE == 1
        { const int sp_ = ph == 0 ? 15 : (ph - 1) % PH_PER_LAYER; asm volatile("s_waitcnt vmcnt(0)" ::: "memory"); __syncthreads(); const unsigned long long pt1 = __builtin_amdgcn_s_memrealtime();
          if (threadIdx.x == 0 && ((PROBE_MASK >> sp_) & 1)) pacc[0] = pacc[0] + (pt1 - pt0); }
#endif
        if (ph + 1 < hi) {
#if !MK_PER_PHASE
            { XcdBarrier bar; bar.bar = (unsigned*)(wsp() + WS_CTL) + CW_BAR; bar.x = xb_xcc_id(); bar.st = (volatile LAS unsigned*)(lds_base() + MISC_OFF) + 8; xcd_barrier(bar); }
#endif
        }
#if PROBE_MASK && !(defined(PROBE_MODE) && PROBE_MODE == 1)
        { const int sp_ = ph == 0 ? 15 : (ph - 1) % PH_PER_LAYER; const unsigned long long pt1 = __builtin_amdgcn_s_memrealtime();
          if (threadIdx.x == 0 && ((PROBE_MASK >> sp_) & 1)) pacc[0] = pacc[0] + (pt1 - pt0); }
#endif
    }
#if PROBE_MASK
    if (threadIdx.x == 0 && blockIdx.x == 0) { const unsigned long long t0 = __builtin_amdgcn_s_memrealtime(), need = pacc[0]; while (__builtin_amdgcn_s_memrealtime() - t0 < need) __builtin_amdgcn_s_sleep(8); }
#endif
}

extern "C" void kernel_launch(void* const* d_in, const int* in_sizes, int n_in, void* d_out, int out_size, void* d_ws, size_t ws_size, hipStream_t stream) {
    static int grid = 0;
    if (grid == 0) {
        if (n_in != 22 || in_sizes[0] != T * D || out_size != T * D || ws_size < WS_END) {
            fprintf(stderr, "kernel_launch: unexpected shapes: n_in %d in0 %d out %d ws %zu (need %zu); nothing launched\n", n_in, n_in > 0 ? in_sizes[0] : -1, out_size, ws_size, (size_t)WS_END); grid = -1; return; }
        int dev = 0, cus = 0;
        if (hipGetDevice(&dev) != hipSuccess || hipDeviceGetAttribute(&cus, hipDeviceAttributeMultiprocessorCount, dev) != hipSuccess) { grid = -1; return; }
        if (hipFuncSetAttribute((const void*)fwd_kernel, hipFuncAttributeMaxDynamicSharedMemorySize, LDS_BYTES) != hipSuccess) { fprintf(stderr, "kernel_launch: hipFuncSetAttribute failed\n"); grid = -1; return; }
        int per_cu = 0;
        if (hipOccupancyMaxActiveBlocksPerMultiprocessor(&per_cu, (const void*)fwd_kernel, NTHREADS, LDS_BYTES) != hipSuccess || per_cu < 1)
            fprintf(stderr, "kernel_launch: note: occupancy query reports %d workgroups per CU\n", per_cu);
        (void)hipGetLastError();
        grid = cus;
    }
    if (grid < 0) return;
    (void)hipMemsetAsync((char*)d_ws + WS_CTL, 0, CTL_ZERO_BYTES, stream);
    Args a{};
    for (int i = 0; i < 22; ++i) a.in[i] = (const float*)d_in[i];
    a.out = (float*)d_out; a.ws = (unsigned char*)d_ws;
#if MK_PER_PHASE
    for (int ph = 0; ph < N_PHASES; ++ph) { a.ph_lo = ph; a.ph_hi = ph + 1; hipLaunchKernelGGL(fwd_kernel, dim3(grid), dim3(NTHREADS), LDS_BYTES, stream, a); }
#else
    a.ph_lo = 0; a.ph_hi = N_PHASES; hipLaunchKernelGGL(fwd_kernel, dim3(grid), dim3(NTHREADS), LDS_BYTES, stream, a);
#endif
}
```

```cpp
#include <hip/hip_runtime.h>
#include <cstdio>
#include <cstdint>

#ifndef PH_MASK
#define PH_MASK 0xFFFF
#endif
#define PHEN(k) ((PH_MASK >> (k)) & 1)
#ifndef PROBE_MASK
#define PROBE_MASK 0
#endif
#ifndef MK_PER_PHASE
#define MK_PER_PHASE 0
#endif

#define GAS __attribute__((address_space(1)))
#define LAS __attribute__((address_space(3)))
typedef unsigned short bf16;
typedef short bf16x8 __attribute__((ext_vector_type(8)));
typedef float f32x4 __attribute__((ext_vector_type(4)));
typedef float f32x2 __attribute__((ext_vector_type(2)));
typedef unsigned u32x4 __attribute__((ext_vector_type(4)));
typedef unsigned u32x2 __attribute__((ext_vector_type(2)));
typedef GAS unsigned gu32;
#define RLX_AGENT __ATOMIC_RELAXED, __HIP_MEMORY_SCOPE_AGENT
#define LDS_WAIT() asm volatile("s_waitcnt lgkmcnt(0)" ::: "memory")
#define VM_WAIT() asm volatile("s_waitcnt vmcnt(0)" ::: "memory")

constexpr int BATCH = 2, SEQ = 8192, D = 1024, T = BATCH * SEQ, DEPTH = 4;
constexpr int NIN = 6672;
constexpr int NHC = 6656;
constexpr int NH = 256;
constexpr int NINP = 6912;
constexpr int NE = 16, CAP = 1024, FF = 1024, NSLOT = BATCH * NE * CAP;
constexpr float ALPHA = 1.6817928305074292f;
constexpr float LN_EPS = 1e-5f;
constexpr size_t HTILE = (size_t)T * 256;
constexpr size_t HU = 0 * HTILE, HV = 1 * HTILE, HAQ = 2 * HTILE, HAK = 3 * HTILE, HAV = 4 * HTILE, HCQ = 5 * HTILE, HCK = 6 * HTILE, HCV = 7 * HTILE, HCO = 8 * HTILE, HDX = 9 * HTILE; constexpr int HG = 2560;

constexpr size_t MiB = 1u << 20;
constexpr size_t WS_CTL = 0, CTL_ZERO_BYTES = 64 * 1024;
constexpr size_t WS_BIN = 1 * MiB;
constexpr size_t WS_WSB = 1 * MiB + 512 * 1024;
constexpr size_t WS_PWT = 1 * MiB + 256 * 1024;
constexpr size_t WS_W = 2 * MiB, LW = 114 * MiB;
constexpr size_t OW_IN = 0, OW_B = 14 * MiB, OW_O = 16 * MiB, OW_13 = 18 * MiB, OW_2 = 82 * MiB;
constexpr size_t WS_XF = 458 * MiB;
constexpr size_t WS_GQ = WS_XF;
constexpr size_t WS_STAT = 876 * MiB;
constexpr size_t WS_WRT = 1 * MiB + 128 * 1024;
constexpr size_t WS_XB = 522 * MiB;
constexpr size_t WS_BIG = 554 * MiB;
constexpr size_t WS_XS = WS_BIG, WS_HID = WS_BIG + 64 * MiB, WS_YE = WS_BIG + 128 * MiB;
constexpr size_t WS_GI = 762 * MiB;
constexpr size_t WS_ATTO = 763 * MiB;
constexpr size_t WS_ATTL = 811 * MiB;
constexpr size_t WS_YS = 812 * MiB;
constexpr size_t WS_MGF = 844 * MiB;
constexpr size_t WS_AG = 878 * MiB;
constexpr size_t WS_BGL = 884 * MiB;
constexpr size_t WS_MGB = 908 * MiB;
constexpr size_t WS_QC = 940 * MiB, WS_KC = 956 * MiB;
constexpr size_t WS_DC = 972 * MiB;
constexpr size_t WS_DG = 1005 * MiB;
constexpr size_t WS_AFF = 1006 * MiB;
constexpr size_t WS_IDX = 1007 * MiB;
constexpr size_t WS_GATE = 1007 * MiB + 512 * 1024;
constexpr size_t WS_SLOT = 1008 * MiB;
constexpr size_t WS_END = 1009 * MiB;

constexpr int CW_BAR = 4096;
constexpr int CW_ML = 1024;

constexpr int RING_BYTES = 131072;
constexpr int MIX_BYTES = 154368;
constexpr int LDSCTL_OFF = MIX_BYTES, MISC_OFF = LDSCTL_OFF + 320;
constexpr int LDS_BYTES = 157184;
constexpr int NWAVES = 8, NTHREADS = 512;

__device__ __forceinline__ float bf2f(unsigned v) { return __uint_as_float(v << 16); }
__device__ __forceinline__ unsigned f2bf(float f) { unsigned u = __float_as_uint(f); return (u + 0x7fffu + ((u >> 16) & 1u)) >> 16; }
typedef __bf16 bf16x2_t_ __attribute__((ext_vector_type(2)));
__device__ __forceinline__ unsigned pk2(float lo, float hi) { f32x2 v = {lo, hi}; bf16x2_t_ b = __builtin_convertvector(v, bf16x2_t_); return __builtin_bit_cast(unsigned, b); }
__device__ __forceinline__ float rcpf_(float x) { return __builtin_amdgcn_rcpf(x); }
__device__ __forceinline__ void unpack8(const u32x4 w, float (&o)[8]) {
    o[0] = __uint_as_float(w.x << 16); o[1] = __uint_as_float(w.x & 0xffff0000u);
    o[2] = __uint_as_float(w.y << 16); o[3] = __uint_as_float(w.y & 0xffff0000u);
    o[4] = __uint_as_float(w.z << 16); o[5] = __uint_as_float(w.z & 0xffff0000u);
    o[6] = __uint_as_float(w.w << 16); o[7] = __uint_as_float(w.w & 0xffff0000u);
}
__device__ __forceinline__ float sigmoidf_(float x) { return rcpf_(1.0f + __expf(-x)); }
__device__ __forceinline__ float siluf_(float x) { return x * rcpf_(1.0f + __expf(-x)); }
__device__ __forceinline__ float gelu_tanh(float x) { const float u = 1.5957691216057308f * (x + 0.044715f * x * x * x); return x * rcpf_(1.0f + __expf(-u)); }
__device__ __forceinline__ float logsigmoidf_(float z) { return fminf(z, 0.f) - log1pf(__expf(-fabsf(z))); }
__device__ __forceinline__ float shx(float v, int o, int lane) { return __int_as_float(__builtin_amdgcn_ds_bpermute((lane ^ o) << 2, __float_as_int(v))); }
template <int CTRL> __device__ __forceinline__ float dpp_mov(float v) { return __int_as_float(__builtin_amdgcn_update_dpp(0, __float_as_int(v), CTRL, 0xF, 0xF, false)); }
__device__ __forceinline__ float wave_sum(float v, int lane) { (void)lane;
    v += dpp_mov<0xB1>(v); v += dpp_mov<0x4E>(v); v += dpp_mov<0x141>(v); v += dpp_mov<0x140>(v);
    const int iv = __float_as_int(v);
    return (__int_as_float(__builtin_amdgcn_readlane(iv, 0)) + __int_as_float(__builtin_amdgcn_readlane(iv, 16))) + (__int_as_float(__builtin_amdgcn_readlane(iv, 32)) + __int_as_float(__builtin_amdgcn_readlane(iv, 48)));
}

#define XB_TMO      128
#define XB_XCNT(j)  (256  + 64 * (j))
#define XB_XSUB(j)  (1280 + 64 * (j))
#define XB_XGEN(j)  (2304 + 64 * (j))
#define XB_TOP      3328
#define XB_TOPGEN   3392
#define XB_SLOT(j)  (3456 + 64 * (j))
#define XB_XSUBL(j) (4480 + 64 * (j))
#define XB_XGENL(j) (5504 + 64 * (j))
#define XCD_BAR_WORDS 6528
#define XB_SPIN_CAP (1u << 18)
__device__ __forceinline__ unsigned xb_ld(unsigned* p)              { return __hip_atomic_load(p, __ATOMIC_RELAXED, __HIP_MEMORY_SCOPE_AGENT); }
__device__ __forceinline__ unsigned xb_add(unsigned* p, unsigned v) { return __hip_atomic_fetch_add(p, v, __ATOMIC_RELAXED, __HIP_MEMORY_SCOPE_AGENT); }
__device__ __forceinline__ unsigned xb_xcc_id() { return (unsigned)__builtin_amdgcn_s_getreg((3 << 11) | 20) & 0xFu; }
#define XB_SPIN(cond, bar) do { unsigned _sp = 0; while (cond) { __builtin_amdgcn_s_sleep(1); \
    if ((++_sp & 255u) == 0u) { if (xb_ld(&(bar)[XB_TMO])) break; if (_sp > XB_SPIN_CAP) { atomicAdd(&(bar)[XB_TMO], 1u); break; } } } } while (0)
struct XcdBarrier { unsigned* bar; unsigned x; volatile LAS unsigned* st; };
__device__ __forceinline__ XcdBarrier xcd_barrier_post(unsigned* bar, volatile LAS unsigned* st) {
    XcdBarrier b; b.bar = bar; b.x = xb_xcc_id(); b.st = st;
    if (threadIdx.x == 0) { (void)xb_add(&bar[XB_XCNT(b.x)], 1u); st[4] = b.x; st[5] = xb_add(&bar[XB_SLOT(b.x)], 1u); }
    return b;
}
__device__ __forceinline__ void xcd_barrier_complete(unsigned* bar, unsigned x, unsigned& nloc, unsigned& nx, unsigned& uni) {
    const unsigned G = gridDim.x * gridDim.y * gridDim.z;
    unsigned sum, cnt, mine, all32, sp = 0u;
    for (;;) {
        sum = 0u; cnt = 0u; mine = 0u;
        all32 = 1u;
#pragma unroll
        for (unsigned j = 0; j < 16; ++j) { const unsigned c = xb_ld(&bar[XB_XCNT(j)]); sum += c; cnt += (c > 0u) ? 1u : 0u; mine = (j == x) ? c : mine; all32 &= (c == (j < 8u ? 32u : 0u)) ? 1u : 0u; }
        if (sum == G) break;
        __builtin_amdgcn_s_sleep(1);
        if ((++sp & 255u) == 0u) { if (xb_ld(&bar[XB_TMO])) break; if (sp > XB_SPIN_CAP) { atomicAdd(&bar[XB_TMO], 1u); break; } }
    }
    nloc = mine > 0u ? mine : 1u; nx = cnt > 0u ? cnt : 1u; uni = (all32 && G == 256u && sum == G) ? 1u : 0u;
}
__device__ __forceinline__ void xcd_barrier(const XcdBarrier& b) {
    asm volatile("s_waitcnt vmcnt(0)" ::: "memory");
    __syncthreads();
    if (threadIdx.x == 0) {
        unsigned* bar = b.bar;
        __builtin_amdgcn_s_waitcnt(0);
        unsigned nloc = b.st[0], nx = b.st[1];
        if (nloc == 0u) { unsigned uni; xcd_barrier_complete(bar, b.x, nloc, nx, uni); b.st[0] = nloc; b.st[1] = nx; b.st[2] = uni; }
        const unsigned old = xb_add(&bar[XB_XSUB(b.x)], 1u);
        const unsigned gen = old / nloc;
        if (old + 1u == (gen + 1u) * nloc) {
            __builtin_amdgcn_fence(__ATOMIC_RELEASE, "agent");
            asm volatile("s_waitcnt vmcnt(0)" ::: "memory");
            const unsigned og = xb_add(&bar[XB_TOP], 1u);
            const unsigned tg = og / nx;
            if (og + 1u == (tg + 1u) * nx) xb_add(&bar[XB_TOPGEN], 1u);
            else XB_SPIN(xb_ld(&bar[XB_TOPGEN]) == tg, bar);
            __builtin_amdgcn_fence(__ATOMIC_ACQUIRE, "agent");
            xb_add(&bar[XB_XGEN(b.x)], 1u);
            asm volatile("s_waitcnt vmcnt(0)" ::: "memory");
        } else {
            XB_SPIN(xb_ld(&bar[XB_XGEN(b.x)]) == gen, bar);
            __builtin_amdgcn_fence(__ATOMIC_ACQUIRE, "agent");
            asm volatile("s_waitcnt vmcnt(0)" ::: "memory");
        }
    }
    __syncthreads();
}

__device__ __forceinline__ void xcd_local_barrier(unsigned* bar, unsigned x, unsigned nloc) {
    asm volatile("s_waitcnt vmcnt(0)" ::: "memory");
    __syncthreads();
    if (threadIdx.x == 0) {
        __builtin_amdgcn_s_waitcnt(0);
        const unsigned old = xb_add(&bar[XB_XSUBL(x)], 1u), gen = old / nloc;
        if (old + 1u == (gen + 1u) * nloc) xb_add(&bar[XB_XGENL(x)], 1u);
        else XB_SPIN(xb_ld(&bar[XB_XGENL(x)]) == gen, bar);
        __builtin_amdgcn_fence(__ATOMIC_ACQUIRE, "agent");
        asm volatile("s_waitcnt vmcnt(0)" ::: "memory");
    }
    __syncthreads();
}

namespace pg8 {
constexpr int BM = 256, BK = 64, HALF = 128, HTB = HALF * BK * 2, STAGE_BYTES = 8 * HTB, NXCD = 8, WGM = 8;
__host__ __device__ __forceinline__ int lds_byte(int r, int c) { const int st = (r >> 4) * 2 + (c >> 5), rr = r & 15, cc = c & 31, ob = rr * 64 + cc * 2; return st * 1024 + (ob ^ (((ob >> 9) & 1) << 5)); }
__host__ __device__ __forceinline__ void stage_rc(int b, int& R, int& C) { const int st = b / 1024, sb = b % 1024, swz = sb ^ (((sb >> 9) & 1) << 5); R = (st >> 1) * 16 + swz / 64; C = (st & 1) * 32 + (swz % 64) / 2; }
__host__ __device__ __forceinline__ int perm32(int rho) { const int n = rho >> 4, i = rho & 15; return 8 * (i >> 2) + 4 * n + (i & 3); }

struct Unit { int pm, pn, aux; const char* A; const char* B; };
struct GemmP { int K, lda, ldb; };

__device__ __forceinline__ bool tile_of(int i, int G, int c, int nM, int nN, int& pm, int& pn) {
    const int nwg = nM * nN; const int L = i * G + c; if (L >= nwg) return false;
    int wgid = L; { const int q = nwg / NXCD, r = nwg % NXCD, xcd = wgid % NXCD, off = wgid / NXCD; wgid = (xcd < r ? xcd * (q + 1) : r * (q + 1) + (xcd - r) * q) + off; }
    const int nig = WGM * nN, gid = wgid / nig, fm = gid * WGM, gsz = (nM - fm) < WGM ? (nM - fm) : WGM;
    pm = fm + ((wgid % nig) % gsz); pn = (wgid % nig) / gsz; return true;
}

__device__ __forceinline__ unsigned cvt_pk_bf16(float lo, float hi) { unsigned r; asm volatile("v_cvt_pk_bf16_f32 %0, %1, %2" : "=v"(r) : "v"(lo), "v"(hi)); return r; }

template <class Epi, class Sched, bool ALIGN_EPI>
__device__ __forceinline__ void gemm_phase(LAS unsigned char* lds, const int tid, const GemmP g, const Sched& S, const Epi& E) {
    const int wid = __builtin_amdgcn_readfirstlane(tid >> 6), lane = tid & 63, wr = wid >> 2, wc = wid & 3, fr = lane & 15, fq = lane >> 4;
    const int K = g.K, nt = K / BK;
    unsigned voffB[2]; int Ri[2], Ci[2];
#pragma unroll
    for (int i = 0; i < 2; ++i) { int R, C; stage_rc(tid * 16 + i * 8192, R, C); const int Rb = Epi::PERM ? ((R & ~31) + perm32(R & 31)) : R;
        Ri[i] = R; Ci[i] = C; voffB[i] = (unsigned)(Rb * g.ldb + C) * 2u; }
    const size_t kstep = (size_t)(BK * 2);
    const size_t hstepB = (size_t)HALF * g.ldb * 2;
    unsigned vA0[2], vA1[2], nvA0[2], nvA1[2];
    const unsigned ldsw = (unsigned)wid * 1024u;
    const int aoff = lds_byte(wr * 64 + fr, fq * 8), boff = lds_byte(wc * 32 + fr, fq * 8);
#define PG8_SA(b, h) (((b) * 2 + (h)) * HTB)
#define PG8_SB(b, h) ((4 + (b) * 2 + (h)) * HTB)
#define PG8_STAGE(bufoff, gbase, voff) do { _Pragma("unroll") for (int _i = 0; _i < 2; ++_i) \
        __builtin_amdgcn_global_load_lds((const unsigned*)((const char*)(gbase) + (voff)[_i]), (LAS unsigned*)(lds + (bufoff) + ldsw + _i * 8192), 16, 0, 0); } while (0)
#define PG8_LDA(dst, b, h) do { _Pragma("unroll") for (int m = 0; m < 4; ++m) _Pragma("unroll") for (int k = 0; k < 2; ++k) dst[m][k] = *(const LAS bf16x8*)(lds + PG8_SA(b, h) + aoff + m * 2048 + k * 1024); } while (0)
#define PG8_LDB(dst, b, h) do { _Pragma("unroll") for (int n = 0; n < 2; ++n) _Pragma("unroll") for (int k = 0; k < 2; ++k) dst[n][k] = *(const LAS bf16x8*)(lds + PG8_SB(b, h) + boff + n * 2048 + k * 1024); } while (0)
#define PG8_MMA(ai, bj, At, Bt) do { __builtin_amdgcn_s_setprio(1); _Pragma("unroll") for (int m = 0; m < 4; ++m) _Pragma("unroll") for (int n = 0; n < 2; ++n) _Pragma("unroll") for (int k = 0; k < 2; ++k) \
        acc[ai][bj][m][n] = __builtin_amdgcn_mfma_f32_16x16x32_bf16(Bt[n][k], At[m][k], acc[ai][bj][m][n], 0, 0, 0); __builtin_amdgcn_s_setprio(0); } while (0)
#define PG8_WAIT_V(n) asm volatile("s_waitcnt vmcnt(" #n ")" ::: "memory")
#define PG8_WAIT_L(n) asm volatile("s_waitcnt lgkmcnt(" #n ")" ::: "memory")
#define PG8_BAR __builtin_amdgcn_s_barrier()
#define PG8_SCHED __builtin_amdgcn_sched_barrier(0)
    Unit cur, nxt; int ui = 0;
    if (!S.next(0, cur)) return;
    float zf = 0.f; asm volatile("" : "+v"(zf));
    f32x4 acc[2][2][4][2];
#pragma unroll
    for (int a = 0; a < 2; ++a)
#pragma unroll
        for (int b = 0; b < 2; ++b)
#pragma unroll
            for (int m = 0; m < 4; ++m)
#pragma unroll
                for (int n = 0; n < 2; ++n) acc[a][b][m][n] = (f32x4){zf, zf, zf, zf};
    bf16x8 At[4][2], B0[2][2], B1[2][2];
    typename Epi::Pre pre;
    const char* cA = cur.A; const char* cB = cur.B;
    S.a_off(cur, g.lda, Ri, Ci, vA0, vA1);
    PG8_STAGE(PG8_SB(0, 0), cB, voffB); PG8_STAGE(PG8_SB(0, 1), cB + hstepB, voffB); PG8_STAGE(PG8_SA(0, 0), cA, vA0); PG8_STAGE(PG8_SA(0, 1), cA, vA1);
    if constexpr (Epi::INIT) E.init(acc, cur, wr, wc);
    if (wr == 1) PG8_BAR;
    PG8_WAIT_V(2); PG8_BAR;
    PG8_STAGE(PG8_SB(1, 0), cB + kstep, voffB); PG8_STAGE(PG8_SA(1, 0), cA + kstep, vA0); PG8_STAGE(PG8_SB(1, 1), cB + hstepB + kstep, voffB);
    PG8_WAIT_V(6); PG8_BAR;
    for (;;) {
        const bool has_next = S.next(ui + 1, nxt);
        const char* nA = has_next ? nxt.A : cA; const char* nB = has_next ? nxt.B : cB;
        if (has_next) S.a_off(nxt, g.lda, Ri, Ci, nvA0, nvA1); else { nvA0[0] = vA0[0]; nvA0[1] = vA0[1]; nvA1[0] = vA1[0]; nvA1[1] = vA1[1]; }
        for (int t = 0; t < nt; t += 2) {
            if constexpr (Epi::HOOK) { if (t != 0 && (t & 3) == 0) E.hook(acc, cur, t >> 2, wr, wc, fr, fq); }
            const bool last = (t == nt - 2);
            if (last) E.prefetch(cur, wr, wc, fr, fq, pre);
            const char* a1 = cA + (size_t)(t + 1) * kstep;
            const char* a2 = last ? nA : cA + (size_t)(t + 2) * kstep; const char* b2 = last ? nB : cB + (size_t)(t + 2) * kstep;
            const char* a3 = a2 + kstep; const char* b3 = b2 + kstep;
            unsigned w0[2], w1[2];
            w0[0] = last ? nvA0[0] : vA0[0]; w0[1] = last ? nvA0[1] : vA0[1]; w1[0] = last ? nvA1[0] : vA1[0]; w1[1] = last ? nvA1[1] : vA1[1];
            PG8_LDB(B0, 0, 0); PG8_LDB(B1, 0, 1); PG8_SCHED; PG8_LDA(At, 0, 0); PG8_STAGE(PG8_SA(1, 1), a1, vA1);
            PG8_WAIT_V(8); PG8_WAIT_L(0); PG8_BAR; PG8_MMA(0, 0, At, B0); PG8_MMA(0, 1, At, B1); PG8_BAR; PG8_SCHED;
            PG8_LDA(At, 0, 1); PG8_STAGE(PG8_SB(0, 0), b2, voffB); PG8_STAGE(PG8_SB(0, 1), b2 + hstepB, voffB); PG8_STAGE(PG8_SA(0, 0), a2, w0);
            PG8_WAIT_V(8); PG8_WAIT_L(0); PG8_BAR; PG8_MMA(1, 0, At, B0); PG8_MMA(1, 1, At, B1); PG8_BAR; PG8_SCHED;
            PG8_LDB(B0, 1, 0); PG8_LDB(B1, 1, 1); PG8_SCHED; PG8_LDA(At, 1, 0); PG8_STAGE(PG8_SA(0, 1), a2, w1);
            PG8_WAIT_V(8); PG8_WAIT_L(0); PG8_BAR; PG8_MMA(0, 0, At, B0); PG8_MMA(0, 1, At, B1); PG8_BAR; PG8_SCHED;
            PG8_LDA(At, 1, 1); PG8_STAGE(PG8_SB(1, 0), b3, voffB); PG8_STAGE(PG8_SB(1, 1), b3 + hstepB, voffB); PG8_STAGE(PG8_SA(1, 0), a3, w0);
            PG8_WAIT_V(8); PG8_WAIT_L(0); PG8_BAR; PG8_MMA(1, 0, At, B0); PG8_MMA(1, 1, At, B1); PG8_BAR; PG8_SCHED;
        }
        if constexpr (ALIGN_EPI) { if (wr == 0) PG8_BAR; }
        E(acc, cur, wr, wc, fr, fq, pre);
        if (!has_next) break;
#pragma unroll
        for (int a = 0; a < 2; ++a)
#pragma unroll
            for (int b = 0; b < 2; ++b)
#pragma unroll
                for (int m = 0; m < 4; ++m)
#pragma unroll
                    for (int n = 0; n < 2; ++n) acc[a][b][m][n] = (f32x4){zf, zf, zf, zf};
        cur = nxt; cA = nA; cB = nB; ++ui; vA0[0] = nvA0[0]; vA0[1] = nvA0[1]; vA1[0] = nvA1[0]; vA1[1] = nvA1[1];
        if constexpr (Epi::INIT) E.init(acc, cur, wr, wc);
        if constexpr (ALIGN_EPI) { if (wr == 1) PG8_BAR; }
    }
    PG8_WAIT_V(0);
    if constexpr (!ALIGN_EPI) { if (wr == 0) PG8_BAR; }
    PG8_BAR;
#undef PG8_SA
#undef PG8_SB
#undef PG8_STAGE
#undef PG8_LDA
#undef PG8_LDB
#undef PG8_MMA
#undef PG8_WAIT_V
#undef PG8_WAIT_L
#undef PG8_BAR
#undef PG8_SCHED
}
}

struct Frame { LAS unsigned char* lds; int tid, lane, wave, G, bid; float zf; unsigned zu; };
#define FRAME_SETUP Frame F; { int t_ = threadIdx.x, b_ = blockIdx.x, g_ = gridDim.x; float z_ = 0.f; unsigned zu_ = 0u; asm volatile("" : "+v"(t_), "+s"(b_), "+s"(g_), "+v"(z_), "+v"(zu_)); \
    F.lds = lds_base(); F.tid = t_; F.lane = t_ & 63; F.wave = __builtin_amdgcn_readfirstlane(t_ >> 6); F.G = g_; F.bid = b_; F.zf = z_; F.zu = zu_; }
extern __shared__ __attribute__((aligned(16))) unsigned char lds_dyn[];
__device__ __forceinline__ LAS unsigned char* lds_base() { return (LAS unsigned char*)lds_dyn; }
typedef const __attribute__((address_space(4))) unsigned long long karg_t;
__device__ __forceinline__ unsigned long long karg(int k) { asm volatile("" : "+s"(k)); return ((karg_t*)__builtin_amdgcn_kernarg_segment_ptr())[k]; }
__device__ __forceinline__ const float* inp(int k) { return (const float*)(const GAS float*)karg(k); }
__device__ __forceinline__ float* outp() { return (float*)(GAS float*)karg(22); }
__device__ __forceinline__ unsigned char* wsp() { return (unsigned char*)(GAS unsigned char*)karg(23); }
enum { I_X = 0, I_WIN, I_BIN, I_GMLNG, I_GMWS, I_GMBS, I_RELB, I_MLCONV, I_MLFB, I_MLNG, I_POOLW, I_POOLS, I_WBR, I_WOUT, I_LN1G, I_LN1B, I_WR, I_WE1, I_WE3, I_WE2, I_LN2G, I_LN2B };
__device__ __forceinline__ bf16* wl(unsigned char* ws, int l, size_t off) { return (bf16*)(ws + WS_W + (size_t)l * LW + off); }

#define WS_PTRS unsigned char* ws = wsp(); float* BIN = (float*)(ws + WS_BIN); float* XF = (float*)(ws + WS_XF); bf16* XB = (bf16*)(ws + WS_XB); bf16* H = (bf16*)(ws + WS_BIG); bf16* XS = (bf16*)(ws + WS_XS); \
    bf16* HID = (bf16*)(ws + WS_HID); bf16* YE = (bf16*)(ws + WS_YE); float* GI = (float*)(ws + WS_GI); bf16* ATTO = (bf16*)(ws + WS_ATTO); float* ATTL = (float*)(ws + WS_ATTL); bf16* YS = (bf16*)(ws + WS_YS); \
    float* MGF = (float*)(ws + WS_MGF); bf16* MGB = (bf16*)(ws + WS_MGB); bf16* QC = (bf16*)(ws + WS_QC); bf16* KC = (bf16*)(ws + WS_KC); bf16* DC = (bf16*)(ws + WS_DC); float* DG = (float*)(ws + WS_DG); \
    float* AFF = (float*)(ws + WS_AFF); float* GATE = (float*)(ws + WS_GATE); int* IDX = (int*)(ws + WS_IDX); int* SLOT = (int*)(ws + WS_SLOT); \
    (void)BIN; (void)XF; (void)XB; (void)H; (void)XS; (void)HID; (void)YE; (void)GI; (void)ATTO; (void)ATTL; (void)YS; (void)MGF; (void)MGB; (void)QC; (void)KC; (void)DC; (void)DG; (void)AFF; (void)GATE; (void)IDX; (void)SLOT
__device__ __forceinline__ void tr_item(const float* W, int ldw, int k0, int n0, int ncols, bf16* WT, int ldt, int trow0, LAS float* scr, int lane) {
    const int c4 = lane & 7, r = lane >> 3; const bool cv = 4 * c4 < ncols;
    f32x4 tv[8];
#pragma unroll
    for (int i = 0; i < 8; ++i) tv[i] = cv ? __builtin_nontemporal_load((const f32x4*)(W + (size_t)(k0 + r + 8 * i) * ldw + n0 + 4 * c4)) : (f32x4){0.f, 0.f, 0.f, 0.f};
#pragma unroll
    for (int i = 0; i < 8; ++i) { LAS float* d = scr + (r + 8 * i) * 33 + 4 * c4; d[0] = tv[i][0]; d[1] = tv[i][1]; d[2] = tv[i][2]; d[3] = tv[i][3]; }
    LDS_WAIT(); asm volatile("" ::: "memory");
    const int ch = lane & 7;
#pragma unroll
    for (int j = 0; j < 4; ++j) { const int n = (lane >> 3) + 8 * j; const LAS float* s = scr + (8 * ch) * 33 + n;
        u32x4 o; o.x = pk2(s[0 * 33], s[1 * 33]); o.y = pk2(s[2 * 33], s[3 * 33]); o.z = pk2(s[4 * 33], s[5 * 33]); o.w = pk2(s[6 * 33], s[7 * 33]);
        if (n < ncols) *(GAS u32x4*)(WT + (size_t)(trow0 + n) * ldt + k0 + 8 * ch) = o; }
    LDS_WAIT(); asm volatile("" ::: "memory");
}
constexpr int IT_IN = 16 * 209, IT_B = 512, IT_O = 512, IT_13 = 16384, IT_2 = 8192, IT_LAYER = IT_IN + IT_B + IT_O + IT_13 + IT_2;
constexpr int IT_SMALL = IT_IN + IT_B + IT_O, IT_XEXP = 3072, IT_XLAST = 512;
__device__ __forceinline__ void convert_layer(int l, int gw, int NGW, int it_lo = 0, int it_hi = IT_LAYER, int xq = -1) {
    FRAME_SETUP;
    WS_PTRS; const float* w_in = inp(I_WIN); const float* w_branch = inp(I_WBR); const float* w_out = inp(I_WOUT); const float* w_e1 = inp(I_WE1); const float* w_e3 = inp(I_WE3); const float* w_e2 = inp(I_WE2);
    LAS float* scr = (LAS float*)(F.lds + F.wave * 16384);
    const int lane = F.lane;
    for (int q_ = it_lo + gw; q_ < it_hi; q_ += NGW) {
        int it = q_;
        if (xq >= 0) { if (q_ < 2048) it = IT_SMALL + (q_ < 1024 ? xq : xq + 8) * 1024 + (q_ & 1023); else { const int q2 = q_ - 2048; it = IT_SMALL + IT_13 + (q2 < 512 ? xq : xq + 8) * 512 + (q2 & 511); } }
        int r = it; const float* W; int ldw, k0, n0, nc = 32, ldt, trow; bf16* WT;
        if (r < IT_IN) { const int kb = r / 209, cb = r % 209; k0 = 64 * kb;
            if (cb < 72) { n0 = 32 * cb; trow = n0; } else if (cb < 208) { n0 = 2320 + 32 * (cb - 72); trow = 2304 + 32 * (cb - 72); } else { n0 = 2304; trow = 6656; nc = 16; }
            W = w_in + (size_t)l * D * NIN; ldw = NIN; WT = wl(ws, l, OW_IN); ldt = D; }
        else if ((r -= IT_IN) < IT_B) { const int n = r / 128, q = r % 128, kb = q / 32, nb = q % 32;
            W = w_branch + ((size_t)(l * 4 + n) * 256) * D; ldw = D; k0 = 64 * kb; n0 = 32 * nb; WT = wl(ws, l, OW_B) + (size_t)n * 256; ldt = D; trow = 32 * nb; }
        else if ((r -= IT_B) < IT_O) { const int kb = r / 32, nb = r % 32;
            W = w_out + (size_t)l * D * D; ldw = D; k0 = 64 * kb; n0 = 32 * nb; WT = wl(ws, l, OW_O); ldt = D; trow = 32 * nb; }
        else if ((r -= IT_O) < IT_13) { const int e = r / 1024, q = r % 1024, which = q / 512, q2 = q % 512, kb = q2 / 32, nb = q2 % 32, f0 = 32 * nb;
            W = (which ? w_e3 : w_e1) + ((size_t)(l * NE + e) * D) * FF; ldw = FF; k0 = 64 * kb; n0 = f0; WT = wl(ws, l, OW_13) + (size_t)e * 2048 * D; ldt = D; trow = (f0 / 128) * 256 + (f0 % 128) + which * 128; }
        else { r -= IT_13; const int e = r / 512, q = r % 512, kb = q / 32, nb = q % 32;
            W = w_e2 + ((size_t)(l * NE + e) * FF) * D; ldw = D; k0 = 64 * kb; n0 = 32 * nb; WT = wl(ws, l, OW_2) + (size_t)e * D * FF; ldt = FF; trow = 32 * nb; }
        tr_item(W, ldw, k0, n0, nc, WT, ldt, trow, scr, lane);
    }
}
__device__ __forceinline__ void p0_prologue() {
    FRAME_SETUP;
    WS_PTRS; const float* x = inp(I_X); const float* b_in = inp(I_BIN);
    convert_layer(0, F.bid * NWAVES + F.wave, F.G * NWAVES, 0, IT_SMALL);
    const int gt = F.bid * NTHREADS + F.tid, NGT = F.G * NTHREADS;
    for (int i = gt; i < DEPTH * 240 * (D / 8); i += NGT) { const int l = i / (240 * (D / 8)), r = i % (240 * (D / 8));
        *(GAS u32x4*)(wl(ws, l, OW_IN) + (size_t)NIN * D + (size_t)r * 8) = (u32x4){F.zu, F.zu, F.zu, F.zu}; }
    for (int i = gt; i < DEPTH * NINP; i += NGT) { const int l = i / NINP, c = i % NINP;
        float v = 0.f; if (c < 2304) v = b_in[l * NIN + c]; else if (c < NHC) v = b_in[l * NIN + c + 16]; else if (c < NHC + 16) v = b_in[l * NIN + c - NHC + 2304];
        BIN[i] = v; }
    { const float* gm_ws = inp(I_GMWS); bf16* WSB = (bf16*)(ws + WS_WSB);
      for (int i = gt; i < DEPTH * 4 * 128 * 128 / 4; i += NGT) { const f32x4 v = ((const GAS f32x4*)gm_ws)[i]; u32x2 w; w.x = pk2(v.x, v.y); w.y = pk2(v.z, v.w); ((GAS u32x2*)WSB)[i] = w; } }
    { const float* pool_w = inp(I_POOLW); bf16* PWT = (bf16*)(ws + WS_PWT);
      for (int i = gt; i < DEPTH * 4 * 64 * 64; i += NGT) { const int lg = i >> 12, o = (i >> 6) & 63, ii = i & 63; PWT[i] = (bf16)f2bf(pool_w[(size_t)lg * 4096 + ii * 64 + o]); } }
    { const float* w_router = inp(I_WR); bf16* WRT = (bf16*)(ws + WS_WRT);
      for (int i = gt; i < DEPTH * NE * D; i += NGT) { const int ll = i / (NE * D), e = (i / D) % NE, d = i % D; WRT[i] = (bf16)f2bf(w_router[((size_t)ll * D + d) * NE + e]); } }
    for (int i = gt; i < T * D / 4; i += NGT) { const f32x4 v = ((const GAS f32x4*)x)[i];
        u32x2 w; w.x = pk2(v.x, v.y); w.y = pk2(v.z, v.w); ((GAS u32x2*)XB)[i] = w; }
}

typedef f32x4 Acc[2][2][4][2];
struct SchedG1 { int G, c; const char* A; const char* B; int xx, xs;
    __device__ __forceinline__ void a_off(const pg8::Unit&, int lda, const int (&Ri)[2], const int (&Ci)[2], unsigned (&v0)[2], unsigned (&v1)[2]) const {
#pragma unroll
        for (int i = 0; i < 2; ++i) { v0[i] = (unsigned)(Ri[i] * lda + Ci[i]) * 2u; v1[i] = v0[i] + (unsigned)(128 * lda * 2); } }
    __device__ __forceinline__ bool next(int i, pg8::Unit& u) const { int pm, pn; if (xs >= 0) { const int ui = xs + 32 * i; if (ui >= 216) return false; pn = ui >> 3; pm = 8 * (ui & 7) + xx; } else if (!pg8::tile_of(i, G, c, T / 256, NINP / 256, pm, pn)) return false;
        u.pm = pm; u.pn = pn; u.aux = 0; u.A = A + (size_t)pm * 256 * D * 2; u.B = B + (size_t)pn * 256 * D * 2; return true; } };
struct EpiG1 { static constexpr bool INIT = false; static constexpr bool PERM = true, HOOK = false; bf16* H; float* GI; const float* bias; u32x4* GQ;
    struct Pre { f32x4 bv[2][2]; };
    __device__ __forceinline__ void prefetch(const pg8::Unit& u, int wr, int wc, int fr, int fq, Pre& p) const { const int col0 = u.pn * 256 + wc * 32 + 8 * fq;
#pragma unroll
        for (int bj = 0; bj < 2; ++bj)
#pragma unroll
            for (int n = 0; n < 2; ++n) p.bv[bj][n] = *(const f32x4*)(bias + col0 + bj * 128 + 4 * n); }
    __device__ __forceinline__ void operator()(const Acc& acc, const pg8::Unit& u, int wr, int wc, int fr_, int fq_, const Pre& pre) const {
        unsigned t_ = threadIdx.x; asm volatile("" : "+v"(t_)); const int fr = (int)(t_ & 15u), fq = (int)((t_ >> 4) & 3u);
        const int row0 = u.pm * 256 + wr * 64 + fr;
        if (u.pn < 26) {
            const int col0 = u.pn * 256 + wc * 32 + 8 * fq; const bool act = u.pn < 2, sg = u.pn >= 10;
            const unsigned gq0 = (unsigned)((wr * 4 + wc) * 512 + fq * 16 + fr);
#pragma unroll
            for (int ai = 0; ai < 2; ++ai)
#pragma unroll
                for (int m = 0; m < 4; ++m) { bf16* rowp = H + (size_t)u.pn * HTILE + (size_t)(row0 + ai * 128 + m * 16) * NH + (col0 - u.pn * 256);
                    u32x4 qq = (u32x4){0u, 0u, 0u, 0u};
#pragma unroll
                    for (int bj = 0; bj < 2; ++bj) { f32x4 v0 = acc[ai][bj][m][0] + pre.bv[bj][0], v1 = acc[ai][bj][m][1] + pre.bv[bj][1];
                        if (act) { v0 = (f32x4){gelu_tanh(v0[0]), gelu_tanh(v0[1]), gelu_tanh(v0[2]), gelu_tanh(v0[3])}; v1 = (f32x4){gelu_tanh(v1[0]), gelu_tanh(v1[1]), gelu_tanh(v1[2]), gelu_tanh(v1[3])}; }
                        if (sg) {
                            u32x2 qb; qb.x = 0u; qb.y = 0u;
#pragma unroll
                            for (int j = 0; j < 4; ++j) { qb.x = __builtin_amdgcn_cvt_pk_u8_f32(sigmoidf_(v0[j]) * 256.0f - 0.5f, j, qb.x); qb.y = __builtin_amdgcn_cvt_pk_u8_f32(sigmoidf_(v1[j]) * 256.0f - 0.5f, j, qb.y); }
                            if (bj == 0) { qq.x = qb.x; qq.y = qb.y; } else { qq.z = qb.x; qq.w = qb.y; }
                        } else {
                        u32x4 w; w.x = pk2(v0[0], v0[1]); w.y = pk2(v0[2], v0[3]); w.z = pk2(v1[0], v1[1]); w.w = pk2(v1[2], v1[3]);
                        *(u32x4*)(rowp + bj * 128) = w; } }
                    if (sg) GQ[(size_t)((u.pm * 4 + ((u.pn - 10) & 3)) * 4 + ((u.pn - 10) >> 2)) * 4096 + gq0 + (ai * 4 + m) * 64] = qq; }
        } else if (wc == 0 && fq < 2) {
            const unsigned fq8 = 8u * fq;
#pragma unroll
            for (int ai = 0; ai < 2; ++ai)
#pragma unroll
                for (int m = 0; m < 4; ++m) { float* rowp = GI + (size_t)(row0 + ai * 128 + m * 16) * 16 + fq8;
#pragma unroll
                    for (int n = 0; n < 2; ++n) *(f32x4*)(rowp + 4 * n) = acc[ai][0][m][n] + pre.bv[0][n]; }
        }
    } };
struct SchedG2 { int G, c; const char* A; const char* B; int xx, xs;
    __device__ __forceinline__ void a_off(const pg8::Unit&, int lda, const int (&Ri)[2], const int (&Ci)[2], unsigned (&v0)[2], unsigned (&v1)[2]) const {
#pragma unroll
        for (int i = 0; i < 2; ++i) { v0[i] = (unsigned)(Ri[i] * lda + Ci[i]) * 2u; v1[i] = v0[i] + (unsigned)(128 * lda * 2); } }
    __device__ __forceinline__ bool next(int i, pg8::Unit& u) const { int pm, pn; if (xs >= 0) { if (i) return false; pm = 8 * (xs >> 2) + xx; pn = xs & 3; } else if (!pg8::tile_of(i, G, c, T / 256, D / 256, pm, pn)) return false;
        u.pm = pm; u.pn = pn; u.aux = 0; u.A = A + (size_t)pm * 256 * D * 2; u.B = B + (size_t)pn * 256 * D * 2; return true; } };
__device__ __forceinline__ void unq8(const u32x2 w, float (&o)[8]) {
    o[0] = ((float)(w.x & 255u) + 0.5f) * (1.0f / 256.0f); o[1] = ((float)((w.x >> 8) & 255u) + 0.5f) * (1.0f / 256.0f); o[2] = ((float)((w.x >> 16) & 255u) + 0.5f) * (1.0f / 256.0f); o[3] = ((float)(w.x >> 24) + 0.5f) * (1.0f / 256.0f);
    o[4] = ((float)(w.y & 255u) + 0.5f) * (1.0f / 256.0f); o[5] = ((float)((w.y >> 8) & 255u) + 0.5f) * (1.0f / 256.0f); o[6] = ((float)((w.y >> 16) & 255u) + 0.5f) * (1.0f / 256.0f); o[7] = ((float)(w.y >> 24) + 0.5f) * (1.0f / 256.0f); }
struct EpiG2 { static constexpr bool INIT = false; static constexpr bool PERM = true, HOOK = true; struct Pre {}; __device__ __forceinline__ void prefetch(const pg8::Unit&, int, int, int, int, Pre&) const {} const u32x4* GQ; bf16* MGB;
    __device__ __forceinline__ void hook(Acc& acc, const pg8::Unit& u, int n, int wr, int wc, int fr, int fq) const {
        const u32x4* ga_p = GQ + ((((size_t)(u.pm * 4 + u.pn) * 4 + (n - 1)) * 8 + (wr * 4 + wc)) * 8) * 64 + fq * 16 + fr; const u32x4* gb_p = ga_p + 8 * 8 * 64;
        u32x4 ga[8], gb[8];
#pragma unroll
        for (int q = 0; q < 8; ++q) { ga[q] = ga_p[q * 64]; gb[q] = gb_p[q * 64]; }
#pragma unroll
        for (int q = 0; q < 8; ++q) { const int ai = q >> 2, m = q & 3;
            { float sa[8], sb[8]; unq8((u32x2){ga[q].x, ga[q].y}, sa); unq8((u32x2){gb[q].x, gb[q].y}, sb);
              acc[ai][0][m][0] *= (f32x4){sa[0] * __builtin_amdgcn_rcpf(sb[0]), sa[1] * __builtin_amdgcn_rcpf(sb[1]), sa[2] * __builtin_amdgcn_rcpf(sb[2]), sa[3] * __builtin_amdgcn_rcpf(sb[3])};
              acc[ai][0][m][1] *= (f32x4){sa[4] * __builtin_amdgcn_rcpf(sb[4]), sa[5] * __builtin_amdgcn_rcpf(sb[5]), sa[6] * __builtin_amdgcn_rcpf(sb[6]), sa[7] * __builtin_amdgcn_rcpf(sb[7])}; }
            { float sa[8], sb[8]; unq8((u32x2){ga[q].z, ga[q].w}, sa); unq8((u32x2){gb[q].z, gb[q].w}, sb);
              acc[ai][1][m][0] *= (f32x4){sa[0] * __builtin_amdgcn_rcpf(sb[0]), sa[1] * __builtin_amdgcn_rcpf(sb[1]), sa[2] * __builtin_amdgcn_rcpf(sb[2]), sa[3] * __builtin_amdgcn_rcpf(sb[3])};
              acc[ai][1][m][1] *= (f32x4){sa[4] * __builtin_amdgcn_rcpf(sb[4]), sa[5] * __builtin_amdgcn_rcpf(sb[5]), sa[6] * __builtin_amdgcn_rcpf(sb[6]), sa[7] * __builtin_amdgcn_rcpf(sb[7])}; }
            __builtin_amdgcn_sched_barrier(0); }
        asm volatile("" ::: "memory");
    }
    __device__ __forceinline__ void operator()(const Acc& acc, const pg8::Unit& u, int wr, int wc, int fr, int fq, const Pre& pre) const {
        const size_t rowb = (size_t)(u.pm * 256 + wr * 64 + fr); const int col0 = u.pn * 256 + wc * 32 + 8 * fq;
        const u32x4* gp = GQ + ((((size_t)(u.pm * 4 + u.pn) * 4 + 3) * 8 + (wr * 4 + wc)) * 8) * 64 + fq * 16 + fr; bf16* bp = MGB + rowb * D + col0;
        u32x4 gv[8];
#pragma unroll
        for (int q = 0; q < 8; ++q) gv[q] = gp[q * 64];
#pragma unroll
        for (int ai = 0; ai < 2; ++ai)
#pragma unroll
            for (int m = 0; m < 4; ++m)
#pragma unroll
                for (int bj = 0; bj < 2; ++bj) { const int ro = ai * 128 + m * 16; const u32x4 G = gv[ai * 4 + m]; float sv[8]; unq8(bj ? (u32x2){G.z, G.w} : (u32x2){G.x, G.y}, sv);
                    const f32x4 a0 = acc[ai][bj][m][0], a1 = acc[ai][bj][m][1];
                    u32x4 w; w.x = pk2(a0[0] * sv[0], a0[1] * sv[1]); w.y = pk2(a0[2] * sv[2], a0[3] * sv[3]); w.z = pk2(a1[0] * sv[4], a1[1] * sv[5]); w.w = pk2(a1[2] * sv[6], a1[3] * sv[7]);
                    *(u32x4*)(bp + (size_t)ro * D + bj * 128) = w; }
    } };
struct SchedG3 { int G, c; const char* A; const char* B; int xx, xs;
    __device__ __forceinline__ void a_off(const pg8::Unit&, int lda, const int (&Ri)[2], const int (&Ci)[2], unsigned (&v0)[2], unsigned (&v1)[2]) const {
#pragma unroll
        for (int i = 0; i < 2; ++i) { v0[i] = (unsigned)(Ri[i] * lda + Ci[i]) * 2u; v1[i] = v0[i] + (unsigned)(128 * lda * 2); } }
    __device__ __forceinline__ bool next(int i, pg8::Unit& u) const { int pm, pn; if (xs >= 0) { if (i) return false; pm = 8 * (xs >> 2) + xx; pn = xs & 3; } else if (!pg8::tile_of(i, G, c, T / 256, D / 256, pm, pn)) return false;
        u.pm = pm; u.pn = pn; u.aux = 0; u.A = A + (size_t)pm * 256 * D * 2; u.B = B + (size_t)pn * 256 * D * 2; return true; } };
struct EpiG3 { static constexpr bool INIT = true; static constexpr bool PERM = true, HOOK = false; struct Pre {}; __device__ __forceinline__ void prefetch(const pg8::Unit&, int, int, int, int, Pre&) const {} const bf16* XB; bf16* R; float* STAT;
    __device__ __forceinline__ void init(Acc& acc, const pg8::Unit& u, int wr, int wc) const {
        unsigned t_ = threadIdx.x; asm volatile("" : "+v"(t_)); const int fr = (int)(t_ & 15u), fq = (int)((t_ >> 4) & 3u);
        const int row0 = u.pm * 256 + wr * 64 + fr, col0 = u.pn * 256 + wc * 32 + 8 * fq;
#pragma unroll
        for (int ai = 0; ai < 2; ++ai) { u32x4 xr[4][2];
#pragma unroll
            for (int m = 0; m < 4; ++m)
#pragma unroll
                for (int bj = 0; bj < 2; ++bj) xr[m][bj] = *(const u32x4*)(XB + (size_t)(row0 + ai * 128 + m * 16) * D + col0 + bj * 128);
#pragma unroll
            for (int m = 0; m < 4; ++m)
#pragma unroll
                for (int bj = 0; bj < 2; ++bj) { float x8[8]; unpack8(xr[m][bj], x8); acc[ai][bj][m][0] = (f32x4){x8[0], x8[1], x8[2], x8[3]} * ALPHA; acc[ai][bj][m][1] = (f32x4){x8[4], x8[5], x8[6], x8[7]} * ALPHA; } }
    }
    __device__ __forceinline__ void operator()(const Acc& acc, const pg8::Unit& u, int wr, int wc, int fr, int fq, const Pre& pre) const {
        const int row0 = u.pm * 256 + wr * 64 + fr, col0 = u.pn * 256 + wc * 32 + 8 * fq, lane = fq * 16 + fr;
#pragma unroll
        for (int ai = 0; ai < 2; ++ai) {
#pragma unroll
            for (int m = 0; m < 4; ++m) { const size_t row = (size_t)(row0 + ai * 128 + m * 16); float s1 = 0.f, s2 = 0.f;
#pragma unroll
                for (int bj = 0; bj < 2; ++bj) { const size_t o = row * D + col0 + bj * 128;
                    const f32x4 r0 = acc[ai][bj][m][0], r1 = acc[ai][bj][m][1];
                    { u32x4 w; w.x = pk2(r0[0], r0[1]); w.y = pk2(r0[2], r0[3]); w.z = pk2(r1[0], r1[1]); w.w = pk2(r1[2], r1[3]); *(u32x4*)(R + o) = w; }
                    s1 += ((r0[0] + r0[1]) + (r0[2] + r0[3])) + ((r1[0] + r1[1]) + (r1[2] + r1[3]));
                    s2 += ((r0[0] * r0[0] + r0[1] * r0[1]) + (r0[2] * r0[2] + r0[3] * r0[3])) + ((r1[0] * r1[0] + r1[1] * r1[1]) + (r1[2] * r1[2] + r1[3] * r1[3])); }
                s1 += shx(s1, 16, lane); s1 += shx(s1, 32, lane); s2 += shx(s2, 16, lane); s2 += shx(s2, 32, lane);
                if (fq == 0) *(f32x2*)(STAT + (row * 16 + u.pn * 4 + wc) * 2) = (f32x2){s1, s2}; } }
    } };
struct SchedG4 { int G, c; const char* A; const char* B; const int* IDX; int xx, xs;
    __device__ __forceinline__ bool next(int i, pg8::Unit& u) const { int pm, pn; if (xs >= 0) { if (i >= 4) return false; const int ui = xs + 32 * i, j = ui >> 3; pn = ui & 7; pm = 4 * (xx + 8 * (j >> 2)) + (j & 3); } else if (!pg8::tile_of(i, G, c, NSLOT / 256, 2048 / 256, pm, pn)) return false; const int e = (pm >> 2) & 15;
        u.pm = pm; u.pn = pn; u.aux = e; u.A = A + (size_t)(pm >> 6) * SEQ * D * 2; u.B = B + (size_t)e * 2048 * D * 2 + (size_t)pn * 256 * D * 2; return true; }
    __device__ __forceinline__ void a_off(const pg8::Unit& u, int lda, const int (&Ri)[2], const int (&Ci)[2], unsigned (&v0)[2], unsigned (&v1)[2]) const {
#pragma unroll
        for (int i = 0; i < 2; ++i) { const int r0 = IDX[u.pm * 256 + Ri[i]], r1 = IDX[u.pm * 256 + 128 + Ri[i]]; v0[i] = (unsigned)(r0 * lda + Ci[i]) * 2u; v1[i] = (unsigned)(r1 * lda + Ci[i]) * 2u; } } };
struct EpiG4 { static constexpr bool INIT = false; static constexpr bool PERM = true, HOOK = false; struct Pre {}; __device__ __forceinline__ void prefetch(const pg8::Unit&, int, int, int, int, Pre&) const {} bf16* HID;
    __device__ __forceinline__ void operator()(const Acc& acc, const pg8::Unit& u, int wr, int wc, int fr, int fq, const Pre& pre) const {
        const int row0 = u.pm * 256 + wr * 64 + fr, col0 = u.pn * 128 + wc * 32 + 8 * fq;
#pragma unroll
        for (int ai = 0; ai < 2; ++ai)
#pragma unroll
            for (int m = 0; m < 4; ++m) { const size_t row = (size_t)(row0 + ai * 128 + m * 16);
                const f32x4 a0 = acc[ai][0][m][0], a1 = acc[ai][0][m][1], g0 = acc[ai][1][m][0], g1 = acc[ai][1][m][1];
                u32x4 w; w.x = pk2(siluf_(a0[0]) * g0[0], siluf_(a0[1]) * g0[1]); w.y = pk2(siluf_(a0[2]) * g0[2], siluf_(a0[3]) * g0[3]);
                w.z = pk2(siluf_(a1[0]) * g1[0], siluf_(a1[1]) * g1[1]); w.w = pk2(siluf_(a1[2]) * g1[2], siluf_(a1[3]) * g1[3]);
                *(u32x4*)(HID + row * FF + col0) = w; }
    } };
struct SchedG5 { int G, c; const char* A; const char* B; int xx, xs;
    __device__ __forceinline__ void a_off(const pg8::Unit&, int lda, const int (&Ri)[2], const int (&Ci)[2], unsigned (&v0)[2], unsigned (&v1)[2]) const {
#pragma unroll
        for (int i = 0; i < 2; ++i) { v0[i] = (unsigned)(Ri[i] * lda + Ci[i]) * 2u; v1[i] = v0[i] + (unsigned)(128 * lda * 2); } }
    __device__ __forceinline__ bool next(int i, pg8::Unit& u) const { int pm, pn; if (xs >= 0) { if (i >= 2) return false; const int v = xs + 32 * i, j = v >> 2; pn = v & 3; pm = 4 * (xx + 8 * (j >> 2)) + (j & 3); } else if (!pg8::tile_of(i, G, c, NSLOT / 256, D / 256, pm, pn)) return false; const int e = (pm >> 2) & 15;
        u.pm = pm; u.pn = pn; u.aux = e; u.A = A + (size_t)pm * 256 * FF * 2; u.B = B + (size_t)e * D * FF * 2 + (size_t)pn * 256 * FF * 2; return true; } };
struct EpiG5 { static constexpr bool INIT = false; static constexpr bool PERM = true, HOOK = false; const float* GATE; bf16* YE;
    struct Pre { float g[2][4]; };
    __device__ __forceinline__ void prefetch(const pg8::Unit& u, int wr, int wc, int fr, int fq, Pre& p) const { const int row0 = u.pm * 256 + wr * 64 + fr;
#pragma unroll
        for (int ai = 0; ai < 2; ++ai)
#pragma unroll
            for (int m = 0; m < 4; ++m) p.g[ai][m] = GATE[row0 + ai * 128 + m * 16]; }
    __device__ __forceinline__ void operator()(const Acc& acc, const pg8::Unit& u, int wr, int wc, int fr, int fq, const Pre& pre) const {
        const int row0 = u.pm * 256 + wr * 64 + fr, col0 = u.pn * 256 + wc * 32 + 8 * fq;
#pragma unroll
        for (int ai = 0; ai < 2; ++ai)
#pragma unroll
            for (int m = 0; m < 4; ++m) { const size_t row = (size_t)(row0 + ai * 128 + m * 16); const float gt = pre.g[ai][m];
#pragma unroll
                for (int bj = 0; bj < 2; ++bj) { const f32x4 v0 = acc[ai][bj][m][0] * gt, v1 = acc[ai][bj][m][1] * gt;
                    u32x4 w; w.x = pk2(v0[0], v0[1]); w.y = pk2(v0[2], v0[3]); w.z = pk2(v1[0], v1[1]); w.w = pk2(v1[2], v1[3]);
                    *(u32x4*)(YE + row * D + col0 + bj * 128) = w; } }
    } };

typedef float f32x16 __attribute__((ext_vector_type(16)));
typedef short s16x4 __attribute__((ext_vector_type(4)));
typedef __bf16 bf16x2_t __attribute__((ext_vector_type(2)));
#define MFMA32(a, b, c) __builtin_amdgcn_mfma_f32_32x32x16_bf16((a), (b), (c), 0, 0, 0)
#define PRIO_HI() __builtin_amdgcn_s_setprio(1)
#define PRIO_LO() __builtin_amdgcn_s_setprio(0)
__device__ __forceinline__ int crow(int reg, int h) { return (reg & 3) + 8 * (reg >> 2) + 4 * h; }
__device__ __forceinline__ unsigned cvtpk(float lo, float hi) { f32x2 v = {lo, hi}; bf16x2_t b = __builtin_convertvector(v, bf16x2_t); return __builtin_bit_cast(unsigned, b); }
__device__ __forceinline__ bf16x8 pack8(float a0, float a1, float a2, float a3, float a4, float a5, float a6, float a7) {
    u32x4 p; p.x = cvtpk(a0, a1); p.y = cvtpk(a2, a3); p.z = cvtpk(a4, a5); p.w = cvtpk(a6, a7); return __builtin_bit_cast(bf16x8, p); }
typedef short v4i16_t __attribute__((ext_vector_type(4)));
__device__ __forceinline__ s16x4 tr_rd(const LAS unsigned char* p) { return __builtin_bit_cast(s16x4, __builtin_amdgcn_ds_read_tr16_b64_v4i16((LAS v4i16_t*)p)); }
__device__ __forceinline__ bf16x8 tr_frag(const LAS unsigned char* img, int pitch, int k0, int k1, int col0, int lane) {
    const int i16 = lane & 15, qd = i16 >> 2, p = i16 & 3, blk = (lane >> 4) & 1;
    const s16x4 lo = tr_rd(img + (k0 + qd) * pitch + (col0 + 16 * blk + 4 * p) * 2), hi = tr_rd(img + (k1 + qd) * pitch + (col0 + 16 * blk + 4 * p) * 2);
    return __builtin_shufflevector(lo, hi, 0, 1, 2, 3, 4, 5, 6, 7); }
__device__ __forceinline__ void st16_pair(bf16* row_k, u32x2 a, u32x2 b, int hh) {
    const auto r0 = __builtin_amdgcn_permlane32_swap(a.x, b.x, false, false); const auto r1 = __builtin_amdgcn_permlane32_swap(a.y, b.y, false, false);
    *(u32x4*)(row_k + 8 * hh) = (u32x4){r0[0], r1[0], r0[1], r1[1]};
}
constexpr int C1_ITEM_LDS = 3 * 64 * 144 + 2048;
__device__ __forceinline__ void mlstm_c1m(int l, int bi) {
    FRAME_SETUP; WS_PTRS; const float* ml_conv = inp(I_MLCONV); const float* ml_fbias = inp(I_MLFB);
    const int tid = F.tid, lane = F.lane, w = F.wave, dir = w & 1, jj = w >> 1, tp = tid & 127;
    const int item = bi * 4 + jj, c = item & 127, h = (item >> 7) & 3, b = item >> 9;
    const int p0 = b * SEQ + c * 64, hc = h * 64;
    LAS unsigned char* base = F.lds + jj * C1_ITEM_LDS;
    LAS unsigned char* Vt = base; LAS unsigned char* K0 = base + 64 * 144; LAS unsigned char* K1 = base + 2 * 64 * 144; LAS float* wT = (LAS float*)(base + 3 * 64 * 144);
    const int chain = ((dir * 2 + b) * 4 + h) * 128 + c; bf16* dc = DC + (size_t)chain * 4160;
    u32x4 cq[4][3], ck[4][3], cv[4]; bool rok[4][3];
    const int cg = (tp & 7) * 8, r0 = tp >> 3;
#pragma unroll
    for (int i = 0; i < 4; ++i) { const int row = r0 + 16 * i, sq = c * 64 + row;
#pragma unroll
        for (int dr = 0; dr < 3; ++dr) { rok[i][dr] = (sq + dr - 1 >= 0) && (sq + dr - 1 < SEQ); const int sc = min(max(sq + dr - 1, 0), SEQ - 1); const bf16* r2 = H + (size_t)(b * SEQ + sc) * NH;
            cq[i][dr] = *(const u32x4*)(r2 + HCQ + hc + cg); ck[i][dr] = *(const u32x4*)(r2 + HCK + hc + cg); }
        cv[i] = *(const u32x4*)(H + (size_t)(p0 + row) * NH + HCV + hc + cg); }
    f32x4 cwq[3][2], cwk[3][2];
    { const float* cw = ml_conv + (size_t)l * 3 * 512;
#pragma unroll
      for (int dr = 0; dr < 3; ++dr) { cwq[dr][0] = *(const f32x4*)(cw + dr * 512 + hc + cg); cwq[dr][1] = *(const f32x4*)(cw + dr * 512 + hc + cg + 4); cwk[dr][0] = *(const f32x4*)(cw + dr * 512 + 256 + hc + cg); cwk[dr][1] = *(const f32x4*)(cw + dr * 512 + 256 + hc + cg + 4); } }
    { const float* gi = GI + (size_t)(p0 + lane) * 16; const float li = gi[dir * 4 + h]; float cum = logsigmoidf_(gi[8 + dir * 4 + h] + ml_fbias[l * 8 + dir * 4 + h]);
#pragma unroll
        for (int off = 1; off < 64; off <<= 1) { const int src = dir ? lane + off : lane - off; const float v = __int_as_float(__builtin_amdgcn_ds_bpermute((src & 63) << 2, __float_as_int(cum))); if (src >= 0 && src < 64) cum += v; }
        const float g = __int_as_float(__builtin_amdgcn_ds_bpermute((dir ? 0 : 63) << 2, __float_as_int(cum)));
        wT[dir * 64 + lane] = __expf(g - cum + li); if (lane == 0) DG[chain] = g; }
    __syncthreads();
    {
#pragma unroll
        for (int i = 0; i < 4; ++i) { const int row = r0 + 16 * i; const float w0 = wT[row], w1 = wT[64 + row];
            float qv[8], kv[8];
#pragma unroll
            for (int j = 0; j < 8; ++j) { qv[j] = 0.f; kv[j] = 0.f; }
#pragma unroll
            for (int dr = 0; dr < 3; ++dr) { const float m = rok[i][dr] ? 1.f : 0.f; float q8[8], k8[8]; unpack8(cq[i][dr], q8); unpack8(ck[i][dr], k8);
#pragma unroll
                for (int j = 0; j < 8; ++j) { qv[j] += m * cwq[dr][j >> 2][j & 3] * q8[j]; kv[j] += m * cwk[dr][j >> 2][j & 3] * k8[j]; } }
#pragma unroll
            for (int j = 0; j < 8; ++j) { qv[j] = siluf_(qv[j]); kv[j] = siluf_(kv[j]) * 0.125f; }
            u32x4 wq, wk, wk0, wk1; wq.x = pk2(qv[0], qv[1]); wq.y = pk2(qv[2], qv[3]); wq.z = pk2(qv[4], qv[5]); wq.w = pk2(qv[6], qv[7]); wk.x = pk2(kv[0], kv[1]); wk.y = pk2(kv[2], kv[3]); wk.z = pk2(kv[4], kv[5]); wk.w = pk2(kv[6], kv[7]);
            wk0.x = pk2(kv[0] * w0, kv[1] * w0); wk0.y = pk2(kv[2] * w0, kv[3] * w0); wk0.z = pk2(kv[4] * w0, kv[5] * w0); wk0.w = pk2(kv[6] * w0, kv[7] * w0);
            wk1.x = pk2(kv[0] * w1, kv[1] * w1); wk1.y = pk2(kv[2] * w1, kv[3] * w1); wk1.z = pk2(kv[4] * w1, kv[5] * w1); wk1.w = pk2(kv[6] * w1, kv[7] * w1);
            *(u32x4*)(QC + (size_t)(p0 + row) * 256 + hc + cg) = wq; *(u32x4*)(KC + (size_t)(p0 + row) * 256 + hc + cg) = wk;
            *(LAS u32x4*)(K0 + row * 144 + cg * 2) = wk0; *(LAS u32x4*)(K1 + row * 144 + cg * 2) = wk1; *(LAS u32x4*)(Vt + row * 144 + cg * 2) = cv[i]; }
    }
    __syncthreads();
    {
        const int tl = lane & 31, hh = lane >> 5; const LAS unsigned char* Kimg = dir ? K1 : K0;
#pragma unroll
        for (int kt = 0; kt < 2; ++kt) { bf16x8 kf[4]; float dn = 0.f;
#pragma unroll
            for (int ks = 0; ks < 4; ++ks) { kf[ks] = tr_frag(Kimg, 144, 16 * ks + 8 * hh, 16 * ks + 8 * hh + 4, 32 * kt, lane); float k8[8]; unpack8(__builtin_bit_cast(u32x4, kf[ks]), k8);
#pragma unroll
                for (int j = 0; j < 8; ++j) dn += k8[j]; }
            dn += shx(dn, 32, lane); if (hh == 0) dc[4096 + 32 * kt + tl] = (bf16)f2bf(dn);
#pragma unroll
            for (int vt = 0; vt < 2; ++vt) { f32x16 acc;
#pragma unroll
                for (int i = 0; i < 16; ++i) acc[i] = F.zf;
#pragma unroll
                for (int ks = 0; ks < 4; ++ks) { const bf16x8 vf = tr_frag(Vt, 144, 16 * ks + 8 * hh, 16 * ks + 8 * hh + 4, 32 * vt, lane); acc = MFMA32(kf[ks], vf, acc); }
#pragma unroll
                for (int g4 = 0; g4 < 4; ++g4) { u32x2 wv; wv.x = pk2(acc[4 * g4], acc[4 * g4 + 1]); wv.y = pk2(acc[4 * g4 + 2], acc[4 * g4 + 3]); *(u32x2*)(dc + (32 * vt + tl) * 64 + 32 * kt + 8 * g4 + 4 * hh) = wv; } } }
    }
    __syncthreads();
}
constexpr int GM_PITCH = 576;
__device__ __forceinline__ void gmlp_m(int l, int item) {
    FRAME_SETUP; WS_PTRS; const float* gm_ln_g = inp(I_GMLNG); const float* gm_bs = inp(I_GMBS); const bf16* WSB = (const bf16*)(ws + WS_WSB);
    const int tid = F.tid, lane = F.lane, w = F.wave;
    const int b = item >> 6, ch = item & 63, p0 = b * SEQ + ch * 128;
    LAS unsigned char* vn = F.lds;
    u32x2 up[2][2][4]; float bsp[2];
    { const int g = w >> 1, ph = w & 1, tl = lane & 31, hh = lane >> 5;
#pragma unroll
      for (int pt = 0; pt < 2; ++pt) { const int p = 64 * ph + 32 * pt + tl; bsp[pt] = gm_bs[(size_t)(l * 4 + g) * 128 + p];
#pragma unroll
          for (int dt = 0; dt < 2; ++dt)
#pragma unroll
              for (int gg = 0; gg < 4; ++gg) up[pt][dt][gg] = *(const u32x2*)(H + ((size_t)p0 + p) * NH + HU + g * 64 + 32 * dt + 8 * gg + 4 * hh); } }
    {
        const int part = tid & 7; const float* lgp = gm_ln_g + l * 256;
        u32x4 raw[2][4];
#pragma unroll
        for (int rr = 0; rr < 2; ++rr)
#pragma unroll
            for (int q = 0; q < 4; ++q) raw[rr][q] = *(const u32x4*)(H + (size_t)(p0 + (tid >> 3) + 64 * rr) * NH + HV + (part + 8 * q) * 8);
#pragma unroll
        for (int rr = 0; rr < 2; ++rr) { const int row = (tid >> 3) + 64 * rr; float s = 0.f, s2 = 0.f;
#pragma unroll
            for (int q = 0; q < 4; ++q) { float v8[8]; unpack8(raw[rr][q], v8);
#pragma unroll
                for (int j = 0; j < 8; ++j) { s += v8[j]; s2 += v8[j] * v8[j]; } }
            s += shx(s, 1, lane); s += shx(s, 2, lane); s += shx(s, 4, lane); s2 += shx(s2, 1, lane); s2 += shx(s2, 2, lane); s2 += shx(s2, 4, lane);
            const float mean = s * (1.0f / 256.0f), var = fmaxf(s2 * (1.0f / 256.0f) - mean * mean, 0.f), rstd = 1.0f / sqrtf(var + LN_EPS);
#pragma unroll
            for (int q = 0; q < 4; ++q) { const int c0 = (part + 8 * q) * 8; float v8[8]; unpack8(raw[rr][q], v8); const f32x4 g0 = *(const f32x4*)(lgp + c0), g1 = *(const f32x4*)(lgp + c0 + 4);
                u32x4 o; o.x = pk2((v8[0] - mean) * rstd * g0[0], (v8[1] - mean) * rstd * g0[1]); o.y = pk2((v8[2] - mean) * rstd * g0[2], (v8[3] - mean) * rstd * g0[3]);
                o.z = pk2((v8[4] - mean) * rstd * g1[0], (v8[5] - mean) * rstd * g1[1]); o.w = pk2((v8[6] - mean) * rstd * g1[2], (v8[7] - mean) * rstd * g1[3]);
                *(LAS u32x4*)(vn + row * GM_PITCH + c0 * 2) = o; } }
    }
    __syncthreads();
    {
        const int g = w >> 1, ph = w & 1, tl = lane & 31, hh = lane >> 5;
#pragma unroll
        for (int pt = 0; pt < 2; ++pt) { const int p = 64 * ph + 32 * pt + tl; const size_t tok = (size_t)p0 + p;
            f32x16 M[2];
#pragma unroll
            for (int dt = 0; dt < 2; ++dt)
#pragma unroll
                for (int i = 0; i < 16; ++i) M[dt][i] = F.zf;
            const bf16* wrow = WSB + ((size_t)(l * 4 + g) * 128 + p) * 128 + 8 * hh;
            bf16x8 wfa[8];
#pragma unroll
            for (int ks = 0; ks < 8; ++ks) wfa[ks] = *(const bf16x8*)(wrow + 16 * ks);
#pragma unroll
            for (int ks = 0; ks < 8; ++ks) { const bf16x8 wf = wfa[ks];
#pragma unroll
                for (int dt = 0; dt < 2; ++dt) { const bf16x8 vf = tr_frag(vn, GM_PITCH, 16 * ks + 8 * hh, 16 * ks + 8 * hh + 4, g * 64 + 32 * dt, lane); M[dt] = MFMA32(vf, wf, M[dt]); } }
            const float bsv = bsp[pt];
#pragma unroll
            for (int dt = 0; dt < 2; ++dt)
#pragma unroll
                for (int g2 = 0; g2 < 4; g2 += 2) { u32x2 o2[2];
#pragma unroll
                    for (int e2 = 0; e2 < 2; ++e2) { const int gg = g2 + e2; const u32x2 uw = up[pt][dt][gg];
                        const float u0 = __uint_as_float(uw.x << 16), u1 = __uint_as_float(uw.x & 0xffff0000u), u2 = __uint_as_float(uw.y << 16), u3 = __uint_as_float(uw.y & 0xffff0000u);
                        o2[e2].x = pk2(u0 * (M[dt][4 * gg] + bsv), u1 * (M[dt][4 * gg + 1] + bsv)); o2[e2].y = pk2(u2 * (M[dt][4 * gg + 2] + bsv), u3 * (M[dt][4 * gg + 3] + bsv)); }
                    st16_pair(YS + tok * D + g * 64 + 32 * dt + 8 * g2, o2[0], o2[1], hh); } }
    }
    __syncthreads();
}
__device__ __forceinline__ void mlstm_scan(int wi) {
    FRAME_SETUP;
    WS_PTRS;
    const int lane = F.lane, chain = wi / 17, quad = (wi % 17) * 64 + lane, dir = chain >> 3, base = chain * 128;
    const bool on = quad < 1040;
    const int e = on ? 4 * quad : 0;
    const float d0 = __expf(DG[base + (dir ? 127 - lane : lane)]), d1 = __expf(DG[base + (dir ? 63 - lane : 64 + lane)]);
    f32x4 S = {0.f, 0.f, 0.f, 0.f};
#pragma unroll 1
    for (int i0 = 0; i0 < 128; i0 += 32) {
        u32x2 tmp[32];
#pragma unroll
        for (int j = 0; j < 32; ++j) { const int c = dir ? 127 - (i0 + j) : (i0 + j); tmp[j] = *(const u32x2*)(DC + (size_t)(base + c) * 4160 + e); }
#pragma unroll
        for (int j = 0; j < 32; ++j) { const int c = dir ? 127 - (i0 + j) : (i0 + j);
            const float dec = (i0 < 64) ? __int_as_float(__builtin_amdgcn_readlane(__float_as_int(d0), (i0 & 63) + j)) : __int_as_float(__builtin_amdgcn_readlane(__float_as_int(d1), (i0 & 63) + j));
            if (on) { u32x2 wv; wv.x = pk2(S[0], S[1]); wv.y = pk2(S[2], S[3]); *(u32x2*)(DC + (size_t)(base + c) * 4160 + e) = wv; }
            const f32x4 t = (f32x4){__uint_as_float(tmp[j].x << 16), __uint_as_float(tmp[j].x & 0xffff0000u), __uint_as_float(tmp[j].y << 16), __uint_as_float(tmp[j].y & 0xffff0000u)};
            S = S * dec + t; }
    }
}
constexpr int C3_ITEM_LDS = 20480, C3_PITCH = 144;
__device__ __forceinline__ void mlstm_c3m(int l, int bi) {
    FRAME_SETUP; WS_PTRS; const float* ml_fbias = inp(I_MLFB); const float* ml_norm_g = inp(I_MLNG);
    const int tid = F.tid, lane = F.lane, w = F.wave, dir = w & 1, jj = w >> 1, tp = tid & 127;
    const int item = bi * 4 + jj, c = item & 127, h = (item >> 7) & 3, b = item >> 9;
    const int p0 = b * SEQ + c * 64, hc = h * 64;
    LAS unsigned char* base = F.lds + jj * C3_ITEM_LDS;
    LAS unsigned char* Kt = base; LAS unsigned char* Vt = base + 64 * C3_PITCH;
    LAS float* tab = (LAS float*)(base + 2 * 64 * C3_PITCH);
    LAS float* cumT = tab + dir * 64; LAS float* liT = tab + 128 + dir * 64; LAS float* nsT = tab + 256 + dir * 64;
    LAS float* hbuf = (LAS float*)base;
    const int chain = ((dir * 2 + b) * 4 + h) * 128 + c; const bf16* dc = DC + (size_t)chain * 4160;
    { u32x4 k8[4], v8[4];
#pragma unroll
        for (int u = 0; u < 4; ++u) { const int i = tp + 128 * u, row = i >> 3, cg = (i & 7) * 8; k8[u] = *(const u32x4*)(KC + (size_t)(p0 + row) * 256 + hc + cg); v8[u] = *(const u32x4*)(H + (size_t)(p0 + row) * NH + HCV + hc + cg); }
#pragma unroll
        for (int u = 0; u < 4; ++u) { const int i = tp + 128 * u, row = i >> 3, cg = (i & 7) * 8; *(LAS u32x4*)(Kt + row * C3_PITCH + cg * 2) = k8[u]; *(LAS u32x4*)(Vt + row * C3_PITCH + cg * 2) = v8[u]; } }
    { const float* gi = GI + (size_t)(p0 + lane) * 16; const float li = gi[dir * 4 + h]; float cum = logsigmoidf_(gi[8 + dir * 4 + h] + ml_fbias[l * 8 + dir * 4 + h]);
#pragma unroll
        for (int off = 1; off < 64; off <<= 1) { const int src = dir ? lane + off : lane - off; const float v = __int_as_float(__builtin_amdgcn_ds_bpermute((src & 63) << 2, __float_as_int(cum))); if (src >= 0 && src < 64) cum += v; }
        cumT[lane] = cum; liT[lane] = li - cum; nsT[lane] = bf2f(dc[4096 + lane]); }
    __syncthreads();
    const int tl = lane & 31, hh = lane >> 5;
    f32x16 Hh[2][2];
#pragma unroll
    for (int tt = 0; tt < 2; ++tt) {
        const int t = 32 * tt + tl; const size_t tok = (size_t)p0 + t;
        const float ct = cumT[t], ewt = __expf(ct);
        bf16x8 qf[4], qf2[4]; float nqp = 0.f;
#pragma unroll
        for (int ks = 0; ks < 4; ++ks) { const u32x4 raw = *(const u32x4*)(QC + tok * 256 + hc + 16 * ks + 8 * hh); qf[ks] = __builtin_bit_cast(bf16x8, raw);
            float q8[8]; unpack8(raw, q8);
#pragma unroll
            for (int j = 0; j < 8; ++j) { q8[j] *= ewt; nqp += nsT[16 * ks + 8 * hh + j] * q8[j]; }
            qf2[ks] = pack8(q8[0], q8[1], q8[2], q8[3], q8[4], q8[5], q8[6], q8[7]); }
        f32x16 S[2]; float denp = 0.f;
#pragma unroll
        for (int st = 0; st < 2; ++st) {
#pragma unroll
            for (int i = 0; i < 16; ++i) S[st][i] = F.zf;
#pragma unroll
            for (int ks = 0; ks < 4; ++ks) { const bf16x8 kf = *(const LAS bf16x8*)(Kt + (32 * st + tl) * C3_PITCH + (16 * ks + 8 * hh) * 2); S[st] = MFMA32(kf, qf[ks], S[st]); }
#pragma unroll
            for (int i = 0; i < 16; ++i) { const int sidx = 32 * st + crow(i, hh); const bool valid = dir ? (sidx >= t) : (sidx <= t);
                const float arg = ct + liT[sidx]; const float wgt = __expf(valid ? arg : -1e30f); const float pv = S[st][i] * wgt; S[st][i] = pv; denp += pv; }
            __builtin_amdgcn_sched_barrier(0); }
        const float dn = (denp + shx(denp, 32, lane)) + (nqp + shx(nqp, 32, lane));
        const float inv = 1.0f / fmaxf(fabsf(dn), 1.0f);
#pragma unroll
        for (int vt = 0; vt < 2; ++vt) { f32x16 N;
#pragma unroll
            for (int i = 0; i < 16; ++i) N[i] = F.zf;
#pragma unroll
            for (int st = 0; st < 2; ++st)
#pragma unroll
                for (int s2 = 0; s2 < 2; ++s2) { const bf16x8 pf = pack8(S[st][8 * s2], S[st][8 * s2 + 1], S[st][8 * s2 + 2], S[st][8 * s2 + 3], S[st][8 * s2 + 4], S[st][8 * s2 + 5], S[st][8 * s2 + 6], S[st][8 * s2 + 7]);
                    const int k0 = 32 * st + 16 * s2 + 4 * hh; const bf16x8 vf = tr_frag(Vt, C3_PITCH, k0, k0 + 8, 32 * vt, lane); N = MFMA32(vf, pf, N); }
#pragma unroll
            for (int ks = 0; ks < 4; ++ks) { const bf16x8 cf = *(const bf16x8*)(dc + (32 * vt + tl) * 64 + 16 * ks + 8 * hh); N = MFMA32(cf, qf2[ks], N); }
#pragma unroll
            for (int i = 0; i < 16; ++i) Hh[tt][vt][i] = N[i] * inv; }
    }
    __syncthreads();
    if (dir == 1) {
#pragma unroll
        for (int tt = 0; tt < 2; ++tt)
#pragma unroll
            for (int vt = 0; vt < 2; ++vt)
#pragma unroll
                for (int i = 0; i < 16; ++i) hbuf[(32 * tt + tl) * 65 + 32 * vt + crow(i, hh)] = Hh[tt][vt][i]; }
    __syncthreads();
    if (dir == 0) {
#pragma unroll
        for (int tt = 0; tt < 2; ++tt) { const int t = 32 * tt + tl; const size_t tok = (size_t)p0 + t; float s1 = 0.f;
#pragma unroll
            for (int vt = 0; vt < 2; ++vt)
#pragma unroll
                for (int i = 0; i < 16; ++i) { const float x = Hh[tt][vt][i] + hbuf[t * 65 + 32 * vt + crow(i, hh)]; Hh[tt][vt][i] = x; s1 += x; }
            const float mu = (s1 + shx(s1, 32, lane)) * (1.0f / 64.0f); float s2 = 0.f;
#pragma unroll
            for (int vt = 0; vt < 2; ++vt)
#pragma unroll
                for (int i = 0; i < 16; ++i) { const float dv = Hh[tt][vt][i] - mu; s2 += dv * dv; }
            const float rstd = 1.0f / sqrtf((s2 + shx(s2, 32, lane)) * (1.0f / 64.0f) + LN_EPS);
#pragma unroll
            for (int vt = 0; vt < 2; ++vt)
#pragma unroll
                for (int g = 0; g < 4; ++g) { const int v = 32 * vt + 8 * g + 4 * hh;
                    const u32x2 cw = *(const u32x2*)(H + tok * NH + HCO + hc + v); const f32x4 ng = *(const f32x4*)(ml_norm_g + l * 256 + hc + v);
                    const float o0 = __uint_as_float(cw.x << 16), o1 = __uint_as_float(cw.x & 0xffff0000u), o2 = __uint_as_float(cw.y << 16), o3 = __uint_as_float(cw.y & 0xffff0000u);
                    u32x2 wv; wv.x = pk2((Hh[tt][vt][4 * g] - mu) * rstd * ng[0] * sigmoidf_(o0), (Hh[tt][vt][4 * g + 1] - mu) * rstd * ng[1] * sigmoidf_(o1));
                    wv.y = pk2((Hh[tt][vt][4 * g + 2] - mu) * rstd * ng[2] * sigmoidf_(o2), (Hh[tt][vt][4 * g + 3] - mu) * rstd * ng[3] * sigmoidf_(o3));
                    *(u32x2*)(YS + tok * D + 512 + hc + v) = wv; } }
    }
    __syncthreads();
}
constexpr int MF_ITEM = 29696, MF_V = 0, MF_K = 9216, MF_Q = 18432, MF_WT = 27648, MF_TAB = 28160;
constexpr int MF_CPITCH = 68, MF_CIN = 4 * MF_ITEM, MF_CIN_DIR = (64 * MF_CPITCH + 64) * 4, MF_GT = MF_CIN + 2 * MF_CIN_DIR, MF_BYTES = MF_GT + 64;
static_assert(MF_BYTES <= MIX_BYTES, "LDS work area too small");
__device__ __forceinline__ void mlstm_full(int l, int bi) {
    FRAME_SETUP; WS_PTRS; const float* ml_conv = inp(I_MLCONV); const float* ml_fbias = inp(I_MLFB); const float* ml_norm_g = inp(I_MLNG);
    bf16* AG = (bf16*)(ws + WS_AG); float* BGL = (float*)(ws + WS_BGL);
    const int tid = F.tid, lane = F.lane, w = F.wave, dir = w & 1, jj = w >> 1, tp = tid & 127;
    const int item = bi * 4 + jj, c = item & 127, h = (item >> 7) & 3, b = item >> 9, cb = bi & 31, c0 = 4 * cb;
    const int p0 = b * SEQ + c * 64, hc = h * 64;
    LAS unsigned char* base = F.lds + jj * MF_ITEM;
    LAS unsigned char* Vt = base + MF_V; LAS unsigned char* Kq = base + MF_K; LAS unsigned char* Qi = base + MF_Q; LAS float* wT = (LAS float*)(base + MF_WT); LAS float* tab = (LAS float*)(base + MF_TAB);
    LAS float* cumT = tab + dir * 64; LAS float* liT = tab + 128 + dir * 64; LAS float* nsT = tab + 256 + dir * 64;
    LAS float* gt = (LAS float*)(F.lds + MF_GT);
    {
        u32x4 cq[4][3], ck[4][3], cv[4]; bool rok[4][3];
        const int cg = (tp & 7) * 8, r0 = tp >> 3;
#pragma unroll
        for (int i = 0; i < 4; ++i) { const int row = r0 + 16 * i, sq = c * 64 + row;
#pragma unroll
            for (int dr = 0; dr < 3; ++dr) { rok[i][dr] = (sq + dr - 1 >= 0) && (sq + dr - 1 < SEQ); const int sc = min(max(sq + dr - 1, 0), SEQ - 1); const bf16* r2 = H + (size_t)(b * SEQ + sc) * NH;
                cq[i][dr] = *(const u32x4*)(r2 + HCQ + hc + cg); ck[i][dr] = *(const u32x4*)(r2 + HCK + hc + cg); }
            cv[i] = *(const u32x4*)(H + (size_t)(p0 + row) * NH + HCV + hc + cg); }
        f32x4 cwq[3][2], cwk[3][2];
        { const float* cw = ml_conv + (size_t)l * 3 * 512;
#pragma unroll
          for (int dr = 0; dr < 3; ++dr) { cwq[dr][0] = *(const f32x4*)(cw + dr * 512 + hc + cg); cwq[dr][1] = *(const f32x4*)(cw + dr * 512 + hc + cg + 4); cwk[dr][0] = *(const f32x4*)(cw + dr * 512 + 256 + hc + cg); cwk[dr][1] = *(const f32x4*)(cw + dr * 512 + 256 + hc + cg + 4); } }
        { const float* gi = GI + (size_t)(p0 + lane) * 16; const float li = gi[dir * 4 + h]; float cum = logsigmoidf_(gi[8 + dir * 4 + h] + ml_fbias[l * 8 + dir * 4 + h]);
#pragma unroll
            for (int off = 1; off < 64; off <<= 1) { const int src = dir ? lane + off : lane - off; const float v = __int_as_float(__builtin_amdgcn_ds_bpermute((src & 63) << 2, __float_as_int(cum))); if (src >= 0 && src < 64) cum += v; }
            const float g = __int_as_float(__builtin_amdgcn_ds_bpermute((dir ? 0 : 63) << 2, __float_as_int(cum)));
            wT[dir * 64 + lane] = __expf(g - cum + li); cumT[lane] = cum; liT[lane] = li - cum; if (lane == 0) gt[jj * 2 + dir] = g; }
#pragma unroll
        for (int i = 0; i < 4; ++i) { const int row = r0 + 16 * i;
            float qv[8], kv[8];
#pragma unroll
            for (int j = 0; j < 8; ++j) { qv[j] = 0.f; kv[j] = 0.f; }
#pragma unroll
            for (int dr = 0; dr < 3; ++dr) { const float m = rok[i][dr] ? 1.f : 0.f; float q8[8], k8[8]; unpack8(cq[i][dr], q8); unpack8(ck[i][dr], k8);
#pragma unroll
                for (int j = 0; j < 8; ++j) { qv[j] += m * cwq[dr][j >> 2][j & 3] * q8[j]; kv[j] += m * cwk[dr][j >> 2][j & 3] * k8[j]; } }
#pragma unroll
            for (int j = 0; j < 8; ++j) { qv[j] = siluf_(qv[j]); kv[j] = siluf_(kv[j]) * 0.125f; }
            u32x4 wq, wk; wq.x = pk2(qv[0], qv[1]); wq.y = pk2(qv[2], qv[3]); wq.z = pk2(qv[4], qv[5]); wq.w = pk2(qv[6], qv[7]); wk.x = pk2(kv[0], kv[1]); wk.y = pk2(kv[2], kv[3]); wk.z = pk2(kv[4], kv[5]); wk.w = pk2(kv[6], kv[7]);
            *(LAS u32x4*)(Qi + row * 144 + cg * 2) = wq; *(LAS u32x4*)(Kq + row * 144 + cg * 2) = wk; *(LAS u32x4*)(Vt + row * 144 + cg * 2) = cv[i]; }
    }
    __syncthreads();
    const int tl = lane & 31, hh = lane >> 5;
    {
        const int dB = w & 1, kt = w >> 2, vt = (w >> 1) & 1;
        const int chainB = ((dB * 2 + b) * 4 + h) * 128;
        f32x16 acc;
#pragma unroll
        for (int i = 0; i < 16; ++i) acc[i] = F.zf;
        float nacc = F.zf, gsum = 0.f;
#pragma unroll 1
        for (int m = 0; m < 4; ++m) { const int j2 = dB ? 3 - m : m;
            bf16* dcm = DC + (size_t)(chainB + c0 + j2) * 4160;
#pragma unroll
            for (int g4 = 0; g4 < 4; ++g4) { u32x2 wv; wv.x = pk2(acc[4 * g4], acc[4 * g4 + 1]); wv.y = pk2(acc[4 * g4 + 2], acc[4 * g4 + 3]); *(u32x2*)(dcm + (32 * vt + tl) * 64 + 32 * kt + 8 * g4 + 4 * hh) = wv; }
            if (vt == 0 && hh == 0) dcm[4096 + 32 * kt + tl] = (bf16)f2bf(nacc);
            const float gj = gt[j2 * 2 + dB], d = __expf(gj); gsum += gj;
#pragma unroll
            for (int i = 0; i < 16; ++i) acc[i] *= d;
            nacc *= d;
            const LAS unsigned char* bj = F.lds + j2 * MF_ITEM; const LAS float* wj = (const LAS float*)(bj + MF_WT) + dB * 64;
            float dn = 0.f;
#pragma unroll
            for (int ks = 0; ks < 4; ++ks) { const bf16x8 kf = tr_frag(bj + MF_K, 144, 16 * ks + 8 * hh, 16 * ks + 8 * hh + 4, 32 * kt, lane); float k8[8]; unpack8(__builtin_bit_cast(u32x4, kf), k8);
                const f32x4 wa = *(const LAS f32x4*)(wj + 16 * ks + 8 * hh), wb = *(const LAS f32x4*)(wj + 16 * ks + 8 * hh + 4);
#pragma unroll
                for (int j = 0; j < 4; ++j) { k8[j] *= wa[j]; k8[4 + j] *= wb[j]; }
#pragma unroll
                for (int j = 0; j < 8; ++j) dn += k8[j];
                const bf16x8 kfw = pack8(k8[0], k8[1], k8[2], k8[3], k8[4], k8[5], k8[6], k8[7]);
                const bf16x8 vf = tr_frag(bj + MF_V, 144, 16 * ks + 8 * hh, 16 * ks + 8 * hh + 4, 32 * vt, lane); acc = MFMA32(kfw, vf, acc); }
            dn += shx(dn, 32, lane); nacc += dn; }
        bf16* ag = AG + (size_t)(((dB * 2 + b) * 4 + h) * 32 + cb) * 4160;
#pragma unroll
        for (int g4 = 0; g4 < 4; ++g4) { unsigned long long* ap = (unsigned long long*)(ag + (32 * vt + tl) * 64 + 32 * kt + 8 * g4 + 4 * hh);
            __hip_atomic_store(ap, (unsigned long long)pk2(acc[4 * g4], acc[4 * g4 + 1]) | ((unsigned long long)pk2(acc[4 * g4 + 2], acc[4 * g4 + 3]) << 32), __ATOMIC_RELAXED, __HIP_MEMORY_SCOPE_AGENT); }
        { const float nn = shx(nacc, 1, lane); if (vt == 0 && hh == 0 && (tl & 1) == 0) __hip_atomic_store((unsigned*)(ag + 4096 + 32 * kt + tl), pk2(nacc, nn), __ATOMIC_RELAXED, __HIP_MEMORY_SCOPE_AGENT); }
        if ((w >> 1) == 0 && lane == 0) __hip_atomic_store(BGL + ((dB * 2 + b) * 4 + h) * 32 + cb, gsum, __ATOMIC_RELAXED, __HIP_MEMORY_SCOPE_AGENT);
    }
    asm volatile("s_waitcnt vmcnt(0)" ::: "memory");
    __syncthreads();
    if (tid == 0) { unsigned* ctl = (unsigned*)(ws + WS_CTL); unsigned* cnt = ctl + CW_ML + 64 * (l * 8 + b * 4 + h); (void)xb_add(cnt, 1u);
        XB_SPIN(xb_ld(cnt) < 32u, ctl + CW_BAR); __builtin_amdgcn_fence(__ATOMIC_ACQUIRE, "agent"); asm volatile("s_waitcnt vmcnt(0)" ::: "memory"); }
    __syncthreads();
    { const int Jf = cb, Jb = 31 - cb, Jmax = Jf > Jb ? Jf : Jb; const size_t cbf = (size_t)((0 * 2 + b) * 4 + h) * 32, cbb = (size_t)((1 * 2 + b) * 4 + h) * 32;
      LAS float* cinf = (LAS float*)(F.lds + MF_CIN); LAS float* cinb = (LAS float*)(F.lds + MF_CIN + MF_CIN_DIR);
      for (int ch = tid; ch < 520; ch += NTHREADS) {
        float Cf[8], Cb[8];
#pragma unroll
        for (int j = 0; j < 8; ++j) { Cf[j] = 0.f; Cb[j] = 0.f; }
#pragma unroll 1
        for (int j0 = 0; j0 < Jmax; j0 += 8) { u32x4 af[8], ab[8]; float pf[8], pb[8];
#pragma unroll
            for (int q = 0; q < 8; ++q) { const int jf = max(min(j0 + q, Jf - 1), 0), jb = 31 - max(min(j0 + q, Jb - 1), 0);
                af[q] = *(const u32x4*)(AG + (cbf + jf) * 4160 + 8 * ch); pf[q] = BGL[cbf + jf]; ab[q] = *(const u32x4*)(AG + (cbb + jb) * 4160 + 8 * ch); pb[q] = BGL[cbb + jb]; }
#pragma unroll
            for (int q = 0; q < 8; ++q) {
                if (j0 + q < Jf) { const float e = __expf(pf[q]); float a8[8]; unpack8(af[q], a8);
#pragma unroll
                    for (int j = 0; j < 8; ++j) Cf[j] = Cf[j] * e + a8[j]; }
                if (j0 + q < Jb) { const float e = __expf(pb[q]); float a8[8]; unpack8(ab[q], a8);
#pragma unroll
                    for (int j = 0; j < 8; ++j) Cb[j] = Cb[j] * e + a8[j]; } } }
        const int off = ch < 512 ? (ch >> 3) * MF_CPITCH + 8 * (ch & 7) : 64 * MF_CPITCH + 8 * (ch - 512);
        *(LAS f32x4*)(cinf + off) = (f32x4){Cf[0], Cf[1], Cf[2], Cf[3]}; *(LAS f32x4*)(cinf + off + 4) = (f32x4){Cf[4], Cf[5], Cf[6], Cf[7]};
        *(LAS f32x4*)(cinb + off) = (f32x4){Cb[0], Cb[1], Cb[2], Cb[3]}; *(LAS f32x4*)(cinb + off + 4) = (f32x4){Cb[4], Cb[5], Cb[6], Cb[7]}; } }
    __syncthreads();
    const int chain = ((dir * 2 + b) * 4 + h) * 128 + c; const bf16* dc = DC + (size_t)chain * 4160;
    const LAS float* cin = (const LAS float*)(F.lds + MF_CIN + dir * MF_CIN_DIR);
    float P;
    { float plog = 0.f;
#pragma unroll
      for (int x = 0; x < 4; ++x) { const bool pre = dir ? (x > jj) : (x < jj); plog += pre ? gt[x * 2 + dir] : 0.f; }
      P = __expf(plog); }
    nsT[lane] = P * cin[64 * MF_CPITCH + lane] + bf2f(dc[4096 + lane]);
    LAS float* hbuf = (LAS float*)base;
    bf16x8 cfr[2][4];
#pragma unroll
    for (int vt = 0; vt < 2; ++vt)
#pragma unroll
        for (int ks = 0; ks < 4; ++ks) { float l8[8]; unpack8(*(const u32x4*)(dc + (32 * vt + tl) * 64 + 16 * ks + 8 * hh), l8);
            const LAS float* cr = cin + (32 * vt + tl) * MF_CPITCH + 16 * ks + 8 * hh; const f32x4 ca = *(const LAS f32x4*)cr, cc = *(const LAS f32x4*)(cr + 4);
            cfr[vt][ks] = pack8(P * ca[0] + l8[0], P * ca[1] + l8[1], P * ca[2] + l8[2], P * ca[3] + l8[3], P * cc[0] + l8[4], P * cc[1] + l8[5], P * cc[2] + l8[6], P * cc[3] + l8[7]); }
    f32x16 Hh[2][2];
#pragma unroll
    for (int tt = 0; tt < 2; ++tt) {
        const int t = 32 * tt + tl;
        const float ct = cumT[t], ewt = __expf(ct);
        bf16x8 qf[4], qf2[4]; float nqp = 0.f;
#pragma unroll
        for (int ks = 0; ks < 4; ++ks) { const u32x4 raw = *(const LAS u32x4*)(Qi + t * 144 + (16 * ks + 8 * hh) * 2); qf[ks] = __builtin_bit_cast(bf16x8, raw);
            float q8[8]; unpack8(raw, q8);
#pragma unroll
            for (int j = 0; j < 8; ++j) { q8[j] *= ewt; nqp += nsT[16 * ks + 8 * hh + j] * q8[j]; }
            qf2[ks] = pack8(q8[0], q8[1], q8[2], q8[3], q8[4], q8[5], q8[6], q8[7]); }
        f32x16 S[2]; float denp = 0.f;
#pragma unroll
        for (int st = 0; st < 2; ++st) {
#pragma unroll
            for (int i = 0; i < 16; ++i) S[st][i] = F.zf;
#pragma unroll
            for (int ks = 0; ks < 4; ++ks) { const bf16x8 kf = *(const LAS bf16x8*)(Kq + (32 * st + tl) * 144 + (16 * ks + 8 * hh) * 2); S[st] = MFMA32(kf, qf[ks], S[st]); }
#pragma unroll
            for (int i = 0; i < 16; ++i) { const int sidx = 32 * st + crow(i, hh); const bool valid = dir ? (sidx >= t) : (sidx <= t);
                const float arg = ct + liT[sidx]; const float wgt = __expf(valid ? arg : -1e30f); const float pv = S[st][i] * wgt; S[st][i] = pv; denp += pv; }
            __builtin_amdgcn_sched_barrier(0); }
        const float dn = (denp + shx(denp, 32, lane)) + (nqp + shx(nqp, 32, lane));
        const float inv = 1.0f / fmaxf(fabsf(dn), 1.0f);
#pragma unroll
        for (int vt = 0; vt < 2; ++vt) { f32x16 N;
#pragma unroll
            for (int i = 0; i < 16; ++i) N[i] = F.zf;
#pragma unroll
            for (int st = 0; st < 2; ++st)
#pragma unroll
                for (int s2 = 0; s2 < 2; ++s2) { const bf16x8 pf = pack8(S[st][8 * s2], S[st][8 * s2 + 1], S[st][8 * s2 + 2], S[st][8 * s2 + 3], S[st][8 * s2 + 4], S[st][8 * s2 + 5], S[st][8 * s2 + 6], S[st][8 * s2 + 7]);
                    const int k0 = 32 * st + 16 * s2 + 4 * hh; const bf16x8 vf = tr_frag(Vt, 144, k0, k0 + 8, 32 * vt, lane); N = MFMA32(vf, pf, N); }
#pragma unroll
            for (int ks = 0; ks < 4; ++ks) N = MFMA32(cfr[vt][ks], qf2[ks], N);
#pragma unroll
            for (int i = 0; i < 16; ++i) Hh[tt][vt][i] = N[i] * inv; }
    }
    __syncthreads();
    if (dir == 1) {
#pragma unroll
        for (int tt = 0; tt < 2; ++tt)
#pragma unroll
            for (int vt = 0; vt < 2; ++vt)
#pragma unroll
                for (int i = 0; i < 16; ++i) hbuf[(32 * tt + tl) * 65 + 32 * vt + crow(i, hh)] = Hh[tt][vt][i]; }
    __syncthreads();
    if (dir == 0) {
#pragma unroll
        for (int tt = 0; tt < 2; ++tt) { const int t = 32 * tt + tl; const size_t tok = (size_t)p0 + t; float s1 = 0.f;
#pragma unroll
            for (int vt = 0; vt < 2; ++vt)
#pragma unroll
                for (int i = 0; i < 16; ++i) { const float x = Hh[tt][vt][i] + hbuf[t * 65 + 32 * vt + crow(i, hh)]; Hh[tt][vt][i] = x; s1 += x; }
            const float mu = (s1 + shx(s1, 32, lane)) * (1.0f / 64.0f); float s2 = 0.f;
#pragma unroll
            for (int vt = 0; vt < 2; ++vt)
#pragma unroll
                for (int i = 0; i < 16; ++i) { const float dv = Hh[tt][vt][i] - mu; s2 += dv * dv; }
            const float rstd = 1.0f / sqrtf((s2 + shx(s2, 32, lane)) * (1.0f / 64.0f) + LN_EPS);
#pragma unroll
            for (int vt = 0; vt < 2; ++vt)
#pragma unroll
                for (int g2 = 0; g2 < 4; g2 += 2) { u32x2 w2[2];
#pragma unroll
                    for (int e2 = 0; e2 < 2; ++e2) { const int g = g2 + e2, v = 32 * vt + 8 * g + 4 * hh;
                        const u32x2 cw = *(const u32x2*)(H + tok * NH + HCO + hc + v); const f32x4 ng = *(const f32x4*)(ml_norm_g + l * 256 + hc + v);
                        const float o0 = __uint_as_float(cw.x << 16), o1 = __uint_as_float(cw.x & 0xffff0000u), o2 = __uint_as_float(cw.y << 16), o3 = __uint_as_float(cw.y & 0xffff0000u);
                        w2[e2].x = pk2((Hh[tt][vt][4 * g] - mu) * rstd * ng[0] * sigmoidf_(o0), (Hh[tt][vt][4 * g + 1] - mu) * rstd * ng[1] * sigmoidf_(o1));
                        w2[e2].y = pk2((Hh[tt][vt][4 * g + 2] - mu) * rstd * ng[2] * sigmoidf_(o2), (Hh[tt][vt][4 * g + 3] - mu) * rstd * ng[3] * sigmoidf_(o3)); }
                    st16_pair(YS + tok * D + 512 + hc + 32 * vt + 8 * g2, w2[0], w2[1], hh); } }
    }
    __syncthreads();
}
template <int G_> __device__ __forceinline__ void pool_w(int l, int witem) {
    FRAME_SETUP; WS_PTRS; const float* pool_scale = inp(I_POOLS); const bf16* PWT = (const bf16*)(ws + WS_PWT);
    const int lane = F.lane, tl = lane & 31, hh = lane >> 5;
    constexpr int g = G_, half = 1 << g, W = 2 * half; const int tb = witem >> 2, tok0 = tb * 32, b = tok0 >> 13, s0 = tok0 & (SEQ - 1), s = s0 + tl;
    const int lo = max(s - half, 0), hi = min(s + half, SEQ); const float inv = 1.0f / (float)(hi - lo);
    const bf16* hb = H + (size_t)b * SEQ * NH + HDX + g * 64 + 8 * hh;
    const size_t tok = (size_t)tok0 + tl;
    LAS unsigned char* strip = F.lds + F.wave * 6144 + hh * 768;
    const int r1 = s0 - half + tl, r2 = r1 + 32; const bool ok1 = r1 >= 0 && r1 < SEQ, ok2 = (tl < W - 1) && r2 < SEQ;
    u32x4 ra[4], rb[4]; bf16x8 wfr[4][2];
#pragma unroll
    for (int ks = 0; ks < 4; ++ks) { ra[ks] = *(const u32x4*)(hb + (size_t)min(max(r1, 0), SEQ - 1) * NH + 16 * ks); rb[ks] = *(const u32x4*)(hb + (size_t)min(r2, SEQ - 1) * NH + 16 * ks);
#pragma unroll
        for (int ot = 0; ot < 2; ++ot) wfr[ks][ot] = *(const bf16x8*)(PWT + ((size_t)(l * 4 + g) * 64 + 32 * ot + tl) * 64 + 16 * ks + 8 * hh); }
    const u32x4 z4 = (u32x4){F.zu, F.zu, F.zu, F.zu};
#pragma unroll
    for (int ks = 0; ks < 4; ++ks) { *(LAS u32x4*)(strip + ks * 1536 + tl * 16) = ok1 ? ra[ks] : z4; if (tl < W - 1) *(LAS u32x4*)(strip + ks * 1536 + (32 + tl) * 16) = ok2 ? rb[ks] : z4; }
    LDS_WAIT(); asm volatile("" ::: "memory");
    f32x16 acc[2];
#pragma unroll
    for (int ot = 0; ot < 2; ++ot)
#pragma unroll
        for (int i = 0; i < 16; ++i) acc[ot][i] = F.zf;
#pragma unroll
    for (int ks = 0; ks < 4; ++ks) { float a8[8];
#pragma unroll
        for (int q = 0; q < 8; ++q) a8[q] = 0.f;
#pragma unroll
        for (int j = 0; j < W; ++j) { float v8[8]; unpack8(*(const LAS u32x4*)(strip + ks * 1536 + (tl + j) * 16), v8);
#pragma unroll
            for (int q = 0; q < 8; ++q) a8[q] += v8[q]; }
        float x8[8]; unpack8(*(const LAS u32x4*)(strip + ks * 1536 + (tl + half) * 16), x8);
        const bf16x8 pf = pack8(a8[0] * inv - x8[0], a8[1] * inv - x8[1], a8[2] * inv - x8[2], a8[3] * inv - x8[3], a8[4] * inv - x8[4], a8[5] * inv - x8[5], a8[6] * inv - x8[6], a8[7] * inv - x8[7]);
#pragma unroll
        for (int ot = 0; ot < 2; ++ot) acc[ot] = MFMA32(wfr[ks][ot], pf, acc[ot]); }
#pragma unroll
    for (int ot = 0; ot < 2; ++ot)
#pragma unroll
        for (int g2 = 0; g2 < 4; g2 += 2) { u32x2 w2[2];
#pragma unroll
            for (int e2 = 0; e2 < 2; ++e2) { const int gg = g2 + e2, o = g * 64 + 32 * ot + 8 * gg + 4 * hh; const f32x4 sc = *(const f32x4*)(pool_scale + l * 256 + o);
                w2[e2].x = pk2(acc[ot][4 * gg] * sc[0], acc[ot][4 * gg + 1] * sc[1]); w2[e2].y = pk2(acc[ot][4 * gg + 2] * sc[2], acc[ot][4 * gg + 3] * sc[3]); }
            st16_pair(YS + tok * D + 768 + g * 64 + 32 * ot + 8 * g2, w2[0], w2[1], hh); }
}
__device__ __forceinline__ void pool_m(int l, int witem) { const int g = witem & 3; if (g == 0) pool_w<0>(l, witem); else if (g == 1) pool_w<1>(l, witem); else if (g == 2) pool_w<2>(l, witem); else pool_w<3>(l, witem); }
constexpr int ATT_PITCH = 144;
struct AttPre { u32x4 k8[6], v8[6]; };
__device__ __forceinline__ void att_issue(int item, AttPre& P) {
    FRAME_SETUP; WS_PTRS;
    const int tid = F.tid;
    const int pat = item >> 8, idx = item & 255, dil = 1 << (2 * pat), L = SEQ / dil, nqb = L >> 8;
    const int jr = idx & 31, h = (idx >> 5) & 3, b = idx >> 7, r = jr / nqb, Q0 = (jr % nqb) * 256;
#pragma unroll
    for (int u = 0; u < 6; ++u) { const int i = tid + u * NTHREADS, kk = i >> 3, cg = (i & 7) * 8, kidx = min(max(Q0 - 64 + kk, 0), L - 1);
        const bf16* row = H + (size_t)(b * SEQ + r + dil * kidx) * NH; P.k8[u] = *(const u32x4*)(row + HAK + h * 64 + cg); P.v8[u] = *(const u32x4*)(row + HAV + h * 64 + cg); }
}
__device__ __forceinline__ void att2_item(int item, AttPre& P, int next) {
    FRAME_SETUP;
    WS_PTRS; const float* rel_bias = inp(I_RELB);
    const int tid = F.tid, lane = F.lane, w = F.wave;
    const int pat = item >> 8, idx = item & 255, dil = 1 << (2 * pat), L = SEQ / dil, nqb = L >> 8;
    const int jr = idx & 31, h = (idx >> 5) & 3, b = idx >> 7, r = jr / nqb, Q0 = (jr % nqb) * 256;
    LAS unsigned char* Kt = F.lds; LAS unsigned char* Vt = F.lds + 384 * ATT_PITCH; LAS float* bt = (LAS float*)(F.lds + 2 * 384 * ATT_PITCH);
    {
#pragma unroll
        for (int u = 0; u < 6; ++u) { const int i = tid + u * NTHREADS, kk = i >> 3, cg = (i & 7) * 8;
            *(LAS u32x4*)(Kt + kk * ATT_PITCH + cg * 2) = P.k8[u]; *(LAS u32x4*)(Vt + kk * ATT_PITCH + cg * 2) = P.v8[u]; } }
    if (next >= 0) att_issue(next, P);
    if (tid < 192) { const int u = tid - 32, j = u - 64, rel = dil * j, na = rel < 0 ? -rel : rel;
        int bucket = na < 8 ? na : 8 + (na >= 15) + (na >= 27) + (na >= 50) + (na >= 91) + (na >= 166) + (na >= 305) + (na >= 559);
        if (rel > 0) bucket += 16;
        bt[tid] = (u >= 0 && u <= 128) ? rel_bias[min(bucket, 31) * 4 + h] * 1.4426950408889634f : -1e30f; }
    const int ql = lane & 31, hh = lane >> 5;
    const int qi = Q0 + 32 * w + ql; const size_t tok = (size_t)b * SEQ + r + dil * qi;
    bf16x8 qf[4];
#pragma unroll
    for (int ks = 0; ks < 4; ++ks) qf[ks] = *(const bf16x8*)(H + tok * NH + HAQ + h * 64 + 16 * ks + 8 * hh);
    __syncthreads();
    f32x16 S[5];
#pragma unroll
    for (int tk = 0; tk < 5; ++tk) {
#pragma unroll
        for (int i = 0; i < 16; ++i) S[tk][i] = F.zf;
        { bf16x8 kf4[4];
#pragma unroll
          for (int ks = 0; ks < 4; ++ks) kf4[ks] = *(const LAS bf16x8*)(Kt + (32 * w + 32 * tk + ql) * ATT_PITCH + (16 * ks + 8 * hh) * 2);
          PRIO_HI();
#pragma unroll
          for (int ks = 0; ks < 4; ++ks) S[tk] = MFMA32(kf4[ks], qf[ks], S[tk]);
          PRIO_LO(); } }
    const LAS float* btl = bt + 32 + 4 * hh - ql;
    float mx = -3.0e38f;
#pragma unroll
    for (int tk = 0; tk < 5; ++tk) {
#pragma unroll
        for (int i = 0; i < 16; ++i) { const float sc = S[tk][i] * (0.125f * 1.4426950408889634f) + btl[32 * tk + (i & 3) + 8 * (i >> 2)]; S[tk][i] = sc; mx = fmaxf(mx, sc); }
        __builtin_amdgcn_sched_barrier(0); }
    const int e0 = Q0 - 64 + 32 * w;
    if (e0 < 0 || e0 + 160 > L) {
        mx = -3.0e38f;
#pragma unroll
        for (int tk = 0; tk < 5; ++tk)
#pragma unroll
            for (int i = 0; i < 16; ++i) { const int kidx = e0 + 32 * tk + crow(i, hh); const float sc = (kidx >= 0 && kidx < L) ? S[tk][i] : -1e30f; S[tk][i] = sc; mx = fmaxf(mx, sc); }
    }
    mx = fmaxf(mx, shx(mx, 32, lane));
    float lsum = 0.f;
#pragma unroll
    for (int tk = 0; tk < 5; ++tk)
#pragma unroll
        for (int i = 0; i < 16; ++i) { const float p = __builtin_amdgcn_exp2f(S[tk][i] - mx); S[tk][i] = p; lsum += p; }
    lsum += shx(lsum, 32, lane);
    f32x16 O[2];
#pragma unroll
    for (int dt = 0; dt < 2; ++dt)
#pragma unroll
        for (int i = 0; i < 16; ++i) O[dt][i] = F.zf;
#pragma unroll
    for (int tk = 0; tk < 5; ++tk)
#pragma unroll
        for (int s2 = 0; s2 < 2; ++s2) { const bf16x8 pf = pack8(S[tk][8 * s2], S[tk][8 * s2 + 1], S[tk][8 * s2 + 2], S[tk][8 * s2 + 3], S[tk][8 * s2 + 4], S[tk][8 * s2 + 5], S[tk][8 * s2 + 6], S[tk][8 * s2 + 7]);
            const int k0 = 32 * w + 32 * tk + 16 * s2 + 4 * hh;
            bf16x8 vf2[2];
#pragma unroll
            for (int dt = 0; dt < 2; ++dt) vf2[dt] = tr_frag(Vt, ATT_PITCH, k0, k0 + 8, 32 * dt, lane);
            PRIO_HI();
#pragma unroll
            for (int dt = 0; dt < 2; ++dt) O[dt] = MFMA32(vf2[dt], pf, O[dt]);
            PRIO_LO(); }
    const float inv = 1.0f / lsum;
    bf16* op = ATTO + ((size_t)pat * T + tok) * 256 + h * 64;
#pragma unroll
    for (int dt = 0; dt < 2; ++dt)
#pragma unroll
        for (int g2 = 0; g2 < 4; g2 += 2) { u32x2 w2[2];
#pragma unroll
            for (int e2 = 0; e2 < 2; ++e2) { const int g = g2 + e2; w2[e2].x = pk2(O[dt][4 * g] * inv, O[dt][4 * g + 1] * inv); w2[e2].y = pk2(O[dt][4 * g + 2] * inv, O[dt][4 * g + 3] * inv); }
            st16_pair(op + 32 * dt + 8 * g2, w2[0], w2[1], hh); }
    if (hh == 0) ATTL[((size_t)pat * T + tok) * 4 + h] = (mx + __builtin_amdgcn_logf(lsum)) * 0.6931471805599453f;
    __syncthreads();
}
__device__ __forceinline__ void att_merge(int item) {
    FRAME_SETUP;
    WS_PTRS;
    const int tid = F.tid; const size_t tok = (size_t)item * 64 + (tid >> 3); const int sub = tid & 7, h = sub >> 1, c0 = h * 64 + (sub & 1) * 32;
    const float l0 = ATTL[tok * 4 + h], l1 = ATTL[((size_t)T + tok) * 4 + h], l2 = ATTL[((size_t)2 * T + tok) * 4 + h];
    const float M = fmaxf(l0, fmaxf(l1, l2)); float w0 = __expf(l0 - M), w1 = __expf(l1 - M), w2 = __expf(l2 - M); const float inv = 1.0f / (w0 + w1 + w2); w0 *= inv; w1 *= inv; w2 *= inv;
    const bf16* o0 = ATTO + tok * 256 + c0; const bf16* o1 = ATTO + ((size_t)T + tok) * 256 + c0; const bf16* o2 = ATTO + ((size_t)2 * T + tok) * 256 + c0;
    bf16* yp = YS + tok * D + 256 + c0;
#pragma unroll
    for (int q = 0; q < 4; ++q) { float a8[8], b8[8], c8[8]; unpack8(*(const u32x4*)(o0 + q * 8), a8); unpack8(*(const u32x4*)(o1 + q * 8), b8); unpack8(*(const u32x4*)(o2 + q * 8), c8);
        u32x4 w; w.x = pk2(a8[0] * w0 + b8[0] * w1 + c8[0] * w2, a8[1] * w0 + b8[1] * w1 + c8[1] * w2); w.y = pk2(a8[2] * w0 + b8[2] * w1 + c8[2] * w2, a8[3] * w0 + b8[3] * w1 + c8[3] * w2);
        w.z = pk2(a8[4] * w0 + b8[4] * w1 + c8[4] * w2, a8[5] * w0 + b8[5] * w1 + c8[5] * w2); w.w = pk2(a8[6] * w0 + b8[6] * w1 + c8[6] * w2, a8[7] * w0 + b8[7] * w1 + c8[7] * w2);
        *(u32x4*)(yp + q * 8) = w; }
}

template <int CTRL> __device__ __forceinline__ float dpp_max(float v) { return fmaxf(v, dpp_mov<CTRL>(v)); }
__device__ __forceinline__ void ln1_router(int l) {
    FRAME_SETUP;
    WS_PTRS; const float* ln1_g = inp(I_LN1G); const float* ln1_b = inp(I_LN1B); const bf16* WRT = (const bf16*)(ws + WS_WRT) + (size_t)l * NE * D; const float* STAT = (const float*)(ws + WS_STAT);
    LAS float* gl = (LAS float*)F.lds; LAS float* bl = gl + D;
    { const int i = F.tid * 2; *(LAS f32x2*)(gl + i) = *(const f32x2*)(ln1_g + l * D + i); *(LAS f32x2*)(bl + i) = *(const f32x2*)(ln1_b + l * D + i); }
    __syncthreads();
    const int lane = F.lane, r = lane & 15, kg = lane >> 4;
    LAS f32x4* red = (LAS f32x4*)(bl + D);
    int xlx_, xls_; { volatile LAS unsigned* xst_ = (volatile LAS unsigned*)(lds_base() + MISC_OFF) + 8; xlx_ = (int)xst_[4]; xls_ = xst_[2] ? (int)xst_[5] : -1; }
    const int half = F.wave >> 2;
    for (int it0 = F.bid * 4; it0 < T / 16; it0 += F.G * 4) {
        const int q_ = 4 * xls_ + (F.wave & 3); const int item = xls_ >= 0 ? (8 * (q_ >> 4) + xlx_) * 16 + (q_ & 15) : it0 + (F.wave & 3);
        const size_t tok = (size_t)item * 16 + r;
        float s1 = 0.f, s2 = 0.f;
        { const f32x4 a = *(const f32x4*)(STAT + (tok * 16 + 4 * kg) * 2), c = *(const f32x4*)(STAT + (tok * 16 + 4 * kg) * 2 + 4); s1 = (a[0] + a[2]) + (c[0] + c[2]); s2 = (a[1] + a[3]) + (c[1] + c[3]); }
        s1 += shx(s1, 16, lane); s1 += shx(s1, 32, lane); s2 += shx(s2, 16, lane); s2 += shx(s2, 32, lane);
        const float mean = s1 * (1.0f / D), var = fmaxf(s2 * (1.0f / D) - mean * mean, 0.f), rstd = 1.0f / sqrtf(var + LN_EPS);
        const bf16* rp = (const bf16*)MGF + tok * D + 8 * kg; bf16* xp = XB + tok * D + 8 * kg; const bf16* wp = WRT + (size_t)r * D + 8 * kg;
        f32x4 acc = (f32x4){F.zf, F.zf, F.zf, F.zf};
#pragma unroll 8
        for (int k2 = 0; k2 < 16; ++k2) { const int ks = half * 16 + k2;
            float x8[8]; unpack8(*(const u32x4*)(rp + 32 * ks), x8); const f32x4 x0 = (f32x4){x8[0], x8[1], x8[2], x8[3]}, x1 = (f32x4){x8[4], x8[5], x8[6], x8[7]};
            const f32x4 g0 = *(const LAS f32x4*)(gl + 32 * ks + 8 * kg), g1 = *(const LAS f32x4*)(gl + 32 * ks + 8 * kg + 4), b0 = *(const LAS f32x4*)(bl + 32 * ks + 8 * kg), b1 = *(const LAS f32x4*)(bl + 32 * ks + 8 * kg + 4);
            const f32x4 y0 = (x0 - mean) * rstd * g0 + b0, y1 = (x1 - mean) * rstd * g1 + b1;
            u32x4 yw; yw.x = pk2(y0[0], y0[1]); yw.y = pk2(y0[2], y0[3]); yw.z = pk2(y1[0], y1[1]); yw.w = pk2(y1[2], y1[3]);
            *(u32x4*)(xp + 32 * ks) = yw;
            const bf16x8 wf = *(const bf16x8*)(wp + 32 * ks);
            acc = __builtin_amdgcn_mfma_f32_16x16x32_bf16(__builtin_bit_cast(bf16x8, yw), wf, acc, 0, 0, 0);
        }
        if (half) red[(F.wave & 3) * 64 + lane] = acc;
        __syncthreads();
        if (!half) {
        acc += red[(F.wave & 3) * 64 + lane];
        f32x4 aff;
#pragma unroll
        for (int i = 0; i < 4; ++i) { float m = acc[i]; m = dpp_max<0xB1>(m); m = dpp_max<0x4E>(m); m = dpp_max<0x141>(m); m = dpp_max<0x140>(m);
            const float e = __expf(acc[i] - m); float se = e; se += dpp_mov<0xB1>(se); se += dpp_mov<0x4E>(se); se += dpp_mov<0x141>(se); se += dpp_mov<0x140>(se);
            aff[i] = e * rcpf_(se); }
        { const size_t t0 = (size_t)item * 16 + 4 * kg; const int b = (int)(t0 >> 13), sp = (int)(t0 & (SEQ - 1)); *(f32x4*)(AFF + ((size_t)(b * NE + r)) * SEQ + sp) = aff; }
        }
        __syncthreads();
    }
    __syncthreads();
}
__device__ __forceinline__ unsigned block_excl_scan(LAS unsigned* sc, unsigned val, int tid) {
    sc[tid] = val; __syncthreads();
#pragma unroll 1
    for (int off = 1; off < NTHREADS; off <<= 1) { const unsigned v = tid >= off ? sc[tid - off] : 0u; __syncthreads(); sc[tid] += v; __syncthreads(); }
    const unsigned r = sc[tid] - val; __syncthreads(); return r;
}
__device__ __forceinline__ void topk_item(int be) {
    FRAME_SETUP;
    WS_PTRS;
    const int tid = F.tid, b = be >> 4;
    const float* aff = AFF + (size_t)be * SEQ;
    LAS unsigned* hist = (LAS unsigned*)F.lds; LAS unsigned* sfx = hist + 256; LAS unsigned* sc = sfx + 256; LAS unsigned* misc = sc + 512; LAS int* idxl = (LAS int*)(misc + 4);
    unsigned key[16];
    { const u32x4* ap = (const u32x4*)(aff + tid * 16);
#pragma unroll
        for (int q = 0; q < 4; ++q) { const u32x4 w = ap[q]; key[q * 4] = w.x; key[q * 4 + 1] = w.y; key[q * 4 + 2] = w.z; key[q * 4 + 3] = w.w; } }
    unsigned prefix = 0u, kth = CAP, hmask = 0u;
#pragma unroll 1
    for (int shift = 24; shift >= 0; shift -= 8) {
        if (tid < 256) hist[tid] = 0u;
        __syncthreads();
#pragma unroll
        for (int i = 0; i < 16; ++i) { if (((key[i] ^ prefix) & hmask) == 0u) __hip_atomic_fetch_add(&hist[(key[i] >> shift) & 255u], 1u, __ATOMIC_RELAXED, __HIP_MEMORY_SCOPE_WORKGROUP); }
        __syncthreads();
        if (tid < 256) sfx[tid] = hist[tid];
        __syncthreads();
#pragma unroll 1
        for (int off = 1; off < 256; off <<= 1) { unsigned v = 0u; if (tid < 256 && tid + off < 256) v = sfx[tid + off]; __syncthreads(); if (tid < 256) sfx[tid] += v; __syncthreads(); }
        if (tid < 256) { const unsigned incl = sfx[tid], excl = incl - hist[tid]; if (excl < kth && kth <= incl) { misc[0] = (unsigned)tid; misc[1] = kth - excl; } }
        __syncthreads();
        prefix |= misc[0] << shift; kth = misc[1]; hmask |= 255u << shift;
        __syncthreads();
    }
    unsigned ceq = 0u;
#pragma unroll
    for (int i = 0; i < 16; ++i) ceq += (key[i] == prefix) ? 1u : 0u;
    unsigned eqrank = block_excl_scan(sc, ceq, tid);
    unsigned selmask = 0u, csel = 0u;
#pragma unroll
    for (int i = 0; i < 16; ++i) { bool sel = key[i] > prefix; if (key[i] == prefix) { sel = eqrank < kth; ++eqrank; } if (sel) { selmask |= 1u << i; ++csel; } }
    unsigned slot = block_excl_scan(sc, csel, tid);
#pragma unroll
    for (int i = 0; i < 16; ++i) { const int s = tid * 16 + i;
        if (selmask & (1u << i)) { if (slot < (unsigned)CAP) { IDX[be * CAP + slot] = s; GATE[be * CAP + slot] = __uint_as_float(key[i]); idxl[slot] = s; } SLOT[(size_t)be * SEQ + s] = (int)slot; ++slot; }
        else SLOT[(size_t)be * SEQ + s] = -1; }
    __syncthreads();
    __syncthreads();
}
__device__ __forceinline__ void combine_ln2(int l) {
    FRAME_SETUP;
    WS_PTRS; const float* ln2_g = inp(I_LN2G); const float* ln2_b = inp(I_LN2B); float* out = outp();
    const int lane = F.lane;
    const float* g2 = ln2_g + l * D; const float* b2 = ln2_b + l * D;
    f32x4 gg4[4], bb4[4];
#pragma unroll
    for (int j = 0; j < 4; ++j) { const int d = 8 * lane + 512 * (j >> 1) + 4 * (j & 1); gg4[j] = *(const f32x4*)(g2 + d); bb4[j] = *(const f32x4*)(b2 + d); }
    int xlx_, xls_; { volatile LAS unsigned* xst_ = (volatile LAS unsigned*)(lds_base() + MISC_OFF) + 8; xlx_ = (int)xst_[4]; xls_ = xst_[2] ? (int)xst_[5] : -1; }
    for (int tok0 = (F.bid * NWAVES + F.wave) * 2; tok0 < T; tok0 += F.G * NWAVES * 2) {
        int tok = tok0; if (xls_ >= 0) { const int p = xls_ * NWAVES + F.wave + (tok0 / (F.G * NWAVES * 2)) * 256; tok = (8 * (p >> 7) + xlx_) * 256 + ((2 * p) & 255); }
        const int b = tok >> 13, sp = tok & (SEQ - 1);
        int slotv[2]; unsigned mask[2]; f32x4 v[2][4]; u32x4 xr[2][2];
#pragma unroll
        for (int u = 0; u < 2; ++u) slotv[u] = lane < NE ? SLOT[((size_t)(b * NE + lane)) * SEQ + sp + u] : -1;
#pragma unroll
        for (int u = 0; u < 2; ++u)
#pragma unroll
            for (int jj = 0; jj < 2; ++jj) xr[u][jj] = *(const u32x4*)(XB + (size_t)(tok + u) * D + 8 * lane + 512 * jj);
        __builtin_amdgcn_sched_barrier(0);
#pragma unroll
        for (int u = 0; u < 2; ++u) mask[u] = (unsigned)__ballot(slotv[u] >= 0);
#pragma unroll
        for (int u = 0; u < 2; ++u)
#pragma unroll
            for (int jj = 0; jj < 2; ++jj) { float x8[8]; unpack8(xr[u][jj], x8); v[u][2 * jj] = (f32x4){x8[0], x8[1], x8[2], x8[3]} * ALPHA; v[u][2 * jj + 1] = (f32x4){x8[4], x8[5], x8[6], x8[7]} * ALPHA; }
        while (mask[0] | mask[1]) {
            u32x4 r[2][3][2]; bool on[2][3];
#pragma unroll
            for (int u = 0; u < 2; ++u)
#pragma unroll
                for (int k = 0; k < 3; ++k) { on[u][k] = mask[u] != 0u; const int e = on[u][k] ? __builtin_ctz(mask[u]) : 0; mask[u] &= mask[u] - 1u;
                    const int sl = __builtin_amdgcn_readlane(slotv[u], e);
                    if (on[u][k]) { const bf16* yr = YE + ((size_t)(b * NE + e) * CAP + sl) * D;
#pragma unroll
                        for (int jj = 0; jj < 2; ++jj) r[u][k][jj] = *(const u32x4*)(yr + 8 * lane + 512 * jj); } }
#pragma unroll
            for (int u = 0; u < 2; ++u)
#pragma unroll
                for (int k = 0; k < 3; ++k) if (on[u][k]) {
#pragma unroll
                    for (int jj = 0; jj < 2; ++jj) { float y8[8]; unpack8(r[u][k][jj], y8); v[u][2 * jj] += (f32x4){y8[0], y8[1], y8[2], y8[3]}; v[u][2 * jj + 1] += (f32x4){y8[4], y8[5], y8[6], y8[7]}; } }
        }
        float s[2], s2[2];
#pragma unroll
        for (int u = 0; u < 2; ++u) { s[u] = 0.f;
#pragma unroll
            for (int j = 0; j < 4; ++j) s[u] += (v[u][j].x + v[u][j].y) + (v[u][j].z + v[u][j].w); }
        s[0] = wave_sum(s[0], lane); s[1] = wave_sum(s[1], lane);
#pragma unroll
        for (int u = 0; u < 2; ++u) { const float mean = s[u] * (1.f / D); s2[u] = 0.f;
#pragma unroll
            for (int j = 0; j < 4; ++j) { v[u][j] = v[u][j] - mean; s2[u] += (v[u][j].x * v[u][j].x + v[u][j].y * v[u][j].y) + (v[u][j].z * v[u][j].z + v[u][j].w * v[u][j].w); } }
        s2[0] = wave_sum(s2[0], lane); s2[1] = wave_sum(s2[1], lane);
#pragma unroll
        for (int u = 0; u < 2; ++u) { const float rstd = 1.f / sqrtf(s2[u] * (1.f / D) + LN_EPS);
#pragma unroll
            for (int jj = 0; jj < 2; ++jj) { const int d = 8 * lane + 512 * jj;
                const f32x4 x0 = v[u][2 * jj] * rstd * gg4[2 * jj] + bb4[2 * jj], x1 = v[u][2 * jj + 1] * rstd * gg4[2 * jj + 1] + bb4[2 * jj + 1];
                u32x4 w; w.x = pk2(x0.x, x0.y); w.y = pk2(x0.z, x0.w); w.z = pk2(x1.x, x1.y); w.w = pk2(x1.z, x1.w); if (l < DEPTH - 1) *((u32x4*)(XB + (size_t)(tok + u) * D + d)) = w;
                if (l == DEPTH - 1) { *((f32x4*)(out + (size_t)(tok + u) * D + d)) = x0; *((f32x4*)(out + (size_t)(tok + u) * D + d + 4)) = x1; } } }
    }
}

constexpr int PH_PER_LAYER = 11, N_PHASES = 1 + DEPTH * PH_PER_LAYER;
struct Args { const float* in[22]; float* out; unsigned char* ws; int ph_lo, ph_hi; };
__device__ __forceinline__ void phase_mix1(int l) { FRAME_SETUP;
    for (int it = F.bid; it < 256 + 128; it += F.G) { if (it < 256) mlstm_c1m(l, it); else gmlp_m(l, it - 256); }
    { const int nw = F.G * NWAVES; int first = (F.bid >= 128 ? F.bid - 128 : F.bid + F.G - 128) * NWAVES + F.wave;
      for (int wi = first; wi < 2048; wi += nw) pool_m(l, wi); }
    __syncthreads(); }
__device__ __forceinline__ void phase_mix2(int l) { FRAME_SETUP;
    for (int wi = F.bid * 2 + F.wave; wi < 272 && F.wave < 2; wi += F.G * 2) mlstm_scan(wi);
    const bool g256 = F.G == 256, sc = F.bid < 130;
    const int n = g256 ? (sc ? (F.bid < 4 ? 3 : 2) : 4) : (768 - F.bid + F.G - 1) / F.G, first = g256 ? (sc ? 2 * F.bid : 260 + 4 * (F.bid - 130)) : F.bid, stride = g256 ? 1 : F.G;
    for (int k = 0; k < n; ++k) { AttPre P; const int it = (g256 && sc && k == 2) ? 764 + F.bid : first + k * stride; att_issue(it, P); att2_item(it, P, -1); } }
#define XL_SETUP volatile LAS unsigned* xst_ = (volatile LAS unsigned*)(lds_base() + MISC_OFF) + 8; const int xuni_ = (int)xst_[2], xlx = (int)xst_[4], xls = xuni_ ? (int)xst_[5] : -1
__device__ __forceinline__ void phase_mixA(int l) { FRAME_SETUP;
    mlstm_full(l, F.bid);
    if (F.bid < 128) gmlp_m(l, F.bid);
    AttPre P; const int j0 = F.bid < 128 ? 2 * F.bid : 256 + 4 * (F.bid - 128);
    att_issue(j0, P);
    pool_m(l, (F.bid >= 128 ? F.bid - 128 : F.bid + 128) * NWAVES + F.wave);
    __syncthreads();
    if (F.bid < 128) { att2_item(j0, P, j0 + 1); att2_item(j0 + 1, P, -1); }
    else { att2_item(j0, P, j0 + 1); att2_item(j0 + 1, P, j0 + 2); att2_item(j0 + 2, P, j0 + 3); att2_item(j0 + 3, P, -1); } }
__device__ __forceinline__ void phase_mixB(int l) { FRAME_SETUP; XL_SETUP; att_merge(xls >= 0 ? 4 * (8 * (xls >> 2) + xlx) + (xls & 3) : F.bid); }
__device__ __forceinline__ void phase_mix3(int l) { FRAME_SETUP;
    for (int it = F.bid; it < 256 + 256; it += F.G) { if (it < 256) mlstm_c3m(l, it); else att_merge(it - 256); } }
__device__ __forceinline__ void phase_topk(int l) { FRAME_SETUP; XL_SETUP;
    if (xls >= 0) {
        constexpr int IT_XA = 2880;
        if (xls < 4) { topk_item(xlx + 8 * xls); convert_layer(l, xls * NWAVES + F.wave, 4 * NWAVES, IT_XA, IT_XEXP, xlx); }
        else convert_layer(l, (xls - 4) * NWAVES + F.wave, 28 * NWAVES, l + 1 < DEPTH ? 0 : IT_XLAST, IT_XA, xlx);
        return; }
    const bool wide = F.G > 2 * BATCH * NE;
    for (int it = F.bid; it < BATCH * NE; it += F.G) topk_item(it);
    if (!wide || F.bid >= BATCH * NE) { const int gw = ((wide ? F.bid - BATCH * NE : F.bid)) * NWAVES + F.wave, ngw = (wide ? F.G - BATCH * NE : F.G) * NWAVES;
        convert_layer(l, gw, ngw, IT_SMALL, IT_LAYER); if (l + 1 < DEPTH) convert_layer(l + 1, gw, ngw, 0, IT_SMALL); } }
__device__ __forceinline__ void phase_g1(int l) { FRAME_SETUP; WS_PTRS; XL_SETUP;
    pg8::GemmP g{D, D, D}; SchedG1 S{F.G, F.bid, (const char*)XB, (const char*)wl(ws, l, OW_IN), xlx, xls}; EpiG1 E{H, GI, BIN + (size_t)l * NINP, (u32x4*)(ws + WS_GQ)};
    pg8::gemm_phase<EpiG1, SchedG1, true>(F.lds, F.tid, g, S, E);
    if (xls >= 24) { if (l + 1 < DEPTH) convert_layer(l + 1, (xlx * 8 + xls - 24) * NWAVES + F.wave, 64 * NWAVES, 0, IT_SMALL);
                     else convert_layer(l, (xls - 24) * NWAVES + F.wave, 8 * NWAVES, 0, IT_XLAST, xlx); } }
__device__ __forceinline__ void phase_g2(int l) { FRAME_SETUP; WS_PTRS; XL_SETUP;
    pg8::GemmP g{D, D, D}; SchedG2 S{F.G, F.bid, (const char*)YS, (const char*)wl(ws, l, OW_B), xlx, xls}; EpiG2 E{(const u32x4*)(ws + WS_GQ), MGB};
    pg8::gemm_phase<EpiG2, SchedG2, true>(F.lds, F.tid, g, S, E); }
__device__ __forceinline__ void phase_g3(int l) { FRAME_SETUP; WS_PTRS; XL_SETUP;
    pg8::GemmP g{D, D, D}; SchedG3 S{F.G, F.bid, (const char*)MGB, (const char*)wl(ws, l, OW_O), xlx, xls}; EpiG3 E{XB, (bf16*)MGF, (float*)(ws + WS_STAT)};
    pg8::gemm_phase<EpiG3, SchedG3, true>(F.lds, F.tid, g, S, E); }
__device__ __forceinline__ void phase_g4(int l) { FRAME_SETUP; WS_PTRS; XL_SETUP;
    pg8::GemmP g{D, D, D}; SchedG4 S{F.G, F.bid, (const char*)XB, (const char*)wl(ws, l, OW_13), IDX, xlx, xls}; EpiG4 E{HID};
    pg8::gemm_phase<EpiG4, SchedG4, true>(F.lds, F.tid, g, S, E); }
__device__ __forceinline__ void phase_g5(int l) { FRAME_SETUP; WS_PTRS; XL_SETUP;
    pg8::GemmP g{FF, FF, FF}; SchedG5 S{F.G, F.bid, (const char*)HID, (const char*)wl(ws, l, OW_2), xlx, xls}; EpiG5 E{GATE, YE};
    pg8::gemm_phase<EpiG5, SchedG5, true>(F.lds, F.tid, g, S, E); }

__global__ void __launch_bounds__(NTHREADS, 2) fwd_kernel(Args args) {
    { LAS unsigned char* l0 = lds_base(); for (int u = threadIdx.x; u < (LDS_BYTES - LDSCTL_OFF) / 4; u += NTHREADS) ((LAS unsigned*)(l0 + LDSCTL_OFF))[u] = 0u; }
    __syncthreads();
#if !MK_PER_PHASE
    (void)xcd_barrier_post((unsigned*)(args.ws + WS_CTL) + CW_BAR, (volatile LAS unsigned*)(lds_base() + MISC_OFF) + 8);
#endif
    const int lo = args.ph_lo, hi = args.ph_hi;
#if PROBE_MASK
    volatile LAS unsigned long long* pacc = (volatile LAS unsigned long long*)(lds_base() + MISC_OFF + 64);
#endif
    for (int ph = lo; ph < hi; ++ph) {
#if PROBE_MASK
        const unsigned long long pt0 = __builtin_amdgcn_s_memrealtime();
#endif
        if (ph == 0) { if (PHEN(15)) p0_prologue(); }
        else {
            const int l = (ph - 1) / PH_PER_LAYER, sp = (ph - 1) % PH_PER_LAYER;
            if (sp == 0) { if (PHEN(0)) phase_g1(l); }
            else if (sp == 1) { if (gridDim.x == 256) { if (PHEN(1)) phase_mixA(l); ++ph; } else if (PHEN(1)) phase_mix1(l); }
            else if (sp == 2) { if (PHEN(2)) phase_mix2(l); }
            else if (sp == 3) { if (gridDim.x == 256) { if (PHEN(3)) phase_mixB(l); } else if (PHEN(3)) phase_mix3(l); }
            else if (sp == 4) { if (PHEN(4)) phase_g2(l); }
            else if (sp == 5) { if (PHEN(5)) phase_g3(l); }
            else if (sp == 6) { if (PHEN(6)) ln1_router(l); }
            else if (sp == 7) { if (PHEN(7)) phase_topk(l); }
            else if (sp == 8) { if (PHEN(8)) phase_g4(l); }
            else if (sp == 9) { if (PHEN(9)) phase_g5(l); }
            else { if (PHEN(10)) combine_ln2(l); }
        }
#if PROBE_MASK && defined(PROBE_MODE) && PROBE_MODE == 1
        { const int sp_ = ph == 0 ? 15 : (ph - 1) % PH_PER_LAYER; asm volatile("s_waitcnt vmcnt(0)" ::: "memory"); __syncthreads(); const unsigned long long pt1 = __builtin_amdgcn_s_memrealtime();
          if (threadIdx.x == 0 && ((PROBE_MASK >> sp_) & 1)) pacc[0] = pacc[0] + (pt1 - pt0); }
#endif
        if (ph + 1 < hi) {
#if !MK_PER_PHASE
            { XcdBarrier bar; bar.bar = (unsigned*)(wsp() + WS_CTL) + CW_BAR; bar.x = xb_xcc_id(); bar.st = (volatile LAS unsigned*)(lds_base() + MISC_OFF) + 8;
              const int spb = ph == 0 ? -1 : (ph - 1) % PH_PER_LAYER;
              if (bar.st[2] && (spb == 3 || spb == 4 || spb == 5 || spb == 7 || spb == 8 || spb == 10)) xcd_local_barrier(bar.bar, bar.x, bar.st[0]);
              else xcd_barrier(bar); }
#endif
        }
#if PROBE_MASK && !(defined(PROBE_MODE) && PROBE_MODE == 1)
        { const int sp_ = ph == 0 ? 15 : (ph - 1) % PH_PER_LAYER; const unsigned long long pt1 = __builtin_amdgcn_s_memrealtime();
          if (threadIdx.x == 0 && ((PROBE_MASK >> sp_) & 1)) pacc[0] = pacc[0] + (pt1 - pt0); }
#endif
    }
#if PROBE_MASK
    if (threadIdx.x == 0 && blockIdx.x == 0) { const unsigned long long t0 = __builtin_amdgcn_s_memrealtime(), need = pacc[0]; while (__builtin_amdgcn_s_memrealtime() - t0 < need) __builtin_amdgcn_s_sleep(8); }
#endif
}

extern "C" void kernel_launch(void* const* d_in, const int* in_sizes, int n_in, void* d_out, int out_size, void* d_ws, size_t ws_size, hipStream_t stream) {
    static int grid = 0;
    if (grid == 0) {
        if (n_in != 22 || in_sizes[0] != T * D || out_size != T * D || ws_size < WS_END) {
            fprintf(stderr, "kernel_launch: unexpected shapes: n_in %d in0 %d out %d ws %zu (need %zu); nothing launched\n", n_in, n_in > 0 ? in_sizes[0] : -1, out_size, ws_size, (size_t)WS_END); grid = -1; return; }
        int dev = 0, cus = 0;
        if (hipGetDevice(&dev) != hipSuccess || hipDeviceGetAttribute(&cus, hipDeviceAttributeMultiprocessorCount, dev) != hipSuccess) { grid = -1; return; }
        if (hipFuncSetAttribute((const void*)fwd_kernel, hipFuncAttributeMaxDynamicSharedMemorySize, LDS_BYTES) != hipSuccess) { fprintf(stderr, "kernel_launch: hipFuncSetAttribute failed\n"); grid = -1; return; }
        int per_cu = 0;
        if (hipOccupancyMaxActiveBlocksPerMultiprocessor(&per_cu, (const void*)fwd_kernel, NTHREADS, LDS_BYTES) != hipSuccess || per_cu < 1)
            fprintf(stderr, "kernel_launch: note: occupancy query reports %d workgroups per CU\n", per_cu);
        (void)hipGetLastError();
        grid = cus;
    }
    if (grid < 0) return;
    (void)hipMemsetAsync((char*)d_ws + WS_CTL, 0, CTL_ZERO_BYTES, stream);
    Args a{};
    for (int i = 0; i < 22; ++i) a.in[i] = (const float*)d_in[i];
    a.out = (float*)d_out; a.ws = (unsigned char*)d_ws;
#if MK_PER_PHASE
    for (int ph = 0; ph < N_PHASES; ++ph) { a.ph_lo = ph; a.ph_hi = ph + 1; hipLaunchKernelGGL(fwd_kernel, dim3(grid), dim3(NTHREADS), LDS_BYTES, stream, a); }
#else
    a.ph_lo = 0; a.ph_hi = N_PHASES; hipLaunchKernelGGL(fwd_kernel, dim3(grid), dim3(NTHREADS), LDS_BYTES, stream, a);
#endif
}
```
